# Optimizing an MI355X kernel written in HIP

```python
import jax, jax.numpy as jnp
from jax import lax
import numpy as np

D_MODEL = 1024
BATCH = 4
SEQ = 8192
DEPTH = 1

RNN_WIDTH = D_MODEL
RNN_BLOCKS = 8
RNN_BLOCK_W = RNN_WIDTH // RNN_BLOCKS
CONV_WIDTH = 4
LRU_C = 8.0
MLA_HEADS = 8
QK_NOPE = 128
QK_ROPE = 64
V_HEAD = D_MODEL // MLA_HEADS
Q_LORA = D_MODEL // 4
KV_LORA = D_MODEL // 4
ROPE_THETA = 10000.0
Q_BLOCK = 128
D_FF = 4 * D_MODEL
EPS = 1e-6

IN_SIZES = (RNN_WIDTH, RNN_WIDTH, Q_LORA, KV_LORA, QK_ROPE, D_MODEL, D_MODEL)
IN_TOTAL = sum(IN_SIZES)

kernel_name = "hybrid_rglru_mla_sqrelu"


def rmsnorm(x, g):
    xf = x.astype(jnp.float32)
    y = xf * lax.rsqrt(jnp.mean(xf * xf, axis=-1, keepdims=True) + EPS) * g.astype(jnp.float32)
    return y.astype(x.dtype)


def split_cols(z, sizes):
    offs = np.cumsum(sizes)[:-1].tolist()
    return jnp.split(z, offs, axis=-1)


def causal_depthwise_conv(x, w, b):
    c = x.shape[-1]
    y = lax.conv_general_dilated(
        x, w[:, None, :].astype(x.dtype), window_strides=(1,), padding=[(CONV_WIDTH - 1, 0)],
        dimension_numbers=("NWC", "WIO", "NWC"), feature_group_count=c)
    return y + b


def block_diag_linear(x, w, b):
    bsz, s, c = x.shape
    xb = x.reshape(bsz, s, RNN_BLOCKS, RNN_BLOCK_W)
    y = jnp.einsum("bsnc,ncd->bsnd", xb, w) + b
    return y.reshape(bsz, s, c)


def rg_lru(xa, wa, ba, wx, bx, lam):
    xf = xa.astype(jnp.float32)
    r = jax.nn.sigmoid(block_diag_linear(xa, wa, ba).astype(jnp.float32))
    i = jax.nn.sigmoid(block_diag_linear(xa, wx, bx).astype(jnp.float32))
    log_a = -LRU_C * r * jax.nn.softplus(-lam.astype(jnp.float32))
    a = jnp.exp(log_a)
    b = jnp.sqrt(-jnp.expm1(2.0 * log_a)) * (i * xf)

    def combine(e1, e2):
        a1, b1 = e1
        a2, b2 = e2
        return a1 * a2, a2 * b1 + b2

    _, h = lax.associative_scan(combine, (a, b), axis=1)
    return h


def rope_tables(seq):
    pos = jnp.arange(seq, dtype=jnp.float32)
    inv_freq = 1.0 / (ROPE_THETA ** (jnp.arange(0, QK_ROPE, 2, dtype=jnp.float32) / QK_ROPE))
    ang = pos[:, None] * inv_freq[None, :]
    cos = jnp.cos(ang)
    sin = jnp.sin(ang)
    return jnp.concatenate([cos, cos], -1), jnp.concatenate([sin, sin], -1)


def apply_rope(x, cos, sin):
    half = x.shape[-1] // 2
    rot = jnp.concatenate([-x[..., half:], x[..., :half]], axis=-1)
    return (x.astype(jnp.float32) * cos + rot.astype(jnp.float32) * sin).astype(x.dtype)


def mla(c_q, c_kv, k_rope, q_norm, w_uq, kv_norm, w_ukv):
    bsz, s, _ = c_q.shape
    q = (rmsnorm(c_q, q_norm) @ w_uq).reshape(bsz, s, MLA_HEADS, QK_NOPE + QK_ROPE)
    kv = (rmsnorm(c_kv, kv_norm) @ w_ukv).reshape(bsz, s, MLA_HEADS, QK_NOPE + V_HEAD)
    q_nope, q_rope = q[..., :QK_NOPE], q[..., QK_NOPE:]
    k_nope, v = kv[..., :QK_NOPE], kv[..., QK_NOPE:]
    cos, sin = rope_tables(s)
    q_rope = apply_rope(q_rope, cos[None, :, None, :], sin[None, :, None, :])
    k_rope = apply_rope(k_rope, cos[None], sin[None])
    scale = (QK_NOPE + QK_ROPE) ** -0.5
    nb = s // Q_BLOCK
    qn_b = q_nope.reshape(bsz, nb, Q_BLOCK, MLA_HEADS, QK_NOPE).transpose(1, 0, 2, 3, 4)
    qr_b = q_rope.reshape(bsz, nb, Q_BLOCK, MLA_HEADS, QK_ROPE).transpose(1, 0, 2, 3, 4)
    kpos = jnp.arange(s)
    qpos_b = kpos.reshape(nb, Q_BLOCK)
    neg = jnp.finfo(jnp.float32).min

    def one_block(args):
        qn, qr, qpos = args
        sc = jnp.einsum("bqhd,bkhd->bhqk", qn, k_nope, preferred_element_type=jnp.float32)
        sc = sc + jnp.einsum("bqhr,bkr->bhqk", qr, k_rope, preferred_element_type=jnp.float32)
        mask = qpos[:, None] >= kpos[None, :]
        sc = jnp.where(mask[None, None], sc * scale, neg)
        p = jax.nn.softmax(sc, axis=-1)
        return jnp.einsum("bhqk,bkhd->bqhd", p.astype(v.dtype), v)

    o = lax.map(one_block, (qn_b, qr_b, qpos_b))
    return o.transpose(1, 0, 2, 3, 4).reshape(bsz, s, MLA_HEADS * V_HEAD)


def setup_inputs(seed: int = 0) -> dict:
    key = jax.random.key(seed)
    ks = jax.random.split(key, 20)
    f32 = jnp.float32
    nrm = lambda k, shape, fan: jax.random.normal(k, shape, f32) * fan ** -0.5
    gain = lambda k, n: 1.0 + 0.02 * jax.random.normal(k, (n,), f32)
    u = jax.random.uniform(ks[9], (RNN_WIDTH,), f32, 0.9, 0.999)
    a0 = u ** (1.0 / LRU_C)
    lru_lambda = jnp.log(a0) - jnp.log1p(-a0)
    return {
        "x": jax.random.normal(ks[0], (BATCH, SEQ, D_MODEL), f32),
        "norm_mix": gain(ks[1], D_MODEL),
        "w_in": nrm(ks[2], (D_MODEL, IN_TOTAL), D_MODEL),
        "conv_w": nrm(ks[3], (CONV_WIDTH, RNN_WIDTH), CONV_WIDTH),
        "conv_b": 0.01 * jax.random.normal(ks[4], (RNN_WIDTH,), f32),
        "lru_wa": nrm(ks[5], (RNN_BLOCKS, RNN_BLOCK_W, RNN_BLOCK_W), RNN_BLOCK_W),
        "lru_ba": 0.01 * jax.random.normal(ks[6], (RNN_BLOCKS, RNN_BLOCK_W), f32),
        "lru_wx": nrm(ks[7], (RNN_BLOCKS, RNN_BLOCK_W, RNN_BLOCK_W), RNN_BLOCK_W),
        "lru_bx": 0.01 * jax.random.normal(ks[8], (RNN_BLOCKS, RNN_BLOCK_W), f32),
        "lru_lambda": lru_lambda,
        "q_norm": gain(ks[10], Q_LORA),
        "w_uq": nrm(ks[11], (Q_LORA, MLA_HEADS * (QK_NOPE + QK_ROPE)), Q_LORA),
        "kv_norm": gain(ks[12], KV_LORA),
        "w_ukv": nrm(ks[13], (KV_LORA, MLA_HEADS * (QK_NOPE + V_HEAD)), KV_LORA),
        "w_out": nrm(ks[14], (D_MODEL, D_MODEL), D_MODEL),
        "norm_mlp": gain(ks[15], D_MODEL),
        "w_up": nrm(ks[16], (D_MODEL, D_FF), D_MODEL),
        "w_down": nrm(ks[17], (D_FF, D_MODEL), D_FF),
        "norm_final": gain(ks[18], D_MODEL),
    }


def reference(x, norm_mix, w_in, conv_w, conv_b, lru_wa, lru_ba, lru_wx, lru_bx, lru_lambda,
              q_norm, w_uq, kv_norm, w_ukv, w_out, norm_mlp, w_up, w_down, norm_final):
    h = x
    for _ in range(DEPTH):
        z = rmsnorm(h, norm_mix) @ w_in
        rnn_x, rnn_gate, c_q, c_kv, k_rope, gate_a, gate_b = split_cols(z, IN_SIZES)
        xa = causal_depthwise_conv(rnn_x, conv_w, conv_b)
        hr = rg_lru(xa, lru_wa, lru_ba, lru_wx, lru_bx, lru_lambda)
        y_a = hr * jax.nn.gelu(rnn_gate.astype(jnp.float32))
        y_b = mla(c_q, c_kv, k_rope, q_norm, w_uq, kv_norm, w_ukv).astype(jnp.float32)
        merged = (jax.nn.sigmoid(gate_a.astype(jnp.float32)) * y_a
                  + jax.nn.sigmoid(gate_b.astype(jnp.float32)) * y_b).astype(h.dtype)
        h = h + merged @ w_out
        u = rmsnorm(h, norm_mlp) @ w_up
        h = h + jnp.square(jax.nn.relu(u)) @ w_down
    return rmsnorm(h, norm_final)
```

```cpp
#define N_LAUNCHES 1
#include <hip/hip_runtime.h>
#include <hip/hip_cooperative_groups.h>
#include <cstdio>
#include <cstdint>
namespace cg = cooperative_groups;
namespace pg8 {
#define PG8_LAS __attribute__((address_space(3)))
typedef unsigned short bf16_t;
typedef short bf16x8 __attribute__((ext_vector_type(8)));
typedef float f32x4 __attribute__((ext_vector_type(4)));
typedef unsigned u32x4 __attribute__((ext_vector_type(4)));
constexpr int BM = 256, BK = 64, HALF = 128, HTB = HALF * BK * 2  , STAGE_BYTES = 8 * HTB, NXCD = 8, WGM = 8;

__host__ __device__ __forceinline__ int lds_byte(int r, int c) { const int st = (r >> 4) * 2 + (c >> 5), rr = r & 15, cc = c & 31, ob = rr * 64 + cc * 2; return st * 1024 + (ob ^ (((ob >> 9) & 1) << 5)); }
__host__ __device__ __forceinline__ void stage_rc(int b, int& R, int& C) { const int st = b / 1024, sb = b % 1024, swz = sb ^ (((sb >> 9) & 1) << 5); R = (st >> 1) * 16 + swz / 64; C = (st & 1) * 32 + (swz % 64) / 2; }
__host__ __device__ __forceinline__ int perm32(int rho) { const int n = rho >> 4, i = rho & 15; return 8 * (i >> 2) + 4 * n + (i & 3); }

struct Unit { int pm, pn; };
struct Gemm { const bf16_t* A; const bf16_t* Bt; int M, N, K, lda, ldb; long a_pn_bytes; int a_pn_shift; };

struct StaticOrder {
    int nM, nN, nwg, G, c;
    __host__ __device__ void init(int M, int N, int G_, int c_) { nM = M / BM; nN = N / BM; nwg = nM * nN; G = G_; c = c_; }
    __host__ __device__ bool next(int i, Unit& u) const {
        const long L = (long)i * G + c; if (L >= nwg) return false;
        int wgid = (int)L; { const int q = nwg / NXCD, r = nwg % NXCD, xcd = wgid % NXCD, off = wgid / NXCD; wgid = (xcd < r ? xcd * (q + 1) : r * (q + 1) + (xcd - r) * q) + off; }
        const int nig = WGM * nN, gid = wgid / nig, fm = gid * WGM, gsz = (nM - fm) < WGM ? (nM - fm) : WGM;
        u.pm = fm + ((wgid % nig) % gsz); u.pn = (wgid % nig) / gsz; return true;
    }
    __device__ __forceinline__ void a_ready(const Unit&) const {}
    __device__ __forceinline__ void done(const Unit&) const {}
};

__device__ __forceinline__ unsigned cvt_pk_bf16(float lo, float hi) { unsigned r; asm volatile("v_cvt_pk_bf16_f32 %0, %1, %2" : "=v"(r) : "v"(lo), "v"(hi)); return r; }
typedef float f32x2 __attribute__((ext_vector_type(2)));
typedef unsigned u32x2 __attribute__((ext_vector_type(2)));
typedef _Float16 h16x2 __attribute__((ext_vector_type(2)));
__device__ __forceinline__ float fsigmoid(float v) { return __builtin_amdgcn_rcpf(1.0f + __expf(-v)); }
__device__ __forceinline__ float gelu_tanh(float v) { const float y = 1.5957691216057308f * (v + 0.044715f * v * v * v); return v * fsigmoid(y); }
__device__ __forceinline__ u32x4 pack8f(const f32x4 a, const f32x4 b) { u32x4 w; w.x = cvt_pk_bf16(a[0], a[1]); w.y = cvt_pk_bf16(a[2], a[3]); w.z = cvt_pk_bf16(b[0], b[1]); w.w = cvt_pk_bf16(b[2], b[3]); return w; }
__device__ __forceinline__ float bf2f(unsigned short b) { return __uint_as_float((unsigned)b << 16); }

struct EpiIn {
    static constexpr bool PERM = true, AFTER_DRAIN = false;
    bf16_t *ZX, *G1, *G2, *ZC; const float* rstd;
    __device__ __forceinline__ void operator()(const f32x4 (&acc)[2][2][4][2], const Unit& u, int wr, int wc, int fr, int fq) const {
        const int row0 = u.pm * BM + wr * 64 + fr, cl = wc * 32 + 8 * fq, pn = u.pn;
#pragma unroll
        for (int ai = 0; ai < 2; ++ai)
#pragma unroll
            for (int m = 0; m < 4; ++m) { const int row = row0 + ai * HALF + m * 16; const float rs = rstd[row];
                if (pn >= 4 && pn < 12) {
                    f32x4 o[2];
#pragma unroll
                    for (int n = 0; n < 2; ++n)
#pragma unroll
                        for (int e = 0; e < 4; ++e) o[n][e] = gelu_tanh(acc[ai][0][m][n][e] * rs) * fsigmoid(acc[ai][1][m][n][e] * rs);
                    *(u32x4*)(G1 + (size_t)row * 1024 + (pn - 4) * 128 + cl) = pack8f(o[0], o[1]);
                } else {
#pragma unroll
                    for (int bj = 0; bj < 2; ++bj) { f32x4 v0 = acc[ai][bj][m][0] * rs, v1 = acc[ai][bj][m][1] * rs;
                        if (pn < 4) *(u32x4*)(ZX + (size_t)row * 1024 + pn * 256 + bj * HALF + cl) = pack8f(v0, v1);
                        else if (pn < 16) {
#pragma unroll
                            for (int e = 0; e < 4; ++e) { v0[e] = fsigmoid(v0[e]); v1[e] = fsigmoid(v1[e]); }
                            *(u32x4*)(G2 + (size_t)row * 1024 + (pn - 12) * 256 + bj * HALF + cl) = pack8f(v0, v1);
                        } else *(u32x4*)(ZC + (size_t)row * 768 + (pn - 16) * 256 + bj * HALF + cl) = pack8f(v0, v1);
                    }
                }
            }
    }
};
__device__ __forceinline__ float one_minus_exp(float x) {
    const float p = -x * (1.0f + x * (0.5f + x * (0.16666667f + x * (0.041666668f + x * 0.0083333338f))));
    const float q = 1.0f - __builtin_amdgcn_exp2f(x * 1.4426950408889634f);
    return x > -0.2f ? p : q;
}
struct EpiLru {
    static constexpr bool PERM = true, AFTER_DRAIN = false;
    const bf16_t* XA; const float *ba, *bx, *csp; unsigned* AB;
    __device__ __forceinline__ void operator()(const f32x4 (&acc)[2][2][4][2], const Unit& u, int wr, int wc, int fr, int fq) const {
        const int c0 = u.pn * 128 + wc * 32 + 8 * fq;
        const unsigned lo = (unsigned)((wr * 64 + fr) * 1024 + c0);
        const char* xau = (const char*)(XA + (size_t)u.pm * BM * 1024); char* abu = (char*)(AB + (size_t)u.pm * BM * 1024);
#pragma unroll
        for (int n = 0; n < 2; ++n) {

#ifdef NOBIAS
 const f32x4 vba = {0.f,0.f,0.f,0.f}, vbx = vba, vcs = {1.f,1.f,1.f,1.f};
#else
 const f32x4 vba = *(const f32x4*)(ba + c0 + 4 * n), vbx = *(const f32x4*)(bx + c0 + 4 * n), vcs = *(const f32x4*)(csp + c0 + 4 * n);
#endif

#pragma unroll
            for (int ai = 0; ai < 2; ++ai)
#pragma unroll
                for (int m = 0; m < 4; ++m) { const int ro = (ai * HALF + m * 16) * 1024 + 4 * n;

#ifdef NOXA
 const u32x2 xw = {0x3f803f80u, 0x3f803f80u};
#else
 const u32x2 xw = *(const u32x2*)(xau + (size_t)ro * 2 + lo * 2u);
#endif
 u32x4 ow;
#pragma unroll
                    for (int e = 0; e < 4; ++e) { const unsigned w = xw[e >> 1]; const float xa = __uint_as_float((e & 1) ? (w & 0xffff0000u) : (w << 16));
                        const float r = fsigmoid(acc[ai][0][m][n][e] + vba[e]), ig = fsigmoid(acc[ai][1][m][n][e] + vbx[e]);
                        const float la2 = -vcs[e] * r; const float b = __builtin_amdgcn_sqrtf(fmaxf(1.0f - __builtin_amdgcn_exp2f(2.0f * la2), 0.f)) * (ig * xa);
                        h16x2 hv; hv.x = (_Float16)la2; hv.y = (_Float16)b; ow[e] = __builtin_bit_cast(unsigned, hv); }
                    *(u32x4*)(abu + (size_t)ro * 4 + lo * 4u) = ow;
                    __builtin_amdgcn_sched_barrier(0); }
        }
    }
};
struct EpiQ {
    static constexpr bool PERM = true, AFTER_DRAIN = false;
    bf16_t* Q; const float* rstd; const float* CS;
    __device__ __forceinline__ void operator()(const f32x4 (&acc)[2][2][4][2], const Unit& u, int wr, int wc, int fr, int fq) const {
        const int row0 = u.pm * BM + wr * 64 + fr, cl = wc * 32 + 8 * fq, pn = u.pn;
#pragma unroll
        for (int ai = 0; ai < 2; ++ai)
#pragma unroll
            for (int m = 0; m < 4; ++m) { const int row = row0 + ai * HALF + m * 16; const float rs = rstd[row];
                bf16_t* op = Q + (size_t)row * 1536 + pn * 256 + cl;
                if (pn < 4) {
#pragma unroll
                    for (int bj = 0; bj < 2; ++bj) *(u32x4*)(op + bj * HALF) = pack8f(acc[ai][bj][m][0] * rs, acc[ai][bj][m][1] * rs);
                } else {
                    const float* cs = CS + ((size_t)(row & 8191) * 32 + 16 * (wc & 1) + 4 * fq) * 2;
                    const f32x4 c01 = *(const f32x4*)cs, c23 = *(const f32x4*)(cs + 4);
                    const float co[4] = {c01[0], c01[2], c23[0], c23[2]}, si[4] = {c01[1], c01[3], c23[1], c23[3]};
#pragma unroll
                    for (int bj = 0; bj < 2; ++bj) { const f32x4 lo = acc[ai][bj][m][0] * rs, hi = acc[ai][bj][m][1] * rs; f32x4 olo, ohi;
#pragma unroll
                        for (int e = 0; e < 4; ++e) { olo[e] = lo[e] * co[e] - hi[e] * si[e]; ohi[e] = hi[e] * co[e] + lo[e] * si[e]; }
                        *(u32x4*)(op + bj * HALF) = pack8f(olo, ohi); }
                }
            }
    }
};
struct EpiRowScale {
    static constexpr bool PERM = true, AFTER_DRAIN = false;
    bf16_t* O; int ldc; const float* rstd;
    __device__ __forceinline__ void operator()(const f32x4 (&acc)[2][2][4][2], const Unit& u, int wr, int wc, int fr, int fq) const {
        const int row0 = u.pm * BM + wr * 64 + fr, cl = u.pn * 256 + wc * 32 + 8 * fq;
#pragma unroll
        for (int ai = 0; ai < 2; ++ai)
#pragma unroll
            for (int m = 0; m < 4; ++m) { const int row = row0 + ai * HALF + m * 16; const float rs = rstd[row];
#pragma unroll
                for (int bj = 0; bj < 2; ++bj) *(u32x4*)(O + (size_t)row * ldc + cl + bj * HALF) = pack8f(acc[ai][bj][m][0] * rs, acc[ai][bj][m][1] * rs);
            }
    }
};
template <bool WB> struct EpiRes {
    static constexpr bool PERM = false, AFTER_DRAIN = false;
    const float* base; float* out; bf16_t* outb; float* SS;
    __device__ __forceinline__ void operator()(const f32x4 (&acc)[2][2][4][2], const Unit& u, int wr, int wc, int fr, int fq) const {
        const int row0 = u.pm * BM + wr * 64 + fr, col0 = u.pn * 256 + wc * 32 + 4 * fq;
#pragma unroll
        for (int ai = 0; ai < 2; ++ai)
#pragma unroll
            for (int m = 0; m < 4; ++m) { const int row = row0 + ai * HALF + m * 16; const size_t off = (size_t)row * 1024 + col0; float ss = 0.f;
#pragma unroll
                for (int bj = 0; bj < 2; ++bj)
#pragma unroll
                    for (int n = 0; n < 2; ++n) { const size_t o2 = off + bj * HALF + n * 16; const f32x4 h = *(const f32x4*)(base + o2) + acc[ai][bj][m][n];
                        *(f32x4*)(out + o2) = h; ss += (h[0] * h[0] + h[1] * h[1]) + (h[2] * h[2] + h[3] * h[3]);
                        if (WB) { u32x2 w; w.x = cvt_pk_bf16(h[0], h[1]); w.y = cvt_pk_bf16(h[2], h[3]); *(u32x2*)(outb + o2) = w; } }
                ss += __shfl_xor(ss, 16); ss += __shfl_xor(ss, 32);
                if (fq == 0) SS[(size_t)row * 16 + u.pn * 4 + wc] = ss;
            }
    }
};
struct EpiUp {
    static constexpr bool PERM = true, AFTER_DRAIN = false;
    bf16_t* U; const float* SS;
    __device__ __forceinline__ void operator()(const f32x4 (&acc)[2][2][4][2], const Unit& u, int wr, int wc, int fr, int fq) const {
        const int row0 = u.pm * BM + wr * 64 + fr, cl = u.pn * 256 + wc * 32 + 8 * fq;
#pragma unroll
        for (int ai = 0; ai < 2; ++ai)
#pragma unroll
            for (int m = 0; m < 4; ++m) { const int row = row0 + ai * HALF + m * 16;
                const f32x4* sp = (const f32x4*)(SS + (size_t)row * 16); const f32x4 s = (sp[0] + sp[1]) + (sp[2] + sp[3]);
                const float rs = rsqrtf(((s[0] + s[1]) + (s[2] + s[3])) * (1.0f / 1024.0f) + 1e-6f);
#pragma unroll
                for (int bj = 0; bj < 2; ++bj) { f32x4 v0 = acc[ai][bj][m][0] * rs, v1 = acc[ai][bj][m][1] * rs;
#pragma unroll
                    for (int e = 0; e < 4; ++e) { const float a = fmaxf(v0[e], 0.f), b = fmaxf(v1[e], 0.f); v0[e] = a * a; v1[e] = b * b; }
                    *(u32x4*)(U + (size_t)row * 4096 + cl + bj * HALF) = pack8f(v0, v1); }
            }
    }
};
template <class Epi, class Sched, bool ALIGN_EPI = false, bool SP2 = false>
__device__ __forceinline__ void gemm_phase(PG8_LAS unsigned char* lds, const Gemm g, const Sched& S, const Epi& E) {
    int tid_ = threadIdx.x; asm volatile("" : "+v"(tid_));
    const int tid = tid_, wid = __builtin_amdgcn_readfirstlane(tid >> 6), lane = tid & 63, wr = wid >> 2, wc = wid & 3, fr = lane & 15, fq = lane >> 4;
    int K_ = g.K; asm volatile("" : "+s"(K_));
    const int K = K_, nt = K / BK;
    unsigned voffA[2], voffB[2];
#pragma unroll
    for (int i = 0; i < 2; ++i) { int R, C; stage_rc(tid * 16 + i * 8192, R, C); const int Rb = Epi::PERM ? ((R & ~31) + perm32(R & 31)) : R;
        voffA[i] = (unsigned)(R * g.lda + C) * 2u; voffB[i] = (unsigned)(Rb * g.ldb + C) * 2u; }
    const size_t kstep = (size_t)(BK * 2);
    const size_t hstepA = (size_t)HALF * g.lda * 2, hstepB = (size_t)HALF * g.ldb * 2;
    const size_t tstepA = 2 * hstepA, tstepB = 2 * hstepB;
    const unsigned ldsw = (unsigned)wid * 1024u;
    const int aoff = lds_byte(wr * 64 + fr, fq * 8), boff = lds_byte(wc * 32 + fr, fq * 8);
#define PG8_SA(b, h) (((b) * 2 + (h)) * HTB)
#define PG8_SB(b, h) ((4 + (b) * 2 + (h)) * HTB)
#define PG8_STAGE(bufoff, gbase, voff) do { _Pragma("unroll") for (int _i = 0; _i < 2; ++_i) \
        __builtin_amdgcn_global_load_lds((const unsigned*)((const char*)(gbase) + (voff)[_i]), (PG8_LAS unsigned*)(lds + (bufoff) + ldsw + _i * 8192), 16, 0, 0); } while (0)
#define PG8_LDA(dst, b, h) do { _Pragma("unroll") for (int m = 0; m < 4; ++m) _Pragma("unroll") for (int k = 0; k < 2; ++k) dst[m][k] = *(const PG8_LAS bf16x8*)(lds + PG8_SA(b, h) + aoff + m * 2048 + k * 1024); } while (0)
#define PG8_LDB(dst, b, h) do { _Pragma("unroll") for (int n = 0; n < 2; ++n) _Pragma("unroll") for (int k = 0; k < 2; ++k) dst[n][k] = *(const PG8_LAS bf16x8*)(lds + PG8_SB(b, h) + boff + n * 2048 + k * 1024); } while (0)
#define PG8_MMA(ai, bj, At, Bt) do { __builtin_amdgcn_s_setprio(1); _Pragma("unroll") for (int m = 0; m < 4; ++m) _Pragma("unroll") for (int n = 0; n < 2; ++n) _Pragma("unroll") for (int k = 0; k < 2; ++k) \
        acc[ai][bj][m][n] = __builtin_amdgcn_mfma_f32_16x16x32_bf16(Bt[n][k], At[m][k], acc[ai][bj][m][n], 0, 0, 0); __builtin_amdgcn_s_setprio(0); } while (0)
#define PG8_WAIT_V(n) asm volatile("s_waitcnt vmcnt(" #n ")" ::: "memory")
#define PG8_WAIT_L(n) asm volatile("s_waitcnt lgkmcnt(" #n ")" ::: "memory")
#define PG8_BAR __builtin_amdgcn_s_barrier()
#define PG8_SCHED __builtin_amdgcn_sched_barrier(0)
    Unit cur, nxt; int ui = 0;
    if (!S.next(0, cur)) return;
    f32x4 acc[2][2][4][2];
#pragma unroll
    for (int a = 0; a < 2; ++a)
#pragma unroll
        for (int b = 0; b < 2; ++b)
#pragma unroll
            for (int m = 0; m < 4; ++m)
#pragma unroll
                for (int n = 0; n < 2; ++n) acc[a][b][m][n] = (f32x4){0.f, 0.f, 0.f, 0.f};
    bf16x8 At[4][2], B0[2][2], B1[2][2];
    const char* cA = (const char*)g.A + (size_t)cur.pm * tstepA + (size_t)(cur.pn >> g.a_pn_shift) * g.a_pn_bytes; const char* cB = (const char*)g.Bt + (size_t)cur.pn * tstepB;
    S.a_ready(cur);
    if constexpr (SP2) {
        PG8_STAGE(PG8_SB(0, 0), cB, voffB); PG8_STAGE(PG8_SB(0, 1), cB + hstepB, voffB); PG8_STAGE(PG8_SA(0, 0), cA, voffA); PG8_STAGE(PG8_SA(0, 1), cA + hstepA, voffA);
        if (wr == 1) PG8_BAR;
        PG8_WAIT_V(2); PG8_BAR;
        PG8_STAGE(PG8_SB(1, 0), cB + kstep, voffB); PG8_STAGE(PG8_SA(1, 0), cA + kstep, voffA); PG8_STAGE(PG8_SB(1, 1), cB + hstepB + kstep, voffB);
        PG8_WAIT_V(6); PG8_BAR;
    } else {
        PG8_STAGE(PG8_SB(0, 0), cB, voffB); PG8_STAGE(PG8_SA(0, 0), cA, voffA); PG8_STAGE(PG8_SB(0, 1), cB + hstepB, voffB); PG8_STAGE(PG8_SA(0, 1), cA + hstepA, voffA);
        if (wr == 1) PG8_BAR;
        PG8_WAIT_V(4); PG8_BAR;
        PG8_STAGE(PG8_SB(1, 0), cB + kstep, voffB); PG8_STAGE(PG8_SA(1, 0), cA + kstep, voffA); PG8_STAGE(PG8_SB(1, 1), cB + hstepB + kstep, voffB);
        PG8_WAIT_V(6); PG8_BAR;
    }
    for (;;) {
        const bool has_next = S.next(ui + 1, nxt);
        const char* nA = has_next ? (const char*)g.A + (size_t)nxt.pm * tstepA + (size_t)(nxt.pn >> g.a_pn_shift) * g.a_pn_bytes : cA; const char* nB = has_next ? (const char*)g.Bt + (size_t)nxt.pn * tstepB : cB;
        for (int t = 0; t < nt; t += 2) {
            const bool last = (t == nt - 2);
            const char* a1 = cA + (size_t)(t + 1) * kstep;
            const char* a2 = last ? nA : cA + (size_t)(t + 2) * kstep; const char* b2 = last ? nB : cB + (size_t)(t + 2) * kstep;
            const char* a3 = a2 + kstep; const char* b3 = b2 + kstep;
            if (last && has_next) S.a_ready(nxt);
            if constexpr (SP2) {
            PG8_LDB(B0, 0, 0); PG8_LDB(B1, 0, 1); PG8_SCHED; PG8_LDA(At, 0, 0); PG8_STAGE(PG8_SA(1, 1), a1 + hstepA, voffA);
            PG8_WAIT_V(8); PG8_WAIT_L(0); PG8_BAR; PG8_MMA(0, 0, At, B0); PG8_MMA(0, 1, At, B1); PG8_BAR; PG8_SCHED;
            PG8_LDA(At, 0, 1); PG8_STAGE(PG8_SB(0, 0), b2, voffB); PG8_STAGE(PG8_SB(0, 1), b2 + hstepB, voffB); PG8_STAGE(PG8_SA(0, 0), a2, voffA);
            PG8_WAIT_V(8); PG8_WAIT_L(0); PG8_BAR; PG8_MMA(1, 0, At, B0); PG8_MMA(1, 1, At, B1); PG8_BAR; PG8_SCHED;
            PG8_LDB(B0, 1, 0); PG8_LDB(B1, 1, 1); PG8_SCHED; PG8_LDA(At, 1, 0); PG8_STAGE(PG8_SA(0, 1), a2 + hstepA, voffA);
            PG8_WAIT_V(8); PG8_WAIT_L(0); PG8_BAR; PG8_MMA(0, 0, At, B0); PG8_MMA(0, 1, At, B1); PG8_BAR; PG8_SCHED;
            PG8_LDA(At, 1, 1); PG8_STAGE(PG8_SB(1, 0), b3, voffB); PG8_STAGE(PG8_SB(1, 1), b3 + hstepB, voffB); PG8_STAGE(PG8_SA(1, 0), a3, voffA);
            PG8_WAIT_V(8); PG8_WAIT_L(0); PG8_BAR; PG8_MMA(1, 0, At, B0); PG8_MMA(1, 1, At, B1); PG8_BAR; PG8_SCHED;
            } else {
            PG8_LDB(B0, 0, 0); PG8_SCHED; PG8_LDA(At, 0, 0); PG8_STAGE(PG8_SA(1, 1), a1 + hstepA, voffA);
            PG8_WAIT_L(8); PG8_BAR; PG8_WAIT_L(0); PG8_MMA(0, 0, At, B0); PG8_BAR; PG8_SCHED;
            PG8_LDB(B1, 0, 1); PG8_STAGE(PG8_SB(0, 0), b2, voffB);
            PG8_BAR; PG8_WAIT_L(0); PG8_MMA(0, 1, At, B1); PG8_BAR;
            PG8_LDA(At, 0, 1); PG8_STAGE(PG8_SA(0, 0), a2, voffA);
            PG8_BAR; PG8_WAIT_L(0); PG8_MMA(1, 0, At, B0); PG8_BAR; PG8_SCHED;
            PG8_STAGE(PG8_SB(0, 1), b2 + hstepB, voffB);
            PG8_WAIT_V(6); PG8_BAR; PG8_MMA(1, 1, At, B1); PG8_BAR;
            PG8_LDB(B0, 1, 0); PG8_SCHED; PG8_LDA(At, 1, 0); PG8_STAGE(PG8_SA(0, 1), a2 + hstepA, voffA);
            PG8_WAIT_L(8); PG8_BAR; PG8_WAIT_L(0); PG8_MMA(0, 0, At, B0); PG8_BAR; PG8_SCHED;
            PG8_LDB(B1, 1, 1); PG8_STAGE(PG8_SB(1, 0), b3, voffB);
            PG8_BAR; PG8_WAIT_L(0); PG8_MMA(0, 1, At, B1); PG8_BAR;
            PG8_LDA(At, 1, 1); PG8_STAGE(PG8_SA(1, 0), a3, voffA);
            PG8_BAR; PG8_WAIT_L(0); PG8_MMA(1, 0, At, B0); PG8_BAR; PG8_SCHED;
            PG8_STAGE(PG8_SB(1, 1), b3 + hstepB, voffB);
            PG8_WAIT_V(6); PG8_BAR; PG8_MMA(1, 1, At, B1); PG8_BAR;
            }
        }
        if constexpr (ALIGN_EPI) { if (wr == 0) PG8_BAR; }
        if constexpr (!Epi::AFTER_DRAIN) { E(acc, cur, wr, wc, fr, fq); S.done(cur); }
        if (!has_next) break;
#pragma unroll
        for (int a = 0; a < 2; ++a)
#pragma unroll
            for (int b = 0; b < 2; ++b)
#pragma unroll
                for (int m = 0; m < 4; ++m)
#pragma unroll
                    for (int n = 0; n < 2; ++n) acc[a][b][m][n] = (f32x4){0.f, 0.f, 0.f, 0.f};
        cur = nxt; cA = nA; cB = nB; ++ui;
        if constexpr (ALIGN_EPI) { if (wr == 1) PG8_BAR; }
    }
    PG8_WAIT_V(0);
    if constexpr (!ALIGN_EPI) { if (wr == 0) PG8_BAR; }
    PG8_BAR;
    if constexpr (Epi::AFTER_DRAIN) { E.fused(acc, cur, wr, wc, fr, fq, lds, wid, lane); S.done(cur); }
#undef PG8_SA
#undef PG8_SB
#undef PG8_STAGE
#undef PG8_LDA
#undef PG8_LDB
#undef PG8_MMA
#undef PG8_WAIT_V
#undef PG8_WAIT_L
#undef PG8_BAR
#undef PG8_SCHED
}
}
namespace att {
typedef unsigned short bf16_t;
typedef short bf16x8 __attribute__((ext_vector_type(8)));
typedef short s16x4 __attribute__((ext_vector_type(4)));
typedef float f32x16 __attribute__((ext_vector_type(16)));
typedef float f32x4 __attribute__((ext_vector_type(4)));
typedef unsigned u32x4 __attribute__((ext_vector_type(4)));
constexpr int NW = 8, QBLK = 32, KVBLK = 64, QB = NW * QBLK;
constexpr int DK = 192, DV = 128;
constexpr int QS = 1536, KVS = 2048, KRS = 64, OS = 1024;
constexpr int SHM_V = KVBLK * DV * 2, SHM_K = KVBLK * DK * 2;
constexpr int LDS_QR = 2 * SHM_V + 2 * SHM_K + NW * 64 * 4;
constexpr int LDS_BYTES = LDS_QR + NW * 8192;
constexpr float SCALE = 0.07216878364870322f;
constexpr float THR = 8.f;
#define KSWZ(row, colB) ((row) * 384 + ((colB) ^ (((row) & 7) << 4)))
#define SBAR() __builtin_amdgcn_sched_barrier(0)
__device__ __forceinline__ int v_st(int k, int c) { const int kk = (k & ~0xC) | ((k & 4) << 1) | ((k & 8) >> 1); return ((kk >> 3) * 4 + (c >> 5)) * 512 + ((kk & 7) * 32 + (c & 31)) * 2; }
__device__ __forceinline__ int v_rd_base(int lane) { return ((lane & 3) << 3) | (((lane >> 2) & 3) << 6) | (((lane >> 4) & 1) << 5) | (((lane >> 5) & 1) << 8); }
constexpr int v_rd_off(int d0, int ks, int half) { return d0 * 512 + ks * 4096 + half * 2048; }
__device__ __forceinline__ int crow(int r, int hi) { return (r & 3) + 8 * (r >> 2) + 4 * hi; }
__device__ __forceinline__ unsigned cvtpk(float lo, float hi) { unsigned r; asm volatile("v_cvt_pk_bf16_f32 %0, %1, %2" : "=v"(r) : "v"(lo), "v"(hi)); return r; }
__device__ __forceinline__ bf16x8 load8(const bf16_t* p) { return *reinterpret_cast<const bf16x8*>(p); }
__device__ __forceinline__ void mask_tile(f32x16& p0, f32x16& p1, int dq) {
    const float NEG = -__builtin_inff();
#pragma unroll
    for (int r = 0; r < 16; ++r) {
        const int c = (r & 3) + 8 * (r >> 2);
        if (dq - c < 0) p0[r] = NEG;
        if (dq - c - 32 < 0) p1[r] = NEG;
    }
}
__device__ __forceinline__ void partialSM(f32x16& p0, f32x16& p1, float& m_reg, float& mn, float& alpha) {
    float pmax = p0[0]; for (int r = 1; r < 16; ++r) pmax = fmaxf(pmax, p0[r]); for (int r = 0; r < 16; ++r) pmax = fmaxf(pmax, p1[r]);
    { auto rr = __builtin_amdgcn_permlane32_swap(__float_as_uint(pmax), __float_as_uint(pmax), false, false);
      pmax = fmaxf(__uint_as_float(rr[0]), __uint_as_float(rr[1])); }
    constexpr float C2 = 1.4426950408889634f * SCALE;
    if (__builtin_expect(__all((pmax - m_reg) * SCALE <= THR), 1)) { mn = m_reg; alpha = 1.f; }
    else { mn = fmaxf(m_reg, pmax); alpha = __builtin_amdgcn_exp2f((m_reg - mn) * C2); m_reg = mn; }
    const float mnL = -mn * C2;
    for (int r = 0; r < 16; ++r) p0[r] = fmaf(p0[r], C2, mnL); for (int r = 0; r < 16; ++r) p1[r] = fmaf(p1[r], C2, mnL);
    for (int r = 0; r < 16; ++r) p0[r] = __builtin_amdgcn_exp2f(p0[r]);
}
__device__ __forceinline__ void finishSM(f32x16& p0, f32x16& p1, float alpha, float& l_reg, bf16x8& pa0, bf16x8& pa1, bf16x8& pa2, bf16x8& pa3) {
    for (int r = 0; r < 16; ++r) p1[r] = __builtin_amdgcn_exp2f(p1[r]);
    float ps = 0; for (int r = 0; r < 16; ++r) ps += p0[r]; for (int r = 0; r < 16; ++r) ps += p1[r];
    { auto rr = __builtin_amdgcn_permlane32_swap(__float_as_uint(ps), __float_as_uint(ps), false, false);
      ps = __uint_as_float(rr[0]) + __uint_as_float(rr[1]); }
    l_reg = l_reg * alpha + ps;
#define PK4(P, B_, OUT) do { unsigned a0 = cvtpk(P[B_+0], P[B_+1]), a1 = cvtpk(P[B_+2], P[B_+3]);                          \
        unsigned b0 = cvtpk(P[B_+4], P[B_+5]), b1 = cvtpk(P[B_+6], P[B_+7]);                                             \
        auto r0 = __builtin_amdgcn_permlane32_swap(a0, b0, false, false); auto r1 = __builtin_amdgcn_permlane32_swap(a1, b1, false, false); \
        u32x4 w = {r0[0], r1[0], r0[1], r1[1]}; OUT = *reinterpret_cast<bf16x8*>(&w); } while (0)
    PK4(p0, 0, pa0); PK4(p0, 8, pa1); PK4(p1, 0, pa2); PK4(p1, 8, pa3);
#undef PK4
}
template <int KB>
__device__ __forceinline__ void qkt(f32x16& p0, f32x16& p1, const char* K_lds, int r32, int hi, const bf16x8* qr, const char* qrl) {
    p0 = f32x16{}; p1 = f32x16{};
    const char* kb[4];
#pragma unroll
    for (int dd = 0; dd < 4; ++dd) kb[dd] = K_lds + KB * SHM_K + KSWZ(r32, (dd * 16 + hi * 8) * 2);
#pragma unroll
    for (int d0 = 0; d0 < 12; ++d0) { const char* a = kb[d0 & 3] + (d0 >> 2) * 128;
        bf16x8 b0 = *reinterpret_cast<const bf16x8*>(a);
        bf16x8 b1 = *reinterpret_cast<const bf16x8*>(a + 32 * 384);
        const bf16x8 qf = d0 < 4 ? qr[d0 & 3] : *reinterpret_cast<const bf16x8*>(qrl + (d0 - 4) * 1024);
        p0 = __builtin_amdgcn_mfma_f32_32x32x16_bf16(b0, qf, p0, 0, 0, 0);
        p1 = __builtin_amdgcn_mfma_f32_32x32x16_bf16(b1, qf, p1, 0, 0, 0); }
}
template <int VB>
__device__ __forceinline__ void pv_tile(f32x16* o, int vb0, bf16x8 pa0, bf16x8 pa1, bf16x8 pa2, bf16x8 pa3) {
#define TRRD(dst, off) asm volatile("ds_read_b64_tr_b16 %0, %1 offset:%2" : "=&v"(dst) : "v"(vb0), "i"(off) : "memory")
#define PV_D0(d0) do { s16x4 l0, l1, l2, l3, h0, h1, h2, h3; constexpr int b_ = VB * SHM_V + v_rd_off(d0, 0, 0);   \
        TRRD(l0, b_); TRRD(h0, b_ + 2048); TRRD(l1, b_ + 4096); TRRD(h1, b_ + 6144); TRRD(l2, b_ + 8192); TRRD(h2, b_ + 10240); TRRD(l3, b_ + 12288); TRRD(h3, b_ + 14336); \
        asm volatile("s_waitcnt lgkmcnt(0)" ::: "memory"); SBAR();   \
        o[d0] = __builtin_amdgcn_mfma_f32_32x32x16_bf16(pa0, (bf16x8){l0[0], l0[1], l0[2], l0[3], h0[0], h0[1], h0[2], h0[3]}, o[d0], 0, 0, 0);   \
        o[d0] = __builtin_amdgcn_mfma_f32_32x32x16_bf16(pa1, (bf16x8){l1[0], l1[1], l1[2], l1[3], h1[0], h1[1], h1[2], h1[3]}, o[d0], 0, 0, 0);   \
        o[d0] = __builtin_amdgcn_mfma_f32_32x32x16_bf16(pa2, (bf16x8){l2[0], l2[1], l2[2], l2[3], h2[0], h2[1], h2[2], h2[3]}, o[d0], 0, 0, 0);   \
        o[d0] = __builtin_amdgcn_mfma_f32_32x32x16_bf16(pa3, (bf16x8){l3[0], l3[1], l3[2], l3[3], h3[0], h3[1], h3[2], h3[3]}, o[d0], 0, 0, 0); } while (0)
    PV_D0(0); PV_D0(1); PV_D0(2); PV_D0(3);
#undef PV_D0
#undef TRRD
}
struct BlockRef { const bf16_t* Qn; const bf16_t* Qr; const bf16_t* Kn; const bf16_t* Kr; const bf16_t* V; bf16_t* O; int P0; };
struct Seam { bf16x8 qr[4]; bf16x8 st_v0, st_v1, st_k0, st_k1, st_k2; };
#define VMW() asm volatile("s_waitcnt vmcnt(0)" ::: "memory")
#define VMWN(n) asm volatile("s_waitcnt vmcnt(%0)" :: "i"(n) : "memory")
#define SLOAD_H(R_, k0) do { const char* vb_ = (const char*)((R_).V + (size_t)(k0) * KVS); const char* kb_ = (const char*)((R_).Kn + (size_t)(k0) * KVS); const char* rb_ = (const char*)((R_).Kr + (size_t)(k0) * KRS); \
                         S.st_v0 = *(const bf16x8*)(vb_ + voff); S.st_v1 = *(const bf16x8*)(vb_ + 32 * KVS * 2 + voff);      \
                         S.st_k0 = *(const bf16x8*)(kb_ + voff); S.st_k1 = *(const bf16x8*)(kb_ + 32 * KVS * 2 + voff);      \
                         S.st_k2 = *(const bf16x8*)(rb_ + roff); } while (0)
#define SWRITE_HK(bf) do { *(bf16x8*)(K_lds + (bf) * SHM_K + kws) = S.st_k0; *(bf16x8*)(K_lds + (bf) * SHM_K + kws + 32 * 384) = S.st_k1; *(bf16x8*)(K_lds + (bf) * SHM_K + kws2) = S.st_k2; } while (0)
#define SWRITE_HV(bf) do { *(bf16x8*)(V_lds + (bf) * SHM_V + vst0) = S.st_v0; *(bf16x8*)(V_lds + (bf) * SHM_V + vst1) = S.st_v1; } while (0)
#define SWRITE_H(bf) do { SWRITE_HV(bf); SWRITE_HK(bf); } while (0)
#define QLOAD(R_) do { const char* qn_ = (const char*)((R_).Qn + (size_t)(wid * QBLK) * QS); const char* qr_ = (const char*)((R_).Qr + (size_t)(wid * QBLK) * QS); \
                       _Pragma("unroll") for (int d0 = 0; d0 < 4; ++d0) S.qr[d0] = *(const bf16x8*)(qn_ + qoff + d0 * 32);          \
                       _Pragma("unroll") for (int d0 = 4; d0 < 8; ++d0) *(bf16x8*)(qrl + (d0 - 4) * 1024) = *(const bf16x8*)(qn_ + qoff + d0 * 32);          \
                       _Pragma("unroll") for (int d0 = 0; d0 < 4; ++d0) *(bf16x8*)(qrl + (d0 + 4) * 1024) = *(const bf16x8*)(qr_ + qoff + d0 * 32); } while (0)
__device__ __forceinline__ void attn_prime(const BlockRef& cur, char* lds, Seam& S) {
    const int tid = threadIdx.x, wid = __builtin_amdgcn_readfirstlane(tid >> 6), lane = tid & 63, r32 = lane & 31, hi = lane >> 5;
    const int sr = tid >> 4, sc = (tid & 15) * 8, kws = KSWZ(sr, sc * 2), rr = tid >> 3, rc = (tid & 7) * 8, kws2 = KSWZ(rr, (128 + rc) * 2); char* K_lds = lds + 2 * SHM_V;
    char* qrl = lds + LDS_QR + wid * 8192 + lane * 16;
    const unsigned voff = (unsigned)((sr * KVS + sc) * 2), roff = (unsigned)((rr * KRS + rc) * 2), qoff = (unsigned)((r32 * QS + hi * 8) * 2);
    QLOAD(cur);
    SLOAD_H(cur, 0); VMW(); SWRITE_HK(0);
    __syncthreads();
}
__device__ __forceinline__ void attn_block(const BlockRef& cur, const BlockRef& nxt, char* lds, Seam& S) {
    const int tid = threadIdx.x, wid = __builtin_amdgcn_readfirstlane(tid >> 6), lane = tid & 63, r32 = lane & 31, hi = lane >> 5;
    const int NT = cur.P0 / KVBLK + 4;
    const int qlo = cur.P0 + wid * QBLK, qm = qlo + r32 - 4 * hi;
    char* V_lds = lds; char* K_lds = lds + 2 * SHM_V;
    float* ws = (float*)(lds + 2 * SHM_V + 2 * SHM_K) + wid * 64; float* li_l = ws, * al_l = ws + 32;
    float m_reg = -1e30f, l_reg = 0; f32x16 o[4] = {};
    const int sr = tid >> 4, sc = (tid & 15) * 8, vst0 = v_st(sr, sc), vst1 = v_st(32 + sr, sc), kws = KSWZ(sr, sc * 2);
    const int rr = tid >> 3, rc = (tid & 7) * 8, kws2 = KSWZ(rr, (128 + rc) * 2);
    const int vb0 = (int)(uintptr_t)V_lds + v_rd_base(lane);
    char* qrl = lds + LDS_QR + wid * 8192 + lane * 16;
    const unsigned voff = (unsigned)((sr * KVS + sc) * 2), roff = (unsigned)((rr * KRS + rc) * 2), qoff = (unsigned)((r32 * QS + hi * 8) * 2);
#define RESC(a) do { if (__any((a) < 1.f)) { if (hi == 0) al_l[r32] = (a); asm volatile("s_waitcnt lgkmcnt(0)" ::: "memory");              \
                     for (int d_ = 0; d_ < 4; ++d_) for (int r = 0; r < 16; ++r) o[d_][r] *= al_l[crow(r, hi)]; } } while (0)
#define MASKT(P0_, P1_, t) do { const int kb_ = (t) * KVBLK; if (kb_ + KVBLK - 1 > qlo) mask_tile(P0_, P1_, qm - kb_); } while (0)
    f32x16 pA0, pA1, pB0, pB1; float mnA, mnB, alA, alB; bf16x8 pa0, pa1, pa2, pa3;
    SWRITE_HV(0); SBAR();
    if (NT > 1) SLOAD_H(cur, KVBLK);
    SBAR(); qkt<0>(pA0, pA1, K_lds, r32, hi, S.qr, qrl);
    MASKT(pA0, pA1, 0); partialSM(pA0, pA1, m_reg, mnA, alA);
    if (NT > 1) { VMW(); SWRITE_H(1); }
    __syncthreads();
#define HALF_STEP(PX0, PX1, mnX, alX, PY0, PY1, alY, t, KB, VB, SB) do {                                                      \
        SBAR(); qkt<KB>(PX0, PX1, K_lds, r32, hi, S.qr, qrl);                                                                       \
        finishSM(PY0, PY1, alY, l_reg, pa0, pa1, pa2, pa3); SBAR();                                                           \
        if ((t) + 1 < NT) { SLOAD_H(cur, ((t) + 1) * KVBLK); SBAR(); }                                                        \
        pv_tile<VB>(o, vb0, pa0, pa1, pa2, pa3); MASKT(PX0, PX1, (t)); partialSM(PX0, PX1, m_reg, mnX, alX);                  \
        __syncthreads();                                                                                                      \
        if ((t) + 1 < NT) { VMW(); SWRITE_H(SB); }                                                                            \
        RESC(alX); __syncthreads(); } while (0)
    for (int t = 1; t + 1 < NT; t += 2) {
        HALF_STEP(pB0, pB1, mnB, alB, pA0, pA1, alA, t, 1, 0, 0);
        HALF_STEP(pA0, pA1, mnA, alA, pB0, pB1, alB, t + 1, 0, 1, 1);
    }
    const bool even = (NT & 1) == 0;
    if (even) { SBAR(); qkt<1>(pB0, pB1, K_lds, r32, hi, S.qr, qrl); SBAR(); }
    SLOAD_H(nxt, 0); SBAR();
    QLOAD(nxt);
    SBAR();
    finishSM(pA0, pA1, alA, l_reg, pa0, pa1, pa2, pa3); SBAR();
    pv_tile<0>(o, vb0, pa0, pa1, pa2, pa3);
    if (even) { MASKT(pB0, pB1, NT - 1); partialSM(pB0, pB1, m_reg, mnB, alB); __syncthreads(); RESC(alB);
        finishSM(pB0, pB1, alB, l_reg, pa0, pa1, pa2, pa3); SBAR(); pv_tile<1>(o, vb0, pa0, pa1, pa2, pa3); }
    SBAR(); VMWN(4); SWRITE_HK(0); SBAR();
    if (hi == 0) li_l[r32] = l_reg; asm volatile("s_waitcnt lgkmcnt(0)" ::: "memory");
    float rli[16];
#pragma unroll
    for (int r = 0; r < 16; ++r) rli[r] = __builtin_amdgcn_rcpf(li_l[crow(r, hi)]);
    bf16_t* Ow = cur.O + (size_t)(wid * QBLK) * OS;
#pragma unroll
    for (int r = 0; r < 16; ++r) { const int orow = crow(r, hi);
#pragma unroll
        for (int d0 = 0; d0 < 4; ++d0) { const float v = o[d0][r] * rli[r];
            const float vn = __shfl_xor(v, 1);
            if ((r32 & 1) == 0) *(unsigned*)(Ow + (size_t)orow * OS + d0 * 32 + r32) = cvtpk(v, vn); } }
    __syncthreads();
#undef RESC
#undef MASKT
#undef HALF_STEP
}
#undef VMW
#undef VMWN
#undef SLOAD_H
#undef SWRITE_HK
#undef SWRITE_HV
#undef SWRITE_H
#undef QLOAD
#undef SBAR
#undef KSWZ
}
typedef unsigned short bf16_t;
typedef float f32x4 __attribute__((ext_vector_type(4)));
typedef unsigned u32x4 __attribute__((ext_vector_type(4)));
typedef unsigned u32x2 __attribute__((ext_vector_type(2)));
typedef _Float16 h16x4 __attribute__((ext_vector_type(4)));
#define LAS __attribute__((address_space(3)))
#ifndef N_LAUNCHES
#define N_LAUNCHES 1
#endif
constexpr int NPHASE = 10;
constexpr int T = 32768, SEQ = 8192, DM = 1024;
constexpr size_t MiB = 1u << 20;
constexpr size_t WS_RSTDX = 0, WS_RSTDQ = 128 * 1024, WS_RSTDKV = 256 * 1024, WS_CSP = 384 * 1024;
constexpr size_t WS_SS1 = 1 * MiB, WS_SS2 = 3 * MiB;
constexpr size_t WS_CS = 5 * MiB;
constexpr size_t WS_W1 = 7 * MiB;
constexpr size_t WS_WUP = 17 * MiB;
constexpr size_t WS_WDN = 25 * MiB;
constexpr size_t WS_WOUT = 33 * MiB;
constexpr size_t WS_WUQ = 35 * MiB;
constexpr size_t WS_WUKV = 36 * MiB;
constexpr size_t WS_WLRU = 37 * MiB;
constexpr size_t WS_KR = 38 * MiB;
constexpr size_t WS_G1 = 42 * MiB, WS_G2 = 106 * MiB;
constexpr size_t WS_ZC = 170 * MiB;
constexpr size_t WS_SUM = WS_ZC, WS_SUB = WS_ZC + 1 * MiB;
constexpr size_t WS_KV = 218 * MiB;
constexpr size_t WS_R1 = 346 * MiB;
constexpr size_t WS_XB = WS_R1;
constexpr size_t WS_XA = WS_R1;
constexpr size_t WS_YB = WS_R1;
constexpr size_t WS_ZX = WS_R1 + 64 * MiB;
constexpr size_t WS_Q = WS_R1 + 64 * MiB;
constexpr size_t WS_MG = WS_KV;
constexpr size_t WS_H1B = WS_R1 + 64 * MiB;
constexpr size_t WS_U = 42 * MiB;
constexpr size_t WS_END = 512 * MiB;
static_assert(WS_Q + (size_t)T * 1536 * 2 <= WS_END && WS_U + (size_t)T * 4096 * 2 <= WS_H1B && WS_W1 + 4864 * 1024 * 2 <= WS_WUP, "d_ws map");

struct Args { const float* in[19]; float* out; unsigned char* ws; int ph_lo, ph_hi; };
static_assert(sizeof(Args) == 19 * 8 + 8 + 8 + 8, "Args has no padding");

__device__ __forceinline__ float wave_sum(float v) {
#pragma unroll
    for (int o = 1; o < 64; o <<= 1) v += __shfl_xor(v, o);
    return v;
}
__device__ __forceinline__ unsigned pkbf(float lo, float hi) { return pg8::cvt_pk_bf16(lo, hi); }
__device__ __forceinline__ float bflo(unsigned w) { return __uint_as_float(w << 16); }
__device__ __forceinline__ float bfhi(unsigned w) { return __uint_as_float(w & 0xffff0000u); }

__device__ __forceinline__ int srccol(int which, int p) {
    if (which == 0) {
        const int t = p >> 8, w = p & 255;
        if (t < 4) return p;
        if (t < 12) return w < 128 ? 1024 + 128 * (t - 4) + w : 2624 + 128 * (t - 4) + (w - 128);
        if (t < 16) return 3648 + (p - 3072);
        if (t == 16) return 2048 + w;
        if (t == 17) return 2304 + w;
        return w < 64 ? 2560 + w : -1;
    }
    if (which == 1) {
        if (p < 1024) return (p >> 7) * 192 + (p & 127);
        const int q = p - 1024, h = q >> 6, u = q & 63;
        return h * 192 + 128 + 4 * (u >> 3) + (u & 3) + 32 * ((u >> 2) & 1);
    }
    return p;
}
__device__ __forceinline__ void tr_item(const float* W, int ldw, int K, int Nphys, const float* gain, bf16_t* WT, int which, LAS float* scr, int item, int lane, int ksrc0 = 0, int Ksrc = 1 << 30) {
    const int nblk = Nphys / 32, kb = item / nblk, nb = item % nblk, k0 = 64 * kb, n0 = 32 * nb;
    const int src = srccol(which, n0 + (lane & 31));
#pragma unroll 8
    for (int i = 0; i < 32; ++i) { const int kk = 2 * i + (lane >> 5); float v = 0.f;
        const int ks = k0 + kk - ksrc0;
        if (src >= 0 && ks >= 0 && ks < Ksrc) { v = W[(size_t)ks * ldw + src]; if (gain) v *= gain[k0 + kk]; }
        scr[kk * 33 + (lane & 31)] = v; }
    asm volatile("s_waitcnt lgkmcnt(0)" ::: "memory");
    const int c = lane & 7;
#pragma unroll
    for (int j = 0; j < 4; ++j) { const int n = (lane >> 3) + 8 * j; const LAS float* s = scr + (8 * c) * 33 + n;
        u32x4 o; o.x = pkbf(s[0 * 33], s[1 * 33]); o.y = pkbf(s[2 * 33], s[3 * 33]); o.z = pkbf(s[4 * 33], s[5 * 33]); o.w = pkbf(s[6 * 33], s[7 * 33]);
        *(u32x4*)(WT + (size_t)(n0 + n) * K + k0 + 8 * c) = o; }
    asm volatile("s_waitcnt lgkmcnt(0)" ::: "memory");
}
__device__ __forceinline__ void sincos_d(double a, float& s, float& c) {
    const double n = rint(a * 0.63661977236758134308);
    const double r = (a - n * 1.57079632679489655800) - n * 6.123233995736766036e-17, r2 = r * r;
    double sp = -7.6471637318198164759e-13; sp = sp * r2 + 1.6059043836821614599e-10; sp = sp * r2 - 2.5052108385441718775e-08; sp = sp * r2 + 2.7557319223985890653e-06;
    sp = sp * r2 - 1.9841269841269841270e-04; sp = sp * r2 + 8.3333333333333333333e-03; sp = sp * r2 - 1.6666666666666666667e-01; sp = r + r * r2 * sp;
    double cp = 4.7794773323873852974e-14; cp = cp * r2 - 1.1470745597729724714e-11; cp = cp * r2 + 2.0876756987868098979e-09; cp = cp * r2 - 2.7557319223985890653e-07;
    cp = cp * r2 + 2.4801587301587301587e-05; cp = cp * r2 - 1.3888888888888888889e-03; cp = cp * r2 + 4.1666666666666666667e-02; cp = cp * r2 - 0.5; cp = 1.0 + r2 * cp;
    const int q = (int)((long long)n & 3);
    const double ss = (q & 1) ? cp : sp, cc = (q & 1) ? sp : cp;
    s = (float)((q & 2) ? -ss : ss); c = (float)(((q + 1) & 2) ? -cc : cc);
}

#ifdef DIAG
#define DCHK(code, got, want, rtol, atol) do { const float g_ = (got), w_ = (want); if (!(fabsf(g_ - w_) <= (rtol) * fabsf(w_) + (atol))) { atomicMin(DG, (unsigned)(code)); atomicOr(DG + 1, (code) < 50 ? 0u : (code) < 54 ? 1u : (code) < 60 ? 2u : (code) < 70 ? 4u : (code) < 80 ? 8u : 16u); } } while (0)
__device__ __forceinline__ unsigned dhash(unsigned x) { x ^= x >> 16; x *= 0x7feb352du; x ^= x >> 15; x *= 0x846ca68bu; x ^= x >> 16; return x; }
__device__ __forceinline__ float dbf(const bf16_t* p, size_t i) { return __uint_as_float((unsigned)p[i] << 16); }
__device__ __forceinline__ float dsig(float v) { return 1.0f / (1.0f + expf(-v)); }
__device__ __forceinline__ float ddot(const bf16_t* a, const bf16_t* b, int K) { float s = 0.f; for (int k = 0; k < K; ++k) s += dbf(a, k) * dbf(b, k); return s; }
#endif
__global__ void __launch_bounds__(512, 2) fwd_kernel(Args args) {
    extern __shared__ __attribute__((aligned(16))) unsigned char lds[];
    cg::grid_group grid = cg::this_grid();
    const int tid = threadIdx.x, lane = tid & 63, wave = __builtin_amdgcn_readfirstlane(tid >> 6);
    const int G = gridDim.x, gw = blockIdx.x * 8 + wave, NGW = G * 8;
    unsigned char* ws = args.ws;
    const int lo = args.ph_lo, hi = args.ph_hi;
#ifndef PHMASK
#define PHMASK 0x3ff
#endif
#define IN(k) (((PHMASK >> (k)) & 1) && lo <= (k) && (k) < hi)
#define SEAM(k) do { if (IN(k) && IN((k) + 1)) grid.sync(); } while (0)
    const float* x = args.in[0];
    float* rstdx = (float*)(ws + WS_RSTDX); float* rstdq = (float*)(ws + WS_RSTDQ); float* rstdkv = (float*)(ws + WS_RSTDKV); float* csp = (float*)(ws + WS_CSP);
    float* SS1 = (float*)(ws + WS_SS1); float* SS2 = (float*)(ws + WS_SS2); float* CS = (float*)(ws + WS_CS);
    bf16_t* W1 = (bf16_t*)(ws + WS_W1); bf16_t* WUP = (bf16_t*)(ws + WS_WUP); bf16_t* WDN = (bf16_t*)(ws + WS_WDN); bf16_t* WOUT = (bf16_t*)(ws + WS_WOUT);
    bf16_t* WUQ = (bf16_t*)(ws + WS_WUQ); bf16_t* WUKV = (bf16_t*)(ws + WS_WUKV); bf16_t* WLRU = (bf16_t*)(ws + WS_WLRU);
    bf16_t* KR = (bf16_t*)(ws + WS_KR); bf16_t* G1 = (bf16_t*)(ws + WS_G1); bf16_t* G2 = (bf16_t*)(ws + WS_G2); bf16_t* ZC = (bf16_t*)(ws + WS_ZC);
    bf16_t* KV = (bf16_t*)(ws + WS_KV); bf16_t* XB = (bf16_t*)(ws + WS_XB); bf16_t* XA = (bf16_t*)(ws + WS_XA); bf16_t* YB = (bf16_t*)(ws + WS_YB);
    bf16_t* ZX = (bf16_t*)(ws + WS_ZX); bf16_t* Q = (bf16_t*)(ws + WS_Q); bf16_t* MG = (bf16_t*)(ws + WS_MG); bf16_t* H1B = (bf16_t*)(ws + WS_H1B); bf16_t* U = (bf16_t*)(ws + WS_U);
    float* SUM = (float*)(ws + WS_SUM); float* SUB = (float*)(ws + WS_SUB);
    unsigned* AB = (unsigned*)args.out; float* OUT = args.out;
    LAS unsigned char* ldsg = (LAS unsigned char*)lds;

#ifdef DIAG
    unsigned* DG = (unsigned*)(ws + WS_CSP + 8192); unsigned* SAVE = (unsigned*)(ws + WS_CSP + 16384);
    if (lo >= 100) {
        const int dk = lo - 100; const unsigned gid = blockIdx.x * 512 + tid, NT_ = G * 512;
        if (dk == 0) {
            for (unsigned s = gid; s < 65536; s += NT_) { const unsigned h = dhash(s * 7 + 1);
                { const int p = h % 4864, k = (h >> 13) % 1024, src = srccol(0, p); const float want = src < 0 ? 0.f : args.in[2][(size_t)k * 4672 + src] * args.in[1][k]; DCHK(1, dbf(W1, (size_t)p * 1024 + k), want, 0.01f, 1e-6f); }
                { const int p = h % 1536, k = (h >> 13) % 256; DCHK(2, dbf(WUQ, (size_t)p * 256 + k), args.in[11][(size_t)k * 1536 + srccol(1, p)] * args.in[10][k], 0.01f, 1e-6f); }
                { const int p = h % 2048, k = (h >> 13) % 256; DCHK(3, dbf(WUKV, (size_t)p * 256 + k), args.in[13][(size_t)k * 2048 + p] * args.in[12][k], 0.01f, 1e-6f); }
                { const int p = h % 2048, k = (h >> 13) % 256, nb = p >> 8, isx = (p >> 7) & 1, d = p & 127, kk = k - 128 * (nb & 1);
                  const float want = (kk >= 0 && kk < 128) ? (isx ? args.in[7] : args.in[5])[(size_t)nb * 16384 + kk * 128 + d] : 0.f; DCHK(4, dbf(WLRU, (size_t)p * 256 + k), want, 0.01f, 1e-6f); }
                { const int p = h % 1024, k = (h >> 13) % 1024; DCHK(5, dbf(WOUT, (size_t)p * 1024 + k), args.in[14][(size_t)k * 1024 + p], 0.01f, 1e-6f); }
                { const int p = h % 4096, k = (h >> 13) % 1024; DCHK(6, dbf(WUP, (size_t)p * 1024 + k), args.in[16][(size_t)k * 4096 + p] * args.in[15][k], 0.01f, 1e-6f); }
                { const int p = h % 1024, k = (h >> 13) % 4096; DCHK(7, dbf(WDN, (size_t)p * 4096 + k), args.in[17][(size_t)k * 1024 + p], 0.01f, 1e-6f); }
                { const int r = h % T, c = (h >> 15) % 1024; DCHK(8, dbf(XB, (size_t)r * 1024 + c), x[(size_t)r * 1024 + c], 0.01f, 1e-6f); }
                { const int pos = h % 8191, i = (h >> 13) & 31; const float c0 = CS[(pos * 32 + i) * 2], s0 = CS[(pos * 32 + i) * 2 + 1], c1 = CS[((pos + 1) * 32 + i) * 2], s1 = CS[((pos + 1) * 32 + i) * 2 + 1], cd = CS[(32 + i) * 2], sd = CS[(32 + i) * 2 + 1];
                  DCHK(9, c1, c0 * cd - s0 * sd, 0.f, 1e-5f); DCHK(9, s1, s0 * cd + c0 * sd, 0.f, 1e-5f); DCHK(9, cd, __cosf(powf(10000.f, -(float)i / 32.f)), 0.f, 1e-4f); DCHK(9, CS[i * 2], 1.0f, 0.f, 1e-6f); }
            }
            for (unsigned s = gid; s < 4096; s += NT_) { const int r = dhash(s) % T; float q = 0.f; for (int c = 0; c < 1024; ++c) q += x[(size_t)r * 1024 + c] * x[(size_t)r * 1024 + c]; DCHK(8, rstdx[r], 1.0f / sqrtf(q / 1024.f + 1e-6f), 1e-3f, 0.f); }
        }
        if (dk == 1) for (unsigned s = gid; s < 32768; s += NT_) { const unsigned h = dhash(s * 3 + 11); const int r = h % T, p = (h >> 15) % 4864, t = p >> 8, w = p & 255;
            const float z = ddot(XB + (size_t)r * 1024, W1 + (size_t)p * 1024, 1024) * rstdx[r];
            if (t < 4) DCHK(11, dbf(ZX, (size_t)r * 1024 + p), z, 0.02f, 0.02f);
            else if (t < 12) { if (w < 128) { const float z2 = ddot(XB + (size_t)r * 1024, W1 + (size_t)(p + 128) * 1024, 1024) * rstdx[r];
                const float ge = 0.5f * z * (1.f + tanhf(0.7978845608f * (z + 0.044715f * z * z * z))); DCHK(12, dbf(G1, (size_t)r * 1024 + (t - 4) * 128 + w), ge * dsig(z2), 0.03f, 0.02f); } }
            else if (t < 16) DCHK(13, dbf(G2, (size_t)r * 1024 + p - 3072), dsig(z), 0.02f, 0.01f);
            else DCHK(14, dbf(ZC, (size_t)r * 768 + p - 4096), z, 0.02f, 0.02f); }
        if (dk == 2) for (unsigned s = gid; s < 65536; s += NT_) { const unsigned h = dhash(s * 5 + 3); const int r = (s & 1) ? (h % T) : ((h % 4) * 8192 + (h >> 8) % 6), c = (h >> 15) % 1024, pos = r & 8191;
            float v = args.in[4][c]; for (int j = 0; j < 4; ++j) if (pos - 3 + j >= 0) v += args.in[3][j * 1024 + c] * dbf(ZX, (size_t)(r - 3 + j) * 1024 + c);
            DCHK(21, dbf(XA, (size_t)r * 1024 + c), v, 0.02f, 0.02f);
            if (c < 64) { const int u = c, i = 4 * (u >> 3) + (u & 3), hf = (u >> 2) & 1; const float kl = dbf(ZC, (size_t)r * 768 + 512 + i), kh = dbf(ZC, (size_t)r * 768 + 512 + i + 32), cc = CS[(pos * 32 + i) * 2], ss = CS[(pos * 32 + i) * 2 + 1];
                DCHK(23, dbf(KR, (size_t)r * 64 + u), hf ? kh * cc + kl * ss : kl * cc - kh * ss, 0.02f, 0.02f); }
            if (c == 100) { float q = 0.f, k2 = 0.f; for (int j = 0; j < 256; ++j) { const float a = dbf(ZC, (size_t)r * 768 + j), b = dbf(ZC, (size_t)r * 768 + 256 + j); q += a * a; k2 += b * b; }
                DCHK(22, rstdq[r], 1.0f / sqrtf(q / 256.f + 1e-6f), 1e-3f, 0.f); DCHK(22, rstdkv[r], 1.0f / sqrtf(k2 / 256.f + 1e-6f), 1e-3f, 0.f); } }
        if (dk == 3) for (unsigned s = gid; s < 65536; s += NT_) { const unsigned h = dhash(s * 9 + 5); const int r = h % T, pos = r & 8191;
            { const int c = (h >> 15) % 1024, nb = c >> 7, d = c & 127; float dr = args.in[6][c], di = args.in[8][c];
              for (int k = 0; k < 128; ++k) { const float xv = dbf(XA, (size_t)r * 1024 + nb * 128 + k); dr += xv * args.in[5][(size_t)nb * 16384 + k * 128 + d]; di += xv * args.in[7][(size_t)nb * 16384 + k * 128 + d]; }
              const float rr_ = dsig(dr), ii = dsig(di), la = -8.0f * rr_ * log1pf(expf(-args.in[9][c])), bb = sqrtf(-expm1f(2.f * la)) * ii * dbf(XA, (size_t)r * 1024 + c);
              const pg8::h16x2 pv_ = __builtin_bit_cast(pg8::h16x2, AB[(size_t)r * 1024 + c]);
              DCHK(31, (float)pv_.x, la * 1.4426950408889634f, 0.03f, 1e-5f); DCHK(32, (float)pv_.y, bb, 0.03f, 0.01f); }
            { const int p = (h >> 13) % 1536; const float z = ddot(ZC + (size_t)r * 768, WUQ + (size_t)p * 256, 256) * rstdq[r];
              if (p < 1024) DCHK(33, dbf(Q, (size_t)r * 1536 + p), z, 0.02f, 0.02f);
              else { const int u = (p - 1024) & 63, i = 4 * (u >> 3) + (u & 3), islo = (u & 4) == 0; const float z2 = ddot(ZC + (size_t)r * 768, WUQ + (size_t)(p ^ 4) * 256, 256) * rstdq[r];
                  const float cc = CS[(pos * 32 + i) * 2], ss = CS[(pos * 32 + i) * 2 + 1]; DCHK(34, dbf(Q, (size_t)r * 1536 + p), islo ? z * cc - z2 * ss : z * cc + z2 * ss, 0.02f, 0.03f); } }
            { const int p = (h >> 11) % 2048; DCHK(35, dbf(KV, (size_t)r * 2048 + p), ddot(ZC + (size_t)r * 768 + 256, WUKV + (size_t)p * 256, 256) * rstdkv[r], 0.02f, 0.02f); } }
        if (dk == 3) for (unsigned s = gid; s < 4096; s += NT_) SAVE[s] = AB[dhash(s * 41 + 3) % (unsigned)(T * 1024)];
        if (dk == 4) {
            float* SC = (float*)(ws + WS_ZC + 9 * MiB);
            for (int s = gw; s < 1024; s += NGW) { const unsigned h = dhash(s * 13 + 7); const int b = h & 3, hd = (h >> 2) & 7, pos = (s & 3) == 0 ? (int)((h >> 5) % 300) : (int)((h >> 5) % 8192); const size_t r = (size_t)b * 8192 + pos;
                float* sc = SC + (size_t)s * 8192; float mx = -1e30f;
                for (int j = lane; j <= pos; j += 64) { const size_t kr = (size_t)b * 8192 + j; float d = 0.f;
                    for (int e = 0; e < 128; ++e) d += dbf(Q, r * 1536 + hd * 128 + e) * dbf(KV, kr * 2048 + hd * 256 + e);
                    for (int e = 0; e < 64; ++e) d += dbf(Q, r * 1536 + 1024 + hd * 64 + e) * dbf(KR, kr * 64 + e);
                    d *= 0.07216878364870322f; sc[j] = d; mx = fmaxf(mx, d); }
                for (int o = 1; o < 64; o <<= 1) mx = fmaxf(mx, __shfl_xor(mx, o));
                __builtin_amdgcn_fence(__ATOMIC_RELEASE, "workgroup"); __builtin_amdgcn_s_waitcnt(0);
                float l = 0.f, o0 = 0.f, o1 = 0.f;
                for (int j = 0; j <= pos; ++j) { const float p = expf(__builtin_nontemporal_load(sc + j) - mx); const size_t kr = (size_t)b * 8192 + j; l += p; o0 += p * dbf(KV, kr * 2048 + hd * 256 + 128 + lane); o1 += p * dbf(KV, kr * 2048 + hd * 256 + 192 + lane); }
                DCHK(41, dbf(YB, r * 1024 + hd * 128 + lane), o0 / l, 0.03f, 0.01f); DCHK(41, dbf(YB, r * 1024 + hd * 128 + 64 + lane), o1 / l, 0.03f, 0.01f); } }
        if (dk == 5) for (unsigned s = gid; s < 4096; s += NT_) if (SAVE[s] != AB[dhash(s * 41 + 3) % (unsigned)(T * 1024)]) atomicMin(DG, 48u);
        if (dk == 5) for (unsigned s = gid; s < 8192; s += NT_) { const unsigned h = dhash(s * 17 + 9); const int b = h & 3, c = (h >> 2) % 1024, pos = (s & 3) == 0 ? (int)((h >> 12) % 32) : (s & 3) == 1 ? (int)((h >> 12) % 256) : (int)((h >> 12) % 8192); float hh = 0.f, LL = 0.f;
            for (int j = 0; j <= pos; ++j) { const pg8::h16x2 pv_ = __builtin_bit_cast(pg8::h16x2, AB[((size_t)b * 8192 + j) * 1024 + c]); hh = exp2f((float)pv_.x) * hh + (float)pv_.y; LL += (float)pv_.x;
                if ((j & 31) == 31 && (j >> 5) == (pos >> 5) - 0 && false) {} }
            const size_t o = ((size_t)b * 8192 + pos) * 1024 + c; const int code = pos < 32 ? 51 : pos < 256 ? 52 : 53;
            DCHK(code, dbf(MG, o), dbf(G1, o) * hh + dbf(G2, o) * dbf(YB, o), 0.03f, 0.01f);
            { const int sc_ = (h >> 12) % 256; float h2 = 0.f, L2 = 0.f; for (int j = sc_ * 32; j < sc_ * 32 + 32; ++j) { const pg8::h16x2 pv_ = __builtin_bit_cast(pg8::h16x2, AB[((size_t)b * 8192 + j) * 1024 + c]); h2 = exp2f((float)pv_.x) * h2 + (float)pv_.y; L2 += (float)pv_.x; }
              DCHK(54, SUB[(((size_t)b * 256 + sc_) * 1024 + c) * 2], L2, 1e-3f, 1e-5f); DCHK(55, SUB[(((size_t)b * 256 + sc_) * 1024 + c) * 2 + 1], h2, 1e-3f, 1e-4f); }
            { const int kc = (h >> 12) % 32; float h2 = 0.f, L2 = 0.f; for (int j = kc * 256; j < kc * 256 + 256; ++j) { const pg8::h16x2 pv_ = __builtin_bit_cast(pg8::h16x2, AB[((size_t)b * 8192 + j) * 1024 + c]); h2 = exp2f((float)pv_.x) * h2 + (float)pv_.y; L2 += (float)pv_.x; }
              DCHK(56, SUM[(((size_t)b * 32 + kc) * 1024 + c) * 2], L2, 1e-3f, 1e-5f); DCHK(57, SUM[(((size_t)b * 32 + kc) * 1024 + c) * 2 + 1], h2, 1e-3f, 1e-4f); } }
        if (dk == 6) for (unsigned s = gid; s < 32768; s += NT_) { const unsigned h = dhash(s * 19 + 1); const int r = h % T, c = (h >> 15) % 1024;
            const float v = x[(size_t)r * 1024 + c] + ddot(MG + (size_t)r * 1024, WOUT + (size_t)c * 1024, 1024); DCHK(61, OUT[(size_t)r * 1024 + c], v, 0.02f, 0.02f); DCHK(62, dbf(H1B, (size_t)r * 1024 + c), v, 0.02f, 0.02f);
            if (c == 7) { float q = 0.f, q2 = 0.f; for (int j = 0; j < 1024; ++j) q += OUT[(size_t)r * 1024 + j] * OUT[(size_t)r * 1024 + j]; for (int j = 0; j < 16; ++j) q2 += SS1[(size_t)r * 16 + j]; DCHK(63, q2, q, 1e-3f, 0.f); } }
        if (dk == 7) for (unsigned s = gid; s < 32768; s += NT_) { const unsigned h = dhash(s * 23 + 1); const int r = h % T, c = (h >> 15) % 4096; float q2 = 0.f; for (int j = 0; j < 16; ++j) q2 += SS1[(size_t)r * 16 + j];
            const float u_ = ddot(H1B + (size_t)r * 1024, WUP + (size_t)c * 1024, 1024) / sqrtf(q2 / 1024.f + 1e-6f), rl = fmaxf(u_, 0.f); DCHK(71, dbf(U, (size_t)r * 4096 + c), rl * rl, 0.03f, 0.02f); }
        if (dk == 8) for (unsigned s = gid; s < 16384; s += NT_) { const unsigned h = dhash(s * 29 + 1); const int r = h % T, c = (h >> 15) % 1024;
            const float v = dbf(H1B, (size_t)r * 1024 + c) + ddot(U + (size_t)r * 4096, WDN + (size_t)c * 4096, 4096); DCHK(81, OUT[(size_t)r * 1024 + c], v, 0.02f, 0.04f);
            if (c == 7) { float q = 0.f, q2 = 0.f; for (int j = 0; j < 1024; ++j) q += OUT[(size_t)r * 1024 + j] * OUT[(size_t)r * 1024 + j]; for (int j = 0; j < 16; ++j) q2 += SS2[(size_t)r * 16 + j]; DCHK(82, q2, q, 1e-3f, 0.f); } }
        if (dk == 9) { for (unsigned s = gid; s < 4096; s += NT_) { const int r = dhash(s * 31) % T; float q = 0.f; for (int j = 0; j < 1024; ++j) { const float v = OUT[(size_t)r * 1024 + j] / args.in[18][j]; q += v * v; } DCHK(91, q / 1024.f, 1.0f, 0.01f, 0.f); } }
        if (dk == 10) { if (gid == 0) { const unsigned code = *DG; if (code < 1000u) OUT[0] = 100.0f + 10.0f * (float)code; OUT[1] = 10000.0f * (1.0f + (float)DG[1]); } }
        return;
    }
#endif
    if (IN(0)) {
        LAS float* scr = (LAS float*)(ldsg + wave * 16384);
        constexpr int I_W1 = 16 * (4864 / 32), I_UP = 16 * (4096 / 32), I_DN = 64 * (1024 / 32), I_OUT = 16 * 32, I_UQ = 4 * (1536 / 32), I_UKV = 4 * (2048 / 32), I_LRU = 16 * 16;
        constexpr int NITEMS = I_W1 + I_UP + I_DN + I_OUT + I_UQ + I_UKV + I_LRU;
        for (int it = gw; it < NITEMS; it += NGW) {
            int r = it;
            if (r < I_W1) { tr_item(args.in[2], 4672, 1024, 4864, args.in[1], W1, 0, scr, r, lane); continue; } r -= I_W1;
            if (r < I_UP) { tr_item(args.in[16], 4096, 1024, 4096, args.in[15], WUP, 2, scr, r, lane); continue; } r -= I_UP;
            if (r < I_DN) { tr_item(args.in[17], 1024, 4096, 1024, nullptr, WDN, 2, scr, r, lane); continue; } r -= I_DN;
            if (r < I_OUT) { tr_item(args.in[14], 1024, 1024, 1024, nullptr, WOUT, 2, scr, r, lane); continue; } r -= I_OUT;
            if (r < I_UQ) { tr_item(args.in[11], 1536, 256, 1536, args.in[10], WUQ, 1, scr, r, lane); continue; } r -= I_UQ;
            if (r < I_UKV) { tr_item(args.in[13], 2048, 256, 2048, args.in[12], WUKV, 2, scr, r, lane); continue; } r -= I_UKV;
            { const int blk = r >> 4, sub = r & 15, nb = blk >> 1, isx = blk & 1;
              tr_item((isx ? args.in[7] : args.in[5]) + (size_t)nb * 16384, 128, 256, 128, nullptr, WLRU + (size_t)(256 * nb + 128 * isx) * 256, 2, scr, sub, lane, 128 * (nb & 1), 128); }
        }
        for (int m = gw; m < T; m += NGW) {
            const f32x4* xr = (const f32x4*)(x + (size_t)m * DM) + lane; f32x4 v[4]; float s = 0.f;
#pragma unroll
            for (int j = 0; j < 4; ++j) { v[j] = xr[64 * j]; s += (v[j][0] * v[j][0] + v[j][1] * v[j][1]) + (v[j][2] * v[j][2] + v[j][3] * v[j][3]); }
            s = wave_sum(s);
            if (lane == 0) rstdx[m] = rsqrtf(s * (1.0f / 1024.0f) + 1e-6f);
            u32x2* o = (u32x2*)(XB + (size_t)m * DM) + lane;
#pragma unroll
            for (int j = 0; j < 4; ++j) { u32x2 w; w.x = pkbf(v[j][0], v[j][1]); w.y = pkbf(v[j][2], v[j][3]); o[64 * j] = w; }
        }
        for (int i = blockIdx.x * 512 + tid; i < SEQ * 32; i += G * 512) {
            const int pos = i >> 5, k = i & 31; double inv = 1.0; for (int q = 0; q < k; ++q) inv *= 0.74989420933245582730;
            float s, c; sincos_d((double)pos * inv, s, c); CS[2 * i] = c; CS[2 * i + 1] = s;
        }
        for (int i = blockIdx.x * 512 + tid; i < 1024; i += G * 512) csp[i] = 8.0f * 1.4426950408889634f * log1pf(__expf(-args.in[9][i]));
    }
    SEAM(0);

    if (IN(1)) {
        pg8::Gemm g{XB, W1, T, 4864, 1024, 1024, 1024, 0, 0}; pg8::StaticOrder S; S.init(T, 4864, G, (int)blockIdx.x);
        pg8::EpiIn E{ZX, G1, G2, ZC, rstdx};
        pg8::gemm_phase<pg8::EpiIn, pg8::StaticOrder, true, true>(ldsg, g, S, E);
    }
    SEAM(1);

    if (IN(2)) {
        const float* cw = args.in[3]; const float* cb = args.in[4];
        for (int it = gw; it < (T / 16) * 2; it += NGW) {
            const int t0 = (it >> 1) * 16, c0 = (it & 1) * 512 + lane * 8;
            float w[4][8], bias[8], h0[8], h1[8], h2[8];
#pragma unroll
            for (int j = 0; j < 4; ++j) { const f32x4 a = *(const f32x4*)(cw + j * 1024 + c0), b = *(const f32x4*)(cw + j * 1024 + c0 + 4);
#pragma unroll
                for (int e = 0; e < 4; ++e) { w[j][e] = a[e]; w[j][4 + e] = b[e]; } }
            { const f32x4 a = *(const f32x4*)(cb + c0), b = *(const f32x4*)(cb + c0 + 4);
#pragma unroll
              for (int e = 0; e < 4; ++e) { bias[e] = a[e]; bias[4 + e] = b[e]; } }
            const bool first = (t0 & (SEQ - 1)) == 0;
            { u32x4 r0 = {0u, 0u, 0u, 0u}, r1 = r0, r2 = r0;
              if (!first) { r0 = *(const u32x4*)(ZX + (size_t)(t0 - 3) * DM + c0); r1 = *(const u32x4*)(ZX + (size_t)(t0 - 2) * DM + c0); r2 = *(const u32x4*)(ZX + (size_t)(t0 - 1) * DM + c0); }
#pragma unroll
              for (int e = 0; e < 4; ++e) { h0[2 * e] = bflo(r0[e]); h0[2 * e + 1] = bfhi(r0[e]); h1[2 * e] = bflo(r1[e]); h1[2 * e + 1] = bfhi(r1[e]); h2[2 * e] = bflo(r2[e]); h2[2 * e + 1] = bfhi(r2[e]); } }
#pragma unroll 4
            for (int i = 0; i < 16; ++i) { const u32x4 r = *(const u32x4*)(ZX + (size_t)(t0 + i) * DM + c0); float cur[8], o[8];
#pragma unroll
                for (int e = 0; e < 4; ++e) { cur[2 * e] = bflo(r[e]); cur[2 * e + 1] = bfhi(r[e]); }
#pragma unroll
                for (int e = 0; e < 8; ++e) { o[e] = bias[e] + w[0][e] * h0[e] + w[1][e] * h1[e] + w[2][e] * h2[e] + w[3][e] * cur[e]; h0[e] = h1[e]; h1[e] = h2[e]; h2[e] = cur[e]; }
                u32x4 ow; ow.x = pkbf(o[0], o[1]); ow.y = pkbf(o[2], o[3]); ow.z = pkbf(o[4], o[5]); ow.w = pkbf(o[6], o[7]);
                *(u32x4*)(XA + (size_t)(t0 + i) * DM + c0) = ow; }
        }
        for (int m = gw; m < T; m += NGW) {
            const bf16_t* zr = ZC + (size_t)m * 768;
            const u32x2 a = *(const u32x2*)(zr + lane * 4), b = *(const u32x2*)(zr + 256 + lane * 4);
            float sq = (bflo(a.x) * bflo(a.x) + bfhi(a.x) * bfhi(a.x)) + (bflo(a.y) * bflo(a.y) + bfhi(a.y) * bfhi(a.y));
            float sk = (bflo(b.x) * bflo(b.x) + bfhi(b.x) * bfhi(b.x)) + (bflo(b.y) * bflo(b.y) + bfhi(b.y) * bfhi(b.y));
            sq = wave_sum(sq); sk = wave_sum(sk);
            if (lane == 0) { rstdq[m] = rsqrtf(sq * (1.0f / 256.0f) + 1e-6f); rstdkv[m] = rsqrtf(sk * (1.0f / 256.0f) + 1e-6f); }
            const int u = lane, i = 4 * (u >> 3) + (u & 3), half = (u >> 2) & 1;
            const float klo = pg8::bf2f(zr[512 + i]), khi = pg8::bf2f(zr[512 + i + 32]);
            const float c = CS[((size_t)(m & (SEQ - 1)) * 32 + i) * 2], s = CS[((size_t)(m & (SEQ - 1)) * 32 + i) * 2 + 1];
            const float v = half ? (khi * c + klo * s) : (klo * c - khi * s);
            const float vn = __shfl_xor(v, 1);
            if ((lane & 1) == 0) *(unsigned*)(KR + (size_t)m * 64 + u) = pkbf(v, vn);
        }
    }
    SEAM(2);

    if (IN(3)) {
#ifndef P3SEL
#define P3SEL 7
#endif
        if (P3SEL & 1) { pg8::Gemm g{XA, WLRU, T, 2048, 256, 1024, 256, 512, 1}; pg8::StaticOrder S; S.init(T, 2048, G, (int)blockIdx.x);
#ifdef TESTLRU
          pg8::EpiRowScale E{KV, 2048, rstdkv};
          pg8::gemm_phase<pg8::EpiRowScale, pg8::StaticOrder, true, true>(ldsg, g, S, E); }
#else
          pg8::EpiLru E{XA, args.in[6], args.in[8], csp, AB};
          pg8::gemm_phase<pg8::EpiLru, pg8::StaticOrder, true, true>(ldsg, g, S, E); }
#endif
        if (P3SEL & 2) { pg8::Gemm g{ZC, WUQ, T, 1536, 256, 768, 256, 0, 0}; pg8::StaticOrder S; S.init(T, 1536, G, (int)blockIdx.x);
          pg8::EpiQ E{Q, rstdq, CS};
          pg8::gemm_phase<pg8::EpiQ, pg8::StaticOrder, true, true>(ldsg, g, S, E); }
        if (P3SEL & 4) { pg8::Gemm g{ZC + 256, WUKV, T, 2048, 256, 768, 256, 0, 0}; pg8::StaticOrder S; S.init(T, 2048, G, (int)blockIdx.x);
          pg8::EpiRowScale E{KV, 2048, rstdkv};
          pg8::gemm_phase<pg8::EpiRowScale, pg8::StaticOrder, true, true>(ldsg, g, S, E); }
    }
    SEAM(3);

    if (IN(4)) {
        LAS float* sl = (LAS float*)ldsg;
        for (int un = blockIdx.x; un < 4 * 32 * 8; un += G) {
            const int cb = un & 7, k = (un >> 3) & 31, b = un >> 8, c = cb * 128 + lane * 2;
            const size_t row0 = (size_t)b * SEQ + k * 256 + wave * 32;
            const unsigned* ap = AB + row0 * DM + c;
            float h0 = 0.f, h1 = 0.f, L0 = 0.f, L1 = 0.f;
#pragma unroll 8
            for (int i = 0; i < 32; ++i) { const h16x4 w = *(const h16x4*)(ap + (size_t)i * DM);
                const float l0 = (float)w[0], l1 = (float)w[2];
                h0 = __builtin_amdgcn_exp2f(l0) * h0 + (float)w[1]; h1 = __builtin_amdgcn_exp2f(l1) * h1 + (float)w[3]; L0 += l0; L1 += l1; }
            *(f32x4*)(SUB + (((size_t)b * 256 + k * 8 + wave) * 1024 + c) * 2) = (f32x4){L0, h0, L1, h1};
            *(LAS f32x4*)(sl + (wave * 128 + lane * 2) * 2) = (f32x4){L0, h0, L1, h1};
            __syncthreads();
            if (wave == 0) { float Lc0 = 0.f, Hc0 = 0.f, Lc1 = 0.f, Hc1 = 0.f;
#pragma unroll
                for (int s = 0; s < 8; ++s) { const f32x4 v = *(LAS f32x4*)(sl + (s * 128 + lane * 2) * 2);
                    Hc0 = __builtin_amdgcn_exp2f(v[0]) * Hc0 + v[1]; Lc0 += v[0]; Hc1 = __builtin_amdgcn_exp2f(v[2]) * Hc1 + v[3]; Lc1 += v[2]; }
                *(f32x4*)(SUM + (((size_t)b * 32 + k) * 1024 + c) * 2) = (f32x4){Lc0, Hc0, Lc1, Hc1}; }
            __syncthreads();
        }
        {
            constexpr int NITEM = 32 * 16;
            int L = blockIdx.x;
            if (L < NITEM) {
                att::Seam S; int pass = 0;
#define MKREF(r, LL, ps) do { const int bh_ = (LL) >> 4, xx_ = (LL) & 15, qb_ = (ps) ? 31 - xx_ : xx_, b_ = bh_ >> 3, h_ = bh_ & 7; \
                    const size_t row0_ = (size_t)b_ * SEQ + qb_ * 256, key0_ = (size_t)b_ * SEQ; \
                    r.Qn = Q + row0_ * 1536 + h_ * 128; r.Qr = Q + row0_ * 1536 + 1024 + h_ * 64; r.Kn = KV + key0_ * 2048 + h_ * 256; r.V = r.Kn + 128; r.Kr = KR + key0_ * 64; \
                    r.O = YB + row0_ * 1024 + h_ * 128; r.P0 = qb_ * 256; } while (0)
                att::BlockRef cur, nxt; MKREF(cur, L, 0);
                att::attn_prime(cur, (char*)lds, S);
                for (;;) {
                    const bool more_pass = pass == 0, more_item = L + G < NITEM, last = !more_pass && !more_item;
                    int passn = pass + 1, Ln = L;
                    if (!more_pass) { passn = 0; Ln = more_item ? L + G : L; }
                    MKREF(nxt, Ln, passn);
                    att::attn_block(cur, nxt, (char*)lds, S);
                    if (last) break;
                    cur = nxt; pass = passn; L = Ln;
                }
#undef MKREF
            }
        }
    }
    SEAM(4);

    if (IN(5)) {
        for (int un = blockIdx.x; un < 4 * 32 * 8; un += G) {
            const int cb = un & 7, k = (un >> 3) & 31, b = un >> 8, c = cb * 128 + lane * 2;
            float h0 = 0.f, h1 = 0.f;
            for (int kk = 0; kk < k; ++kk) { const f32x4 v = *(const f32x4*)(SUM + (((size_t)b * 32 + kk) * 1024 + c) * 2);
                h0 = __builtin_amdgcn_exp2f(v[0]) * h0 + v[1]; h1 = __builtin_amdgcn_exp2f(v[2]) * h1 + v[3]; }
            for (int s = 0; s < wave; ++s) { const f32x4 v = *(const f32x4*)(SUB + (((size_t)b * 256 + k * 8 + s) * 1024 + c) * 2);
                h0 = __builtin_amdgcn_exp2f(v[0]) * h0 + v[1]; h1 = __builtin_amdgcn_exp2f(v[2]) * h1 + v[3]; }
            const size_t row0 = (size_t)b * SEQ + k * 256 + wave * 32;
#pragma unroll 8
            for (int i = 0; i < 32; ++i) { const size_t off = (row0 + i) * DM + c;
                const h16x4 w = *(const h16x4*)(AB + off);
                const unsigned g1 = *(const unsigned*)(G1 + off), g2 = *(const unsigned*)(G2 + off), yb = *(const unsigned*)(YB + off);
                h0 = __builtin_amdgcn_exp2f((float)w[0]) * h0 + (float)w[1]; h1 = __builtin_amdgcn_exp2f((float)w[2]) * h1 + (float)w[3];
                *(unsigned*)(MG + off) = pkbf(bflo(g1) * h0 + bflo(g2) * bflo(yb), bfhi(g1) * h1 + bfhi(g2) * bfhi(yb)); }
        }
    }
    SEAM(5);

    if (IN(6)) {
        pg8::Gemm g{MG, WOUT, T, 1024, 1024, 1024, 1024, 0, 0}; pg8::StaticOrder S; S.init(T, 1024, G, (int)blockIdx.x);
        pg8::EpiRes<true> E{x, OUT, H1B, SS1};
        pg8::gemm_phase<pg8::EpiRes<true>, pg8::StaticOrder, true, true>(ldsg, g, S, E);
    }
    SEAM(6);

    if (IN(7)) {
        pg8::Gemm g{H1B, WUP, T, 4096, 1024, 1024, 1024, 0, 0}; pg8::StaticOrder S; S.init(T, 4096, G, (int)blockIdx.x);
        pg8::EpiUp E{U, SS1};
        pg8::gemm_phase<pg8::EpiUp, pg8::StaticOrder, true, true>(ldsg, g, S, E);
    }
    SEAM(7);

    if (IN(8)) {
        pg8::Gemm g{U, WDN, T, 1024, 4096, 4096, 4096, 0, 0}; pg8::StaticOrder S; S.init(T, 1024, G, (int)blockIdx.x);
        pg8::EpiRes<false> E{OUT, OUT, nullptr, SS2};
        pg8::gemm_phase<pg8::EpiRes<false>, pg8::StaticOrder, true, true>(ldsg, g, S, E);
    }
    SEAM(8);

    if (IN(9)) {
        const float* gf = args.in[18];
        for (int m = gw; m < T; m += NGW) {
            const f32x4* sp = (const f32x4*)(SS2 + (size_t)m * 16); const f32x4 s = (sp[0] + sp[1]) + (sp[2] + sp[3]);
            const float rs = rsqrtf(((s[0] + s[1]) + (s[2] + s[3])) * (1.0f / 1024.0f) + 1e-6f);
            f32x4* o = (f32x4*)(OUT + (size_t)m * DM) + lane;
#pragma unroll
            for (int j = 0; j < 4; ++j) { const f32x4 gv = ((const f32x4*)gf)[lane + 64 * j]; o[64 * j] = o[64 * j] * rs * gv; }
        }
    }
#undef IN
#undef SEAM
}

constexpr int LDS_TOTAL = 153600;
static_assert(att::LDS_BYTES <= LDS_TOTAL && pg8::STAGE_BYTES <= LDS_TOTAL, "LDS");
extern "C" void kernel_launch(void* const* d_in, const int* in_sizes, int n_in, void* d_out, int out_size, void* d_ws, size_t ws_size, hipStream_t stream) {
    static int grid = 0;
    if (grid == 0) {
        if (n_in != 19 || out_size != T * DM || ws_size < WS_END) { fprintf(stderr, "kernel_launch: unexpected shapes (n_in %d, out %d, ws %zu)\n", n_in, out_size, ws_size); grid = -1; return; }
        int dev = 0, cus = 0, per_cu = 0;
        (void)hipGetDevice(&dev); (void)hipDeviceGetAttribute(&cus, hipDeviceAttributeMultiprocessorCount, dev);
        if (hipFuncSetAttribute((const void*)fwd_kernel, hipFuncAttributeMaxDynamicSharedMemorySize, LDS_TOTAL) != hipSuccess) { fprintf(stderr, "kernel_launch: hipFuncSetAttribute failed\n"); grid = -1; return; }
        if (hipOccupancyMaxActiveBlocksPerMultiprocessor(&per_cu, (const void*)fwd_kernel, 512, LDS_TOTAL) != hipSuccess || per_cu < 1) { fprintf(stderr, "kernel_launch: occupancy query says %d\n", per_cu); per_cu = 1; }
        (void)hipGetLastError();
        grid = cus * 1;
        if (grid <= 0) grid = 256;
    }
    if (grid < 0) return;
    Args a{};
    for (int i = 0; i < 19; ++i) a.in[i] = (const float*)d_in[i];
    a.out = (float*)d_out; a.ws = (unsigned char*)d_ws;
#if N_LAUNCHES == 1
    a.ph_lo = 0; a.ph_hi = NPHASE;
    void* kargs[] = {&a};
    hipError_t e = hipLaunchCooperativeKernel((const void*)fwd_kernel, dim3(grid), dim3(512), kargs, LDS_TOTAL, stream);
    if (e != hipSuccess) fprintf(stderr, "kernel_launch: cooperative launch failed: %s (grid %d)\n", hipGetErrorString(e), grid);
#else
#ifdef DIAG
    (void)hipMemsetAsync((unsigned char*)d_ws + WS_CSP + 8192, 0x7f, 4, stream); (void)hipMemsetAsync((unsigned char*)d_ws + WS_CSP + 8196, 0, 4, stream);
#endif
    for (int p = 0; p < NPHASE; ++p) { a.ph_lo = p; a.ph_hi = p + 1;
        hipLaunchKernelGGL(fwd_kernel, dim3(grid), dim3(512), LDS_TOTAL, stream, a);
#ifdef DIAG
        a.ph_lo = 100 + p; a.ph_hi = 101 + p; hipLaunchKernelGGL(fwd_kernel, dim3(grid), dim3(512), LDS_TOTAL, stream, a);
        if (p == NPHASE - 1) { a.ph_lo = 110; a.ph_hi = 111; hipLaunchKernelGGL(fwd_kernel, dim3(grid), dim3(512), LDS_TOTAL, stream, a); }
#endif
        if (hipPeekAtLastError() != hipSuccess) { fprintf(stderr, "kernel_launch: launch %d failed\n", p); break; } }
#endif
}
```

```cpp
#define N_LAUNCHES 1
#include <hip/hip_runtime.h>
#include <hip/hip_cooperative_groups.h>
#include <cstdio>
#include <cstdint>
namespace cg = cooperative_groups;
namespace pg8 {
#define PG8_LAS __attribute__((address_space(3)))
typedef unsigned short bf16_t;
typedef short bf16x8 __attribute__((ext_vector_type(8)));
typedef float f32x4 __attribute__((ext_vector_type(4)));
typedef unsigned u32x4 __attribute__((ext_vector_type(4)));
constexpr int BM = 256, BK = 64, HALF = 128, HTB = HALF * BK * 2  , STAGE_BYTES = 8 * HTB, NXCD = 8, WGM = 8;

__host__ __device__ __forceinline__ int lds_byte(int r, int c) { const int st = (r >> 4) * 2 + (c >> 5), rr = r & 15, cc = c & 31, ob = rr * 64 + cc * 2; return st * 1024 + (ob ^ (((ob >> 9) & 1) << 5)); }
__host__ __device__ __forceinline__ void stage_rc(int b, int& R, int& C) { const int st = b / 1024, sb = b % 1024, swz = sb ^ (((sb >> 9) & 1) << 5); R = (st >> 1) * 16 + swz / 64; C = (st & 1) * 32 + (swz % 64) / 2; }
__host__ __device__ __forceinline__ int perm32(int rho) { const int n = rho >> 4, i = rho & 15; return 8 * (i >> 2) + 4 * n + (i & 3); }

struct Unit { int pm, pn; };
struct Gemm { const bf16_t* A; const bf16_t* Bt; int M, N, K, lda, ldb; long a_pn_bytes; int a_pn_shift; };

struct StaticOrder {
    int nM, nN, nwg, G, c;
    __host__ __device__ void init(int M, int N, int G_, int c_) { nM = M / BM; nN = N / BM; nwg = nM * nN; G = G_; c = c_; }
    __host__ __device__ bool next(int i, Unit& u) const {
        const long L = (long)i * G + c; if (L >= nwg) return false;
        int wgid = (int)L; { const int q = nwg / NXCD, r = nwg % NXCD, xcd = wgid % NXCD, off = wgid / NXCD; wgid = (xcd < r ? xcd * (q + 1) : r * (q + 1) + (xcd - r) * q) + off; }
        const int nig = WGM * nN, gid = wgid / nig, fm = gid * WGM, gsz = (nM - fm) < WGM ? (nM - fm) : WGM;
        u.pm = fm + ((wgid % nig) % gsz); u.pn = (wgid % nig) / gsz; return true;
    }
    __device__ __forceinline__ void a_ready(const Unit&) const {}
    __device__ __forceinline__ void done(const Unit&) const {}
};

__device__ __forceinline__ unsigned cvt_pk_bf16(float lo, float hi) { unsigned r; asm volatile("v_cvt_pk_bf16_f32 %0, %1, %2" : "=v"(r) : "v"(lo), "v"(hi)); return r; }
typedef float f32x2 __attribute__((ext_vector_type(2)));
typedef unsigned u32x2 __attribute__((ext_vector_type(2)));
typedef _Float16 h16x2 __attribute__((ext_vector_type(2)));
__device__ __forceinline__ float fsigmoid(float v) { return __builtin_amdgcn_rcpf(1.0f + __expf(-v)); }
__device__ __forceinline__ float gelu_tanh(float v) { const float y = 1.5957691216057308f * (v + 0.044715f * v * v * v); return v * fsigmoid(y); }
__device__ __forceinline__ u32x4 pack8f(const f32x4 a, const f32x4 b) { u32x4 w; w.x = cvt_pk_bf16(a[0], a[1]); w.y = cvt_pk_bf16(a[2], a[3]); w.z = cvt_pk_bf16(b[0], b[1]); w.w = cvt_pk_bf16(b[2], b[3]); return w; }
__device__ __forceinline__ float bf2f(unsigned short b) { return __uint_as_float((unsigned)b << 16); }

struct EpiIn {
    static constexpr bool PERM = true, AFTER_DRAIN = false;
    bf16_t *ZX, *G1, *G2, *ZC; const float* rstd; float *SSQ, *SSKV; bf16_t* KR; const float* CS;
    __device__ __forceinline__ void operator()(const f32x4 (&acc)[2][2][4][2], const Unit& u, int wr, int wc, int fr, int fq) const {
        const int row0 = u.pm * BM + wr * 64 + fr, cl = wc * 32 + 8 * fq, pn = u.pn;
#pragma unroll
        for (int ai = 0; ai < 2; ++ai)
#pragma unroll
            for (int m = 0; m < 4; ++m) { const int row = row0 + ai * HALF + m * 16; const float rs = rstd[row];
                if (pn >= 4 && pn < 12) {
                    f32x4 o[2];
#pragma unroll
                    for (int n = 0; n < 2; ++n)
#pragma unroll
                        for (int e = 0; e < 4; ++e) o[n][e] = gelu_tanh(acc[ai][0][m][n][e] * rs) * fsigmoid(acc[ai][1][m][n][e] * rs);
                    __builtin_nontemporal_store(pack8f(o[0], o[1]), (u32x4*)(G1 + (size_t)row * 1024 + (pn - 4) * 128 + cl));
                } else {
#pragma unroll
                    for (int bj = 0; bj < 2; ++bj) { f32x4 v0 = acc[ai][bj][m][0] * rs, v1 = acc[ai][bj][m][1] * rs;
                        if (pn < 4) *(u32x4*)(ZX + (size_t)row * 1024 + pn * 256 + bj * HALF + cl) = pack8f(v0, v1);
                        else if (pn < 16) {
#pragma unroll
                            for (int e = 0; e < 4; ++e) { v0[e] = fsigmoid(v0[e]); v1[e] = fsigmoid(v1[e]); }
                            __builtin_nontemporal_store(pack8f(v0, v1), (u32x4*)(G2 + (size_t)row * 1024 + (pn - 12) * 256 + bj * HALF + cl));
                        } else if (pn < 18) *(u32x4*)(ZC + (size_t)row * 768 + (pn - 16) * 256 + bj * HALF + cl) = pack8f(v0, v1);
                        else if (bj == 0 && wc < 2) {
                            const float* cs = CS + ((size_t)(row & 8191) * 32 + 16 * wc + 4 * fq) * 2;
                            const f32x4 c01 = *(const f32x4*)cs, c23 = *(const f32x4*)(cs + 4);
                            const float co[4] = {c01[0], c01[2], c23[0], c23[2]}, si[4] = {c01[1], c01[3], c23[1], c23[3]}; f32x4 olo, ohi;
#pragma unroll
                            for (int e2 = 0; e2 < 4; ++e2) { olo[e2] = v0[e2] * co[e2] - v1[e2] * si[e2]; ohi[e2] = v1[e2] * co[e2] + v0[e2] * si[e2]; }
                            *(u32x4*)(KR + (size_t)row * 64 + cl) = pack8f(olo, ohi); }
                    }
                    if (pn == 16 || pn == 17) {
                        float ss = 0.f;
#pragma unroll
                        for (int bj = 0; bj < 2; ++bj)
#pragma unroll
                            for (int n = 0; n < 2; ++n) { const f32x4 z = acc[ai][bj][m][n] * rs; ss += (z[0] * z[0] + z[1] * z[1]) + (z[2] * z[2] + z[3] * z[3]); }
                        ss += __shfl_xor(ss, 16); ss += __shfl_xor(ss, 32);
                        if (fq == 0) (pn == 16 ? SSQ : SSKV)[(size_t)row * 4 + wc] = ss; }
                }
            }
    }
};
__device__ __forceinline__ float one_minus_exp(float x) {
    const float p = -x * (1.0f + x * (0.5f + x * (0.16666667f + x * (0.041666668f + x * 0.0083333338f))));
    const float q = 1.0f - __builtin_amdgcn_exp2f(x * 1.4426950408889634f);
    return x > -0.2f ? p : q;
}
struct EpiLru {
    static constexpr bool PERM = true, AFTER_DRAIN = false;
    const bf16_t* XA; const float *ba, *bx, *csp; unsigned* AB;
    __device__ __forceinline__ void operator()(const f32x4 (&acc)[2][2][4][2], const Unit& u, int wr, int wc, int fr, int fq) const {
        const int c0 = u.pn * 128 + wc * 32 + 8 * fq;
        const unsigned lo = (unsigned)((wr * 64 + fr) * 1024 + c0);
        const char* xau = (const char*)(XA + (size_t)u.pm * BM * 1024); char* abu = (char*)(AB + (size_t)u.pm * BM * 1024);
#pragma unroll
        for (int n = 0; n < 2; ++n) {

#ifdef NOBIAS
 const f32x4 vba = {0.f,0.f,0.f,0.f}, vbx = vba, vcs = {1.f,1.f,1.f,1.f};
#else
 const f32x4 vba = *(const f32x4*)(ba + c0 + 4 * n), vbx = *(const f32x4*)(bx + c0 + 4 * n), vcs = *(const f32x4*)(csp + c0 + 4 * n);
#endif

#pragma unroll
            for (int ai = 0; ai < 2; ++ai)
#pragma unroll
                for (int m = 0; m < 4; ++m) { const int ro = (ai * HALF + m * 16) * 1024 + 4 * n;

#ifdef NOXA
 const u32x2 xw = {0x3f803f80u, 0x3f803f80u};
#else
 const u32x2 xw = *(const u32x2*)(xau + (size_t)ro * 2 + lo * 2u);
#endif
 u32x4 ow;
#pragma unroll
                    for (int e = 0; e < 4; ++e) { const unsigned w = xw[e >> 1]; const float xa = __uint_as_float((e & 1) ? (w & 0xffff0000u) : (w << 16));
                        const float r = fsigmoid(acc[ai][0][m][n][e] + vba[e]), ig = fsigmoid(acc[ai][1][m][n][e] + vbx[e]);
                        const float la2 = -vcs[e] * r; const float b = __builtin_amdgcn_sqrtf(fmaxf(1.0f - __builtin_amdgcn_exp2f(2.0f * la2), 0.f)) * (ig * xa);
                        h16x2 hv; hv.x = (_Float16)la2; hv.y = (_Float16)b; ow[e] = __builtin_bit_cast(unsigned, hv); }
                    *(u32x4*)(abu + (size_t)ro * 4 + lo * 4u) = ow;
                    __builtin_amdgcn_sched_barrier(0); }
        }
    }
};
struct EpiQ {
    static constexpr bool PERM = true, AFTER_DRAIN = false;
    bf16_t* Q; const float* SSp; const float* CS;
    __device__ __forceinline__ void operator()(const f32x4 (&acc)[2][2][4][2], const Unit& u, int wr, int wc, int fr, int fq) const {
        const int row0 = u.pm * BM + wr * 64 + fr, cl = wc * 32 + 8 * fq, pn = u.pn;
#pragma unroll
        for (int ai = 0; ai < 2; ++ai)
#pragma unroll
            for (int m = 0; m < 4; ++m) { const int row = row0 + ai * HALF + m * 16; const f32x4 sp = *(const f32x4*)(SSp + (size_t)row * 4); const float rs = rsqrtf(((sp[0] + sp[1]) + (sp[2] + sp[3])) * (1.0f / 256.0f) + 1e-6f);
                bf16_t* op = Q + (size_t)row * 1536 + pn * 256 + cl;
                if (pn < 4) {
#pragma unroll
                    for (int bj = 0; bj < 2; ++bj) *(u32x4*)(op + bj * HALF) = pack8f(acc[ai][bj][m][0] * rs, acc[ai][bj][m][1] * rs);
                } else {
                    const float* cs = CS + ((size_t)(row & 8191) * 32 + 16 * (wc & 1) + 4 * fq) * 2;
                    const f32x4 c01 = *(const f32x4*)cs, c23 = *(const f32x4*)(cs + 4);
                    const float co[4] = {c01[0], c01[2], c23[0], c23[2]}, si[4] = {c01[1], c01[3], c23[1], c23[3]};
#pragma unroll
                    for (int bj = 0; bj < 2; ++bj) { const f32x4 lo = acc[ai][bj][m][0] * rs, hi = acc[ai][bj][m][1] * rs; f32x4 olo, ohi;
#pragma unroll
                        for (int e = 0; e < 4; ++e) { olo[e] = lo[e] * co[e] - hi[e] * si[e]; ohi[e] = hi[e] * co[e] + lo[e] * si[e]; }
                        *(u32x4*)(op + bj * HALF) = pack8f(olo, ohi); }
                }
            }
    }
};
struct EpiRowScale {
    static constexpr bool PERM = true, AFTER_DRAIN = false;
    bf16_t* O; int ldc; const float* SSp;
    __device__ __forceinline__ void operator()(const f32x4 (&acc)[2][2][4][2], const Unit& u, int wr, int wc, int fr, int fq) const {
        const int row0 = u.pm * BM + wr * 64 + fr, cl = u.pn * 256 + wc * 32 + 8 * fq;
#pragma unroll
        for (int ai = 0; ai < 2; ++ai)
#pragma unroll
            for (int m = 0; m < 4; ++m) { const int row = row0 + ai * HALF + m * 16; const f32x4 sp = *(const f32x4*)(SSp + (size_t)row * 4); const float rs = rsqrtf(((sp[0] + sp[1]) + (sp[2] + sp[3])) * (1.0f / 256.0f) + 1e-6f);
#pragma unroll
                for (int bj = 0; bj < 2; ++bj) *(u32x4*)(O + (size_t)row * ldc + cl + bj * HALF) = pack8f(acc[ai][bj][m][0] * rs, acc[ai][bj][m][1] * rs);
            }
    }
};
template <bool BASE_F32> struct EpiRes {
    static constexpr bool PERM = false, AFTER_DRAIN = false;
    const float* basef; const bf16_t* baseb; bf16_t* outb; float* SS;
    __device__ __forceinline__ void operator()(const f32x4 (&acc)[2][2][4][2], const Unit& u, int wr, int wc, int fr, int fq) const {
        const int row0 = u.pm * BM + wr * 64 + fr, col0 = u.pn * 256 + wc * 32 + 4 * fq;
#pragma unroll
        for (int ai = 0; ai < 2; ++ai)
#pragma unroll
            for (int m = 0; m < 4; ++m) { const int row = row0 + ai * HALF + m * 16; const size_t off = (size_t)row * 1024 + col0; float ss = 0.f;
#pragma unroll
                for (int bj = 0; bj < 2; ++bj)
#pragma unroll
                    for (int n = 0; n < 2; ++n) { const size_t o2 = off + bj * HALF + n * 16; f32x4 h;
                        if (BASE_F32) h = __builtin_nontemporal_load((const f32x4*)(basef + o2)) + acc[ai][bj][m][n];
                        else { const u32x2 bw = *(const u32x2*)(baseb + o2); h = (f32x4){__uint_as_float(bw.x << 16), __uint_as_float(bw.x & 0xffff0000u), __uint_as_float(bw.y << 16), __uint_as_float(bw.y & 0xffff0000u)} + acc[ai][bj][m][n]; }
                        ss += (h[0] * h[0] + h[1] * h[1]) + (h[2] * h[2] + h[3] * h[3]);
                        u32x2 w; w.x = cvt_pk_bf16(h[0], h[1]); w.y = cvt_pk_bf16(h[2], h[3]); *(u32x2*)(outb + o2) = w; }
                ss += __shfl_xor(ss, 16); ss += __shfl_xor(ss, 32);
                if (fq == 0) SS[(size_t)row * 16 + u.pn * 4 + wc] = ss;
            }
    }
};
struct EpiUp {
    static constexpr bool PERM = true, AFTER_DRAIN = false;
    bf16_t* U; const float* SS;
    __device__ __forceinline__ void operator()(const f32x4 (&acc)[2][2][4][2], const Unit& u, int wr, int wc, int fr, int fq) const {
        const int row0 = u.pm * BM + wr * 64 + fr, cl = u.pn * 256 + wc * 32 + 8 * fq;
#pragma unroll
        for (int ai = 0; ai < 2; ++ai)
#pragma unroll
            for (int m = 0; m < 4; ++m) { const int row = row0 + ai * HALF + m * 16;
                const f32x4* sp = (const f32x4*)(SS + (size_t)row * 16); const f32x4 s = (sp[0] + sp[1]) + (sp[2] + sp[3]);
                const float rs = rsqrtf(((s[0] + s[1]) + (s[2] + s[3])) * (1.0f / 1024.0f) + 1e-6f);
#pragma unroll
                for (int bj = 0; bj < 2; ++bj) { f32x4 v0 = acc[ai][bj][m][0] * rs, v1 = acc[ai][bj][m][1] * rs;
#pragma unroll
                    for (int e = 0; e < 4; ++e) { const float a = fmaxf(v0[e], 0.f), b = fmaxf(v1[e], 0.f); v0[e] = a * a; v1[e] = b * b; }
                    *(u32x4*)(U + (size_t)row * 4096 + cl + bj * HALF) = pack8f(v0, v1); }
            }
    }
};
template <class Epi, class Sched, bool ALIGN_EPI = false, bool SP2 = false>
__device__ __forceinline__ void gemm_phase(PG8_LAS unsigned char* lds, const Gemm g, const Sched& S, const Epi& E, const int tid0) {
    int tid_ = tid0; asm volatile("" : "+v"(tid_));
    const int tid = tid_, wid = __builtin_amdgcn_readfirstlane(tid >> 6), lane = tid & 63, wr = wid >> 2, wc = wid & 3, fr = lane & 15, fq = lane >> 4;
    int K_ = g.K; asm volatile("" : "+s"(K_));
    const int K = K_, nt = K / BK;
    unsigned voffA[2], voffB[2];
#pragma unroll
    for (int i = 0; i < 2; ++i) { int R, C; stage_rc(tid * 16 + i * 8192, R, C); const int Rb = Epi::PERM ? ((R & ~31) + perm32(R & 31)) : R;
        voffA[i] = (unsigned)(R * g.lda + C) * 2u; voffB[i] = (unsigned)(Rb * g.ldb + C) * 2u; }
    const size_t kstep = (size_t)(BK * 2);
    const size_t hstepA = (size_t)HALF * g.lda * 2, hstepB = (size_t)HALF * g.ldb * 2;
    const size_t tstepA = 2 * hstepA, tstepB = 2 * hstepB;
    const unsigned ldsw = (unsigned)wid * 1024u;
    const int aoff = lds_byte(wr * 64 + fr, fq * 8), boff = lds_byte(wc * 32 + fr, fq * 8);
#define PG8_SA(b, h) (((b) * 2 + (h)) * HTB)
#define PG8_SB(b, h) ((4 + (b) * 2 + (h)) * HTB)
#define PG8_STAGE(bufoff, gbase, voff) do { _Pragma("unroll") for (int _i = 0; _i < 2; ++_i) \
        __builtin_amdgcn_global_load_lds((const unsigned*)((const char*)(gbase) + (voff)[_i]), (PG8_LAS unsigned*)(lds + (bufoff) + ldsw + _i * 8192), 16, 0, 0); } while (0)
#define PG8_LDA(dst, b, h) do { _Pragma("unroll") for (int m = 0; m < 4; ++m) _Pragma("unroll") for (int k = 0; k < 2; ++k) dst[m][k] = *(const PG8_LAS bf16x8*)(lds + PG8_SA(b, h) + aoff + m * 2048 + k * 1024); } while (0)
#define PG8_LDB(dst, b, h) do { _Pragma("unroll") for (int n = 0; n < 2; ++n) _Pragma("unroll") for (int k = 0; k < 2; ++k) dst[n][k] = *(const PG8_LAS bf16x8*)(lds + PG8_SB(b, h) + boff + n * 2048 + k * 1024); } while (0)
#define PG8_MMA(ai, bj, At, Bt) do { __builtin_amdgcn_s_setprio(1); _Pragma("unroll") for (int m = 0; m < 4; ++m) _Pragma("unroll") for (int n = 0; n < 2; ++n) _Pragma("unroll") for (int k = 0; k < 2; ++k) \
        acc[ai][bj][m][n] = __builtin_amdgcn_mfma_f32_16x16x32_bf16(Bt[n][k], At[m][k], acc[ai][bj][m][n], 0, 0, 0); __builtin_amdgcn_s_setprio(0); } while (0)
#define PG8_WAIT_V(n) asm volatile("s_waitcnt vmcnt(" #n ")" ::: "memory")
#define PG8_WAIT_L(n) asm volatile("s_waitcnt lgkmcnt(" #n ")" ::: "memory")
#define PG8_BAR __builtin_amdgcn_s_barrier()
#define PG8_SCHED __builtin_amdgcn_sched_barrier(0)
    Unit cur, nxt; int ui = 0;
    if (!S.next(0, cur)) return;
    f32x4 acc[2][2][4][2];
#pragma unroll
    for (int a = 0; a < 2; ++a)
#pragma unroll
        for (int b = 0; b < 2; ++b)
#pragma unroll
            for (int m = 0; m < 4; ++m)
#pragma unroll
                for (int n = 0; n < 2; ++n) acc[a][b][m][n] = (f32x4){0.f, 0.f, 0.f, 0.f};
    bf16x8 At[4][2], B0[2][2], B1[2][2];
    const char* cA = (const char*)g.A + (size_t)cur.pm * tstepA + (size_t)(cur.pn >> g.a_pn_shift) * g.a_pn_bytes; const char* cB = (const char*)g.Bt + (size_t)cur.pn * tstepB;
    S.a_ready(cur);
    if constexpr (SP2) {
        PG8_STAGE(PG8_SB(0, 0), cB, voffB); PG8_STAGE(PG8_SB(0, 1), cB + hstepB, voffB); PG8_STAGE(PG8_SA(0, 0), cA, voffA); PG8_STAGE(PG8_SA(0, 1), cA + hstepA, voffA);
        if (wr == 1) PG8_BAR;
        PG8_WAIT_V(2); PG8_BAR;
        PG8_STAGE(PG8_SB(1, 0), cB + kstep, voffB); PG8_STAGE(PG8_SA(1, 0), cA + kstep, voffA); PG8_STAGE(PG8_SB(1, 1), cB + hstepB + kstep, voffB);
        PG8_WAIT_V(6); PG8_BAR;
    } else {
        PG8_STAGE(PG8_SB(0, 0), cB, voffB); PG8_STAGE(PG8_SA(0, 0), cA, voffA); PG8_STAGE(PG8_SB(0, 1), cB + hstepB, voffB); PG8_STAGE(PG8_SA(0, 1), cA + hstepA, voffA);
        if (wr == 1) PG8_BAR;
        PG8_WAIT_V(4); PG8_BAR;
        PG8_STAGE(PG8_SB(1, 0), cB + kstep, voffB); PG8_STAGE(PG8_SA(1, 0), cA + kstep, voffA); PG8_STAGE(PG8_SB(1, 1), cB + hstepB + kstep, voffB);
        PG8_WAIT_V(6); PG8_BAR;
    }
    for (;;) {
        const bool has_next = S.next(ui + 1, nxt);
        const char* nA = has_next ? (const char*)g.A + (size_t)nxt.pm * tstepA + (size_t)(nxt.pn >> g.a_pn_shift) * g.a_pn_bytes : cA; const char* nB = has_next ? (const char*)g.Bt + (size_t)nxt.pn * tstepB : cB;
        for (int t = 0; t < nt; t += 2) {
            const bool last = (t == nt - 2);
            const char* a1 = cA + (size_t)(t + 1) * kstep;
            const char* a2 = last ? nA : cA + (size_t)(t + 2) * kstep; const char* b2 = last ? nB : cB + (size_t)(t + 2) * kstep;
            const char* a3 = a2 + kstep; const char* b3 = b2 + kstep;
            if (last && has_next) S.a_ready(nxt);
            if constexpr (SP2) {
            PG8_LDB(B0, 0, 0); PG8_LDB(B1, 0, 1); PG8_SCHED; PG8_LDA(At, 0, 0); PG8_STAGE(PG8_SA(1, 1), a1 + hstepA, voffA);
            PG8_WAIT_V(8); PG8_WAIT_L(0); PG8_BAR; PG8_MMA(0, 0, At, B0); PG8_MMA(0, 1, At, B1); PG8_BAR; PG8_SCHED;
            PG8_LDA(At, 0, 1); PG8_STAGE(PG8_SB(0, 0), b2, voffB); PG8_STAGE(PG8_SB(0, 1), b2 + hstepB, voffB); PG8_STAGE(PG8_SA(0, 0), a2, voffA);
            PG8_WAIT_V(8); PG8_WAIT_L(0); PG8_BAR; PG8_MMA(1, 0, At, B0); PG8_MMA(1, 1, At, B1); PG8_BAR; PG8_SCHED;
            PG8_LDB(B0, 1, 0); PG8_LDB(B1, 1, 1); PG8_SCHED; PG8_LDA(At, 1, 0); PG8_STAGE(PG8_SA(0, 1), a2 + hstepA, voffA);
            PG8_WAIT_V(8); PG8_WAIT_L(0); PG8_BAR; PG8_MMA(0, 0, At, B0); PG8_MMA(0, 1, At, B1); PG8_BAR; PG8_SCHED;
            PG8_LDA(At, 1, 1); PG8_STAGE(PG8_SB(1, 0), b3, voffB); PG8_STAGE(PG8_SB(1, 1), b3 + hstepB, voffB); PG8_STAGE(PG8_SA(1, 0), a3, voffA);
            PG8_WAIT_V(8); PG8_WAIT_L(0); PG8_BAR; PG8_MMA(1, 0, At, B0); PG8_MMA(1, 1, At, B1); PG8_BAR; PG8_SCHED;
            } else {
            PG8_LDB(B0, 0, 0); PG8_SCHED; PG8_LDA(At, 0, 0); PG8_STAGE(PG8_SA(1, 1), a1 + hstepA, voffA);
            PG8_WAIT_L(8); PG8_BAR; PG8_WAIT_L(0); PG8_MMA(0, 0, At, B0); PG8_BAR; PG8_SCHED;
            PG8_LDB(B1, 0, 1); PG8_STAGE(PG8_SB(0, 0), b2, voffB);
            PG8_BAR; PG8_WAIT_L(0); PG8_MMA(0, 1, At, B1); PG8_BAR;
            PG8_LDA(At, 0, 1); PG8_STAGE(PG8_SA(0, 0), a2, voffA);
            PG8_BAR; PG8_WAIT_L(0); PG8_MMA(1, 0, At, B0); PG8_BAR; PG8_SCHED;
            PG8_STAGE(PG8_SB(0, 1), b2 + hstepB, voffB);
            PG8_WAIT_V(6); PG8_BAR; PG8_MMA(1, 1, At, B1); PG8_BAR;
            PG8_LDB(B0, 1, 0); PG8_SCHED; PG8_LDA(At, 1, 0); PG8_STAGE(PG8_SA(0, 1), a2 + hstepA, voffA);
            PG8_WAIT_L(8); PG8_BAR; PG8_WAIT_L(0); PG8_MMA(0, 0, At, B0); PG8_BAR; PG8_SCHED;
            PG8_LDB(B1, 1, 1); PG8_STAGE(PG8_SB(1, 0), b3, voffB);
            PG8_BAR; PG8_WAIT_L(0); PG8_MMA(0, 1, At, B1); PG8_BAR;
            PG8_LDA(At, 1, 1); PG8_STAGE(PG8_SA(1, 0), a3, voffA);
            PG8_BAR; PG8_WAIT_L(0); PG8_MMA(1, 0, At, B0); PG8_BAR; PG8_SCHED;
            PG8_STAGE(PG8_SB(1, 1), b3 + hstepB, voffB);
            PG8_WAIT_V(6); PG8_BAR; PG8_MMA(1, 1, At, B1); PG8_BAR;
            }
        }
        if constexpr (ALIGN_EPI) { if (wr == 0) PG8_BAR; }
        if constexpr (!Epi::AFTER_DRAIN) { E(acc, cur, wr, wc, fr, fq); S.done(cur); }
        if (!has_next) break;
#pragma unroll
        for (int a = 0; a < 2; ++a)
#pragma unroll
            for (int b = 0; b < 2; ++b)
#pragma unroll
                for (int m = 0; m < 4; ++m)
#pragma unroll
                    for (int n = 0; n < 2; ++n) acc[a][b][m][n] = (f32x4){0.f, 0.f, 0.f, 0.f};
        cur = nxt; cA = nA; cB = nB; ++ui;
        if constexpr (ALIGN_EPI) { if (wr == 1) PG8_BAR; }
    }
    PG8_WAIT_V(0);
    if constexpr (!ALIGN_EPI) { if (wr == 0) PG8_BAR; }
    PG8_BAR;
    if constexpr (Epi::AFTER_DRAIN) { E.fused(acc, cur, wr, wc, fr, fq, lds, wid, lane); S.done(cur); }
#undef PG8_SA
#undef PG8_SB
#undef PG8_STAGE
#undef PG8_LDA
#undef PG8_LDB
#undef PG8_MMA
#undef PG8_WAIT_V
#undef PG8_WAIT_L
#undef PG8_BAR
#undef PG8_SCHED
}
}
namespace att {
typedef unsigned short bf16_t;
typedef short bf16x8 __attribute__((ext_vector_type(8)));
typedef short s16x4 __attribute__((ext_vector_type(4)));
typedef float f32x16 __attribute__((ext_vector_type(16)));
typedef float f32x4 __attribute__((ext_vector_type(4)));
typedef unsigned u32x4 __attribute__((ext_vector_type(4)));
constexpr int NW = 8, QBLK = 32, KVBLK = 64, QB = NW * QBLK;
constexpr int DK = 192, DV = 128;
constexpr int QS = 1536, KVS = 2048, KRS = 64, OS = 1024;
constexpr int SHM_V = KVBLK * DV * 2, SHM_K = KVBLK * DK * 2;
constexpr int LDS_QR = 2 * SHM_V + 2 * SHM_K + NW * 64 * 4;
constexpr int LDS_BYTES = LDS_QR + NW * 8192;
constexpr float SCALE = 0.07216878364870322f;
constexpr float THR = 8.f;
#define KSWZ(row, colB) ((row) * 384 + ((colB) ^ (((row) & 7) << 4)))
#define SBAR() __builtin_amdgcn_sched_barrier(0)
__device__ __forceinline__ int v_st(int k, int c) { const int kk = (k & ~0xC) | ((k & 4) << 1) | ((k & 8) >> 1); return ((kk >> 3) * 4 + (c >> 5)) * 512 + ((kk & 7) * 32 + (c & 31)) * 2; }
__device__ __forceinline__ int v_rd_base(int lane) { return ((lane & 3) << 3) | (((lane >> 2) & 3) << 6) | (((lane >> 4) & 1) << 5) | (((lane >> 5) & 1) << 8); }
constexpr int v_rd_off(int d0, int ks, int half) { return d0 * 512 + ks * 4096 + half * 2048; }
__device__ __forceinline__ int crow(int r, int hi) { return (r & 3) + 8 * (r >> 2) + 4 * hi; }
__device__ __forceinline__ unsigned cvtpk(float lo, float hi) { unsigned r; asm volatile("v_cvt_pk_bf16_f32 %0, %1, %2" : "=v"(r) : "v"(lo), "v"(hi)); return r; }
__device__ __forceinline__ bf16x8 load8(const bf16_t* p) { return *reinterpret_cast<const bf16x8*>(p); }
__device__ __forceinline__ void mask_tile(f32x16& p0, f32x16& p1, int dq) {
    const float NEG = -__builtin_inff();
#pragma unroll
    for (int r = 0; r < 16; ++r) {
        const int c = (r & 3) + 8 * (r >> 2);
        if (dq - c < 0) p0[r] = NEG;
        if (dq - c - 32 < 0) p1[r] = NEG;
    }
}
__device__ __forceinline__ void partialSM(f32x16& p0, f32x16& p1, float& m_reg, float& mn, float& alpha) {
    float pmax = p0[0]; for (int r = 1; r < 16; ++r) pmax = fmaxf(pmax, p0[r]); for (int r = 0; r < 16; ++r) pmax = fmaxf(pmax, p1[r]);
    { auto rr = __builtin_amdgcn_permlane32_swap(__float_as_uint(pmax), __float_as_uint(pmax), false, false);
      pmax = fmaxf(__uint_as_float(rr[0]), __uint_as_float(rr[1])); }
    constexpr float C2 = 1.4426950408889634f * SCALE;
    if (__builtin_expect(__all((pmax - m_reg) * SCALE <= THR), 1)) { mn = m_reg; alpha = 1.f; }
    else { mn = fmaxf(m_reg, pmax); alpha = __builtin_amdgcn_exp2f((m_reg - mn) * C2); m_reg = mn; }
    const float mnL = -mn * C2;
    for (int r = 0; r < 16; ++r) p0[r] = fmaf(p0[r], C2, mnL); for (int r = 0; r < 16; ++r) p1[r] = fmaf(p1[r], C2, mnL);
    for (int r = 0; r < 16; ++r) p0[r] = __builtin_amdgcn_exp2f(p0[r]);
}
__device__ __forceinline__ void finishSM(f32x16& p0, f32x16& p1, float alpha, float& l_reg, bf16x8& pa0, bf16x8& pa1, bf16x8& pa2, bf16x8& pa3) {
    for (int r = 0; r < 16; ++r) p1[r] = __builtin_amdgcn_exp2f(p1[r]);
    float ps = 0; for (int r = 0; r < 16; ++r) ps += p0[r]; for (int r = 0; r < 16; ++r) ps += p1[r];
    { auto rr = __builtin_amdgcn_permlane32_swap(__float_as_uint(ps), __float_as_uint(ps), false, false);
      ps = __uint_as_float(rr[0]) + __uint_as_float(rr[1]); }
    l_reg = l_reg * alpha + ps;
#define PK4(P, B_, OUT) do { unsigned a0 = cvtpk(P[B_+0], P[B_+1]), a1 = cvtpk(P[B_+2], P[B_+3]);                          \
        unsigned b0 = cvtpk(P[B_+4], P[B_+5]), b1 = cvtpk(P[B_+6], P[B_+7]);                                             \
        auto r0 = __builtin_amdgcn_permlane32_swap(a0, b0, false, false); auto r1 = __builtin_amdgcn_permlane32_swap(a1, b1, false, false); \
        u32x4 w = {r0[0], r1[0], r0[1], r1[1]}; OUT = *reinterpret_cast<bf16x8*>(&w); } while (0)
    PK4(p0, 0, pa0); PK4(p0, 8, pa1); PK4(p1, 0, pa2); PK4(p1, 8, pa3);
#undef PK4
}
template <int KB>
__device__ __forceinline__ void qkt(f32x16& p0, f32x16& p1, const char* K_lds, int r32, int hi, const bf16x8* qr, const char* qrl) {
    p0 = f32x16{}; p1 = f32x16{};
    const char* kb[4];
#pragma unroll
    for (int dd = 0; dd < 4; ++dd) kb[dd] = K_lds + KB * SHM_K + KSWZ(r32, (dd * 16 + hi * 8) * 2);
#pragma unroll
    for (int d0 = 0; d0 < 12; ++d0) { const char* a = kb[d0 & 3] + (d0 >> 2) * 128;
        bf16x8 b0 = *reinterpret_cast<const bf16x8*>(a);
        bf16x8 b1 = *reinterpret_cast<const bf16x8*>(a + 32 * 384);
        const bf16x8 qf = d0 < 4 ? qr[d0 & 3] : *reinterpret_cast<const bf16x8*>(qrl + (d0 - 4) * 1024);
        p0 = __builtin_amdgcn_mfma_f32_32x32x16_bf16(b0, qf, p0, 0, 0, 0);
        p1 = __builtin_amdgcn_mfma_f32_32x32x16_bf16(b1, qf, p1, 0, 0, 0); }
}
template <int VB>
__device__ __forceinline__ void pv_tile(f32x16* o, int vb0, bf16x8 pa0, bf16x8 pa1, bf16x8 pa2, bf16x8 pa3) {
#define TRRD(dst, off) asm volatile("ds_read_b64_tr_b16 %0, %1 offset:%2" : "=&v"(dst) : "v"(vb0), "i"(off) : "memory")
#define PV_D0(d0) do { s16x4 l0, l1, l2, l3, h0, h1, h2, h3; constexpr int b_ = VB * SHM_V + v_rd_off(d0, 0, 0);   \
        TRRD(l0, b_); TRRD(h0, b_ + 2048); TRRD(l1, b_ + 4096); TRRD(h1, b_ + 6144); TRRD(l2, b_ + 8192); TRRD(h2, b_ + 10240); TRRD(l3, b_ + 12288); TRRD(h3, b_ + 14336); \
        asm volatile("s_waitcnt lgkmcnt(0)" ::: "memory"); SBAR();   \
        o[d0] = __builtin_amdgcn_mfma_f32_32x32x16_bf16(pa0, (bf16x8){l0[0], l0[1], l0[2], l0[3], h0[0], h0[1], h0[2], h0[3]}, o[d0], 0, 0, 0);   \
        o[d0] = __builtin_amdgcn_mfma_f32_32x32x16_bf16(pa1, (bf16x8){l1[0], l1[1], l1[2], l1[3], h1[0], h1[1], h1[2], h1[3]}, o[d0], 0, 0, 0);   \
        o[d0] = __builtin_amdgcn_mfma_f32_32x32x16_bf16(pa2, (bf16x8){l2[0], l2[1], l2[2], l2[3], h2[0], h2[1], h2[2], h2[3]}, o[d0], 0, 0, 0);   \
        o[d0] = __builtin_amdgcn_mfma_f32_32x32x16_bf16(pa3, (bf16x8){l3[0], l3[1], l3[2], l3[3], h3[0], h3[1], h3[2], h3[3]}, o[d0], 0, 0, 0); } while (0)
    PV_D0(0); PV_D0(1); PV_D0(2); PV_D0(3);
#undef PV_D0
#undef TRRD
}
struct BlockRef { const bf16_t* Qn; const bf16_t* Qr; const bf16_t* Kn; const bf16_t* Kr; const bf16_t* V; bf16_t* O; int P0; };
struct Seam { bf16x8 qr[4]; bf16x8 st_v0, st_v1, st_k0, st_k1, st_k2; };
#define VMW() asm volatile("s_waitcnt vmcnt(0)" ::: "memory")
#define VMWN(n) asm volatile("s_waitcnt vmcnt(%0)" :: "i"(n) : "memory")
#define SLOAD_H(R_, k0) do { const char* vb_ = (const char*)((R_).V + (size_t)(k0) * KVS); const char* kb_ = (const char*)((R_).Kn + (size_t)(k0) * KVS); const char* rb_ = (const char*)((R_).Kr + (size_t)(k0) * KRS); \
                         S.st_v0 = *(const bf16x8*)(vb_ + voff); S.st_v1 = *(const bf16x8*)(vb_ + 32 * KVS * 2 + voff);      \
                         S.st_k0 = *(const bf16x8*)(kb_ + voff); S.st_k1 = *(const bf16x8*)(kb_ + 32 * KVS * 2 + voff);      \
                         S.st_k2 = *(const bf16x8*)(rb_ + roff); } while (0)
#define SWRITE_HK(bf) do { *(bf16x8*)(K_lds + (bf) * SHM_K + kws) = S.st_k0; *(bf16x8*)(K_lds + (bf) * SHM_K + kws + 32 * 384) = S.st_k1; *(bf16x8*)(K_lds + (bf) * SHM_K + kws2) = S.st_k2; } while (0)
#define SWRITE_HV(bf) do { *(bf16x8*)(V_lds + (bf) * SHM_V + vst0) = S.st_v0; *(bf16x8*)(V_lds + (bf) * SHM_V + vst1) = S.st_v1; } while (0)
#define SWRITE_H(bf) do { SWRITE_HV(bf); SWRITE_HK(bf); } while (0)
#define QLOAD(R_) do { const char* qn_ = (const char*)((R_).Qn + (size_t)(wid * QBLK) * QS); const char* qr_ = (const char*)((R_).Qr + (size_t)(wid * QBLK) * QS); \
                       _Pragma("unroll") for (int d0 = 0; d0 < 4; ++d0) S.qr[d0] = *(const bf16x8*)(qn_ + qoff + d0 * 32);          \
                       _Pragma("unroll") for (int d0 = 4; d0 < 8; ++d0) *(bf16x8*)(qrl + (d0 - 4) * 1024) = *(const bf16x8*)(qn_ + qoff + d0 * 32);          \
                       _Pragma("unroll") for (int d0 = 0; d0 < 4; ++d0) *(bf16x8*)(qrl + (d0 + 4) * 1024) = *(const bf16x8*)(qr_ + qoff + d0 * 32); } while (0)
__device__ __forceinline__ void attn_prime(const BlockRef& cur, char* lds, Seam& S, const int tid0) {
    const int tid = tid0, wid = __builtin_amdgcn_readfirstlane(tid >> 6), lane = tid & 63, r32 = lane & 31, hi = lane >> 5;
    const int sr = tid >> 4, sc = (tid & 15) * 8, kws = KSWZ(sr, sc * 2), rr = tid >> 3, rc = (tid & 7) * 8, kws2 = KSWZ(rr, (128 + rc) * 2); char* K_lds = lds + 2 * SHM_V;
    char* qrl = lds + LDS_QR + wid * 8192 + lane * 16;
    const unsigned voff = (unsigned)((sr * KVS + sc) * 2), roff = (unsigned)((rr * KRS + rc) * 2), qoff = (unsigned)((r32 * QS + hi * 8) * 2);
    QLOAD(cur);
    SLOAD_H(cur, 0); VMW(); SWRITE_HK(0);
    __syncthreads();
}
__device__ __forceinline__ void attn_block(const BlockRef& cur, const BlockRef& nxt, char* lds, Seam& S, const int tid0) {
    const int tid = tid0, wid = __builtin_amdgcn_readfirstlane(tid >> 6), lane = tid & 63, r32 = lane & 31, hi = lane >> 5;
    const int NT = cur.P0 / KVBLK + 4;
    const int qlo = cur.P0 + wid * QBLK, qm = qlo + r32 - 4 * hi;
    char* V_lds = lds; char* K_lds = lds + 2 * SHM_V;
    float* ws = (float*)(lds + 2 * SHM_V + 2 * SHM_K) + wid * 64; float* li_l = ws, * al_l = ws + 32;
    float m_reg = -1e30f, l_reg = 0; f32x16 o[4] = {};
    const int sr = tid >> 4, sc = (tid & 15) * 8, vst0 = v_st(sr, sc), vst1 = v_st(32 + sr, sc), kws = KSWZ(sr, sc * 2);
    const int rr = tid >> 3, rc = (tid & 7) * 8, kws2 = KSWZ(rr, (128 + rc) * 2);
    const int vb0 = (int)(uintptr_t)V_lds + v_rd_base(lane);
    char* qrl = lds + LDS_QR + wid * 8192 + lane * 16;
    const unsigned voff = (unsigned)((sr * KVS + sc) * 2), roff = (unsigned)((rr * KRS + rc) * 2), qoff = (unsigned)((r32 * QS + hi * 8) * 2);
#define RESC(a) do { if (__any((a) < 1.f)) { if (hi == 0) al_l[r32] = (a); asm volatile("s_waitcnt lgkmcnt(0)" ::: "memory");              \
                     for (int d_ = 0; d_ < 4; ++d_) for (int r = 0; r < 16; ++r) o[d_][r] *= al_l[crow(r, hi)]; } } while (0)
#define MASKT(P0_, P1_, t) do { const int kb_ = (t) * KVBLK; if (kb_ + KVBLK - 1 > qlo) mask_tile(P0_, P1_, qm - kb_); } while (0)
    f32x16 pA0, pA1, pB0, pB1; float mnA, mnB, alA, alB; bf16x8 pa0, pa1, pa2, pa3;
    SWRITE_HV(0); SBAR();
    if (NT > 1) SLOAD_H(cur, KVBLK);
    SBAR(); qkt<0>(pA0, pA1, K_lds, r32, hi, S.qr, qrl);
    MASKT(pA0, pA1, 0); partialSM(pA0, pA1, m_reg, mnA, alA);
    if (NT > 1) { VMW(); SWRITE_H(1); }
    __syncthreads();
#define HALF_STEP(PX0, PX1, mnX, alX, PY0, PY1, alY, t, KB, VB, SB) do {                                                      \
        SBAR(); qkt<KB>(PX0, PX1, K_lds, r32, hi, S.qr, qrl);                                                                       \
        finishSM(PY0, PY1, alY, l_reg, pa0, pa1, pa2, pa3); SBAR();                                                           \
        if ((t) + 1 < NT) { SLOAD_H(cur, ((t) + 1) * KVBLK); SBAR(); }                                                        \
        pv_tile<VB>(o, vb0, pa0, pa1, pa2, pa3); MASKT(PX0, PX1, (t)); partialSM(PX0, PX1, m_reg, mnX, alX);                  \
        __syncthreads();                                                                                                      \
        if ((t) + 1 < NT) { VMW(); SWRITE_H(SB); }                                                                            \
        RESC(alX); __syncthreads(); } while (0)
    for (int t = 1; t + 1 < NT; t += 2) {
        HALF_STEP(pB0, pB1, mnB, alB, pA0, pA1, alA, t, 1, 0, 0);
        HALF_STEP(pA0, pA1, mnA, alA, pB0, pB1, alB, t + 1, 0, 1, 1);
    }
    const bool even = (NT & 1) == 0;
    if (even) { SBAR(); qkt<1>(pB0, pB1, K_lds, r32, hi, S.qr, qrl); SBAR(); }
    SLOAD_H(nxt, 0); SBAR();
    QLOAD(nxt);
    SBAR();
    finishSM(pA0, pA1, alA, l_reg, pa0, pa1, pa2, pa3); SBAR();
    pv_tile<0>(o, vb0, pa0, pa1, pa2, pa3);
    if (even) { MASKT(pB0, pB1, NT - 1); partialSM(pB0, pB1, m_reg, mnB, alB); __syncthreads(); RESC(alB);
        finishSM(pB0, pB1, alB, l_reg, pa0, pa1, pa2, pa3); SBAR(); pv_tile<1>(o, vb0, pa0, pa1, pa2, pa3); }
    SBAR(); VMWN(4); SWRITE_HK(0); SBAR();
    if (hi == 0) li_l[r32] = l_reg; asm volatile("s_waitcnt lgkmcnt(0)" ::: "memory");
    float rli[16];
#pragma unroll
    for (int r = 0; r < 16; ++r) rli[r] = __builtin_amdgcn_rcpf(li_l[crow(r, hi)]);
    char* Ow = (char*)(cur.O + (size_t)(wid * QBLK) * OS);
    const unsigned loff = (unsigned)((4 * hi * OS + r32) * 2);
#pragma unroll
    for (int r = 0; r < 16; ++r) { const int cro = ((r & 3) + 8 * (r >> 2)) * OS;
#pragma unroll
        for (int d0 = 0; d0 < 4; ++d0) { const float v = o[d0][r] * rli[r];
            const float vn = __shfl_xor(v, 1);
            if ((r32 & 1) == 0) *(unsigned*)(Ow + (size_t)(cro + d0 * 32) * 2 + loff) = cvtpk(v, vn); } }
    __syncthreads();
#undef RESC
#undef MASKT
#undef HALF_STEP
}
#undef VMW
#undef VMWN
#undef SLOAD_H
#undef SWRITE_HK
#undef SWRITE_HV
#undef SWRITE_H
#undef QLOAD
#undef SBAR
#undef KSWZ
}
typedef unsigned short bf16_t;
typedef float f32x4 __attribute__((ext_vector_type(4)));
typedef unsigned u32x4 __attribute__((ext_vector_type(4)));
typedef unsigned u32x2 __attribute__((ext_vector_type(2)));
typedef _Float16 h16x4 __attribute__((ext_vector_type(4)));
#define LAS __attribute__((address_space(3)))
#ifndef N_LAUNCHES
#define N_LAUNCHES 1
#endif
constexpr int NPHASE = 10;
constexpr int T = 32768, SEQ = 8192, DM = 1024;
constexpr size_t MiB = 1u << 20;
constexpr size_t WS_RSTDX = 0, WS_RSTDQ = 128 * 1024, WS_RSTDKV = 256 * 1024, WS_CSP = 384 * 1024;
constexpr size_t WS_SS1 = 1 * MiB, WS_SS2 = 3 * MiB;
constexpr size_t WS_CS = 5 * MiB;
constexpr size_t WS_W1 = 7 * MiB;
constexpr size_t WS_WUP = 17 * MiB;
constexpr size_t WS_WDN = 25 * MiB;
constexpr size_t WS_WOUT = 33 * MiB;
constexpr size_t WS_WUQ = 35 * MiB;
constexpr size_t WS_WUKV = 36 * MiB;
constexpr size_t WS_WLRU = 37 * MiB;
constexpr size_t WS_KR = 38 * MiB;
constexpr size_t WS_G1 = 42 * MiB, WS_G2 = 106 * MiB;
constexpr size_t WS_ZC = 170 * MiB;
constexpr size_t WS_SUM = WS_ZC, WS_SUB = WS_ZC + 2 * MiB;
constexpr size_t WS_KV = 218 * MiB;
constexpr size_t WS_R1 = 346 * MiB;
constexpr size_t WS_XB = WS_R1;
constexpr size_t WS_XA = WS_R1;
constexpr size_t WS_YB = WS_R1;
constexpr size_t WS_ZX = WS_R1 + 64 * MiB;
constexpr size_t WS_Q = WS_R1 + 64 * MiB;
constexpr size_t WS_MG = WS_KV;
constexpr size_t WS_H1B = WS_R1 + 64 * MiB;
constexpr size_t WS_U = 42 * MiB;
constexpr size_t WS_H2B = 298 * MiB;
constexpr size_t WS_END = 512 * MiB;
static_assert(WS_Q + (size_t)T * 1536 * 2 <= WS_END && WS_U + (size_t)T * 4096 * 2 <= WS_H1B && WS_W1 + 4864 * 1024 * 2 <= WS_WUP, "d_ws map");

struct Args { const float* in[19]; float* out; unsigned char* ws; int ph_lo, ph_hi; };
static_assert(sizeof(Args) == 19 * 8 + 8 + 8 + 8, "Args has no padding");

__device__ __forceinline__ float wave_sum(float v) {
#pragma unroll
    for (int o = 1; o < 64; o <<= 1) v += __shfl_xor(v, o);
    return v;
}
__device__ __forceinline__ unsigned pkbf(float lo, float hi) { return pg8::cvt_pk_bf16(lo, hi); }
__device__ __forceinline__ float bflo(unsigned w) { return __uint_as_float(w << 16); }
__device__ __forceinline__ float bfhi(unsigned w) { return __uint_as_float(w & 0xffff0000u); }

__device__ __forceinline__ int srccol(int which, int p) {
    if (which == 0) {
        const int t = p >> 8, w = p & 255;
        if (t < 4) return p;
        if (t < 12) return w < 128 ? 1024 + 128 * (t - 4) + w : 2624 + 128 * (t - 4) + (w - 128);
        if (t < 16) return 3648 + (p - 3072);
        if (t == 16) return 2048 + w;
        if (t == 17) return 2304 + w;
        return w < 64 ? 2560 + 4 * (w >> 3) + (w & 3) + 32 * ((w >> 2) & 1) : -1;
    }
    if (which == 1) {
        if (p < 1024) return (p >> 7) * 192 + (p & 127);
        const int q = p - 1024, h = q >> 6, u = q & 63;
        return h * 192 + 128 + 4 * (u >> 3) + (u & 3) + 32 * ((u >> 2) & 1);
    }
    return p;
}
__device__ __forceinline__ void tr_item(const float* W, int ldw, int K, int Nphys, const float* gain, bf16_t* WT, int which, LAS float* scr, int item, int lane, int ksrc0 = 0, int Ksrc = 1 << 30) {
    const int nblk = Nphys / 32, kb = item / nblk, nb = item % nblk, k0 = 64 * kb, n0 = 32 * nb;
    const int src = srccol(which, n0 + (lane & 31));
#pragma unroll 16
    for (int i = 0; i < 32; ++i) { const int kk = 2 * i + (lane >> 5); float v = 0.f;
        const int ks = k0 + kk - ksrc0;
        if (src >= 0 && ks >= 0 && ks < Ksrc) { v = __builtin_nontemporal_load(W + (size_t)ks * ldw + src); if (gain) v *= gain[k0 + kk]; }
        scr[kk * 33 + (lane & 31)] = v; }
    asm volatile("s_waitcnt lgkmcnt(0)" ::: "memory");
    const int c = lane & 7;
#pragma unroll
    for (int j = 0; j < 4; ++j) { const int n = (lane >> 3) + 8 * j; const LAS float* s = scr + (8 * c) * 33 + n;
        u32x4 o; o.x = pkbf(s[0 * 33], s[1 * 33]); o.y = pkbf(s[2 * 33], s[3 * 33]); o.z = pkbf(s[4 * 33], s[5 * 33]); o.w = pkbf(s[6 * 33], s[7 * 33]);
        *(u32x4*)(WT + (size_t)(n0 + n) * K + k0 + 8 * c) = o; }
    asm volatile("s_waitcnt lgkmcnt(0)" ::: "memory");
}
__device__ __forceinline__ void tr_item64(const float* W, int ldw, int K, int Nphys, const float* gain, bf16_t* WT, int which, int item, int lane, int ksrc0 = 0, int Ksrc = 1 << 30) {
    const int nblk = Nphys / 64, kb = item / nblk, nb = item % nblk, k0 = 64 * kb, n0 = 64 * nb;
    const int src = srccol(which, n0 + lane); const bool kin = (k0 - ksrc0 >= 0) && (k0 - ksrc0 < Ksrc);
    float v[64];
#pragma unroll
    for (int kk = 0; kk < 64; ++kk) v[kk] = (src >= 0 && kin) ? __builtin_nontemporal_load(W + (size_t)(k0 + kk - ksrc0) * ldw + src) : 0.f;
    if (gain) {
#pragma unroll
        for (int kk = 0; kk < 64; ++kk) v[kk] *= gain[k0 + kk];
    }
    bf16_t* o = WT + (size_t)(n0 + lane) * K + k0;
#pragma unroll
    for (int j = 0; j < 8; ++j) { u32x4 w; w.x = pkbf(v[8 * j], v[8 * j + 1]); w.y = pkbf(v[8 * j + 2], v[8 * j + 3]); w.z = pkbf(v[8 * j + 4], v[8 * j + 5]); w.w = pkbf(v[8 * j + 6], v[8 * j + 7]); *(u32x4*)(o + 8 * j) = w; }
}
__device__ __forceinline__ void sincos_d(double a, float& s, float& c) {
    const double n = rint(a * 0.63661977236758134308);
    const double r = (a - n * 1.57079632679489655800) - n * 6.123233995736766036e-17, r2 = r * r;
    double sp = -7.6471637318198164759e-13; sp = sp * r2 + 1.6059043836821614599e-10; sp = sp * r2 - 2.5052108385441718775e-08; sp = sp * r2 + 2.7557319223985890653e-06;
    sp = sp * r2 - 1.9841269841269841270e-04; sp = sp * r2 + 8.3333333333333333333e-03; sp = sp * r2 - 1.6666666666666666667e-01; sp = r + r * r2 * sp;
    double cp = 4.7794773323873852974e-14; cp = cp * r2 - 1.1470745597729724714e-11; cp = cp * r2 + 2.0876756987868098979e-09; cp = cp * r2 - 2.7557319223985890653e-07;
    cp = cp * r2 + 2.4801587301587301587e-05; cp = cp * r2 - 1.3888888888888888889e-03; cp = cp * r2 + 4.1666666666666666667e-02; cp = cp * r2 - 0.5; cp = 1.0 + r2 * cp;
    const int q = (int)((long long)n & 3);
    const double ss = (q & 1) ? cp : sp, cc = (q & 1) ? sp : cp;
    s = (float)((q & 2) ? -ss : ss); c = (float)(((q + 1) & 2) ? -cc : cc);
}

#ifdef DIAG
#define DCHK(code, got, want, rtol, atol) do { const float g_ = (got), w_ = (want); if (!(fabsf(g_ - w_) <= (rtol) * fabsf(w_) + (atol))) { atomicMin(DG, (unsigned)(code)); atomicOr(DG + 1, (code) < 50 ? 0u : (code) < 54 ? 1u : (code) < 60 ? 2u : (code) < 70 ? 4u : (code) < 80 ? 8u : 16u); } } while (0)
__device__ __forceinline__ unsigned dhash(unsigned x) { x ^= x >> 16; x *= 0x7feb352du; x ^= x >> 15; x *= 0x846ca68bu; x ^= x >> 16; return x; }
__device__ __forceinline__ float dbf(const bf16_t* p, size_t i) { return __uint_as_float((unsigned)p[i] << 16); }
__device__ __forceinline__ float dsig(float v) { return 1.0f / (1.0f + expf(-v)); }
__device__ __forceinline__ float ddot(const bf16_t* a, const bf16_t* b, int K) { float s = 0.f; for (int k = 0; k < K; ++k) s += dbf(a, k) * dbf(b, k); return s; }
#endif
#define XB_TMO      128
#define XB_XCNT(j)  (256  + 64 * (j))
#define XB_XSUB(j)  (1280 + 64 * (j))
#define XB_XGEN(j)  (2304 + 64 * (j))
#define XB_TOP      3328
#define XB_TOPGEN   3392
#define XCD_BAR_WORDS 3456
#define XB_SPIN_CAP (1u << 18)

__device__ __forceinline__ unsigned xb_ld(unsigned* p)              { return __hip_atomic_load(p, __ATOMIC_RELAXED, __HIP_MEMORY_SCOPE_AGENT); }
__device__ __forceinline__ unsigned xb_add(unsigned* p, unsigned v) { return __hip_atomic_fetch_add(p, v, __ATOMIC_RELAXED, __HIP_MEMORY_SCOPE_AGENT); }
__device__ __forceinline__ unsigned xb_xcc_id() { return (unsigned)__builtin_amdgcn_s_getreg((3 << 11) | 20) & 0xFu; }
#define XB_SPIN(cond, bar) do { unsigned _sp = 0; while (cond) { __builtin_amdgcn_s_sleep(1); \
    if ((++_sp & 255u) == 0u) { if (xb_ld(&(bar)[XB_TMO])) break; if (_sp > XB_SPIN_CAP) { atomicAdd(&(bar)[XB_TMO], 1u); break; } } } } while (0)

struct XcdBarrier {
    unsigned* bar; unsigned x;
    volatile LAS unsigned* st;
};

__device__ __forceinline__ XcdBarrier xcd_barrier_post(unsigned* bar, volatile LAS unsigned* st, const bool leader) {
    XcdBarrier b; b.bar = bar; b.x = xb_xcc_id(); b.st = st;
    if (leader) (void)xb_add(&bar[XB_XCNT(b.x)], 1u);
    return b;
}
__device__ __forceinline__ void xcd_barrier_complete(unsigned* bar, unsigned x, unsigned& nloc, unsigned& nx) {
    const unsigned G = gridDim.x * gridDim.y * gridDim.z;
    unsigned sum, cnt, mine, sp = 0u;
    for (;;) {
        sum = 0u; cnt = 0u; mine = 0u;
#pragma unroll
        for (unsigned j = 0; j < 16; ++j) { const unsigned c = xb_ld(&bar[XB_XCNT(j)]); sum += c; cnt += (c > 0u) ? 1u : 0u; mine = (j == x) ? c : mine; }
        if (sum == G) break;
        __builtin_amdgcn_s_sleep(1);
        if ((++sp & 255u) == 0u) { if (xb_ld(&bar[XB_TMO])) break; if (sp > XB_SPIN_CAP) { atomicAdd(&bar[XB_TMO], 1u); break; } }
    }
    nloc = mine > 0u ? mine : 1u; nx = cnt > 0u ? cnt : 1u;
}

__device__ __forceinline__ void xcd_barrier(const XcdBarrier& b, const bool leader) {
    asm volatile("s_waitcnt vmcnt(0)" ::: "memory");
    __syncthreads();
    if (leader) {
        unsigned* bar = b.bar;
        __builtin_amdgcn_s_waitcnt(0);
        unsigned nloc = b.st[0], nx = b.st[1];
        if (nloc == 0u) { xcd_barrier_complete(bar, b.x, nloc, nx); b.st[0] = nloc; b.st[1] = nx; }
        const unsigned old = xb_add(&bar[XB_XSUB(b.x)], 1u);
        const unsigned gen = old / nloc;
        if (old + 1u == (gen + 1u) * nloc) {
            __builtin_amdgcn_fence(__ATOMIC_RELEASE, "agent");
            asm volatile("s_waitcnt vmcnt(0)" ::: "memory");
            const unsigned og = xb_add(&bar[XB_TOP], 1u);
            const unsigned tg = og / nx;
            if (og + 1u == (tg + 1u) * nx) xb_add(&bar[XB_TOPGEN], 1u);
            else XB_SPIN(xb_ld(&bar[XB_TOPGEN]) == tg, bar);
            __builtin_amdgcn_fence(__ATOMIC_ACQUIRE, "agent");
            xb_add(&bar[XB_XGEN(b.x)], 1u);
            asm volatile("s_waitcnt vmcnt(0)" ::: "memory");
        } else {
            XB_SPIN(xb_ld(&bar[XB_XGEN(b.x)]) == gen, bar);
            __builtin_amdgcn_fence(__ATOMIC_ACQUIRE, "agent");
            asm volatile("s_waitcnt vmcnt(0)" ::: "memory");
        }
    }
    __syncthreads();
}

constexpr size_t WS_BAR = WS_CSP + 65536;
constexpr int LDS_BARW = 153600 - 64;
__global__ void __launch_bounds__(512, 2) fwd_kernel(Args args) {
    extern __shared__ __attribute__((aligned(16))) unsigned char lds[];
    cg::grid_group grid = cg::this_grid();
    const int wave_top = __builtin_amdgcn_readfirstlane((int)threadIdx.x >> 6);
    const int tid = threadIdx.x, lane = tid & 63, wave = wave_top;
    const int G = gridDim.x, gw = blockIdx.x * 8 + wave, NGW = G * 8; (void)tid; (void)lane; (void)gw;
    unsigned char* ws = args.ws;
    const int lo = args.ph_lo, hi = args.ph_hi;
#ifndef PHMASK
#define PHMASK 0x3ff
#endif
#define IN(k) (((PHMASK >> (k)) & 1) && lo <= (k) && (k) < hi)
#ifndef REPMASK
#define REPMASK 0
#endif
#define FRESH_IDS int lane_o_ = __builtin_amdgcn_mbcnt_hi(~0u, __builtin_amdgcn_mbcnt_lo(~0u, 0u)); asm volatile("" : "+v"(lane_o_)); const int lane = lane_o_, wave = wave_top, tid = wave * 64 + lane, gw = blockIdx.x * 8 + wave; (void)tid; (void)gw;
#define PLAIN_IDS int tid_o_ = threadIdx.x; asm volatile("" : "+v"(tid_o_)); const int tid = tid_o_, lane = tid & 63, wave = wave_top, gw = blockIdx.x * 8 + wave; (void)lane; (void)gw;
#define REP(k) for (int rep_ = 0; rep_ <= ((REPMASK >> (k)) & 1); ++rep_)
#ifdef TSTAMP
    unsigned long long* TS = (unsigned long long*)(ws + WS_CSP + 32768);
#define SEAM(k) do { if (IN(k) && IN((k) + 1)) grid.sync(); if (blockIdx.x == 0 && tid == 0) TS[(k) + 1] = __builtin_amdgcn_s_memrealtime(); } while (0)
    if (blockIdx.x == 0 && tid == 0) TS[0] = __builtin_amdgcn_s_memrealtime();
#else
#define SEAM(k) do { if (IN(k) && IN((k) + 1)) { if (lo < 0) grid.sync();   xcd_barrier(xbar, wave_top == 0 && __builtin_amdgcn_mbcnt_hi(~0u, __builtin_amdgcn_mbcnt_lo(~0u, 0u)) == 0u); } } while (0)
#endif
    const float* x = args.in[0];
    float* rstdx = (float*)(ws + WS_RSTDX); float* rstdq = (float*)(ws + WS_RSTDQ); float* rstdkv = (float*)(ws + WS_RSTDKV); float* csp = (float*)(ws + WS_CSP);
    float* SS1 = (float*)(ws + WS_SS1); float* SS2 = (float*)(ws + WS_SS2); float* CS = (float*)(ws + WS_CS);
    bf16_t* W1 = (bf16_t*)(ws + WS_W1); bf16_t* WUP = (bf16_t*)(ws + WS_WUP); bf16_t* WDN = (bf16_t*)(ws + WS_WDN); bf16_t* WOUT = (bf16_t*)(ws + WS_WOUT);
    bf16_t* WUQ = (bf16_t*)(ws + WS_WUQ); bf16_t* WUKV = (bf16_t*)(ws + WS_WUKV); bf16_t* WLRU = (bf16_t*)(ws + WS_WLRU);
    bf16_t* KR = (bf16_t*)(ws + WS_KR); bf16_t* G1 = (bf16_t*)(ws + WS_G1); bf16_t* G2 = (bf16_t*)(ws + WS_G2); bf16_t* ZC = (bf16_t*)(ws + WS_ZC);
    bf16_t* KV = (bf16_t*)(ws + WS_KV); bf16_t* XB = (bf16_t*)(ws + WS_XB); bf16_t* XA = (bf16_t*)(ws + WS_XA); bf16_t* YB = (bf16_t*)(ws + WS_YB);
    bf16_t* ZX = (bf16_t*)(ws + WS_ZX); bf16_t* Q = (bf16_t*)(ws + WS_Q); bf16_t* MG = (bf16_t*)(ws + WS_MG); bf16_t* H1B = (bf16_t*)(ws + WS_H1B); bf16_t* U = (bf16_t*)(ws + WS_U);
    float* SSQ = (float*)(ws + WS_SS2); float* SSKV = (float*)(ws + WS_SS2 + 512 * 1024);
    bf16_t* H2B = (bf16_t*)(ws + WS_H2B); float* SUM = (float*)(ws + WS_SUM); float* SUB = (float*)(ws + WS_SUB);
    unsigned* AB = (unsigned*)args.out; float* OUT = args.out;
    LAS unsigned char* ldsg = (LAS unsigned char*)lds;

    if (threadIdx.x < 2) ((volatile LAS unsigned*)(ldsg + LDS_BARW))[threadIdx.x] = 0u;
    __syncthreads();
    XcdBarrier xbar; xbar.bar = (unsigned*)(ws + WS_BAR); xbar.x = 0; xbar.st = nullptr;
    if (hi - lo > 1) xbar = xcd_barrier_post((unsigned*)(ws + WS_BAR), (volatile LAS unsigned*)(ldsg + LDS_BARW), threadIdx.x == 0);
#ifdef DIAG
    unsigned* DG = (unsigned*)(ws + WS_CSP + 8192); unsigned* SAVE = (unsigned*)(ws + WS_CSP + 16384);
    if (lo >= 100) {
        const int dk = lo - 100; const unsigned gid = blockIdx.x * 512 + tid, NT_ = G * 512;
        if (dk == 0) {
            for (unsigned s = gid; s < 65536; s += NT_) { const unsigned h = dhash(s * 7 + 1);
                { const int p = h % 4864, k = (h >> 13) % 1024, src = srccol(0, p); const float want = src < 0 ? 0.f : args.in[2][(size_t)k * 4672 + src] * args.in[1][k]; DCHK(1, dbf(W1, (size_t)p * 1024 + k), want, 0.01f, 1e-6f); }
                { const int p = h % 1536, k = (h >> 13) % 256; DCHK(2, dbf(WUQ, (size_t)p * 256 + k), args.in[11][(size_t)k * 1536 + srccol(1, p)] * args.in[10][k], 0.01f, 1e-6f); }
                { const int p = h % 2048, k = (h >> 13) % 256; DCHK(3, dbf(WUKV, (size_t)p * 256 + k), args.in[13][(size_t)k * 2048 + p] * args.in[12][k], 0.01f, 1e-6f); }
                { const int p = h % 2048, k = (h >> 13) % 256, nb = p >> 8, isx = (p >> 7) & 1, d = p & 127, kk = k - 128 * (nb & 1);
                  const float want = (kk >= 0 && kk < 128) ? (isx ? args.in[7] : args.in[5])[(size_t)nb * 16384 + kk * 128 + d] : 0.f; DCHK(4, dbf(WLRU, (size_t)p * 256 + k), want, 0.01f, 1e-6f); }
                { const int p = h % 1024, k = (h >> 13) % 1024; DCHK(5, dbf(WOUT, (size_t)p * 1024 + k), args.in[14][(size_t)k * 1024 + p], 0.01f, 1e-6f); }
                { const int p = h % 4096, k = (h >> 13) % 1024; DCHK(6, dbf(WUP, (size_t)p * 1024 + k), args.in[16][(size_t)k * 4096 + p] * args.in[15][k], 0.01f, 1e-6f); }
                { const int p = h % 1024, k = (h >> 13) % 4096; DCHK(7, dbf(WDN, (size_t)p * 4096 + k), args.in[17][(size_t)k * 1024 + p], 0.01f, 1e-6f); }
                { const int r = h % T, c = (h >> 15) % 1024; DCHK(8, dbf(XB, (size_t)r * 1024 + c), x[(size_t)r * 1024 + c], 0.01f, 1e-6f); }
                { const int pos = h % 8191, i = (h >> 13) & 31; const float c0 = CS[(pos * 32 + i) * 2], s0 = CS[(pos * 32 + i) * 2 + 1], c1 = CS[((pos + 1) * 32 + i) * 2], s1 = CS[((pos + 1) * 32 + i) * 2 + 1], cd = CS[(32 + i) * 2], sd = CS[(32 + i) * 2 + 1];
                  DCHK(9, c1, c0 * cd - s0 * sd, 0.f, 1e-5f); DCHK(9, s1, s0 * cd + c0 * sd, 0.f, 1e-5f); DCHK(9, cd, __cosf(powf(10000.f, -(float)i / 32.f)), 0.f, 1e-4f); DCHK(9, CS[i * 2], 1.0f, 0.f, 1e-6f); }
            }
            for (unsigned s = gid; s < 4096; s += NT_) { const int r = dhash(s) % T; float q = 0.f; for (int c = 0; c < 1024; ++c) q += x[(size_t)r * 1024 + c] * x[(size_t)r * 1024 + c]; DCHK(8, rstdx[r], 1.0f / sqrtf(q / 1024.f + 1e-6f), 1e-3f, 0.f); }
        }
        if (dk == 1) for (unsigned s = gid; s < 32768; s += NT_) { const unsigned h = dhash(s * 3 + 11); const int r = h % T, p = (h >> 15) % 4864, t = p >> 8, w = p & 255;
            const float z = ddot(XB + (size_t)r * 1024, W1 + (size_t)p * 1024, 1024) * rstdx[r];
            if (t < 4) DCHK(11, dbf(ZX, (size_t)r * 1024 + p), z, 0.02f, 0.02f);
            else if (t < 12) { if (w < 128) { const float z2 = ddot(XB + (size_t)r * 1024, W1 + (size_t)(p + 128) * 1024, 1024) * rstdx[r];
                const float ge = 0.5f * z * (1.f + tanhf(0.7978845608f * (z + 0.044715f * z * z * z))); DCHK(12, dbf(G1, (size_t)r * 1024 + (t - 4) * 128 + w), ge * dsig(z2), 0.03f, 0.02f); } }
            else if (t < 16) DCHK(13, dbf(G2, (size_t)r * 1024 + p - 3072), dsig(z), 0.02f, 0.01f);
            else DCHK(14, dbf(ZC, (size_t)r * 768 + p - 4096), z, 0.02f, 0.02f); }
        if (dk == 2) for (unsigned s = gid; s < 65536; s += NT_) { const unsigned h = dhash(s * 5 + 3); const int r = (s & 1) ? (h % T) : ((h % 4) * 8192 + (h >> 8) % 6), c = (h >> 15) % 1024, pos = r & 8191;
            float v = args.in[4][c]; for (int j = 0; j < 4; ++j) if (pos - 3 + j >= 0) v += args.in[3][j * 1024 + c] * dbf(ZX, (size_t)(r - 3 + j) * 1024 + c);
            DCHK(21, dbf(XA, (size_t)r * 1024 + c), v, 0.02f, 0.02f);
            if (c < 64) { const int u = c, i = 4 * (u >> 3) + (u & 3), hf = (u >> 2) & 1; const float kl = dbf(ZC, (size_t)r * 768 + 512 + i), kh = dbf(ZC, (size_t)r * 768 + 512 + i + 32), cc = CS[(pos * 32 + i) * 2], ss = CS[(pos * 32 + i) * 2 + 1];
                DCHK(23, dbf(KR, (size_t)r * 64 + u), hf ? kh * cc + kl * ss : kl * cc - kh * ss, 0.02f, 0.02f); }
            if (c == 100) { float q = 0.f, k2 = 0.f; for (int j = 0; j < 256; ++j) { const float a = dbf(ZC, (size_t)r * 768 + j), b = dbf(ZC, (size_t)r * 768 + 256 + j); q += a * a; k2 += b * b; }
                DCHK(22, rstdq[r], 1.0f / sqrtf(q / 256.f + 1e-6f), 1e-3f, 0.f); DCHK(22, rstdkv[r], 1.0f / sqrtf(k2 / 256.f + 1e-6f), 1e-3f, 0.f); } }
        if (dk == 3) for (unsigned s = gid; s < 65536; s += NT_) { const unsigned h = dhash(s * 9 + 5); const int r = h % T, pos = r & 8191;
            { const int c = (h >> 15) % 1024, nb = c >> 7, d = c & 127; float dr = args.in[6][c], di = args.in[8][c];
              for (int k = 0; k < 128; ++k) { const float xv = dbf(XA, (size_t)r * 1024 + nb * 128 + k); dr += xv * args.in[5][(size_t)nb * 16384 + k * 128 + d]; di += xv * args.in[7][(size_t)nb * 16384 + k * 128 + d]; }
              const float rr_ = dsig(dr), ii = dsig(di), la = -8.0f * rr_ * log1pf(expf(-args.in[9][c])), bb = sqrtf(-expm1f(2.f * la)) * ii * dbf(XA, (size_t)r * 1024 + c);
              const pg8::h16x2 pv_ = __builtin_bit_cast(pg8::h16x2, AB[(size_t)r * 1024 + c]);
              DCHK(31, (float)pv_.x, la * 1.4426950408889634f, 0.03f, 1e-5f); DCHK(32, (float)pv_.y, bb, 0.03f, 0.01f); }
            { const int p = (h >> 13) % 1536; const float z = ddot(ZC + (size_t)r * 768, WUQ + (size_t)p * 256, 256) * rstdq[r];
              if (p < 1024) DCHK(33, dbf(Q, (size_t)r * 1536 + p), z, 0.02f, 0.02f);
              else { const int u = (p - 1024) & 63, i = 4 * (u >> 3) + (u & 3), islo = (u & 4) == 0; const float z2 = ddot(ZC + (size_t)r * 768, WUQ + (size_t)(p ^ 4) * 256, 256) * rstdq[r];
                  const float cc = CS[(pos * 32 + i) * 2], ss = CS[(pos * 32 + i) * 2 + 1]; DCHK(34, dbf(Q, (size_t)r * 1536 + p), islo ? z * cc - z2 * ss : z * cc + z2 * ss, 0.02f, 0.03f); } }
            { const int p = (h >> 11) % 2048; DCHK(35, dbf(KV, (size_t)r * 2048 + p), ddot(ZC + (size_t)r * 768 + 256, WUKV + (size_t)p * 256, 256) * rstdkv[r], 0.02f, 0.02f); } }
        if (dk == 3) for (unsigned s = gid; s < 4096; s += NT_) SAVE[s] = AB[dhash(s * 41 + 3) % (unsigned)(T * 1024)];
        if (dk == 4) {
            float* SC = (float*)(ws + WS_ZC + 9 * MiB);
            for (int s = gw; s < 1024; s += NGW) { const unsigned h = dhash(s * 13 + 7); const int b = h & 3, hd = (h >> 2) & 7, pos = (s & 3) == 0 ? (int)((h >> 5) % 300) : (int)((h >> 5) % 8192); const size_t r = (size_t)b * 8192 + pos;
                float* sc = SC + (size_t)s * 8192; float mx = -1e30f;
                for (int j = lane; j <= pos; j += 64) { const size_t kr = (size_t)b * 8192 + j; float d = 0.f;
                    for (int e = 0; e < 128; ++e) d += dbf(Q, r * 1536 + hd * 128 + e) * dbf(KV, kr * 2048 + hd * 256 + e);
                    for (int e = 0; e < 64; ++e) d += dbf(Q, r * 1536 + 1024 + hd * 64 + e) * dbf(KR, kr * 64 + e);
                    d *= 0.07216878364870322f; sc[j] = d; mx = fmaxf(mx, d); }
                for (int o = 1; o < 64; o <<= 1) mx = fmaxf(mx, __shfl_xor(mx, o));
                __builtin_amdgcn_fence(__ATOMIC_RELEASE, "workgroup"); __builtin_amdgcn_s_waitcnt(0);
                float l = 0.f, o0 = 0.f, o1 = 0.f;
                for (int j = 0; j <= pos; ++j) { const float p = expf(__builtin_nontemporal_load(sc + j) - mx); const size_t kr = (size_t)b * 8192 + j; l += p; o0 += p * dbf(KV, kr * 2048 + hd * 256 + 128 + lane); o1 += p * dbf(KV, kr * 2048 + hd * 256 + 192 + lane); }
                DCHK(41, dbf(YB, r * 1024 + hd * 128 + lane), o0 / l, 0.03f, 0.01f); DCHK(41, dbf(YB, r * 1024 + hd * 128 + 64 + lane), o1 / l, 0.03f, 0.01f); } }
        if (dk == 5) for (unsigned s = gid; s < 4096; s += NT_) if (SAVE[s] != AB[dhash(s * 41 + 3) % (unsigned)(T * 1024)]) atomicMin(DG, 48u);
        if (dk == 5) for (unsigned s = gid; s < 8192; s += NT_) { const unsigned h = dhash(s * 17 + 9); const int b = h & 3, c = (h >> 2) % 1024, pos = (s & 3) == 0 ? (int)((h >> 12) % 32) : (s & 3) == 1 ? (int)((h >> 12) % 256) : (int)((h >> 12) % 8192); float hh = 0.f, LL = 0.f;
            for (int j = 0; j <= pos; ++j) { const pg8::h16x2 pv_ = __builtin_bit_cast(pg8::h16x2, AB[((size_t)b * 8192 + j) * 1024 + c]); hh = exp2f((float)pv_.x) * hh + (float)pv_.y; LL += (float)pv_.x;
                if ((j & 31) == 31 && (j >> 5) == (pos >> 5) - 0 && false) {} }
            const size_t o = ((size_t)b * 8192 + pos) * 1024 + c; const int code = pos < 32 ? 51 : pos < 256 ? 52 : 53;
            DCHK(code, dbf(MG, o), dbf(G1, o) * hh + dbf(G2, o) * dbf(YB, o), 0.03f, 0.01f);
            { const int sc_ = (h >> 12) % 256; float h2 = 0.f, L2 = 0.f; for (int j = sc_ * 32; j < sc_ * 32 + 32; ++j) { const pg8::h16x2 pv_ = __builtin_bit_cast(pg8::h16x2, AB[((size_t)b * 8192 + j) * 1024 + c]); h2 = exp2f((float)pv_.x) * h2 + (float)pv_.y; L2 += (float)pv_.x; }
              DCHK(54, SUB[(((size_t)b * 256 + sc_) * 1024 + c) * 2], L2, 1e-3f, 1e-5f); DCHK(55, SUB[(((size_t)b * 256 + sc_) * 1024 + c) * 2 + 1], h2, 1e-3f, 1e-4f); }
            { const int kc = (h >> 12) % 32; float h2 = 0.f, L2 = 0.f; for (int j = kc * 256; j < kc * 256 + 256; ++j) { const pg8::h16x2 pv_ = __builtin_bit_cast(pg8::h16x2, AB[((size_t)b * 8192 + j) * 1024 + c]); h2 = exp2f((float)pv_.x) * h2 + (float)pv_.y; L2 += (float)pv_.x; }
              DCHK(56, SUM[(((size_t)b * 32 + kc) * 1024 + c) * 2], L2, 1e-3f, 1e-5f); DCHK(57, SUM[(((size_t)b * 32 + kc) * 1024 + c) * 2 + 1], h2, 1e-3f, 1e-4f); } }
        if (dk == 6) for (unsigned s = gid; s < 32768; s += NT_) { const unsigned h = dhash(s * 19 + 1); const int r = h % T, c = (h >> 15) % 1024;
            const float v = x[(size_t)r * 1024 + c] + ddot(MG + (size_t)r * 1024, WOUT + (size_t)c * 1024, 1024); DCHK(61, OUT[(size_t)r * 1024 + c], v, 0.02f, 0.02f); DCHK(62, dbf(H1B, (size_t)r * 1024 + c), v, 0.02f, 0.02f);
            if (c == 7) { float q = 0.f, q2 = 0.f; for (int j = 0; j < 1024; ++j) q += OUT[(size_t)r * 1024 + j] * OUT[(size_t)r * 1024 + j]; for (int j = 0; j < 16; ++j) q2 += SS1[(size_t)r * 16 + j]; DCHK(63, q2, q, 1e-3f, 0.f); } }
        if (dk == 7) for (unsigned s = gid; s < 32768; s += NT_) { const unsigned h = dhash(s * 23 + 1); const int r = h % T, c = (h >> 15) % 4096; float q2 = 0.f; for (int j = 0; j < 16; ++j) q2 += SS1[(size_t)r * 16 + j];
            const float u_ = ddot(H1B + (size_t)r * 1024, WUP + (size_t)c * 1024, 1024) / sqrtf(q2 / 1024.f + 1e-6f), rl = fmaxf(u_, 0.f); DCHK(71, dbf(U, (size_t)r * 4096 + c), rl * rl, 0.03f, 0.02f); }
        if (dk == 8) for (unsigned s = gid; s < 16384; s += NT_) { const unsigned h = dhash(s * 29 + 1); const int r = h % T, c = (h >> 15) % 1024;
            const float v = dbf(H1B, (size_t)r * 1024 + c) + ddot(U + (size_t)r * 4096, WDN + (size_t)c * 4096, 4096); DCHK(81, OUT[(size_t)r * 1024 + c], v, 0.02f, 0.04f);
            if (c == 7) { float q = 0.f, q2 = 0.f; for (int j = 0; j < 1024; ++j) q += OUT[(size_t)r * 1024 + j] * OUT[(size_t)r * 1024 + j]; for (int j = 0; j < 16; ++j) q2 += SS2[(size_t)r * 16 + j]; DCHK(82, q2, q, 1e-3f, 0.f); } }
        if (dk == 9) { for (unsigned s = gid; s < 4096; s += NT_) { const int r = dhash(s * 31) % T; float q = 0.f; for (int j = 0; j < 1024; ++j) { const float v = OUT[(size_t)r * 1024 + j] / args.in[18][j]; q += v * v; } DCHK(91, q / 1024.f, 1.0f, 0.01f, 0.f); } }
        if (dk == 10) { if (gid == 0) { const unsigned code = *DG; if (code < 1000u) OUT[0] = 100.0f + 10.0f * (float)code; OUT[1] = 10000.0f * (1.0f + (float)DG[1]); } }
        return;
    }
#endif
    if (IN(0)) REP(0) { PLAIN_IDS
        LAS float* scr = (LAS float*)(ldsg + wave * 16384);
        constexpr int I_W1 = 16 * (4864 / 64), I_UP = 16 * (4096 / 64), I_DN = 64 * (1024 / 64), I_OUT = 16 * 16, I_UQ = 4 * (1536 / 64), I_UKV = 4 * (2048 / 64), I_LRU = 16 * 8;
        constexpr int NITEMS = I_W1 + I_UP + I_DN + I_OUT + I_UQ + I_UKV + I_LRU;
        const int gw4 = gw, NGW4 = NGW;
        {
        for (int m0 = gw4 * 4; m0 < T; m0 += NGW4 * 4) {
            f32x4 v[4][4];
#pragma unroll
            for (int r = 0; r < 4; ++r) { const f32x4* xr = (const f32x4*)(x + (size_t)(m0 + r) * DM) + lane;
#pragma unroll
                for (int j = 0; j < 4; ++j) v[r][j] = __builtin_nontemporal_load(xr + 64 * j); }
#pragma unroll
            for (int r = 0; r < 4; ++r) { float s = 0.f;
#pragma unroll
                for (int j = 0; j < 4; ++j) s += (v[r][j][0] * v[r][j][0] + v[r][j][1] * v[r][j][1]) + (v[r][j][2] * v[r][j][2] + v[r][j][3] * v[r][j][3]);
                s = wave_sum(s);
                if (lane == 0) rstdx[m0 + r] = rsqrtf(s * (1.0f / 1024.0f) + 1e-6f);
                u32x2* o = (u32x2*)(XB + (size_t)(m0 + r) * DM) + lane;
#pragma unroll
                for (int j = 0; j < 4; ++j) { u32x2 w; w.x = pkbf(v[r][j][0], v[r][j][1]); w.y = pkbf(v[r][j][2], v[r][j][3]); o[64 * j] = w; } }
        }
        }
        {
        for (int it = gw4; it < NITEMS; it += NGW4) {
            int r = it;
            if (r < I_W1) { tr_item64(args.in[2], 4672, 1024, 4864, args.in[1], W1, 0, r, lane); continue; } r -= I_W1;
            if (r < I_UP) { tr_item64(args.in[16], 4096, 1024, 4096, args.in[15], WUP, 2, r, lane); continue; } r -= I_UP;
            if (r < I_DN) { tr_item64(args.in[17], 1024, 4096, 1024, nullptr, WDN, 2, r, lane); continue; } r -= I_DN;
            if (r < I_OUT) { tr_item64(args.in[14], 1024, 1024, 1024, nullptr, WOUT, 2, r, lane); continue; } r -= I_OUT;
            if (r < I_UQ) { tr_item64(args.in[11], 1536, 256, 1536, args.in[10], WUQ, 1, r, lane); continue; } r -= I_UQ;
            if (r < I_UKV) { tr_item64(args.in[13], 2048, 256, 2048, args.in[12], WUKV, 2, r, lane); continue; } r -= I_UKV;
            { const int blk = r >> 3, sub = r & 7, nb = blk >> 1, isx = blk & 1;
              tr_item64((isx ? args.in[7] : args.in[5]) + (size_t)nb * 16384, 128, 256, 128, nullptr, WLRU + (size_t)(256 * nb + 128 * isx) * 256, 2, sub, lane, 128 * (nb & 1), 128); }
        }
        for (int i = blockIdx.x * 512 + tid; i < SEQ * 32; i += G * 512) {
            const int pos = i >> 5, k = i & 31; double inv = 1.0; for (int q = 0; q < k; ++q) inv *= 0.74989420933245582730;
            float s, c; sincos_d((double)pos * inv, s, c); CS[2 * i] = c; CS[2 * i + 1] = s;
        }
        for (int i = blockIdx.x * 512 + tid; i < 1024; i += G * 512) csp[i] = 8.0f * 1.4426950408889634f * log1pf(__expf(-args.in[9][i]));
            }
    }
    SEAM(0);

    if (IN(1)) REP(1) { PLAIN_IDS
        pg8::Gemm g{XB, W1, T, 4864, 1024, 1024, 1024, 0, 0}; pg8::StaticOrder S; S.init(T, 4864, G, (int)blockIdx.x);
        pg8::EpiIn E{ZX, G1, G2, ZC, rstdx, SSQ, SSKV, KR, CS};
        pg8::gemm_phase<pg8::EpiIn, pg8::StaticOrder, true, true>(ldsg, g, S, E, tid);
    }
    SEAM(1);

    if (IN(2)) REP(2) { PLAIN_IDS
        const float* cw = args.in[3]; const float* cb = args.in[4];
        for (int it = gw; it < (T / 16) * 2; it += NGW) {
            const int t0 = (it >> 1) * 16, c0 = (it & 1) * 512 + lane * 8;
            float w[4][8], bias[8], h0[8], h1[8], h2[8];
#pragma unroll
            for (int j = 0; j < 4; ++j) { const f32x4 a = *(const f32x4*)(cw + j * 1024 + c0), b = *(const f32x4*)(cw + j * 1024 + c0 + 4);
#pragma unroll
                for (int e = 0; e < 4; ++e) { w[j][e] = a[e]; w[j][4 + e] = b[e]; } }
            { const f32x4 a = *(const f32x4*)(cb + c0), b = *(const f32x4*)(cb + c0 + 4);
#pragma unroll
              for (int e = 0; e < 4; ++e) { bias[e] = a[e]; bias[4 + e] = b[e]; } }
            const bool first = (t0 & (SEQ - 1)) == 0;
            { u32x4 r0 = {0u, 0u, 0u, 0u}, r1 = r0, r2 = r0;
              if (!first) { r0 = *(const u32x4*)(ZX + (size_t)(t0 - 3) * DM + c0); r1 = *(const u32x4*)(ZX + (size_t)(t0 - 2) * DM + c0); r2 = *(const u32x4*)(ZX + (size_t)(t0 - 1) * DM + c0); }
#pragma unroll
              for (int e = 0; e < 4; ++e) { h0[2 * e] = bflo(r0[e]); h0[2 * e + 1] = bfhi(r0[e]); h1[2 * e] = bflo(r1[e]); h1[2 * e + 1] = bfhi(r1[e]); h2[2 * e] = bflo(r2[e]); h2[2 * e + 1] = bfhi(r2[e]); } }
            u32x4 rows[16];
#pragma unroll
            for (int i = 0; i < 16; ++i) rows[i] = __builtin_nontemporal_load((const u32x4*)(ZX + (size_t)(t0 + i) * DM + c0));
#pragma unroll
            for (int i = 0; i < 16; ++i) { const u32x4 r = rows[i]; float cur[8], o[8];
#pragma unroll
                for (int e = 0; e < 4; ++e) { cur[2 * e] = bflo(r[e]); cur[2 * e + 1] = bfhi(r[e]); }
#pragma unroll
                for (int e = 0; e < 8; ++e) { o[e] = bias[e] + w[0][e] * h0[e] + w[1][e] * h1[e] + w[2][e] * h2[e] + w[3][e] * cur[e]; h0[e] = h1[e]; h1[e] = h2[e]; h2[e] = cur[e]; }
                u32x4 ow; ow.x = pkbf(o[0], o[1]); ow.y = pkbf(o[2], o[3]); ow.z = pkbf(o[4], o[5]); ow.w = pkbf(o[6], o[7]);
                *(u32x4*)(XA + (size_t)(t0 + i) * DM + c0) = ow; }
        }
    }
    SEAM(2);

    if (IN(3)) REP(3) { PLAIN_IDS
#ifndef P3SEL
#define P3SEL 7
#endif
        if (P3SEL & 1) { pg8::Gemm g{XA, WLRU, T, 2048, 256, 1024, 256, 512, 1}; pg8::StaticOrder S; S.init(T, 2048, G, (int)blockIdx.x);
#ifdef TESTLRU
          pg8::EpiRowScale E{KV, 2048, SSKV};
          pg8::gemm_phase<pg8::EpiRowScale, pg8::StaticOrder, true, true>(ldsg, g, S, E, tid); }
#else
          pg8::EpiLru E{XA, args.in[6], args.in[8], csp, AB};
          pg8::gemm_phase<pg8::EpiLru, pg8::StaticOrder, true, true>(ldsg, g, S, E, tid); }
#endif
        if (P3SEL & 2) { pg8::Gemm g{ZC, WUQ, T, 1536, 256, 768, 256, 0, 0}; pg8::StaticOrder S; S.init(T, 1536, G, (int)blockIdx.x);
          pg8::EpiQ E{Q, SSQ, CS};
          pg8::gemm_phase<pg8::EpiQ, pg8::StaticOrder, true, true>(ldsg, g, S, E, tid); }
        if (P3SEL & 4) { pg8::Gemm g{ZC + 256, WUKV, T, 2048, 256, 768, 256, 0, 0}; pg8::StaticOrder S; S.init(T, 2048, G, (int)blockIdx.x);
          pg8::EpiRowScale E{KV, 2048, SSKV};
          pg8::gemm_phase<pg8::EpiRowScale, pg8::StaticOrder, true, true>(ldsg, g, S, E, tid); }
    }
    SEAM(3);

    if (IN(4)) REP(4) { FRESH_IDS
        for (int un = blockIdx.x; un < 256; un += G) {
            const int b = un >> 6, ch = un & 63, c = wave * 128 + lane * 2;
            const unsigned* ap = AB + ((size_t)b * SEQ + ch * 128) * DM + c;
            float h0 = 0.f, h1 = 0.f, L0 = 0.f, L1 = 0.f;
            for (int i0 = 0; i0 < 128; i0 += 32) { h16x4 w[32];
#pragma unroll
                for (int i = 0; i < 32; ++i) w[i] = __builtin_nontemporal_load((const h16x4*)(ap + (size_t)(i0 + i) * DM));
#pragma unroll
                for (int i = 0; i < 32; ++i) { const float l0 = (float)w[i][0], l1 = (float)w[i][2];
                    h0 = __builtin_amdgcn_exp2f(l0) * h0 + (float)w[i][1]; h1 = __builtin_amdgcn_exp2f(l1) * h1 + (float)w[i][3]; L0 += l0; L1 += l1; } }
            *(f32x4*)(SUM + (((size_t)b * 64 + ch) * 1024 + c) * 2) = (f32x4){L0, h0, L1, h1};
        }
        {
            constexpr int NITEM = 32 * 16;
#define ITEM_BH(LL) (G == 256 ? (((LL) & 7) + 8 * (2 * ((LL) >> 8) + (((LL) >> 7) & 1))) : ((LL) >> 4))
#define ITEM_X(LL)  (G == 256 ? (((LL) >> 3) & 15) : ((LL) & 15))
            int L = blockIdx.x;
            if (L < NITEM) {
                att::Seam S; int pass = 0;
#define MKREF(r, LL, ps) do { const int bh_ = ITEM_BH(LL), xx_ = ITEM_X(LL), qb_ = (ps) ? 31 - xx_ : xx_, b_ = bh_ >> 3, h_ = bh_ & 7; \
                    const size_t row0_ = (size_t)b_ * SEQ + qb_ * 256, key0_ = (size_t)b_ * SEQ; \
                    r.Qn = Q + row0_ * 1536 + h_ * 128; r.Qr = Q + row0_ * 1536 + 1024 + h_ * 64; r.Kn = KV + key0_ * 2048 + h_ * 256; r.V = r.Kn + 128; r.Kr = KR + key0_ * 64; \
                    r.O = YB + row0_ * 1024 + h_ * 128; r.P0 = qb_ * 256; } while (0)
                att::BlockRef cur, nxt; MKREF(cur, L, 0);
                att::attn_prime(cur, (char*)lds, S, tid);
                for (;;) {
                    const bool more_pass = pass == 0, more_item = L + G < NITEM, last = !more_pass && !more_item;
                    int passn = pass + 1, Ln = L;
                    if (!more_pass) { passn = 0; Ln = more_item ? L + G : L; }
                    MKREF(nxt, Ln, passn);
                    att::attn_block(cur, nxt, (char*)lds, S, tid);
                    if (last) break;
                    cur = nxt; pass = passn; L = Ln;
                }
            }
#undef MKREF
#undef ITEM_BH
#undef ITEM_X
        }
    }
    SEAM(4);

    if (IN(5)) REP(5) { FRESH_IDS
        for (int gi = blockIdx.x; gi < 256; gi += G) {
            const int b = gi >> 6, ch = gi & 63, c = wave * 128 + lane * 2;
            float h0 = 0.f, h1 = 0.f;
            for (int k0 = 0; k0 < ch; k0 += 8) { f32x4 sv[8];
#pragma unroll
                for (int j = 0; j < 8; ++j) { const int kk = (k0 + j < 63) ? k0 + j : 63; sv[j] = *(const f32x4*)(SUM + (((size_t)b * 64 + kk) * 1024 + c) * 2); }
#pragma unroll
                for (int j = 0; j < 8; ++j) if (k0 + j < ch) { h0 = __builtin_amdgcn_exp2f(sv[j][0]) * h0 + sv[j][1]; h1 = __builtin_amdgcn_exp2f(sv[j][2]) * h1 + sv[j][3]; } }
            const size_t row0 = (size_t)b * SEQ + ch * 128;
            for (int i0 = 0; i0 < 128; i0 += 32) { h16x4 w[32]; unsigned g1[32], g2[32], yb[32];
#pragma unroll
                for (int i = 0; i < 32; ++i) { const size_t off = (row0 + i0 + i) * DM + c;
                    w[i] = __builtin_nontemporal_load((const h16x4*)(AB + off)); g1[i] = __builtin_nontemporal_load((const unsigned*)(G1 + off)); g2[i] = __builtin_nontemporal_load((const unsigned*)(G2 + off)); yb[i] = __builtin_nontemporal_load((const unsigned*)(YB + off)); }
#pragma unroll
                for (int i = 0; i < 32; ++i) { const size_t off = (row0 + i0 + i) * DM + c;
                    h0 = __builtin_amdgcn_exp2f((float)w[i][0]) * h0 + (float)w[i][1]; h1 = __builtin_amdgcn_exp2f((float)w[i][2]) * h1 + (float)w[i][3];
                    *(unsigned*)(MG + off) = pkbf(bflo(g1[i]) * h0 + bflo(g2[i]) * bflo(yb[i]), bfhi(g1[i]) * h1 + bfhi(g2[i]) * bfhi(yb[i])); } }
        }
    }
    SEAM(5);

    if (IN(6)) REP(6) { FRESH_IDS
        pg8::Gemm g{MG, WOUT, T, 1024, 1024, 1024, 1024, 0, 0}; pg8::StaticOrder S; S.init(T, 1024, G, (int)blockIdx.x);
        pg8::EpiRes<true> E{x, nullptr, H1B, SS1};
        pg8::gemm_phase<pg8::EpiRes<true>, pg8::StaticOrder, true, true>(ldsg, g, S, E, tid);
    }
    SEAM(6);

    if (IN(7)) REP(7) { FRESH_IDS
        pg8::Gemm g{H1B, WUP, T, 4096, 1024, 1024, 1024, 0, 0}; pg8::StaticOrder S; S.init(T, 4096, G, (int)blockIdx.x);
        pg8::EpiUp E{U, SS1};
        pg8::gemm_phase<pg8::EpiUp, pg8::StaticOrder, true, true>(ldsg, g, S, E, tid);
    }
    SEAM(7);

    if (IN(8)) REP(8) { FRESH_IDS
        pg8::Gemm g{U, WDN, T, 1024, 4096, 4096, 4096, 0, 0}; pg8::StaticOrder S; S.init(T, 1024, G, (int)blockIdx.x);
        pg8::EpiRes<false> E{nullptr, H1B, H2B, SS2};
        pg8::gemm_phase<pg8::EpiRes<false>, pg8::StaticOrder, true, true>(ldsg, g, S, E, tid);
    }
    SEAM(8);

    if (IN(9)) REP(9) { FRESH_IDS
        const float* gf = args.in[18];
        f32x4 gv[4];
#pragma unroll
        for (int j = 0; j < 4; ++j) gv[j] = ((const f32x4*)gf)[lane + 64 * j];
        for (int m0 = gw * 4; m0 < T; m0 += NGW * 4) {
            f32x4 v[4][4]; float rs[4];
#pragma unroll
            for (int r = 0; r < 4; ++r) { const u32x2* o = (const u32x2*)(H2B + (size_t)(m0 + r) * DM) + lane;
#pragma unroll
                for (int j = 0; j < 4; ++j) { const u32x2 bw = __builtin_nontemporal_load(o + 64 * j); v[r][j] = (f32x4){bflo(bw.x), bfhi(bw.x), bflo(bw.y), bfhi(bw.y)}; }
                const f32x4* sp = (const f32x4*)(SS2 + (size_t)(m0 + r) * 16); const f32x4 s = (sp[0] + sp[1]) + (sp[2] + sp[3]);
                rs[r] = rsqrtf(((s[0] + s[1]) + (s[2] + s[3])) * (1.0f / 1024.0f) + 1e-6f); }
#pragma unroll
            for (int r = 0; r < 4; ++r) { f32x4* o = (f32x4*)(OUT + (size_t)(m0 + r) * DM) + lane;
#pragma unroll
                for (int j = 0; j < 4; ++j) __builtin_nontemporal_store(v[r][j] * rs[r] * gv[j], o + 64 * j); }
        }
    }
#ifdef TSTAMP
    grid.sync();
    if (blockIdx.x == 0 && tid == 0) TS[10] = __builtin_amdgcn_s_memrealtime();
    __threadfence(); grid.sync();
    { const float da = (float)(TS[TSTAMP_A + 1] - TS[TSTAMP_A]) * 0.01f, db = (float)(TS[TSTAMP_B + 1] - TS[TSTAMP_B]) * 0.01f;
      for (size_t i = (size_t)blockIdx.x * 512 + tid; i < ((size_t)1 << 22); i += (size_t)G * 512) OUT[i] = (i == 0) ? 10.0f * da : db; }
#endif
#undef IN
#undef SEAM
}

constexpr int LDS_TOTAL = 153600;
static_assert(att::LDS_BYTES <= LDS_TOTAL && pg8::STAGE_BYTES <= LDS_TOTAL, "LDS");
extern "C" void kernel_launch(void* const* d_in, const int* in_sizes, int n_in, void* d_out, int out_size, void* d_ws, size_t ws_size, hipStream_t stream) {
    static int grid = 0;
    if (grid == 0) {
        if (n_in != 19 || out_size != T * DM || ws_size < WS_END) { fprintf(stderr, "kernel_launch: unexpected shapes (n_in %d, out %d, ws %zu)\n", n_in, out_size, ws_size); grid = -1; return; }
        int dev = 0, cus = 0, per_cu = 0;
        (void)hipGetDevice(&dev); (void)hipDeviceGetAttribute(&cus, hipDeviceAttributeMultiprocessorCount, dev);
        if (hipFuncSetAttribute((const void*)fwd_kernel, hipFuncAttributeMaxDynamicSharedMemorySize, LDS_TOTAL) != hipSuccess) { fprintf(stderr, "kernel_launch: hipFuncSetAttribute failed\n"); grid = -1; return; }
        if (hipOccupancyMaxActiveBlocksPerMultiprocessor(&per_cu, (const void*)fwd_kernel, 512, LDS_TOTAL) != hipSuccess || per_cu < 1) { fprintf(stderr, "kernel_launch: occupancy query says %d\n", per_cu); per_cu = 1; }
        (void)hipGetLastError();
        grid = cus * 1;
        if (grid <= 0) grid = 256;
    }
    if (grid < 0) return;
    Args a{};
    for (int i = 0; i < 19; ++i) a.in[i] = (const float*)d_in[i];
    a.out = (float*)d_out; a.ws = (unsigned char*)d_ws;
#if N_LAUNCHES == 1
    a.ph_lo = 0; a.ph_hi = NPHASE;
    (void)hipMemsetAsync((unsigned char*)d_ws + WS_BAR, 0, 16384, stream);
    void* kargs[] = {&a};
    hipError_t e = hipLaunchCooperativeKernel((const void*)fwd_kernel, dim3(grid), dim3(512), kargs, LDS_TOTAL, stream);
    if (e != hipSuccess) fprintf(stderr, "kernel_launch: cooperative launch failed: %s (grid %d)\n", hipGetErrorString(e), grid);
#else
#ifdef DIAG
    (void)hipMemsetAsync((unsigned char*)d_ws + WS_CSP + 8192, 0x7f, 4, stream); (void)hipMemsetAsync((unsigned char*)d_ws + WS_CSP + 8196, 0, 4, stream);
#endif
#ifndef PROBE_LIST
#define PROBE_LIST 0,1,2,3,4,5,6,7,8,9
#endif
    static const int plist[] = {PROBE_LIST};
    for (int pi = 0; pi < (int)(sizeof(plist) / sizeof(int)); ++pi) { const int p = plist[pi]; a.ph_lo = p; a.ph_hi = p + 1;
        hipLaunchKernelGGL(fwd_kernel, dim3(grid), dim3(512), LDS_TOTAL, stream, a);
#ifdef DIAG
        a.ph_lo = 100 + p; a.ph_hi = 101 + p; hipLaunchKernelGGL(fwd_kernel, dim3(grid), dim3(512), LDS_TOTAL, stream, a);
        if (p == NPHASE - 1) { a.ph_lo = 110; a.ph_hi = 111; hipLaunchKernelGGL(fwd_kernel, dim3(grid), dim3(512), LDS_TOTAL, stream, a); }
#endif
        if (hipPeekAtLastError() != hipSuccess) { fprintf(stderr, "kernel_launch: launch %d failed\n", p); break; } }
#endif
}
```

```cpp
#define N_LAUNCHES 1
#include <hip/hip_runtime.h>
#include <hip/hip_cooperative_groups.h>
#include <cstdio>
#include <cstdint>
namespace cg = cooperative_groups;
namespace pg8 {
#define PG8_LAS __attribute__((address_space(3)))
typedef unsigned short bf16_t;
typedef short bf16x8 __attribute__((ext_vector_type(8)));
typedef float f32x4 __attribute__((ext_vector_type(4)));
typedef unsigned u32x4 __attribute__((ext_vector_type(4)));
constexpr int BM = 256, BK = 64, HALF = 128, HTB = HALF * BK * 2  , STAGE_BYTES = 8 * HTB, NXCD = 8, WGM = 8;

__host__ __device__ __forceinline__ int lds_byte(int r, int c) { const int st = (r >> 4) * 2 + (c >> 5), rr = r & 15, cc = c & 31, ob = rr * 64 + cc * 2; return st * 1024 + (ob ^ (((ob >> 9) & 1) << 5)); }
__host__ __device__ __forceinline__ void stage_rc(int b, int& R, int& C) { const int st = b / 1024, sb = b % 1024, swz = sb ^ (((sb >> 9) & 1) << 5); R = (st >> 1) * 16 + swz / 64; C = (st & 1) * 32 + (swz % 64) / 2; }
__host__ __device__ __forceinline__ int perm32(int rho) { const int n = rho >> 4, i = rho & 15; return 8 * (i >> 2) + 4 * n + (i & 3); }

struct Unit { int pm, pn; };
struct Gemm { const bf16_t* A; const bf16_t* Bt; int M, N, K, lda, ldb; long a_pn_bytes; int a_pn_shift; };

struct StaticOrder {
    int nM, nN, nwg, G, c;
    __host__ __device__ void init(int M, int N, int G_, int c_) { nM = M / BM; nN = N / BM; nwg = nM * nN; G = G_; c = c_; }
    __host__ __device__ bool next(int i, Unit& u) const {
        const long L = (long)i * G + c; if (L >= nwg) return false;
        int wgid = (int)L; { const int q = nwg / NXCD, r = nwg % NXCD, xcd = wgid % NXCD, off = wgid / NXCD; wgid = (xcd < r ? xcd * (q + 1) : r * (q + 1) + (xcd - r) * q) + off; }
        const int nig = WGM * nN, gid = wgid / nig, fm = gid * WGM, gsz = (nM - fm) < WGM ? (nM - fm) : WGM;
        u.pm = fm + ((wgid % nig) % gsz); u.pn = (wgid % nig) / gsz; return true;
    }
    __device__ __forceinline__ void a_ready(const Unit&) const {}
    __device__ __forceinline__ void done(const Unit&) const {}
};

__device__ __forceinline__ unsigned cvt_pk_bf16(float lo, float hi) { unsigned r; asm volatile("v_cvt_pk_bf16_f32 %0, %1, %2" : "=v"(r) : "v"(lo), "v"(hi)); return r; }
typedef float f32x2 __attribute__((ext_vector_type(2)));
typedef unsigned u32x2 __attribute__((ext_vector_type(2)));
typedef _Float16 h16x2 __attribute__((ext_vector_type(2)));
__device__ __forceinline__ float fsigmoid(float v) { return __builtin_amdgcn_rcpf(1.0f + __expf(-v)); }
__device__ __forceinline__ float gelu_tanh(float v) { const float y = 1.5957691216057308f * (v + 0.044715f * v * v * v); return v * fsigmoid(y); }
__device__ __forceinline__ u32x4 pack8f(const f32x4 a, const f32x4 b) { u32x4 w; w.x = cvt_pk_bf16(a[0], a[1]); w.y = cvt_pk_bf16(a[2], a[3]); w.z = cvt_pk_bf16(b[0], b[1]); w.w = cvt_pk_bf16(b[2], b[3]); return w; }
__device__ __forceinline__ float bf2f(unsigned short b) { return __uint_as_float((unsigned)b << 16); }

struct EpiIn {
    static constexpr bool PERM = true, AFTER_DRAIN = false;
    bf16_t *ZX, *G1, *G2, *ZC; const float* rstd; float *SSQ, *SSKV; bf16_t* KR; const float* CS;
    __device__ __forceinline__ void operator()(const f32x4 (&acc)[2][2][4][2], const Unit& u, int wr, int wc, int fr, int fq) const {
        const int row0 = u.pm * BM + wr * 64 + fr, cl = wc * 32 + 8 * fq, pn = u.pn;
#pragma unroll
        for (int ai = 0; ai < 2; ++ai)
#pragma unroll
            for (int m = 0; m < 4; ++m) { const int row = row0 + ai * HALF + m * 16; const float rs = rstd[row];
                if (pn >= 4 && pn < 12) {
                    f32x4 o[2];
#pragma unroll
                    for (int n = 0; n < 2; ++n)
#pragma unroll
                        for (int e = 0; e < 4; ++e) o[n][e] = gelu_tanh(acc[ai][0][m][n][e] * rs) * fsigmoid(acc[ai][1][m][n][e] * rs);
                    __builtin_nontemporal_store(pack8f(o[0], o[1]), (u32x4*)(G1 + (size_t)row * 1024 + (pn - 4) * 128 + cl));
                } else {
#pragma unroll
                    for (int bj = 0; bj < 2; ++bj) { f32x4 v0 = acc[ai][bj][m][0] * rs, v1 = acc[ai][bj][m][1] * rs;
                        if (pn < 4) *(u32x4*)(ZX + (size_t)row * 1024 + pn * 256 + bj * HALF + cl) = pack8f(v0, v1);
                        else if (pn < 16) {
#pragma unroll
                            for (int e = 0; e < 4; ++e) { v0[e] = fsigmoid(v0[e]); v1[e] = fsigmoid(v1[e]); }
                            __builtin_nontemporal_store(pack8f(v0, v1), (u32x4*)(G2 + (size_t)row * 1024 + (pn - 12) * 256 + bj * HALF + cl));
                        } else if (pn < 18) *(u32x4*)(ZC + (size_t)row * 768 + (pn - 16) * 256 + bj * HALF + cl) = pack8f(v0, v1);
                        else if (bj == 0 && wc < 2) {
                            const float* cs = CS + ((size_t)(row & 8191) * 32 + 16 * wc + 4 * fq) * 2;
                            const f32x4 c01 = *(const f32x4*)cs, c23 = *(const f32x4*)(cs + 4);
                            const float co[4] = {c01[0], c01[2], c23[0], c23[2]}, si[4] = {c01[1], c01[3], c23[1], c23[3]}; f32x4 olo, ohi;
#pragma unroll
                            for (int e2 = 0; e2 < 4; ++e2) { olo[e2] = v0[e2] * co[e2] - v1[e2] * si[e2]; ohi[e2] = v1[e2] * co[e2] + v0[e2] * si[e2]; }
                            *(u32x4*)(KR + (size_t)row * 64 + cl) = pack8f(olo, ohi); }
                    }
                    if (pn == 16 || pn == 17) {
                        float ss = 0.f;
#pragma unroll
                        for (int bj = 0; bj < 2; ++bj)
#pragma unroll
                            for (int n = 0; n < 2; ++n) { const f32x4 z = acc[ai][bj][m][n] * rs; ss += (z[0] * z[0] + z[1] * z[1]) + (z[2] * z[2] + z[3] * z[3]); }
                        ss += __shfl_xor(ss, 16); ss += __shfl_xor(ss, 32);
                        if (fq == 0) (pn == 16 ? SSQ : SSKV)[(size_t)row * 4 + wc] = ss; }
                }
            }
    }
};
__device__ __forceinline__ float one_minus_exp(float x) {
    const float p = -x * (1.0f + x * (0.5f + x * (0.16666667f + x * (0.041666668f + x * 0.0083333338f))));
    const float q = 1.0f - __builtin_amdgcn_exp2f(x * 1.4426950408889634f);
    return x > -0.2f ? p : q;
}
struct EpiLru {
    static constexpr bool PERM = true, AFTER_DRAIN = false;
    const bf16_t* XA; const float *ba, *bx, *csp; unsigned* AB;
    __device__ __forceinline__ void operator()(const f32x4 (&acc)[2][2][4][2], const Unit& u, int wr, int wc, int fr, int fq) const {
        const int c0 = u.pn * 128 + wc * 32 + 8 * fq;
        const unsigned lo = (unsigned)((wr * 64 + fr) * 1024 + c0);
        const char* xau = (const char*)(XA + (size_t)u.pm * BM * 1024); char* abu = (char*)(AB + (size_t)u.pm * BM * 1024);
#pragma unroll
        for (int n = 0; n < 2; ++n) {

#ifdef NOBIAS
 const f32x4 vba = {0.f,0.f,0.f,0.f}, vbx = vba, vcs = {1.f,1.f,1.f,1.f};
#else
 const f32x4 vba = *(const f32x4*)(ba + c0 + 4 * n), vbx = *(const f32x4*)(bx + c0 + 4 * n), vcs = *(const f32x4*)(csp + c0 + 4 * n);
#endif

#pragma unroll
            for (int ai = 0; ai < 2; ++ai)
#pragma unroll
                for (int m = 0; m < 4; ++m) { const int ro = (ai * HALF + m * 16) * 1024 + 4 * n;

#ifdef NOXA
 const u32x2 xw = {0x3f803f80u, 0x3f803f80u};
#else
 const u32x2 xw = *(const u32x2*)(xau + (size_t)ro * 2 + lo * 2u);
#endif
 u32x4 ow;
#pragma unroll
                    for (int e = 0; e < 4; ++e) { const unsigned w = xw[e >> 1]; const float xa = __uint_as_float((e & 1) ? (w & 0xffff0000u) : (w << 16));
                        const float r = fsigmoid(acc[ai][0][m][n][e] + vba[e]), ig = fsigmoid(acc[ai][1][m][n][e] + vbx[e]);
                        const float la2 = -vcs[e] * r; const float b = __builtin_amdgcn_sqrtf(fmaxf(1.0f - __builtin_amdgcn_exp2f(2.0f * la2), 0.f)) * (ig * xa);
                        h16x2 hv; hv.x = (_Float16)la2; hv.y = (_Float16)b; ow[e] = __builtin_bit_cast(unsigned, hv); }
                    *(u32x4*)(abu + (size_t)ro * 4 + lo * 4u) = ow;
                    __builtin_amdgcn_sched_barrier(0); }
        }
    }
};
struct EpiQ {
    static constexpr bool PERM = true, AFTER_DRAIN = false;
    bf16_t* Q; const float* SSp; const float* CS;
    __device__ __forceinline__ void operator()(const f32x4 (&acc)[2][2][4][2], const Unit& u, int wr, int wc, int fr, int fq) const {
        const int row0 = u.pm * BM + wr * 64 + fr, cl = wc * 32 + 8 * fq, pn = u.pn;
#pragma unroll
        for (int ai = 0; ai < 2; ++ai)
#pragma unroll
            for (int m = 0; m < 4; ++m) { const int row = row0 + ai * HALF + m * 16; const f32x4 sp = *(const f32x4*)(SSp + (size_t)row * 4); const float rs = rsqrtf(((sp[0] + sp[1]) + (sp[2] + sp[3])) * (1.0f / 256.0f) + 1e-6f);
                bf16_t* op = Q + (size_t)row * 1536 + pn * 256 + cl;
                if (pn < 4) {
#pragma unroll
                    for (int bj = 0; bj < 2; ++bj) *(u32x4*)(op + bj * HALF) = pack8f(acc[ai][bj][m][0] * rs, acc[ai][bj][m][1] * rs);
                } else {
                    const float* cs = CS + ((size_t)(row & 8191) * 32 + 16 * (wc & 1) + 4 * fq) * 2;
                    const f32x4 c01 = *(const f32x4*)cs, c23 = *(const f32x4*)(cs + 4);
                    const float co[4] = {c01[0], c01[2], c23[0], c23[2]}, si[4] = {c01[1], c01[3], c23[1], c23[3]};
#pragma unroll
                    for (int bj = 0; bj < 2; ++bj) { const f32x4 lo = acc[ai][bj][m][0] * rs, hi = acc[ai][bj][m][1] * rs; f32x4 olo, ohi;
#pragma unroll
                        for (int e = 0; e < 4; ++e) { olo[e] = lo[e] * co[e] - hi[e] * si[e]; ohi[e] = hi[e] * co[e] + lo[e] * si[e]; }
                        *(u32x4*)(op + bj * HALF) = pack8f(olo, ohi); }
                }
            }
    }
};
struct EpiRowScale {
    static constexpr bool PERM = true, AFTER_DRAIN = false;
    bf16_t* O; int ldc; const float* SSp;
    __device__ __forceinline__ void operator()(const f32x4 (&acc)[2][2][4][2], const Unit& u, int wr, int wc, int fr, int fq) const {
        const int row0 = u.pm * BM + wr * 64 + fr, cl = u.pn * 256 + wc * 32 + 8 * fq;
#pragma unroll
        for (int ai = 0; ai < 2; ++ai)
#pragma unroll
            for (int m = 0; m < 4; ++m) { const int row = row0 + ai * HALF + m * 16; const f32x4 sp = *(const f32x4*)(SSp + (size_t)row * 4); const float rs = rsqrtf(((sp[0] + sp[1]) + (sp[2] + sp[3])) * (1.0f / 256.0f) + 1e-6f);
#pragma unroll
                for (int bj = 0; bj < 2; ++bj) *(u32x4*)(O + (size_t)row * ldc + cl + bj * HALF) = pack8f(acc[ai][bj][m][0] * rs, acc[ai][bj][m][1] * rs);
            }
    }
};
template <bool BASE_F32> struct EpiRes {
    static constexpr bool PERM = false, AFTER_DRAIN = false;
    const float* basef; const bf16_t* baseb; bf16_t* outb; float* SS;
    __device__ __forceinline__ void operator()(const f32x4 (&acc)[2][2][4][2], const Unit& u, int wr, int wc, int fr, int fq) const {
        const int row0 = u.pm * BM + wr * 64 + fr, col0 = u.pn * 256 + wc * 32 + 4 * fq;
#pragma unroll
        for (int ai = 0; ai < 2; ++ai)
#pragma unroll
            for (int m = 0; m < 4; ++m) { const int row = row0 + ai * HALF + m * 16; const size_t off = (size_t)row * 1024 + col0; float ss = 0.f;
#pragma unroll
                for (int bj = 0; bj < 2; ++bj)
#pragma unroll
                    for (int n = 0; n < 2; ++n) { const size_t o2 = off + bj * HALF + n * 16; f32x4 h;
                        if (BASE_F32) h = __builtin_nontemporal_load((const f32x4*)(basef + o2)) + acc[ai][bj][m][n];
                        else { const u32x2 bw = *(const u32x2*)(baseb + o2); h = (f32x4){__uint_as_float(bw.x << 16), __uint_as_float(bw.x & 0xffff0000u), __uint_as_float(bw.y << 16), __uint_as_float(bw.y & 0xffff0000u)} + acc[ai][bj][m][n]; }
                        ss += (h[0] * h[0] + h[1] * h[1]) + (h[2] * h[2] + h[3] * h[3]);
                        u32x2 w; w.x = cvt_pk_bf16(h[0], h[1]); w.y = cvt_pk_bf16(h[2], h[3]); *(u32x2*)(outb + o2) = w; }
                ss += __shfl_xor(ss, 16); ss += __shfl_xor(ss, 32);
                if (fq == 0) SS[(size_t)row * 16 + u.pn * 4 + wc] = ss;
            }
    }
};
struct EpiUp {
    static constexpr bool PERM = true, AFTER_DRAIN = false;
    bf16_t* U; const float* SS;
    __device__ __forceinline__ void operator()(const f32x4 (&acc)[2][2][4][2], const Unit& u, int wr, int wc, int fr, int fq) const {
        const int row0 = u.pm * BM + wr * 64 + fr, cl = u.pn * 256 + wc * 32 + 8 * fq;
#pragma unroll
        for (int ai = 0; ai < 2; ++ai)
#pragma unroll
            for (int m = 0; m < 4; ++m) { const int row = row0 + ai * HALF + m * 16;
                const f32x4* sp = (const f32x4*)(SS + (size_t)row * 16); const f32x4 s = (sp[0] + sp[1]) + (sp[2] + sp[3]);
                const float rs = rsqrtf(((s[0] + s[1]) + (s[2] + s[3])) * (1.0f / 1024.0f) + 1e-6f);
#pragma unroll
                for (int bj = 0; bj < 2; ++bj) { f32x4 v0 = acc[ai][bj][m][0] * rs, v1 = acc[ai][bj][m][1] * rs;
#pragma unroll
                    for (int e = 0; e < 4; ++e) { const float a = fmaxf(v0[e], 0.f), b = fmaxf(v1[e], 0.f); v0[e] = a * a; v1[e] = b * b; }
                    *(u32x4*)(U + (size_t)row * 4096 + cl + bj * HALF) = pack8f(v0, v1); }
            }
    }
};
template <class Epi, class Sched, bool ALIGN_EPI = false, bool SP2 = false>
__device__ __forceinline__ void gemm_phase(PG8_LAS unsigned char* lds, const Gemm g, const Sched& S, const Epi& E, const int tid0) {
    int tid_ = tid0; asm volatile("" : "+v"(tid_));
    const int tid = tid_, wid = __builtin_amdgcn_readfirstlane(tid >> 6), lane = tid & 63, wr = wid >> 2, wc = wid & 3, fr = lane & 15, fq = lane >> 4;
    int K_ = g.K; asm volatile("" : "+s"(K_));
    const int K = K_, nt = K / BK;
    unsigned voffA[2], voffB[2];
#pragma unroll
    for (int i = 0; i < 2; ++i) { int R, C; stage_rc(tid * 16 + i * 8192, R, C); const int Rb = Epi::PERM ? ((R & ~31) + perm32(R & 31)) : R;
        voffA[i] = (unsigned)(R * g.lda + C) * 2u; voffB[i] = (unsigned)(Rb * g.ldb + C) * 2u; }
    const size_t kstep = (size_t)(BK * 2);
    const size_t hstepA = (size_t)HALF * g.lda * 2, hstepB = (size_t)HALF * g.ldb * 2;
    const size_t tstepA = 2 * hstepA, tstepB = 2 * hstepB;
    const unsigned ldsw = (unsigned)wid * 1024u;
    const int aoff = lds_byte(wr * 64 + fr, fq * 8), boff = lds_byte(wc * 32 + fr, fq * 8);
#define PG8_SA(b, h) (((b) * 2 + (h)) * HTB)
#define PG8_SB(b, h) ((4 + (b) * 2 + (h)) * HTB)
#define PG8_STAGE(bufoff, gbase, voff) do { _Pragma("unroll") for (int _i = 0; _i < 2; ++_i) \
        __builtin_amdgcn_global_load_lds((const unsigned*)((const char*)(gbase) + (voff)[_i]), (PG8_LAS unsigned*)(lds + (bufoff) + ldsw + _i * 8192), 16, 0, 0); } while (0)
#define PG8_LDA(dst, b, h) do { _Pragma("unroll") for (int m = 0; m < 4; ++m) _Pragma("unroll") for (int k = 0; k < 2; ++k) dst[m][k] = *(const PG8_LAS bf16x8*)(lds + PG8_SA(b, h) + aoff + m * 2048 + k * 1024); } while (0)
#define PG8_LDB(dst, b, h) do { _Pragma("unroll") for (int n = 0; n < 2; ++n) _Pragma("unroll") for (int k = 0; k < 2; ++k) dst[n][k] = *(const PG8_LAS bf16x8*)(lds + PG8_SB(b, h) + boff + n * 2048 + k * 1024); } while (0)
#define PG8_MMA(ai, bj, At, Bt) do { __builtin_amdgcn_s_setprio(1); _Pragma("unroll") for (int m = 0; m < 4; ++m) _Pragma("unroll") for (int n = 0; n < 2; ++n) _Pragma("unroll") for (int k = 0; k < 2; ++k) \
        acc[ai][bj][m][n] = __builtin_amdgcn_mfma_f32_16x16x32_bf16(Bt[n][k], At[m][k], acc[ai][bj][m][n], 0, 0, 0); __builtin_amdgcn_s_setprio(0); } while (0)
#define PG8_WAIT_V(n) asm volatile("s_waitcnt vmcnt(" #n ")" ::: "memory")
#define PG8_WAIT_L(n) asm volatile("s_waitcnt lgkmcnt(" #n ")" ::: "memory")
#define PG8_BAR __builtin_amdgcn_s_barrier()
#define PG8_SCHED __builtin_amdgcn_sched_barrier(0)
    Unit cur, nxt; int ui = 0;
    if (!S.next(0, cur)) return;
    f32x4 acc[2][2][4][2];
#pragma unroll
    for (int a = 0; a < 2; ++a)
#pragma unroll
        for (int b = 0; b < 2; ++b)
#pragma unroll
            for (int m = 0; m < 4; ++m)
#pragma unroll
                for (int n = 0; n < 2; ++n) acc[a][b][m][n] = (f32x4){0.f, 0.f, 0.f, 0.f};
    bf16x8 At[4][2], B0[2][2], B1[2][2];
    const char* cA = (const char*)g.A + (size_t)cur.pm * tstepA + (size_t)(cur.pn >> g.a_pn_shift) * g.a_pn_bytes; const char* cB = (const char*)g.Bt + (size_t)cur.pn * tstepB;
    S.a_ready(cur);
    if constexpr (SP2) {
        PG8_STAGE(PG8_SB(0, 0), cB, voffB); PG8_STAGE(PG8_SB(0, 1), cB + hstepB, voffB); PG8_STAGE(PG8_SA(0, 0), cA, voffA); PG8_STAGE(PG8_SA(0, 1), cA + hstepA, voffA);
        if (wr == 1) PG8_BAR;
        PG8_WAIT_V(2); PG8_BAR;
        PG8_STAGE(PG8_SB(1, 0), cB + kstep, voffB); PG8_STAGE(PG8_SA(1, 0), cA + kstep, voffA); PG8_STAGE(PG8_SB(1, 1), cB + hstepB + kstep, voffB);
        PG8_WAIT_V(6); PG8_BAR;
    } else {
        PG8_STAGE(PG8_SB(0, 0), cB, voffB); PG8_STAGE(PG8_SA(0, 0), cA, voffA); PG8_STAGE(PG8_SB(0, 1), cB + hstepB, voffB); PG8_STAGE(PG8_SA(0, 1), cA + hstepA, voffA);
        if (wr == 1) PG8_BAR;
        PG8_WAIT_V(4); PG8_BAR;
        PG8_STAGE(PG8_SB(1, 0), cB + kstep, voffB); PG8_STAGE(PG8_SA(1, 0), cA + kstep, voffA); PG8_STAGE(PG8_SB(1, 1), cB + hstepB + kstep, voffB);
        PG8_WAIT_V(6); PG8_BAR;
    }
    for (;;) {
        const bool has_next = S.next(ui + 1, nxt);
        const char* nA = has_next ? (const char*)g.A + (size_t)nxt.pm * tstepA + (size_t)(nxt.pn >> g.a_pn_shift) * g.a_pn_bytes : cA; const char* nB = has_next ? (const char*)g.Bt + (size_t)nxt.pn * tstepB : cB;
        for (int t = 0; t < nt; t += 2) {
            const bool last = (t == nt - 2);
            const char* a1 = cA + (size_t)(t + 1) * kstep;
            const char* a2 = last ? nA : cA + (size_t)(t + 2) * kstep; const char* b2 = last ? nB : cB + (size_t)(t + 2) * kstep;
            const char* a3 = a2 + kstep; const char* b3 = b2 + kstep;
            if (last && has_next) S.a_ready(nxt);
            if constexpr (SP2) {
            PG8_LDB(B0, 0, 0); PG8_LDB(B1, 0, 1); PG8_SCHED; PG8_LDA(At, 0, 0); PG8_STAGE(PG8_SA(1, 1), a1 + hstepA, voffA);
            PG8_WAIT_V(8); PG8_WAIT_L(0); PG8_BAR; PG8_MMA(0, 0, At, B0); PG8_MMA(0, 1, At, B1); PG8_BAR; PG8_SCHED;
            PG8_LDA(At, 0, 1); PG8_STAGE(PG8_SB(0, 0), b2, voffB); PG8_STAGE(PG8_SB(0, 1), b2 + hstepB, voffB); PG8_STAGE(PG8_SA(0, 0), a2, voffA);
            PG8_WAIT_V(8); PG8_WAIT_L(0); PG8_BAR; PG8_MMA(1, 0, At, B0); PG8_MMA(1, 1, At, B1); PG8_BAR; PG8_SCHED;
            PG8_LDB(B0, 1, 0); PG8_LDB(B1, 1, 1); PG8_SCHED; PG8_LDA(At, 1, 0); PG8_STAGE(PG8_SA(0, 1), a2 + hstepA, voffA);
            PG8_WAIT_V(8); PG8_WAIT_L(0); PG8_BAR; PG8_MMA(0, 0, At, B0); PG8_MMA(0, 1, At, B1); PG8_BAR; PG8_SCHED;
            PG8_LDA(At, 1, 1); PG8_STAGE(PG8_SB(1, 0), b3, voffB); PG8_STAGE(PG8_SB(1, 1), b3 + hstepB, voffB); PG8_STAGE(PG8_SA(1, 0), a3, voffA);
            PG8_WAIT_V(8); PG8_WAIT_L(0); PG8_BAR; PG8_MMA(1, 0, At, B0); PG8_MMA(1, 1, At, B1); PG8_BAR; PG8_SCHED;
            } else {
            PG8_LDB(B0, 0, 0); PG8_SCHED; PG8_LDA(At, 0, 0); PG8_STAGE(PG8_SA(1, 1), a1 + hstepA, voffA);
            PG8_WAIT_L(8); PG8_BAR; PG8_WAIT_L(0); PG8_MMA(0, 0, At, B0); PG8_BAR; PG8_SCHED;
            PG8_LDB(B1, 0, 1); PG8_STAGE(PG8_SB(0, 0), b2, voffB);
            PG8_BAR; PG8_WAIT_L(0); PG8_MMA(0, 1, At, B1); PG8_BAR;
            PG8_LDA(At, 0, 1); PG8_STAGE(PG8_SA(0, 0), a2, voffA);
            PG8_BAR; PG8_WAIT_L(0); PG8_MMA(1, 0, At, B0); PG8_BAR; PG8_SCHED;
            PG8_STAGE(PG8_SB(0, 1), b2 + hstepB, voffB);
            PG8_WAIT_V(6); PG8_BAR; PG8_MMA(1, 1, At, B1); PG8_BAR;
            PG8_LDB(B0, 1, 0); PG8_SCHED; PG8_LDA(At, 1, 0); PG8_STAGE(PG8_SA(0, 1), a2 + hstepA, voffA);
            PG8_WAIT_L(8); PG8_BAR; PG8_WAIT_L(0); PG8_MMA(0, 0, At, B0); PG8_BAR; PG8_SCHED;
            PG8_LDB(B1, 1, 1); PG8_STAGE(PG8_SB(1, 0), b3, voffB);
            PG8_BAR; PG8_WAIT_L(0); PG8_MMA(0, 1, At, B1); PG8_BAR;
            PG8_LDA(At, 1, 1); PG8_STAGE(PG8_SA(1, 0), a3, voffA);
            PG8_BAR; PG8_WAIT_L(0); PG8_MMA(1, 0, At, B0); PG8_BAR; PG8_SCHED;
            PG8_STAGE(PG8_SB(1, 1), b3 + hstepB, voffB);
            PG8_WAIT_V(6); PG8_BAR; PG8_MMA(1, 1, At, B1); PG8_BAR;
            }
        }
        if constexpr (ALIGN_EPI) { if (wr == 0) PG8_BAR; }
        if constexpr (!Epi::AFTER_DRAIN) { E(acc, cur, wr, wc, fr, fq); S.done(cur); }
        if (!has_next) break;
#pragma unroll
        for (int a = 0; a < 2; ++a)
#pragma unroll
            for (int b = 0; b < 2; ++b)
#pragma unroll
                for (int m = 0; m < 4; ++m)
#pragma unroll
                    for (int n = 0; n < 2; ++n) acc[a][b][m][n] = (f32x4){0.f, 0.f, 0.f, 0.f};
        cur = nxt; cA = nA; cB = nB; ++ui;
        if constexpr (ALIGN_EPI) { if (wr == 1) PG8_BAR; }
    }
    PG8_WAIT_V(0);
    if constexpr (!ALIGN_EPI) { if (wr == 0) PG8_BAR; }
    PG8_BAR;
    if constexpr (Epi::AFTER_DRAIN) { E.fused(acc, cur, wr, wc, fr, fq, lds, wid, lane); S.done(cur); }
#undef PG8_SA
#undef PG8_SB
#undef PG8_STAGE
#undef PG8_LDA
#undef PG8_LDB
#undef PG8_MMA
#undef PG8_WAIT_V
#undef PG8_WAIT_L
#undef PG8_BAR
#undef PG8_SCHED
}
}
namespace att {
typedef unsigned short bf16_t;
typedef short bf16x8 __attribute__((ext_vector_type(8)));
typedef short s16x4 __attribute__((ext_vector_type(4)));
typedef float f32x16 __attribute__((ext_vector_type(16)));
typedef float f32x4 __attribute__((ext_vector_type(4)));
typedef unsigned u32x4 __attribute__((ext_vector_type(4)));
constexpr int NW = 8, QBLK = 32, KVBLK = 64, QB = NW * QBLK;
constexpr int DK = 192, DV = 128;
constexpr int QS = 1536, KVS = 2048, KRS = 64, OS = 1024;
constexpr int SHM_V = KVBLK * DV * 2, SHM_K = KVBLK * DK * 2;
constexpr int LDS_QR = 2 * SHM_V + 2 * SHM_K + NW * 64 * 4;
constexpr int LDS_BYTES = LDS_QR + NW * 8192;
constexpr float SCALE = 0.07216878364870322f;
constexpr float THR = 8.f;
#define KSWZ(row, colB) ((row) * 384 + ((colB) ^ (((row) & 7) << 4)))
#define SBAR() __builtin_amdgcn_sched_barrier(0)
__device__ __forceinline__ int v_st(int k, int c) { const int kk = (k & ~0xC) | ((k & 4) << 1) | ((k & 8) >> 1); return ((kk >> 3) * 4 + (c >> 5)) * 512 + ((kk & 7) * 32 + (c & 31)) * 2; }
__device__ __forceinline__ int v_rd_base(int lane) { return ((lane & 3) << 3) | (((lane >> 2) & 3) << 6) | (((lane >> 4) & 1) << 5) | (((lane >> 5) & 1) << 8); }
constexpr int v_rd_off(int d0, int ks, int half) { return d0 * 512 + ks * 4096 + half * 2048; }
__device__ __forceinline__ int crow(int r, int hi) { return (r & 3) + 8 * (r >> 2) + 4 * hi; }
__device__ __forceinline__ unsigned cvtpk(float lo, float hi) { unsigned r; asm volatile("v_cvt_pk_bf16_f32 %0, %1, %2" : "=v"(r) : "v"(lo), "v"(hi)); return r; }
__device__ __forceinline__ bf16x8 load8(const bf16_t* p) { return *reinterpret_cast<const bf16x8*>(p); }
__device__ __forceinline__ void mask_tile(f32x16& p0, f32x16& p1, int dq) {
    const float NEG = -__builtin_inff();
#pragma unroll
    for (int r = 0; r < 16; ++r) {
        const int c = (r & 3) + 8 * (r >> 2);
        if (dq - c < 0) p0[r] = NEG;
        if (dq - c - 32 < 0) p1[r] = NEG;
    }
}
__device__ __forceinline__ void partialSM(f32x16& p0, f32x16& p1, float& m_reg, float& mn, float& alpha) {
    float pmax = p0[0]; for (int r = 1; r < 16; ++r) pmax = fmaxf(pmax, p0[r]); for (int r = 0; r < 16; ++r) pmax = fmaxf(pmax, p1[r]);
    { auto rr = __builtin_amdgcn_permlane32_swap(__float_as_uint(pmax), __float_as_uint(pmax), false, false);
      pmax = fmaxf(__uint_as_float(rr[0]), __uint_as_float(rr[1])); }
    constexpr float C2 = 1.4426950408889634f * SCALE;
    if (__builtin_expect(__all((pmax - m_reg) * SCALE <= THR), 1)) { mn = m_reg; alpha = 1.f; }
    else { mn = fmaxf(m_reg, pmax); alpha = __builtin_amdgcn_exp2f((m_reg - mn) * C2); m_reg = mn; }
    const float mnL = -mn * C2;
    for (int r = 0; r < 16; ++r) p0[r] = fmaf(p0[r], C2, mnL); for (int r = 0; r < 16; ++r) p1[r] = fmaf(p1[r], C2, mnL);
    for (int r = 0; r < 16; ++r) p0[r] = __builtin_amdgcn_exp2f(p0[r]);
}
__device__ __forceinline__ void finishSM(f32x16& p0, f32x16& p1, float alpha, float& l_reg, bf16x8& pa0, bf16x8& pa1, bf16x8& pa2, bf16x8& pa3) {
    for (int r = 0; r < 16; ++r) p1[r] = __builtin_amdgcn_exp2f(p1[r]);
    float ps = 0; for (int r = 0; r < 16; ++r) ps += p0[r]; for (int r = 0; r < 16; ++r) ps += p1[r];
    { auto rr = __builtin_amdgcn_permlane32_swap(__float_as_uint(ps), __float_as_uint(ps), false, false);
      ps = __uint_as_float(rr[0]) + __uint_as_float(rr[1]); }
    l_reg = l_reg * alpha + ps;
#define PK4(P, B_, OUT) do { unsigned a0 = cvtpk(P[B_+0], P[B_+1]), a1 = cvtpk(P[B_+2], P[B_+3]);                          \
        unsigned b0 = cvtpk(P[B_+4], P[B_+5]), b1 = cvtpk(P[B_+6], P[B_+7]);                                             \
        auto r0 = __builtin_amdgcn_permlane32_swap(a0, b0, false, false); auto r1 = __builtin_amdgcn_permlane32_swap(a1, b1, false, false); \
        u32x4 w = {r0[0], r1[0], r0[1], r1[1]}; OUT = *reinterpret_cast<bf16x8*>(&w); } while (0)
    PK4(p0, 0, pa0); PK4(p0, 8, pa1); PK4(p1, 0, pa2); PK4(p1, 8, pa3);
#undef PK4
}
template <int KB>
__device__ __forceinline__ void qkt(f32x16& p0, f32x16& p1, const char* K_lds, int r32, int hi, const bf16x8* qr, const char* qrl) {
    p0 = f32x16{}; p1 = f32x16{};
    const char* kb[4];
#pragma unroll
    for (int dd = 0; dd < 4; ++dd) kb[dd] = K_lds + KB * SHM_K + KSWZ(r32, (dd * 16 + hi * 8) * 2);
#pragma unroll
    for (int d0 = 0; d0 < 12; ++d0) { const char* a = kb[d0 & 3] + (d0 >> 2) * 128;
        bf16x8 b0 = *reinterpret_cast<const bf16x8*>(a);
        bf16x8 b1 = *reinterpret_cast<const bf16x8*>(a + 32 * 384);
        const bf16x8 qf = d0 < 4 ? qr[d0 & 3] : *reinterpret_cast<const bf16x8*>(qrl + (d0 - 4) * 1024);
        p0 = __builtin_amdgcn_mfma_f32_32x32x16_bf16(b0, qf, p0, 0, 0, 0);
        p1 = __builtin_amdgcn_mfma_f32_32x32x16_bf16(b1, qf, p1, 0, 0, 0); }
}
template <int VB>
__device__ __forceinline__ void pv_tile(f32x16* o, int vb0, bf16x8 pa0, bf16x8 pa1, bf16x8 pa2, bf16x8 pa3) {
#define TRRD(dst, off) asm volatile("ds_read_b64_tr_b16 %0, %1 offset:%2" : "=&v"(dst) : "v"(vb0), "i"(off) : "memory")
#define PV_D0(d0) do { s16x4 l0, l1, l2, l3, h0, h1, h2, h3; constexpr int b_ = VB * SHM_V + v_rd_off(d0, 0, 0);   \
        TRRD(l0, b_); TRRD(h0, b_ + 2048); TRRD(l1, b_ + 4096); TRRD(h1, b_ + 6144); TRRD(l2, b_ + 8192); TRRD(h2, b_ + 10240); TRRD(l3, b_ + 12288); TRRD(h3, b_ + 14336); \
        asm volatile("s_waitcnt lgkmcnt(0)" ::: "memory"); SBAR();   \
        o[d0] = __builtin_amdgcn_mfma_f32_32x32x16_bf16(pa0, (bf16x8){l0[0], l0[1], l0[2], l0[3], h0[0], h0[1], h0[2], h0[3]}, o[d0], 0, 0, 0);   \
        o[d0] = __builtin_amdgcn_mfma_f32_32x32x16_bf16(pa1, (bf16x8){l1[0], l1[1], l1[2], l1[3], h1[0], h1[1], h1[2], h1[3]}, o[d0], 0, 0, 0);   \
        o[d0] = __builtin_amdgcn_mfma_f32_32x32x16_bf16(pa2, (bf16x8){l2[0], l2[1], l2[2], l2[3], h2[0], h2[1], h2[2], h2[3]}, o[d0], 0, 0, 0);   \
        o[d0] = __builtin_amdgcn_mfma_f32_32x32x16_bf16(pa3, (bf16x8){l3[0], l3[1], l3[2], l3[3], h3[0], h3[1], h3[2], h3[3]}, o[d0], 0, 0, 0); } while (0)
    PV_D0(0); PV_D0(1); PV_D0(2); PV_D0(3);
#undef PV_D0
#undef TRRD
}
struct BlockRef { const bf16_t* Qn; const bf16_t* Qr; const bf16_t* Kn; const bf16_t* Kr; const bf16_t* V; bf16_t* O; int P0; };
struct Seam { bf16x8 qr[4]; bf16x8 st_v0, st_v1, st_k0, st_k1, st_k2; };
#define VMW() asm volatile("s_waitcnt vmcnt(0)" ::: "memory")
#define VMWN(n) asm volatile("s_waitcnt vmcnt(%0)" :: "i"(n) : "memory")
#define SLOAD_H(R_, k0) do { const char* vb_ = (const char*)((R_).V + (size_t)(k0) * KVS); const char* kb_ = (const char*)((R_).Kn + (size_t)(k0) * KVS); const char* rb_ = (const char*)((R_).Kr + (size_t)(k0) * KRS); \
                         S.st_v0 = *(const bf16x8*)(vb_ + voff); S.st_v1 = *(const bf16x8*)(vb_ + 32 * KVS * 2 + voff);      \
                         S.st_k0 = *(const bf16x8*)(kb_ + voff); S.st_k1 = *(const bf16x8*)(kb_ + 32 * KVS * 2 + voff);      \
                         S.st_k2 = *(const bf16x8*)(rb_ + roff); } while (0)
#define SWRITE_HK(bf) do { *(bf16x8*)(K_lds + (bf) * SHM_K + kws) = S.st_k0; *(bf16x8*)(K_lds + (bf) * SHM_K + kws + 32 * 384) = S.st_k1; *(bf16x8*)(K_lds + (bf) * SHM_K + kws2) = S.st_k2; } while (0)
#define SWRITE_HV(bf) do { *(bf16x8*)(V_lds + (bf) * SHM_V + vst0) = S.st_v0; *(bf16x8*)(V_lds + (bf) * SHM_V + vst1) = S.st_v1; } while (0)
#define SWRITE_H(bf) do { SWRITE_HV(bf); SWRITE_HK(bf); } while (0)
#define QLOAD(R_) do { const char* qn_ = (const char*)((R_).Qn + (size_t)(wid * QBLK) * QS); const char* qr_ = (const char*)((R_).Qr + (size_t)(wid * QBLK) * QS); \
                       _Pragma("unroll") for (int d0 = 0; d0 < 4; ++d0) S.qr[d0] = *(const bf16x8*)(qn_ + qoff + d0 * 32);          \
                       _Pragma("unroll") for (int d0 = 4; d0 < 8; ++d0) *(bf16x8*)(qrl + (d0 - 4) * 1024) = *(const bf16x8*)(qn_ + qoff + d0 * 32);          \
                       _Pragma("unroll") for (int d0 = 0; d0 < 4; ++d0) *(bf16x8*)(qrl + (d0 + 4) * 1024) = *(const bf16x8*)(qr_ + qoff + d0 * 32); } while (0)
__device__ __forceinline__ void attn_prime(const BlockRef& cur, char* lds, Seam& S, const int tid0) {
    const int tid = tid0, wid = __builtin_amdgcn_readfirstlane(tid >> 6), lane = tid & 63, r32 = lane & 31, hi = lane >> 5;
    const int sr = tid >> 4, sc = (tid & 15) * 8, kws = KSWZ(sr, sc * 2), rr = tid >> 3, rc = (tid & 7) * 8, kws2 = KSWZ(rr, (128 + rc) * 2); char* K_lds = lds + 2 * SHM_V;
    char* qrl = lds + LDS_QR + wid * 8192 + lane * 16;
    const unsigned voff = (unsigned)((sr * KVS + sc) * 2), roff = (unsigned)((rr * KRS + rc) * 2), qoff = (unsigned)((r32 * QS + hi * 8) * 2);
    QLOAD(cur);
    SLOAD_H(cur, 0); VMW(); SWRITE_HK(0);
    __syncthreads();
}
__device__ __forceinline__ void attn_block(const BlockRef& cur, const BlockRef& nxt, char* lds, Seam& S, const int tid0) {
    const int tid = tid0, wid = __builtin_amdgcn_readfirstlane(tid >> 6), lane = tid & 63, r32 = lane & 31, hi = lane >> 5;
    const int NT = cur.P0 / KVBLK + 4;
    const int qlo = cur.P0 + wid * QBLK, qm = qlo + r32 - 4 * hi;
    char* V_lds = lds; char* K_lds = lds + 2 * SHM_V;
    float* ws = (float*)(lds + 2 * SHM_V + 2 * SHM_K) + wid * 64; float* li_l = ws, * al_l = ws + 32;
    float m_reg = -1e30f, l_reg = 0; f32x16 o[4] = {};
    const int sr = tid >> 4, sc = (tid & 15) * 8, vst0 = v_st(sr, sc), vst1 = v_st(32 + sr, sc), kws = KSWZ(sr, sc * 2);
    const int rr = tid >> 3, rc = (tid & 7) * 8, kws2 = KSWZ(rr, (128 + rc) * 2);
    const int vb0 = (int)(uintptr_t)V_lds + v_rd_base(lane);
    char* qrl = lds + LDS_QR + wid * 8192 + lane * 16;
    const unsigned voff = (unsigned)((sr * KVS + sc) * 2), roff = (unsigned)((rr * KRS + rc) * 2), qoff = (unsigned)((r32 * QS + hi * 8) * 2);
#define RESC(a) do { if (__any((a) < 1.f)) { if (hi == 0) al_l[r32] = (a); asm volatile("s_waitcnt lgkmcnt(0)" ::: "memory");              \
                     for (int d_ = 0; d_ < 4; ++d_) for (int r = 0; r < 16; ++r) o[d_][r] *= al_l[crow(r, hi)]; } } while (0)
#define MASKT(P0_, P1_, t) do { const int kb_ = (t) * KVBLK; if (kb_ + KVBLK - 1 > qlo) mask_tile(P0_, P1_, qm - kb_); } while (0)
    f32x16 pA0, pA1, pB0, pB1; float mnA, mnB, alA, alB; bf16x8 pa0, pa1, pa2, pa3;
    SWRITE_HV(0); SBAR();
    if (NT > 1) SLOAD_H(cur, KVBLK);
    SBAR(); qkt<0>(pA0, pA1, K_lds, r32, hi, S.qr, qrl);
    MASKT(pA0, pA1, 0); partialSM(pA0, pA1, m_reg, mnA, alA);
    if (NT > 1) { VMW(); SWRITE_HK(1); }
    __syncthreads();
#define HALF_STEP(PX0, PX1, mnX, alX, PY0, PY1, alY, t, KB, VB, SB) do {                                                      \
        SWRITE_HV(KB);                                                             \
        SBAR(); qkt<KB>(PX0, PX1, K_lds, r32, hi, S.qr, qrl);                                                                       \
        finishSM(PY0, PY1, alY, l_reg, pa0, pa1, pa2, pa3); SBAR();                                                           \
        if ((t) + 1 < NT) { SLOAD_H(cur, ((t) + 1) * KVBLK); SBAR(); }                                                        \
        pv_tile<VB>(o, vb0, pa0, pa1, pa2, pa3); MASKT(PX0, PX1, (t)); partialSM(PX0, PX1, m_reg, mnX, alX);                  \
        if ((t) + 1 < NT) { VMW(); SWRITE_HK(SB); }                                                                           \
        RESC(alX); __syncthreads(); } while (0)
    for (int t = 1; t + 1 < NT; t += 2) {
        HALF_STEP(pB0, pB1, mnB, alB, pA0, pA1, alA, t, 1, 0, 0);
        HALF_STEP(pA0, pA1, mnA, alA, pB0, pB1, alB, t + 1, 0, 1, 1);
    }
    const bool even = (NT & 1) == 0;
    if (even) { SWRITE_HV(1); SBAR(); qkt<1>(pB0, pB1, K_lds, r32, hi, S.qr, qrl); SBAR(); }
    SLOAD_H(nxt, 0); SBAR();
    QLOAD(nxt);
    SBAR();
    finishSM(pA0, pA1, alA, l_reg, pa0, pa1, pa2, pa3); SBAR();
    pv_tile<0>(o, vb0, pa0, pa1, pa2, pa3);
    if (even) { MASKT(pB0, pB1, NT - 1); partialSM(pB0, pB1, m_reg, mnB, alB); __syncthreads(); RESC(alB);
        finishSM(pB0, pB1, alB, l_reg, pa0, pa1, pa2, pa3); SBAR(); pv_tile<1>(o, vb0, pa0, pa1, pa2, pa3); }
    SBAR(); VMWN(4); SWRITE_HK(0); SBAR();
    if (hi == 0) li_l[r32] = l_reg; asm volatile("s_waitcnt lgkmcnt(0)" ::: "memory");
    float rli[16];
#pragma unroll
    for (int r = 0; r < 16; ++r) rli[r] = __builtin_amdgcn_rcpf(li_l[crow(r, hi)]);
    char* Ow = (char*)(cur.O + (size_t)(wid * QBLK) * OS);
    const unsigned loff = (unsigned)((4 * hi * OS + r32) * 2);
#pragma unroll
    for (int r = 0; r < 16; ++r) { const int cro = ((r & 3) + 8 * (r >> 2)) * OS;
#pragma unroll
        for (int d0 = 0; d0 < 4; ++d0) { const float v = o[d0][r] * rli[r];
            const float vn = __shfl_xor(v, 1);
            if ((r32 & 1) == 0) *(unsigned*)(Ow + (size_t)(cro + d0 * 32) * 2 + loff) = cvtpk(v, vn); } }
    __syncthreads();
#undef RESC
#undef MASKT
#undef HALF_STEP
}
#undef VMW
#undef VMWN
#undef SLOAD_H
#undef SWRITE_HK
#undef SWRITE_HV
#undef SWRITE_H
#undef QLOAD
#undef SBAR
#undef KSWZ
}
typedef unsigned short bf16_t;
typedef float f32x4 __attribute__((ext_vector_type(4)));
typedef unsigned u32x4 __attribute__((ext_vector_type(4)));
typedef unsigned u32x2 __attribute__((ext_vector_type(2)));
typedef _Float16 h16x4 __attribute__((ext_vector_type(4)));
#define LAS __attribute__((address_space(3)))
#ifndef N_LAUNCHES
#define N_LAUNCHES 1
#endif
constexpr int NPHASE = 10;
constexpr int T = 32768, SEQ = 8192, DM = 1024;
constexpr size_t MiB = 1u << 20;
constexpr size_t WS_RSTDX = 0, WS_RSTDQ = 128 * 1024, WS_RSTDKV = 256 * 1024, WS_CSP = 384 * 1024;
constexpr size_t WS_SS1 = 1 * MiB, WS_SS2 = 3 * MiB;
constexpr size_t WS_CS = 5 * MiB;
constexpr size_t WS_W1 = 7 * MiB;
constexpr size_t WS_WUP = 17 * MiB;
constexpr size_t WS_WDN = 25 * MiB;
constexpr size_t WS_WOUT = 33 * MiB;
constexpr size_t WS_WUQ = 35 * MiB;
constexpr size_t WS_WUKV = 36 * MiB;
constexpr size_t WS_WLRU = 37 * MiB;
constexpr size_t WS_KR = 38 * MiB;
constexpr size_t WS_G1 = 42 * MiB, WS_G2 = 106 * MiB;
constexpr size_t WS_ZC = 170 * MiB;
constexpr size_t WS_SUM = WS_ZC, WS_SUB = WS_ZC + 2 * MiB;
constexpr size_t WS_KV = 218 * MiB;
constexpr size_t WS_R1 = 346 * MiB;
constexpr size_t WS_XB = WS_R1;
constexpr size_t WS_XA = WS_R1;
constexpr size_t WS_YB = WS_R1;
constexpr size_t WS_ZX = WS_R1 + 64 * MiB;
constexpr size_t WS_Q = WS_R1 + 64 * MiB;
constexpr size_t WS_MG = WS_KV;
constexpr size_t WS_H1B = WS_R1 + 64 * MiB;
constexpr size_t WS_U = 42 * MiB;
constexpr size_t WS_H2B = 298 * MiB;
constexpr size_t WS_END = 512 * MiB;
static_assert(WS_Q + (size_t)T * 1536 * 2 <= WS_END && WS_U + (size_t)T * 4096 * 2 <= WS_H1B && WS_W1 + 4864 * 1024 * 2 <= WS_WUP, "d_ws map");

struct Args { const float* in[19]; float* out; unsigned char* ws; int ph_lo, ph_hi; };
static_assert(sizeof(Args) == 19 * 8 + 8 + 8 + 8, "Args has no padding");

__device__ __forceinline__ float wave_sum(float v) {
#pragma unroll
    for (int o = 1; o < 64; o <<= 1) v += __shfl_xor(v, o);
    return v;
}
__device__ __forceinline__ unsigned pkbf(float lo, float hi) { return pg8::cvt_pk_bf16(lo, hi); }
__device__ __forceinline__ float bflo(unsigned w) { return __uint_as_float(w << 16); }
__device__ __forceinline__ float bfhi(unsigned w) { return __uint_as_float(w & 0xffff0000u); }

__device__ __forceinline__ int srccol(int which, int p) {
    if (which == 0) {
        const int t = p >> 8, w = p & 255;
        if (t < 4) return p;
        if (t < 12) return w < 128 ? 1024 + 128 * (t - 4) + w : 2624 + 128 * (t - 4) + (w - 128);
        if (t < 16) return 3648 + (p - 3072);
        if (t == 16) return 2048 + w;
        if (t == 17) return 2304 + w;
        return w < 64 ? 2560 + 4 * (w >> 3) + (w & 3) + 32 * ((w >> 2) & 1) : -1;
    }
    if (which == 1) {
        if (p < 1024) return (p >> 7) * 192 + (p & 127);
        const int q = p - 1024, h = q >> 6, u = q & 63;
        return h * 192 + 128 + 4 * (u >> 3) + (u & 3) + 32 * ((u >> 2) & 1);
    }
    return p;
}
__device__ __forceinline__ void tr_item(const float* W, int ldw, int K, int Nphys, const float* gain, bf16_t* WT, int which, LAS float* scr, int item, int lane, int ksrc0 = 0, int Ksrc = 1 << 30) {
    const int nblk = Nphys / 32, kb = item / nblk, nb = item % nblk, k0 = 64 * kb, n0 = 32 * nb;
    const int src = srccol(which, n0 + (lane & 31));
#pragma unroll 16
    for (int i = 0; i < 32; ++i) { const int kk = 2 * i + (lane >> 5); float v = 0.f;
        const int ks = k0 + kk - ksrc0;
        if (src >= 0 && ks >= 0 && ks < Ksrc) { v = __builtin_nontemporal_load(W + (size_t)ks * ldw + src); if (gain) v *= gain[k0 + kk]; }
        scr[kk * 33 + (lane & 31)] = v; }
    asm volatile("s_waitcnt lgkmcnt(0)" ::: "memory");
    const int c = lane & 7;
#pragma unroll
    for (int j = 0; j < 4; ++j) { const int n = (lane >> 3) + 8 * j; const LAS float* s = scr + (8 * c) * 33 + n;
        u32x4 o; o.x = pkbf(s[0 * 33], s[1 * 33]); o.y = pkbf(s[2 * 33], s[3 * 33]); o.z = pkbf(s[4 * 33], s[5 * 33]); o.w = pkbf(s[6 * 33], s[7 * 33]);
        *(u32x4*)(WT + (size_t)(n0 + n) * K + k0 + 8 * c) = o; }
    asm volatile("s_waitcnt lgkmcnt(0)" ::: "memory");
}
__device__ __forceinline__ void tr_item64(const float* W, int ldw, int K, int Nphys, const float* gain, bf16_t* WT, int which, int item, int lane, int ksrc0 = 0, int Ksrc = 1 << 30) {
    const int nblk = Nphys / 64, kb = item / nblk, nb = item % nblk, k0 = 64 * kb, n0 = 64 * nb;
    const int src = srccol(which, n0 + lane); const bool kin = (k0 - ksrc0 >= 0) && (k0 - ksrc0 < Ksrc);
    float v[64];
#pragma unroll
    for (int kk = 0; kk < 64; ++kk) v[kk] = (src >= 0 && kin) ? __builtin_nontemporal_load(W + (size_t)(k0 + kk - ksrc0) * ldw + src) : 0.f;
    if (gain) {
#pragma unroll
        for (int kk = 0; kk < 64; ++kk) v[kk] *= gain[k0 + kk];
    }
    bf16_t* o = WT + (size_t)(n0 + lane) * K + k0;
#pragma unroll
    for (int j = 0; j < 8; ++j) { u32x4 w; w.x = pkbf(v[8 * j], v[8 * j + 1]); w.y = pkbf(v[8 * j + 2], v[8 * j + 3]); w.z = pkbf(v[8 * j + 4], v[8 * j + 5]); w.w = pkbf(v[8 * j + 6], v[8 * j + 7]); *(u32x4*)(o + 8 * j) = w; }
}
__device__ __forceinline__ void sincos_d(double a, float& s, float& c) {
    const double n = rint(a * 0.63661977236758134308);
    const double r = (a - n * 1.57079632679489655800) - n * 6.123233995736766036e-17, r2 = r * r;
    double sp = -7.6471637318198164759e-13; sp = sp * r2 + 1.6059043836821614599e-10; sp = sp * r2 - 2.5052108385441718775e-08; sp = sp * r2 + 2.7557319223985890653e-06;
    sp = sp * r2 - 1.9841269841269841270e-04; sp = sp * r2 + 8.3333333333333333333e-03; sp = sp * r2 - 1.6666666666666666667e-01; sp = r + r * r2 * sp;
    double cp = 4.7794773323873852974e-14; cp = cp * r2 - 1.1470745597729724714e-11; cp = cp * r2 + 2.0876756987868098979e-09; cp = cp * r2 - 2.7557319223985890653e-07;
    cp = cp * r2 + 2.4801587301587301587e-05; cp = cp * r2 - 1.3888888888888888889e-03; cp = cp * r2 + 4.1666666666666666667e-02; cp = cp * r2 - 0.5; cp = 1.0 + r2 * cp;
    const int q = (int)((long long)n & 3);
    const double ss = (q & 1) ? cp : sp, cc = (q & 1) ? sp : cp;
    s = (float)((q & 2) ? -ss : ss); c = (float)(((q + 1) & 2) ? -cc : cc);
}

#ifdef DIAG
#define DCHK(code, got, want, rtol, atol) do { const float g_ = (got), w_ = (want); if (!(fabsf(g_ - w_) <= (rtol) * fabsf(w_) + (atol))) { atomicMin(DG, (unsigned)(code)); atomicOr(DG + 1, (code) < 50 ? 0u : (code) < 54 ? 1u : (code) < 60 ? 2u : (code) < 70 ? 4u : (code) < 80 ? 8u : 16u); } } while (0)
__device__ __forceinline__ unsigned dhash(unsigned x) { x ^= x >> 16; x *= 0x7feb352du; x ^= x >> 15; x *= 0x846ca68bu; x ^= x >> 16; return x; }
__device__ __forceinline__ float dbf(const bf16_t* p, size_t i) { return __uint_as_float((unsigned)p[i] << 16); }
__device__ __forceinline__ float dsig(float v) { return 1.0f / (1.0f + expf(-v)); }
__device__ __forceinline__ float ddot(const bf16_t* a, const bf16_t* b, int K) { float s = 0.f; for (int k = 0; k < K; ++k) s += dbf(a, k) * dbf(b, k); return s; }
#endif
#define XB_TMO      128
#define XB_XCNT(j)  (256  + 64 * (j))
#define XB_XSUB(j)  (1280 + 64 * (j))
#define XB_XGEN(j)  (2304 + 64 * (j))
#define XB_TOP      3328
#define XB_TOPGEN   3392
#define XCD_BAR_WORDS 3456
#define XB_SPIN_CAP (1u << 18)

__device__ __forceinline__ unsigned xb_ld(unsigned* p)              { return __hip_atomic_load(p, __ATOMIC_RELAXED, __HIP_MEMORY_SCOPE_AGENT); }
__device__ __forceinline__ unsigned xb_add(unsigned* p, unsigned v) { return __hip_atomic_fetch_add(p, v, __ATOMIC_RELAXED, __HIP_MEMORY_SCOPE_AGENT); }
__device__ __forceinline__ unsigned xb_xcc_id() { return (unsigned)__builtin_amdgcn_s_getreg((3 << 11) | 20) & 0xFu; }
#define XB_SPIN(cond, bar) do { unsigned _sp = 0; while (cond) { __builtin_amdgcn_s_sleep(1); \
    if ((++_sp & 255u) == 0u) { if (xb_ld(&(bar)[XB_TMO])) break; if (_sp > XB_SPIN_CAP) { atomicAdd(&(bar)[XB_TMO], 1u); break; } } } } while (0)

struct XcdBarrier {
    unsigned* bar; unsigned x;
    volatile LAS unsigned* st;
};

__device__ __forceinline__ XcdBarrier xcd_barrier_post(unsigned* bar, volatile LAS unsigned* st, const bool leader) {
    XcdBarrier b; b.bar = bar; b.x = xb_xcc_id(); b.st = st;
    if (leader) (void)xb_add(&bar[XB_XCNT(b.x)], 1u);
    return b;
}
__device__ __forceinline__ void xcd_barrier_complete(unsigned* bar, unsigned x, unsigned& nloc, unsigned& nx) {
    const unsigned G = gridDim.x * gridDim.y * gridDim.z;
    unsigned sum, cnt, mine, sp = 0u;
    for (;;) {
        sum = 0u; cnt = 0u; mine = 0u;
#pragma unroll
        for (unsigned j = 0; j < 16; ++j) { const unsigned c = xb_ld(&bar[XB_XCNT(j)]); sum += c; cnt += (c > 0u) ? 1u : 0u; mine = (j == x) ? c : mine; }
        if (sum == G) break;
        __builtin_amdgcn_s_sleep(1);
        if ((++sp & 255u) == 0u) { if (xb_ld(&bar[XB_TMO])) break; if (sp > XB_SPIN_CAP) { atomicAdd(&bar[XB_TMO], 1u); break; } }
    }
    nloc = mine > 0u ? mine : 1u; nx = cnt > 0u ? cnt : 1u;
}

__device__ __forceinline__ void xcd_barrier(const XcdBarrier& b, const bool leader) {
    asm volatile("s_waitcnt vmcnt(0)" ::: "memory");
    __syncthreads();
    if (leader) {
        unsigned* bar = b.bar;
        __builtin_amdgcn_s_waitcnt(0);
        unsigned nloc = b.st[0], nx = b.st[1];
        if (nloc == 0u) { xcd_barrier_complete(bar, b.x, nloc, nx); b.st[0] = nloc; b.st[1] = nx; }
        const unsigned old = xb_add(&bar[XB_XSUB(b.x)], 1u);
        const unsigned gen = old / nloc;
        if (old + 1u == (gen + 1u) * nloc) {
            __builtin_amdgcn_fence(__ATOMIC_RELEASE, "agent");
            asm volatile("s_waitcnt vmcnt(0)" ::: "memory");
            const unsigned og = xb_add(&bar[XB_TOP], 1u);
            const unsigned tg = og / nx;
            if (og + 1u == (tg + 1u) * nx) xb_add(&bar[XB_TOPGEN], 1u);
            else XB_SPIN(xb_ld(&bar[XB_TOPGEN]) == tg, bar);
            __builtin_amdgcn_fence(__ATOMIC_ACQUIRE, "agent");
            xb_add(&bar[XB_XGEN(b.x)], 1u);
            asm volatile("s_waitcnt vmcnt(0)" ::: "memory");
        } else {
            XB_SPIN(xb_ld(&bar[XB_XGEN(b.x)]) == gen, bar);
            __builtin_amdgcn_fence(__ATOMIC_ACQUIRE, "agent");
            asm volatile("s_waitcnt vmcnt(0)" ::: "memory");
        }
    }
    __syncthreads();
}

constexpr size_t WS_BAR = WS_CSP + 65536;
constexpr int LDS_BARW = 153600 - 64;
__global__ void __launch_bounds__(512, 2) fwd_kernel(Args args) {
    extern __shared__ __attribute__((aligned(16))) unsigned char lds[];
    cg::grid_group grid = cg::this_grid();
    const int wave_top = __builtin_amdgcn_readfirstlane((int)threadIdx.x >> 6);
    const int tid = threadIdx.x, lane = tid & 63, wave = wave_top;
    const int G = gridDim.x, gw = blockIdx.x * 8 + wave, NGW = G * 8; (void)tid; (void)lane; (void)gw;
    unsigned char* ws = args.ws;
    const int lo = args.ph_lo, hi = args.ph_hi;
#ifndef PHMASK
#define PHMASK 0x3ff
#endif
#define IN(k) (((PHMASK >> (k)) & 1) && lo <= (k) && (k) < hi)
#ifndef REPMASK
#define REPMASK 0
#endif
#define FRESH_IDS int lane_o_ = __builtin_amdgcn_mbcnt_hi(~0u, __builtin_amdgcn_mbcnt_lo(~0u, 0u)); asm volatile("" : "+v"(lane_o_)); const int lane = lane_o_, wave = wave_top, tid = wave * 64 + lane, gw = blockIdx.x * 8 + wave; (void)tid; (void)gw;
#define PLAIN_IDS int tid_o_ = threadIdx.x; asm volatile("" : "+v"(tid_o_)); const int tid = tid_o_, lane = tid & 63, wave = wave_top, gw = blockIdx.x * 8 + wave; (void)lane; (void)gw;
#define REP(k) for (int rep_ = 0; rep_ <= ((REPMASK >> (k)) & 1); ++rep_)
#ifdef TSTAMP
    unsigned long long* TS = (unsigned long long*)(ws + WS_CSP + 32768);
#define SEAM(k) do { if (IN(k) && IN((k) + 1)) grid.sync(); if (blockIdx.x == 0 && tid == 0) TS[(k) + 1] = __builtin_amdgcn_s_memrealtime(); } while (0)
    if (blockIdx.x == 0 && tid == 0) TS[0] = __builtin_amdgcn_s_memrealtime();
#else
#define SEAM(k) do { if (IN(k) && IN((k) + 1)) { if (lo < 0) grid.sync();   xcd_barrier(xbar, wave_top == 0 && __builtin_amdgcn_mbcnt_hi(~0u, __builtin_amdgcn_mbcnt_lo(~0u, 0u)) == 0u); } } while (0)
#endif
    const float* x = args.in[0];
    float* rstdx = (float*)(ws + WS_RSTDX); float* rstdq = (float*)(ws + WS_RSTDQ); float* rstdkv = (float*)(ws + WS_RSTDKV); float* csp = (float*)(ws + WS_CSP);
    float* SS1 = (float*)(ws + WS_SS1); float* SS2 = (float*)(ws + WS_SS2); float* CS = (float*)(ws + WS_CS);
    bf16_t* W1 = (bf16_t*)(ws + WS_W1); bf16_t* WUP = (bf16_t*)(ws + WS_WUP); bf16_t* WDN = (bf16_t*)(ws + WS_WDN); bf16_t* WOUT = (bf16_t*)(ws + WS_WOUT);
    bf16_t* WUQ = (bf16_t*)(ws + WS_WUQ); bf16_t* WUKV = (bf16_t*)(ws + WS_WUKV); bf16_t* WLRU = (bf16_t*)(ws + WS_WLRU);
    bf16_t* KR = (bf16_t*)(ws + WS_KR); bf16_t* G1 = (bf16_t*)(ws + WS_G1); bf16_t* G2 = (bf16_t*)(ws + WS_G2); bf16_t* ZC = (bf16_t*)(ws + WS_ZC);
    bf16_t* KV = (bf16_t*)(ws + WS_KV); bf16_t* XB = (bf16_t*)(ws + WS_XB); bf16_t* XA = (bf16_t*)(ws + WS_XA); bf16_t* YB = (bf16_t*)(ws + WS_YB);
    bf16_t* ZX = (bf16_t*)(ws + WS_ZX); bf16_t* Q = (bf16_t*)(ws + WS_Q); bf16_t* MG = (bf16_t*)(ws + WS_MG); bf16_t* H1B = (bf16_t*)(ws + WS_H1B); bf16_t* U = (bf16_t*)(ws + WS_U);
    float* SSQ = (float*)(ws + WS_SS2); float* SSKV = (float*)(ws + WS_SS2 + 512 * 1024);
    bf16_t* H2B = (bf16_t*)(ws + WS_H2B); float* SUM = (float*)(ws + WS_SUM); float* SUB = (float*)(ws + WS_SUB);
    unsigned* AB = (unsigned*)args.out; float* OUT = args.out;
    LAS unsigned char* ldsg = (LAS unsigned char*)lds;

    if (threadIdx.x < 2) ((volatile LAS unsigned*)(ldsg + LDS_BARW))[threadIdx.x] = 0u;
    __syncthreads();
    XcdBarrier xbar; xbar.bar = (unsigned*)(ws + WS_BAR); xbar.x = 0; xbar.st = nullptr;
    if (hi - lo > 1) xbar = xcd_barrier_post((unsigned*)(ws + WS_BAR), (volatile LAS unsigned*)(ldsg + LDS_BARW), threadIdx.x == 0);
#ifdef DIAG
    unsigned* DG = (unsigned*)(ws + WS_CSP + 8192); unsigned* SAVE = (unsigned*)(ws + WS_CSP + 16384);
    if (lo >= 100) {
        const int dk = lo - 100; const unsigned gid = blockIdx.x * 512 + tid, NT_ = G * 512;
        if (dk == 0) {
            for (unsigned s = gid; s < 65536; s += NT_) { const unsigned h = dhash(s * 7 + 1);
                { const int p = h % 4864, k = (h >> 13) % 1024, src = srccol(0, p); const float want = src < 0 ? 0.f : args.in[2][(size_t)k * 4672 + src] * args.in[1][k]; DCHK(1, dbf(W1, (size_t)p * 1024 + k), want, 0.01f, 1e-6f); }
                { const int p = h % 1536, k = (h >> 13) % 256; DCHK(2, dbf(WUQ, (size_t)p * 256 + k), args.in[11][(size_t)k * 1536 + srccol(1, p)] * args.in[10][k], 0.01f, 1e-6f); }
                { const int p = h % 2048, k = (h >> 13) % 256; DCHK(3, dbf(WUKV, (size_t)p * 256 + k), args.in[13][(size_t)k * 2048 + p] * args.in[12][k], 0.01f, 1e-6f); }
                { const int p = h % 2048, k = (h >> 13) % 256, nb = p >> 8, isx = (p >> 7) & 1, d = p & 127, kk = k - 128 * (nb & 1);
                  const float want = (kk >= 0 && kk < 128) ? (isx ? args.in[7] : args.in[5])[(size_t)nb * 16384 + kk * 128 + d] : 0.f; DCHK(4, dbf(WLRU, (size_t)p * 256 + k), want, 0.01f, 1e-6f); }
                { const int p = h % 1024, k = (h >> 13) % 1024; DCHK(5, dbf(WOUT, (size_t)p * 1024 + k), args.in[14][(size_t)k * 1024 + p], 0.01f, 1e-6f); }
                { const int p = h % 4096, k = (h >> 13) % 1024; DCHK(6, dbf(WUP, (size_t)p * 1024 + k), args.in[16][(size_t)k * 4096 + p] * args.in[15][k], 0.01f, 1e-6f); }
                { const int p = h % 1024, k = (h >> 13) % 4096; DCHK(7, dbf(WDN, (size_t)p * 4096 + k), args.in[17][(size_t)k * 1024 + p], 0.01f, 1e-6f); }
                { const int r = h % T, c = (h >> 15) % 1024; DCHK(8, dbf(XB, (size_t)r * 1024 + c), x[(size_t)r * 1024 + c], 0.01f, 1e-6f); }
                { const int pos = h % 8191, i = (h >> 13) & 31; const float c0 = CS[(pos * 32 + i) * 2], s0 = CS[(pos * 32 + i) * 2 + 1], c1 = CS[((pos + 1) * 32 + i) * 2], s1 = CS[((pos + 1) * 32 + i) * 2 + 1], cd = CS[(32 + i) * 2], sd = CS[(32 + i) * 2 + 1];
                  DCHK(9, c1, c0 * cd - s0 * sd, 0.f, 1e-5f); DCHK(9, s1, s0 * cd + c0 * sd, 0.f, 1e-5f); DCHK(9, cd, __cosf(powf(10000.f, -(float)i / 32.f)), 0.f, 1e-4f); DCHK(9, CS[i * 2], 1.0f, 0.f, 1e-6f); }
            }
            for (unsigned s = gid; s < 4096; s += NT_) { const int r = dhash(s) % T; float q = 0.f; for (int c = 0; c < 1024; ++c) q += x[(size_t)r * 1024 + c] * x[(size_t)r * 1024 + c]; DCHK(8, rstdx[r], 1.0f / sqrtf(q / 1024.f + 1e-6f), 1e-3f, 0.f); }
        }
        if (dk == 1) for (unsigned s = gid; s < 32768; s += NT_) { const unsigned h = dhash(s * 3 + 11); const int r = h % T, p = (h >> 15) % 4864, t = p >> 8, w = p & 255;
            const float z = ddot(XB + (size_t)r * 1024, W1 + (size_t)p * 1024, 1024) * rstdx[r];
            if (t < 4) DCHK(11, dbf(ZX, (size_t)r * 1024 + p), z, 0.02f, 0.02f);
            else if (t < 12) { if (w < 128) { const float z2 = ddot(XB + (size_t)r * 1024, W1 + (size_t)(p + 128) * 1024, 1024) * rstdx[r];
                const float ge = 0.5f * z * (1.f + tanhf(0.7978845608f * (z + 0.044715f * z * z * z))); DCHK(12, dbf(G1, (size_t)r * 1024 + (t - 4) * 128 + w), ge * dsig(z2), 0.03f, 0.02f); } }
            else if (t < 16) DCHK(13, dbf(G2, (size_t)r * 1024 + p - 3072), dsig(z), 0.02f, 0.01f);
            else DCHK(14, dbf(ZC, (size_t)r * 768 + p - 4096), z, 0.02f, 0.02f); }
        if (dk == 2) for (unsigned s = gid; s < 65536; s += NT_) { const unsigned h = dhash(s * 5 + 3); const int r = (s & 1) ? (h % T) : ((h % 4) * 8192 + (h >> 8) % 6), c = (h >> 15) % 1024, pos = r & 8191;
            float v = args.in[4][c]; for (int j = 0; j < 4; ++j) if (pos - 3 + j >= 0) v += args.in[3][j * 1024 + c] * dbf(ZX, (size_t)(r - 3 + j) * 1024 + c);
            DCHK(21, dbf(XA, (size_t)r * 1024 + c), v, 0.02f, 0.02f);
            if (c < 64) { const int u = c, i = 4 * (u >> 3) + (u & 3), hf = (u >> 2) & 1; const float kl = dbf(ZC, (size_t)r * 768 + 512 + i), kh = dbf(ZC, (size_t)r * 768 + 512 + i + 32), cc = CS[(pos * 32 + i) * 2], ss = CS[(pos * 32 + i) * 2 + 1];
                DCHK(23, dbf(KR, (size_t)r * 64 + u), hf ? kh * cc + kl * ss : kl * cc - kh * ss, 0.02f, 0.02f); }
            if (c == 100) { float q = 0.f, k2 = 0.f; for (int j = 0; j < 256; ++j) { const float a = dbf(ZC, (size_t)r * 768 + j), b = dbf(ZC, (size_t)r * 768 + 256 + j); q += a * a; k2 += b * b; }
                DCHK(22, rstdq[r], 1.0f / sqrtf(q / 256.f + 1e-6f), 1e-3f, 0.f); DCHK(22, rstdkv[r], 1.0f / sqrtf(k2 / 256.f + 1e-6f), 1e-3f, 0.f); } }
        if (dk == 3) for (unsigned s = gid; s < 65536; s += NT_) { const unsigned h = dhash(s * 9 + 5); const int r = h % T, pos = r & 8191;
            { const int c = (h >> 15) % 1024, nb = c >> 7, d = c & 127; float dr = args.in[6][c], di = args.in[8][c];
              for (int k = 0; k < 128; ++k) { const float xv = dbf(XA, (size_t)r * 1024 + nb * 128 + k); dr += xv * args.in[5][(size_t)nb * 16384 + k * 128 + d]; di += xv * args.in[7][(size_t)nb * 16384 + k * 128 + d]; }
              const float rr_ = dsig(dr), ii = dsig(di), la = -8.0f * rr_ * log1pf(expf(-args.in[9][c])), bb = sqrtf(-expm1f(2.f * la)) * ii * dbf(XA, (size_t)r * 1024 + c);
              const pg8::h16x2 pv_ = __builtin_bit_cast(pg8::h16x2, AB[(size_t)r * 1024 + c]);
              DCHK(31, (float)pv_.x, la * 1.4426950408889634f, 0.03f, 1e-5f); DCHK(32, (float)pv_.y, bb, 0.03f, 0.01f); }
            { const int p = (h >> 13) % 1536; const float z = ddot(ZC + (size_t)r * 768, WUQ + (size_t)p * 256, 256) * rstdq[r];
              if (p < 1024) DCHK(33, dbf(Q, (size_t)r * 1536 + p), z, 0.02f, 0.02f);
              else { const int u = (p - 1024) & 63, i = 4 * (u >> 3) + (u & 3), islo = (u & 4) == 0; const float z2 = ddot(ZC + (size_t)r * 768, WUQ + (size_t)(p ^ 4) * 256, 256) * rstdq[r];
                  const float cc = CS[(pos * 32 + i) * 2], ss = CS[(pos * 32 + i) * 2 + 1]; DCHK(34, dbf(Q, (size_t)r * 1536 + p), islo ? z * cc - z2 * ss : z * cc + z2 * ss, 0.02f, 0.03f); } }
            { const int p = (h >> 11) % 2048; DCHK(35, dbf(KV, (size_t)r * 2048 + p), ddot(ZC + (size_t)r * 768 + 256, WUKV + (size_t)p * 256, 256) * rstdkv[r], 0.02f, 0.02f); } }
        if (dk == 3) for (unsigned s = gid; s < 4096; s += NT_) SAVE[s] = AB[dhash(s * 41 + 3) % (unsigned)(T * 1024)];
        if (dk == 4) {
            float* SC = (float*)(ws + WS_ZC + 9 * MiB);
            for (int s = gw; s < 1024; s += NGW) { const unsigned h = dhash(s * 13 + 7); const int b = h & 3, hd = (h >> 2) & 7, pos = (s & 3) == 0 ? (int)((h >> 5) % 300) : (int)((h >> 5) % 8192); const size_t r = (size_t)b * 8192 + pos;
                float* sc = SC + (size_t)s * 8192; float mx = -1e30f;
                for (int j = lane; j <= pos; j += 64) { const size_t kr = (size_t)b * 8192 + j; float d = 0.f;
                    for (int e = 0; e < 128; ++e) d += dbf(Q, r * 1536 + hd * 128 + e) * dbf(KV, kr * 2048 + hd * 256 + e);
                    for (int e = 0; e < 64; ++e) d += dbf(Q, r * 1536 + 1024 + hd * 64 + e) * dbf(KR, kr * 64 + e);
                    d *= 0.07216878364870322f; sc[j] = d; mx = fmaxf(mx, d); }
                for (int o = 1; o < 64; o <<= 1) mx = fmaxf(mx, __shfl_xor(mx, o));
                __builtin_amdgcn_fence(__ATOMIC_RELEASE, "workgroup"); __builtin_amdgcn_s_waitcnt(0);
                float l = 0.f, o0 = 0.f, o1 = 0.f;
                for (int j = 0; j <= pos; ++j) { const float p = expf(__builtin_nontemporal_load(sc + j) - mx); const size_t kr = (size_t)b * 8192 + j; l += p; o0 += p * dbf(KV, kr * 2048 + hd * 256 + 128 + lane); o1 += p * dbf(KV, kr * 2048 + hd * 256 + 192 + lane); }
                DCHK(41, dbf(YB, r * 1024 + hd * 128 + lane), o0 / l, 0.03f, 0.01f); DCHK(41, dbf(YB, r * 1024 + hd * 128 + 64 + lane), o1 / l, 0.03f, 0.01f); } }
        if (dk == 5) for (unsigned s = gid; s < 4096; s += NT_) if (SAVE[s] != AB[dhash(s * 41 + 3) % (unsigned)(T * 1024)]) atomicMin(DG, 48u);
        if (dk == 5) for (unsigned s = gid; s < 8192; s += NT_) { const unsigned h = dhash(s * 17 + 9); const int b = h & 3, c = (h >> 2) % 1024, pos = (s & 3) == 0 ? (int)((h >> 12) % 32) : (s & 3) == 1 ? (int)((h >> 12) % 256) : (int)((h >> 12) % 8192); float hh = 0.f, LL = 0.f;
            for (int j = 0; j <= pos; ++j) { const pg8::h16x2 pv_ = __builtin_bit_cast(pg8::h16x2, AB[((size_t)b * 8192 + j) * 1024 + c]); hh = exp2f((float)pv_.x) * hh + (float)pv_.y; LL += (float)pv_.x;
                if ((j & 31) == 31 && (j >> 5) == (pos >> 5) - 0 && false) {} }
            const size_t o = ((size_t)b * 8192 + pos) * 1024 + c; const int code = pos < 32 ? 51 : pos < 256 ? 52 : 53;
            DCHK(code, dbf(MG, o), dbf(G1, o) * hh + dbf(G2, o) * dbf(YB, o), 0.03f, 0.01f);
            { const int sc_ = (h >> 12) % 256; float h2 = 0.f, L2 = 0.f; for (int j = sc_ * 32; j < sc_ * 32 + 32; ++j) { const pg8::h16x2 pv_ = __builtin_bit_cast(pg8::h16x2, AB[((size_t)b * 8192 + j) * 1024 + c]); h2 = exp2f((float)pv_.x) * h2 + (float)pv_.y; L2 += (float)pv_.x; }
              DCHK(54, SUB[(((size_t)b * 256 + sc_) * 1024 + c) * 2], L2, 1e-3f, 1e-5f); DCHK(55, SUB[(((size_t)b * 256 + sc_) * 1024 + c) * 2 + 1], h2, 1e-3f, 1e-4f); }
            { const int kc = (h >> 12) % 32; float h2 = 0.f, L2 = 0.f; for (int j = kc * 256; j < kc * 256 + 256; ++j) { const pg8::h16x2 pv_ = __builtin_bit_cast(pg8::h16x2, AB[((size_t)b * 8192 + j) * 1024 + c]); h2 = exp2f((float)pv_.x) * h2 + (float)pv_.y; L2 += (float)pv_.x; }
              DCHK(56, SUM[(((size_t)b * 32 + kc) * 1024 + c) * 2], L2, 1e-3f, 1e-5f); DCHK(57, SUM[(((size_t)b * 32 + kc) * 1024 + c) * 2 + 1], h2, 1e-3f, 1e-4f); } }
        if (dk == 6) for (unsigned s = gid; s < 32768; s += NT_) { const unsigned h = dhash(s * 19 + 1); const int r = h % T, c = (h >> 15) % 1024;
            const float v = x[(size_t)r * 1024 + c] + ddot(MG + (size_t)r * 1024, WOUT + (size_t)c * 1024, 1024); DCHK(61, OUT[(size_t)r * 1024 + c], v, 0.02f, 0.02f); DCHK(62, dbf(H1B, (size_t)r * 1024 + c), v, 0.02f, 0.02f);
            if (c == 7) { float q = 0.f, q2 = 0.f; for (int j = 0; j < 1024; ++j) q += OUT[(size_t)r * 1024 + j] * OUT[(size_t)r * 1024 + j]; for (int j = 0; j < 16; ++j) q2 += SS1[(size_t)r * 16 + j]; DCHK(63, q2, q, 1e-3f, 0.f); } }
        if (dk == 7) for (unsigned s = gid; s < 32768; s += NT_) { const unsigned h = dhash(s * 23 + 1); const int r = h % T, c = (h >> 15) % 4096; float q2 = 0.f; for (int j = 0; j < 16; ++j) q2 += SS1[(size_t)r * 16 + j];
            const float u_ = ddot(H1B + (size_t)r * 1024, WUP + (size_t)c * 1024, 1024) / sqrtf(q2 / 1024.f + 1e-6f), rl = fmaxf(u_, 0.f); DCHK(71, dbf(U, (size_t)r * 4096 + c), rl * rl, 0.03f, 0.02f); }
        if (dk == 8) for (unsigned s = gid; s < 16384; s += NT_) { const unsigned h = dhash(s * 29 + 1); const int r = h % T, c = (h >> 15) % 1024;
            const float v = dbf(H1B, (size_t)r * 1024 + c) + ddot(U + (size_t)r * 4096, WDN + (size_t)c * 4096, 4096); DCHK(81, OUT[(size_t)r * 1024 + c], v, 0.02f, 0.04f);
            if (c == 7) { float q = 0.f, q2 = 0.f; for (int j = 0; j < 1024; ++j) q += OUT[(size_t)r * 1024 + j] * OUT[(size_t)r * 1024 + j]; for (int j = 0; j < 16; ++j) q2 += SS2[(size_t)r * 16 + j]; DCHK(82, q2, q, 1e-3f, 0.f); } }
        if (dk == 9) { for (unsigned s = gid; s < 4096; s += NT_) { const int r = dhash(s * 31) % T; float q = 0.f; for (int j = 0; j < 1024; ++j) { const float v = OUT[(size_t)r * 1024 + j] / args.in[18][j]; q += v * v; } DCHK(91, q / 1024.f, 1.0f, 0.01f, 0.f); } }
        if (dk == 10) { if (gid == 0) { const unsigned code = *DG; if (code < 1000u) OUT[0] = 100.0f + 10.0f * (float)code; OUT[1] = 10000.0f * (1.0f + (float)DG[1]); } }
        return;
    }
#endif
    if (IN(0)) REP(0) { PLAIN_IDS
        LAS float* scr = (LAS float*)(ldsg + wave * 16384);
        constexpr int I_W1 = 16 * (4864 / 64), I_UP = 16 * (4096 / 64), I_DN = 64 * (1024 / 64), I_OUT = 16 * 16, I_UQ = 4 * (1536 / 64), I_UKV = 4 * (2048 / 64), I_LRU = 16 * 8;
        constexpr int NITEMS = I_W1 + I_UP + I_DN + I_OUT + I_UQ + I_UKV + I_LRU;
        const int gw4 = gw, NGW4 = NGW;
        {
        for (int m0 = gw4 * 4; m0 < T; m0 += NGW4 * 4) {
            f32x4 v[4][4];
#pragma unroll
            for (int r = 0; r < 4; ++r) { const f32x4* xr = (const f32x4*)(x + (size_t)(m0 + r) * DM) + lane;
#pragma unroll
                for (int j = 0; j < 4; ++j) v[r][j] = __builtin_nontemporal_load(xr + 64 * j); }
#pragma unroll
            for (int r = 0; r < 4; ++r) { float s = 0.f;
#pragma unroll
                for (int j = 0; j < 4; ++j) s += (v[r][j][0] * v[r][j][0] + v[r][j][1] * v[r][j][1]) + (v[r][j][2] * v[r][j][2] + v[r][j][3] * v[r][j][3]);
                s = wave_sum(s);
                if (lane == 0) rstdx[m0 + r] = rsqrtf(s * (1.0f / 1024.0f) + 1e-6f);
                u32x2* o = (u32x2*)(XB + (size_t)(m0 + r) * DM) + lane;
#pragma unroll
                for (int j = 0; j < 4; ++j) { u32x2 w; w.x = pkbf(v[r][j][0], v[r][j][1]); w.y = pkbf(v[r][j][2], v[r][j][3]); o[64 * j] = w; } }
        }
        }
        {
        for (int it = gw4; it < NITEMS; it += NGW4) {
            int r = it;
            if (r < I_W1) { tr_item64(args.in[2], 4672, 1024, 4864, args.in[1], W1, 0, r, lane); continue; } r -= I_W1;
            if (r < I_UP) { tr_item64(args.in[16], 4096, 1024, 4096, args.in[15], WUP, 2, r, lane); continue; } r -= I_UP;
            if (r < I_DN) { tr_item64(args.in[17], 1024, 4096, 1024, nullptr, WDN, 2, r, lane); continue; } r -= I_DN;
            if (r < I_OUT) { tr_item64(args.in[14], 1024, 1024, 1024, nullptr, WOUT, 2, r, lane); continue; } r -= I_OUT;
            if (r < I_UQ) { tr_item64(args.in[11], 1536, 256, 1536, args.in[10], WUQ, 1, r, lane); continue; } r -= I_UQ;
            if (r < I_UKV) { tr_item64(args.in[13], 2048, 256, 2048, args.in[12], WUKV, 2, r, lane); continue; } r -= I_UKV;
            { const int blk = r >> 3, sub = r & 7, nb = blk >> 1, isx = blk & 1;
              tr_item64((isx ? args.in[7] : args.in[5]) + (size_t)nb * 16384, 128, 256, 128, nullptr, WLRU + (size_t)(256 * nb + 128 * isx) * 256, 2, sub, lane, 128 * (nb & 1), 128); }
        }
        for (int i = blockIdx.x * 512 + tid; i < SEQ * 32; i += G * 512) {
            const int pos = i >> 5, k = i & 31; double inv = 1.0; for (int q = 0; q < k; ++q) inv *= 0.74989420933245582730;
            float s, c; sincos_d((double)pos * inv, s, c); CS[2 * i] = c; CS[2 * i + 1] = s;
        }
        for (int i = blockIdx.x * 512 + tid; i < 1024; i += G * 512) csp[i] = 8.0f * 1.4426950408889634f * log1pf(__expf(-args.in[9][i]));
            }
    }
    SEAM(0);

    if (IN(1)) REP(1) { PLAIN_IDS
        pg8::Gemm g{XB, W1, T, 4864, 1024, 1024, 1024, 0, 0}; pg8::StaticOrder S; S.init(T, 4864, G, (int)blockIdx.x);
        pg8::EpiIn E{ZX, G1, G2, ZC, rstdx, SSQ, SSKV, KR, CS};
        pg8::gemm_phase<pg8::EpiIn, pg8::StaticOrder, true, true>(ldsg, g, S, E, tid);
    }
    SEAM(1);

    if (IN(2)) REP(2) { PLAIN_IDS
        const float* cw = args.in[3]; const float* cb = args.in[4];
        for (int it = gw; it < (T / 16) * 2; it += NGW) {
            const int t0 = (it >> 1) * 16, c0 = (it & 1) * 512 + lane * 8;
            float w[4][8], bias[8], h0[8], h1[8], h2[8];
#pragma unroll
            for (int j = 0; j < 4; ++j) { const f32x4 a = *(const f32x4*)(cw + j * 1024 + c0), b = *(const f32x4*)(cw + j * 1024 + c0 + 4);
#pragma unroll
                for (int e = 0; e < 4; ++e) { w[j][e] = a[e]; w[j][4 + e] = b[e]; } }
            { const f32x4 a = *(const f32x4*)(cb + c0), b = *(const f32x4*)(cb + c0 + 4);
#pragma unroll
              for (int e = 0; e < 4; ++e) { bias[e] = a[e]; bias[4 + e] = b[e]; } }
            const bool first = (t0 & (SEQ - 1)) == 0;
            { u32x4 r0 = {0u, 0u, 0u, 0u}, r1 = r0, r2 = r0;
              if (!first) { r0 = *(const u32x4*)(ZX + (size_t)(t0 - 3) * DM + c0); r1 = *(const u32x4*)(ZX + (size_t)(t0 - 2) * DM + c0); r2 = *(const u32x4*)(ZX + (size_t)(t0 - 1) * DM + c0); }
#pragma unroll
              for (int e = 0; e < 4; ++e) { h0[2 * e] = bflo(r0[e]); h0[2 * e + 1] = bfhi(r0[e]); h1[2 * e] = bflo(r1[e]); h1[2 * e + 1] = bfhi(r1[e]); h2[2 * e] = bflo(r2[e]); h2[2 * e + 1] = bfhi(r2[e]); } }
            u32x4 rows[16];
#pragma unroll
            for (int i = 0; i < 16; ++i) rows[i] = __builtin_nontemporal_load((const u32x4*)(ZX + (size_t)(t0 + i) * DM + c0));
#pragma unroll
            for (int i = 0; i < 16; ++i) { const u32x4 r = rows[i]; float cur[8], o[8];
#pragma unroll
                for (int e = 0; e < 4; ++e) { cur[2 * e] = bflo(r[e]); cur[2 * e + 1] = bfhi(r[e]); }
#pragma unroll
                for (int e = 0; e < 8; ++e) { o[e] = bias[e] + w[0][e] * h0[e] + w[1][e] * h1[e] + w[2][e] * h2[e] + w[3][e] * cur[e]; h0[e] = h1[e]; h1[e] = h2[e]; h2[e] = cur[e]; }
                u32x4 ow; ow.x = pkbf(o[0], o[1]); ow.y = pkbf(o[2], o[3]); ow.z = pkbf(o[4], o[5]); ow.w = pkbf(o[6], o[7]);
                *(u32x4*)(XA + (size_t)(t0 + i) * DM + c0) = ow; }
        }
    }
    SEAM(2);

    if (IN(3)) REP(3) { PLAIN_IDS
#ifndef P3SEL
#define P3SEL 7
#endif
        if (P3SEL & 1) { pg8::Gemm g{XA, WLRU, T, 2048, 256, 1024, 256, 512, 1}; pg8::StaticOrder S; S.init(T, 2048, G, (int)blockIdx.x);
#ifdef TESTLRU
          pg8::EpiRowScale E{KV, 2048, SSKV};
          pg8::gemm_phase<pg8::EpiRowScale, pg8::StaticOrder, true, true>(ldsg, g, S, E, tid); }
#else
          pg8::EpiLru E{XA, args.in[6], args.in[8], csp, AB};
          pg8::gemm_phase<pg8::EpiLru, pg8::StaticOrder, true, true>(ldsg, g, S, E, tid); }
#endif
        if (P3SEL & 2) { pg8::Gemm g{ZC, WUQ, T, 1536, 256, 768, 256, 0, 0}; pg8::StaticOrder S; S.init(T, 1536, G, (int)blockIdx.x);
          pg8::EpiQ E{Q, SSQ, CS};
          pg8::gemm_phase<pg8::EpiQ, pg8::StaticOrder, true, true>(ldsg, g, S, E, tid); }
        if (P3SEL & 4) { pg8::Gemm g{ZC + 256, WUKV, T, 2048, 256, 768, 256, 0, 0}; pg8::StaticOrder S; S.init(T, 2048, G, (int)blockIdx.x);
          pg8::EpiRowScale E{KV, 2048, SSKV};
          pg8::gemm_phase<pg8::EpiRowScale, pg8::StaticOrder, true, true>(ldsg, g, S, E, tid); }
    }
    SEAM(3);

    if (IN(4)) REP(4) { FRESH_IDS
        for (int un = blockIdx.x; un < 256; un += G) {
            const int b = un >> 6, ch = un & 63, c = wave * 128 + lane * 2;
            const unsigned* ap = AB + ((size_t)b * SEQ + ch * 128) * DM + c;
            float h0 = 0.f, h1 = 0.f, L0 = 0.f, L1 = 0.f;
            for (int i0 = 0; i0 < 128; i0 += 16) { h16x4 w[16];
#pragma unroll
                for (int i = 0; i < 16; ++i) w[i] = __builtin_nontemporal_load((const h16x4*)(ap + (size_t)(i0 + i) * DM));
#pragma unroll
                for (int i = 0; i < 16; ++i) { const float l0 = (float)w[i][0], l1 = (float)w[i][2];
                    h0 = __builtin_amdgcn_exp2f(l0) * h0 + (float)w[i][1]; h1 = __builtin_amdgcn_exp2f(l1) * h1 + (float)w[i][3]; L0 += l0; L1 += l1; } }
            *(f32x4*)(SUM + (((size_t)b * 64 + ch) * 1024 + c) * 2) = (f32x4){L0, h0, L1, h1};
        }
        {
            constexpr int NITEM = 32 * 16;
#define ITEM_BH(LL) (G == 256 ? (((LL) & 7) + 8 * (2 * ((LL) >> 8) + (((LL) >> 7) & 1))) : ((LL) >> 4))
#define ITEM_X(LL)  (G == 256 ? (((LL) >> 3) & 15) : ((LL) & 15))
            int L = blockIdx.x;
            if (L < NITEM) {
                att::Seam S; int pass = 0;
#define MKREF(r, LL, ps) do { const int bh_ = ITEM_BH(LL), xx_ = ITEM_X(LL), qb_ = (ps) ? 31 - xx_ : xx_, b_ = bh_ >> 3, h_ = bh_ & 7; \
                    const size_t row0_ = (size_t)b_ * SEQ + qb_ * 256, key0_ = (size_t)b_ * SEQ; \
                    r.Qn = Q + row0_ * 1536 + h_ * 128; r.Qr = Q + row0_ * 1536 + 1024 + h_ * 64; r.Kn = KV + key0_ * 2048 + h_ * 256; r.V = r.Kn + 128; r.Kr = KR + key0_ * 64; \
                    r.O = YB + row0_ * 1024 + h_ * 128; r.P0 = qb_ * 256; } while (0)
                att::BlockRef cur, nxt; MKREF(cur, L, 0);
                att::attn_prime(cur, (char*)lds, S, tid);
                for (;;) {
                    const bool more_pass = pass == 0, more_item = L + G < NITEM, last = !more_pass && !more_item;
                    int passn = pass + 1, Ln = L;
                    if (!more_pass) { passn = 0; Ln = more_item ? L + G : L; }
                    MKREF(nxt, Ln, passn);
                    att::attn_block(cur, nxt, (char*)lds, S, tid);
                    if (last) break;
                    cur = nxt; pass = passn; L = Ln;
                }
            }
#undef MKREF
#undef ITEM_BH
#undef ITEM_X
        }
    }
    SEAM(4);

    if (IN(5)) REP(5) { FRESH_IDS
        for (int gi = blockIdx.x; gi < 256; gi += G) {
            const int b = gi >> 6, ch = gi & 63, c = wave * 128 + lane * 2;
            float h0 = 0.f, h1 = 0.f;
            for (int k0 = 0; k0 < ch; k0 += 8) { f32x4 sv[8];
#pragma unroll
                for (int j = 0; j < 8; ++j) { const int kk = (k0 + j < 63) ? k0 + j : 63; sv[j] = *(const f32x4*)(SUM + (((size_t)b * 64 + kk) * 1024 + c) * 2); }
#pragma unroll
                for (int j = 0; j < 8; ++j) if (k0 + j < ch) { h0 = __builtin_amdgcn_exp2f(sv[j][0]) * h0 + sv[j][1]; h1 = __builtin_amdgcn_exp2f(sv[j][2]) * h1 + sv[j][3]; } }
            const size_t row0 = (size_t)b * SEQ + ch * 128;
            for (int i0 = 0; i0 < 128; i0 += 32) { h16x4 w[32]; unsigned g1[32], g2[32], yb[32];
#pragma unroll
                for (int i = 0; i < 32; ++i) { const size_t off = (row0 + i0 + i) * DM + c;
                    w[i] = __builtin_nontemporal_load((const h16x4*)(AB + off)); g1[i] = __builtin_nontemporal_load((const unsigned*)(G1 + off)); g2[i] = __builtin_nontemporal_load((const unsigned*)(G2 + off)); yb[i] = __builtin_nontemporal_load((const unsigned*)(YB + off)); }
#pragma unroll
                for (int i = 0; i < 32; ++i) { const size_t off = (row0 + i0 + i) * DM + c;
                    h0 = __builtin_amdgcn_exp2f((float)w[i][0]) * h0 + (float)w[i][1]; h1 = __builtin_amdgcn_exp2f((float)w[i][2]) * h1 + (float)w[i][3];
                    *(unsigned*)(MG + off) = pkbf(bflo(g1[i]) * h0 + bflo(g2[i]) * bflo(yb[i]), bfhi(g1[i]) * h1 + bfhi(g2[i]) * bfhi(yb[i])); } }
        }
    }
    SEAM(5);

    if (IN(6)) REP(6) { FRESH_IDS
        pg8::Gemm g{MG, WOUT, T, 1024, 1024, 1024, 1024, 0, 0}; pg8::StaticOrder S; S.init(T, 1024, G, (int)blockIdx.x);
        pg8::EpiRes<true> E{x, nullptr, H1B, SS1};
        pg8::gemm_phase<pg8::EpiRes<true>, pg8::StaticOrder, true, true>(ldsg, g, S, E, tid);
    }
    SEAM(6);

    if (IN(7)) REP(7) { FRESH_IDS
        pg8::Gemm g{H1B, WUP, T, 4096, 1024, 1024, 1024, 0, 0}; pg8::StaticOrder S; S.init(T, 4096, G, (int)blockIdx.x);
        pg8::EpiUp E{U, SS1};
        pg8::gemm_phase<pg8::EpiUp, pg8::StaticOrder, true, true>(ldsg, g, S, E, tid);
    }
    SEAM(7);

    if (IN(8)) REP(8) { FRESH_IDS
        pg8::Gemm g{U, WDN, T, 1024, 4096, 4096, 4096, 0, 0}; pg8::StaticOrder S; S.init(T, 1024, G, (int)blockIdx.x);
        pg8::EpiRes<false> E{nullptr, H1B, H2B, SS2};
        pg8::gemm_phase<pg8::EpiRes<false>, pg8::StaticOrder, true, true>(ldsg, g, S, E, tid);
    }
    SEAM(8);

    if (IN(9)) REP(9) { FRESH_IDS
        const float* gf = args.in[18];
        f32x4 gv[4];
#pragma unroll
        for (int j = 0; j < 4; ++j) gv[j] = ((const f32x4*)gf)[lane + 64 * j];
        for (int m0 = gw * 4; m0 < T; m0 += NGW * 4) {
            f32x4 v[4][4]; float rs[4];
#pragma unroll
            for (int r = 0; r < 4; ++r) { const u32x2* o = (const u32x2*)(H2B + (size_t)(m0 + r) * DM) + lane;
#pragma unroll
                for (int j = 0; j < 4; ++j) { const u32x2 bw = __builtin_nontemporal_load(o + 64 * j); v[r][j] = (f32x4){bflo(bw.x), bfhi(bw.x), bflo(bw.y), bfhi(bw.y)}; }
                const f32x4* sp = (const f32x4*)(SS2 + (size_t)(m0 + r) * 16); const f32x4 s = (sp[0] + sp[1]) + (sp[2] + sp[3]);
                rs[r] = rsqrtf(((s[0] + s[1]) + (s[2] + s[3])) * (1.0f / 1024.0f) + 1e-6f); }
#pragma unroll
            for (int r = 0; r < 4; ++r) { f32x4* o = (f32x4*)(OUT + (size_t)(m0 + r) * DM) + lane;
#pragma unroll
                for (int j = 0; j < 4; ++j) __builtin_nontemporal_store(v[r][j] * rs[r] * gv[j], o + 64 * j); }
        }
    }
#ifdef TSTAMP
    grid.sync();
    if (blockIdx.x == 0 && tid == 0) TS[10] = __builtin_amdgcn_s_memrealtime();
    __threadfence(); grid.sync();
    { const float da = (float)(TS[TSTAMP_A + 1] - TS[TSTAMP_A]) * 0.01f, db = (float)(TS[TSTAMP_B + 1] - TS[TSTAMP_B]) * 0.01f;
      for (size_t i = (size_t)blockIdx.x * 512 + tid; i < ((size_t)1 << 22); i += (size_t)G * 512) OUT[i] = (i == 0) ? 10.0f * da : db; }
#endif
#undef IN
#undef SEAM
}

constexpr int LDS_TOTAL = 153600;
static_assert(att::LDS_BYTES <= LDS_TOTAL && pg8::STAGE_BYTES <= LDS_TOTAL, "LDS");
extern "C" void kernel_launch(void* const* d_in, const int* in_sizes, int n_in, void* d_out, int out_size, void* d_ws, size_t ws_size, hipStream_t stream) {
    static int grid = 0;
    if (grid == 0) {
        if (n_in != 19 || out_size != T * DM || ws_size < WS_END) { fprintf(stderr, "kernel_launch: unexpected shapes (n_in %d, out %d, ws %zu)\n", n_in, out_size, ws_size); grid = -1; return; }
        int dev = 0, cus = 0, per_cu = 0;
        (void)hipGetDevice(&dev); (void)hipDeviceGetAttribute(&cus, hipDeviceAttributeMultiprocessorCount, dev);
        if (hipFuncSetAttribute((const void*)fwd_kernel, hipFuncAttributeMaxDynamicSharedMemorySize, LDS_TOTAL) != hipSuccess) { fprintf(stderr, "kernel_launch: hipFuncSetAttribute failed\n"); grid = -1; return; }
        if (hipOccupancyMaxActiveBlocksPerMultiprocessor(&per_cu, (const void*)fwd_kernel, 512, LDS_TOTAL) != hipSuccess || per_cu < 1) { fprintf(stderr, "kernel_launch: occupancy query says %d\n", per_cu); per_cu = 1; }
        (void)hipGetLastError();
        grid = cus * 1;
        if (grid <= 0) grid = 256;
    }
    if (grid < 0) return;
    Args a{};
    for (int i = 0; i < 19; ++i) a.in[i] = (const float*)d_in[i];
    a.out = (float*)d_out; a.ws = (unsigned char*)d_ws;
#if N_LAUNCHES == 1
    a.ph_lo = 0; a.ph_hi = NPHASE;
    (void)hipMemsetAsync((unsigned char*)d_ws + WS_BAR, 0, 16384, stream);
    void* kargs[] = {&a};
    hipError_t e = hipLaunchCooperativeKernel((const void*)fwd_kernel, dim3(grid), dim3(512), kargs, LDS_TOTAL, stream);
    if (e != hipSuccess) fprintf(stderr, "kernel_launch: cooperative launch failed: %s (grid %d)\n", hipGetErrorString(e), grid);
#else
#ifdef DIAG
    (void)hipMemsetAsync((unsigned char*)d_ws + WS_CSP + 8192, 0x7f, 4, stream); (void)hipMemsetAsync((unsigned char*)d_ws + WS_CSP + 8196, 0, 4, stream);
#endif
#ifndef PROBE_LIST
#define PROBE_LIST 0,1,2,3,4,5,6,7,8,9
#endif
    static const int plist[] = {PROBE_LIST};
    for (int pi = 0; pi < (int)(sizeof(plist) / sizeof(int)); ++pi) { const int p = plist[pi]; a.ph_lo = p; a.ph_hi = p + 1;
        hipLaunchKernelGGL(fwd_kernel, dim3(grid), dim3(512), LDS_TOTAL, stream, a);
#ifdef DIAG
        a.ph_lo = 100 + p; a.ph_hi = 101 + p; hipLaunchKernelGGL(fwd_kernel, dim3(grid), dim3(512), LDS_TOTAL, stream, a);
        if (p == NPHASE - 1) { a.ph_lo = 110; a.ph_hi = 111; hipLaunchKernelGGL(fwd_kernel, dim3(grid), dim3(512), LDS_TOTAL, stream, a); }
#endif
        if (hipPeekAtLastError() != hipSuccess) { fprintf(stderr, "kernel_launch: launch %d failed\n", p); break; } }
#endif
}
```

```cpp
#define N_LAUNCHES 1
#include <hip/hip_runtime.h>
#include <hip/hip_cooperative_groups.h>
#include <cstdio>
#include <cstdint>
namespace cg = cooperative_groups;
namespace pg8 {
#define PG8_LAS __attribute__((address_space(3)))
typedef unsigned short bf16_t;
typedef short bf16x8 __attribute__((ext_vector_type(8)));
typedef float f32x4 __attribute__((ext_vector_type(4)));
typedef unsigned u32x4 __attribute__((ext_vector_type(4)));
constexpr int BM = 256, BK = 64, HALF = 128, HTB = HALF * BK * 2  , STAGE_BYTES = 8 * HTB, NXCD = 8, WGM = 8;

__host__ __device__ __forceinline__ int lds_byte(int r, int c) { const int st = (r >> 4) * 2 + (c >> 5), rr = r & 15, cc = c & 31, ob = rr * 64 + cc * 2; return st * 1024 + (ob ^ (((ob >> 9) & 1) << 5)); }
__host__ __device__ __forceinline__ void stage_rc(int b, int& R, int& C) { const int st = b / 1024, sb = b % 1024, swz = sb ^ (((sb >> 9) & 1) << 5); R = (st >> 1) * 16 + swz / 64; C = (st & 1) * 32 + (swz % 64) / 2; }
__host__ __device__ __forceinline__ int perm32(int rho) { const int n = rho >> 4, i = rho & 15; return 8 * (i >> 2) + 4 * n + (i & 3); }

struct Unit { int pm, pn; };
struct Gemm { const bf16_t* A; const bf16_t* Bt; int M, N, K, lda, ldb; long a_pn_bytes; int a_pn_shift; };

struct StaticOrder {
    int nM, nN, nwg, G, c;
    __host__ __device__ void init(int M, int N, int G_, int c_) { nM = M / BM; nN = N / BM; nwg = nM * nN; G = G_; c = c_; }
    __host__ __device__ bool next(int i, Unit& u) const {
        const long L = (long)i * G + c; if (L >= nwg) return false;
        int wgid = (int)L; { const int q = nwg / NXCD, r = nwg % NXCD, xcd = wgid % NXCD, off = wgid / NXCD; wgid = (xcd < r ? xcd * (q + 1) : r * (q + 1) + (xcd - r) * q) + off; }
        const int nig = WGM * nN, gid = wgid / nig, fm = gid * WGM, gsz = (nM - fm) < WGM ? (nM - fm) : WGM;
        u.pm = fm + ((wgid % nig) % gsz); u.pn = (wgid % nig) / gsz; return true;
    }
    __device__ __forceinline__ void a_ready(const Unit&) const {}
    __device__ __forceinline__ void done(const Unit&) const {}
};

__device__ __forceinline__ unsigned cvt_pk_bf16(float lo, float hi) { unsigned r; asm volatile("v_cvt_pk_bf16_f32 %0, %1, %2" : "=v"(r) : "v"(lo), "v"(hi)); return r; }
typedef float f32x2 __attribute__((ext_vector_type(2)));
typedef unsigned u32x2 __attribute__((ext_vector_type(2)));
typedef _Float16 h16x2 __attribute__((ext_vector_type(2)));
__device__ __forceinline__ float fsigmoid(float v) { return __builtin_amdgcn_rcpf(1.0f + __expf(-v)); }
__device__ __forceinline__ float gelu_tanh(float v) { const float y = 1.5957691216057308f * (v + 0.044715f * v * v * v); return v * fsigmoid(y); }
__device__ __forceinline__ u32x4 pack8f(const f32x4 a, const f32x4 b) { u32x4 w; w.x = cvt_pk_bf16(a[0], a[1]); w.y = cvt_pk_bf16(a[2], a[3]); w.z = cvt_pk_bf16(b[0], b[1]); w.w = cvt_pk_bf16(b[2], b[3]); return w; }
__device__ __forceinline__ float bf2f(unsigned short b) { return __uint_as_float((unsigned)b << 16); }

struct EpiIn {
    static constexpr bool PERM = true, AFTER_DRAIN = false;
    bf16_t *ZX, *G1, *G2, *ZC; const float* rstd; float *SSQ, *SSKV; bf16_t* KR; const float* CS;
    __device__ __forceinline__ void operator()(const f32x4 (&acc)[2][2][4][2], const Unit& u, int wr, int wc, int fr, int fq) const {
        const int row0 = u.pm * BM + wr * 64 + fr, cl = wc * 32 + 8 * fq, pn = u.pn;
#pragma unroll
        for (int ai = 0; ai < 2; ++ai)
#pragma unroll
            for (int m = 0; m < 4; ++m) { const int row = row0 + ai * HALF + m * 16; const float rs = rstd[row];
                if (pn >= 4 && pn < 12) {
                    f32x4 o[2];
#pragma unroll
                    for (int n = 0; n < 2; ++n)
#pragma unroll
                        for (int e = 0; e < 4; ++e) o[n][e] = gelu_tanh(acc[ai][0][m][n][e] * rs) * fsigmoid(acc[ai][1][m][n][e] * rs);
                    __builtin_nontemporal_store(pack8f(o[0], o[1]), (u32x4*)(G1 + (size_t)row * 1024 + (pn - 4) * 128 + cl));
                } else {
#pragma unroll
                    for (int bj = 0; bj < 2; ++bj) { f32x4 v0 = acc[ai][bj][m][0] * rs, v1 = acc[ai][bj][m][1] * rs;
                        if (pn < 4) *(u32x4*)(ZX + (size_t)row * 1024 + pn * 256 + bj * HALF + cl) = pack8f(v0, v1);
                        else if (pn < 16) {
#pragma unroll
                            for (int e = 0; e < 4; ++e) { v0[e] = fsigmoid(v0[e]); v1[e] = fsigmoid(v1[e]); }
                            __builtin_nontemporal_store(pack8f(v0, v1), (u32x4*)(G2 + (size_t)row * 1024 + (pn - 12) * 256 + bj * HALF + cl));
                        } else if (pn < 18) *(u32x4*)(ZC + (size_t)row * 768 + (pn - 16) * 256 + bj * HALF + cl) = pack8f(v0, v1);
                        else if (bj == 0 && wc < 2) {
                            const float* cs = CS + ((size_t)(row & 8191) * 32 + 16 * wc + 4 * fq) * 2;
                            const f32x4 c01 = *(const f32x4*)cs, c23 = *(const f32x4*)(cs + 4);
                            const float co[4] = {c01[0], c01[2], c23[0], c23[2]}, si[4] = {c01[1], c01[3], c23[1], c23[3]}; f32x4 olo, ohi;
#pragma unroll
                            for (int e2 = 0; e2 < 4; ++e2) { olo[e2] = v0[e2] * co[e2] - v1[e2] * si[e2]; ohi[e2] = v1[e2] * co[e2] + v0[e2] * si[e2]; }
                            *(u32x4*)(KR + (size_t)row * 64 + cl) = pack8f(olo, ohi); }
                    }
                    if (pn == 16 || pn == 17) {
                        float ss = 0.f;
#pragma unroll
                        for (int bj = 0; bj < 2; ++bj)
#pragma unroll
                            for (int n = 0; n < 2; ++n) { const f32x4 z = acc[ai][bj][m][n] * rs; ss += (z[0] * z[0] + z[1] * z[1]) + (z[2] * z[2] + z[3] * z[3]); }
                        ss += __shfl_xor(ss, 16); ss += __shfl_xor(ss, 32);
                        if (fq == 0) (pn == 16 ? SSQ : SSKV)[(size_t)row * 4 + wc] = ss; }
                }
            }
    }
};
__device__ __forceinline__ float one_minus_exp(float x) {
    const float p = -x * (1.0f + x * (0.5f + x * (0.16666667f + x * (0.041666668f + x * 0.0083333338f))));
    const float q = 1.0f - __builtin_amdgcn_exp2f(x * 1.4426950408889634f);
    return x > -0.2f ? p : q;
}
struct EpiLru {
    static constexpr bool PERM = true, AFTER_DRAIN = false;
    const bf16_t* XA; const float *ba, *bx, *csp; unsigned* AB;
    __device__ __forceinline__ void operator()(const f32x4 (&acc)[2][2][4][2], const Unit& u, int wr, int wc, int fr, int fq) const {
        const int c0 = u.pn * 128 + wc * 32 + 8 * fq;
        const unsigned lo = (unsigned)((wr * 64 + fr) * 1024 + c0);
        const char* xau = (const char*)(XA + (size_t)u.pm * BM * 1024); char* abu = (char*)(AB + (size_t)u.pm * BM * 1024);
#pragma unroll
        for (int n = 0; n < 2; ++n) {

#ifdef NOBIAS
 const f32x4 vba = {0.f,0.f,0.f,0.f}, vbx = vba, vcs = {1.f,1.f,1.f,1.f};
#else
 const f32x4 vba = *(const f32x4*)(ba + c0 + 4 * n), vbx = *(const f32x4*)(bx + c0 + 4 * n), vcs = *(const f32x4*)(csp + c0 + 4 * n);
#endif

#pragma unroll
            for (int ai = 0; ai < 2; ++ai)
#pragma unroll
                for (int m = 0; m < 4; ++m) { const int ro = (ai * HALF + m * 16) * 1024 + 4 * n;

#ifdef NOXA
 const u32x2 xw = {0x3f803f80u, 0x3f803f80u};
#else
 const u32x2 xw = *(const u32x2*)(xau + (size_t)ro * 2 + lo * 2u);
#endif
 u32x4 ow;
#pragma unroll
                    for (int e = 0; e < 4; ++e) { const unsigned w = xw[e >> 1]; const float xa = __uint_as_float((e & 1) ? (w & 0xffff0000u) : (w << 16));
                        const float r = fsigmoid(acc[ai][0][m][n][e] + vba[e]), ig = fsigmoid(acc[ai][1][m][n][e] + vbx[e]);
                        const float la2 = -vcs[e] * r; const float b = __builtin_amdgcn_sqrtf(fmaxf(1.0f - __builtin_amdgcn_exp2f(2.0f * la2), 0.f)) * (ig * xa);
                        h16x2 hv; hv.x = (_Float16)la2; hv.y = (_Float16)b; ow[e] = __builtin_bit_cast(unsigned, hv); }
                    *(u32x4*)(abu + (size_t)ro * 4 + lo * 4u) = ow;
                    __builtin_amdgcn_sched_barrier(0); }
        }
    }
};
struct EpiQ {
    static constexpr bool PERM = true, AFTER_DRAIN = false;
    bf16_t* Q; const float* SSp; const float* CS;
    __device__ __forceinline__ void operator()(const f32x4 (&acc)[2][2][4][2], const Unit& u, int wr, int wc, int fr, int fq) const {
        const int row0 = u.pm * BM + wr * 64 + fr, cl = wc * 32 + 8 * fq, pn = u.pn;
#pragma unroll
        for (int ai = 0; ai < 2; ++ai)
#pragma unroll
            for (int m = 0; m < 4; ++m) { const int row = row0 + ai * HALF + m * 16; const f32x4 sp = *(const f32x4*)(SSp + (size_t)row * 4); const float rs = rsqrtf(((sp[0] + sp[1]) + (sp[2] + sp[3])) * (1.0f / 256.0f) + 1e-6f);
                bf16_t* op = Q + (size_t)row * 1536 + pn * 256 + cl;
                if (pn < 4) {
#pragma unroll
                    for (int bj = 0; bj < 2; ++bj) *(u32x4*)(op + bj * HALF) = pack8f(acc[ai][bj][m][0] * rs, acc[ai][bj][m][1] * rs);
                } else {
                    const float* cs = CS + ((size_t)(row & 8191) * 32 + 16 * (wc & 1) + 4 * fq) * 2;
                    const f32x4 c01 = *(const f32x4*)cs, c23 = *(const f32x4*)(cs + 4);
                    const float co[4] = {c01[0], c01[2], c23[0], c23[2]}, si[4] = {c01[1], c01[3], c23[1], c23[3]};
#pragma unroll
                    for (int bj = 0; bj < 2; ++bj) { const f32x4 lo = acc[ai][bj][m][0] * rs, hi = acc[ai][bj][m][1] * rs; f32x4 olo, ohi;
#pragma unroll
                        for (int e = 0; e < 4; ++e) { olo[e] = lo[e] * co[e] - hi[e] * si[e]; ohi[e] = hi[e] * co[e] + lo[e] * si[e]; }
                        *(u32x4*)(op + bj * HALF) = pack8f(olo, ohi); }
                }
            }
    }
};
struct EpiRowScale {
    static constexpr bool PERM = true, AFTER_DRAIN = false;
    bf16_t* O; int ldc; const float* SSp;
    __device__ __forceinline__ void operator()(const f32x4 (&acc)[2][2][4][2], const Unit& u, int wr, int wc, int fr, int fq) const {
        const int row0 = u.pm * BM + wr * 64 + fr, cl = u.pn * 256 + wc * 32 + 8 * fq;
#pragma unroll
        for (int ai = 0; ai < 2; ++ai)
#pragma unroll
            for (int m = 0; m < 4; ++m) { const int row = row0 + ai * HALF + m * 16; const f32x4 sp = *(const f32x4*)(SSp + (size_t)row * 4); const float rs = rsqrtf(((sp[0] + sp[1]) + (sp[2] + sp[3])) * (1.0f / 256.0f) + 1e-6f);
#pragma unroll
                for (int bj = 0; bj < 2; ++bj) *(u32x4*)(O + (size_t)row * ldc + cl + bj * HALF) = pack8f(acc[ai][bj][m][0] * rs, acc[ai][bj][m][1] * rs);
            }
    }
};
template <bool BASE_F32> struct EpiRes {
    static constexpr bool PERM = false, AFTER_DRAIN = false;
    const float* basef; const bf16_t* baseb; bf16_t* outb; float* SS;
    __device__ __forceinline__ void operator()(const f32x4 (&acc)[2][2][4][2], const Unit& u, int wr, int wc, int fr, int fq) const {
        const int row0 = u.pm * BM + wr * 64 + fr, col0 = u.pn * 256 + wc * 32 + 4 * fq;
#pragma unroll
        for (int ai = 0; ai < 2; ++ai)
#pragma unroll
            for (int m = 0; m < 4; ++m) { const int row = row0 + ai * HALF + m * 16; const size_t off = (size_t)row * 1024 + col0; float ss = 0.f;
#pragma unroll
                for (int bj = 0; bj < 2; ++bj)
#pragma unroll
                    for (int n = 0; n < 2; ++n) { const size_t o2 = off + bj * HALF + n * 16; f32x4 h;
                        if (BASE_F32) h = __builtin_nontemporal_load((const f32x4*)(basef + o2)) + acc[ai][bj][m][n];
                        else { const u32x2 bw = *(const u32x2*)(baseb + o2); h = (f32x4){__uint_as_float(bw.x << 16), __uint_as_float(bw.x & 0xffff0000u), __uint_as_float(bw.y << 16), __uint_as_float(bw.y & 0xffff0000u)} + acc[ai][bj][m][n]; }
                        ss += (h[0] * h[0] + h[1] * h[1]) + (h[2] * h[2] + h[3] * h[3]);
                        u32x2 w; w.x = cvt_pk_bf16(h[0], h[1]); w.y = cvt_pk_bf16(h[2], h[3]); *(u32x2*)(outb + o2) = w; }
                ss += __shfl_xor(ss, 16); ss += __shfl_xor(ss, 32);
                if (fq == 0) SS[(size_t)row * 16 + u.pn * 4 + wc] = ss;
            }
    }
};
struct EpiUp {
    static constexpr bool PERM = true, AFTER_DRAIN = false;
    bf16_t* U; const float* SS;
    __device__ __forceinline__ void operator()(const f32x4 (&acc)[2][2][4][2], const Unit& u, int wr, int wc, int fr, int fq) const {
        const int row0 = u.pm * BM + wr * 64 + fr, cl = u.pn * 256 + wc * 32 + 8 * fq;
#pragma unroll
        for (int ai = 0; ai < 2; ++ai)
#pragma unroll
            for (int m = 0; m < 4; ++m) { const int row = row0 + ai * HALF + m * 16;
                const f32x4* sp = (const f32x4*)(SS + (size_t)row * 16); const f32x4 s = (sp[0] + sp[1]) + (sp[2] + sp[3]);
                const float rs = rsqrtf(((s[0] + s[1]) + (s[2] + s[3])) * (1.0f / 1024.0f) + 1e-6f);
#pragma unroll
                for (int bj = 0; bj < 2; ++bj) { f32x4 v0 = acc[ai][bj][m][0] * rs, v1 = acc[ai][bj][m][1] * rs;
#pragma unroll
                    for (int e = 0; e < 4; ++e) { const float a = fmaxf(v0[e], 0.f), b = fmaxf(v1[e], 0.f); v0[e] = a * a; v1[e] = b * b; }
                    *(u32x4*)(U + (size_t)row * 4096 + cl + bj * HALF) = pack8f(v0, v1); }
            }
    }
};
template <class Epi, class Sched, bool ALIGN_EPI = false, bool SP2 = false>
__device__ __forceinline__ void gemm_phase(PG8_LAS unsigned char* lds, const Gemm g, const Sched& S, const Epi& E, const int tid0) {
    int tid_ = tid0; asm volatile("" : "+v"(tid_));
    const int tid = tid_, wid = __builtin_amdgcn_readfirstlane(tid >> 6), lane = tid & 63, wr = wid >> 2, wc = wid & 3, fr = lane & 15, fq = lane >> 4;
    int K_ = g.K; asm volatile("" : "+s"(K_));
    const int K = K_, nt = K / BK;
    unsigned voffA[2], voffB[2];
#pragma unroll
    for (int i = 0; i < 2; ++i) { int R, C; stage_rc(tid * 16 + i * 8192, R, C); const int Rb = Epi::PERM ? ((R & ~31) + perm32(R & 31)) : R;
        voffA[i] = (unsigned)(R * g.lda + C) * 2u; voffB[i] = (unsigned)(Rb * g.ldb + C) * 2u; }
    const size_t kstep = (size_t)(BK * 2);
    const size_t hstepA = (size_t)HALF * g.lda * 2, hstepB = (size_t)HALF * g.ldb * 2;
    const size_t tstepA = 2 * hstepA, tstepB = 2 * hstepB;
    const unsigned ldsw = (unsigned)wid * 1024u;
    const int aoff = lds_byte(wr * 64 + fr, fq * 8), boff = lds_byte(wc * 32 + fr, fq * 8);
#define PG8_SA(b, h) (((b) * 2 + (h)) * HTB)
#define PG8_SB(b, h) ((4 + (b) * 2 + (h)) * HTB)
#define PG8_STAGE(bufoff, gbase, voff) do { _Pragma("unroll") for (int _i = 0; _i < 2; ++_i) \
        __builtin_amdgcn_global_load_lds((const unsigned*)((const char*)(gbase) + (voff)[_i]), (PG8_LAS unsigned*)(lds + (bufoff) + ldsw + _i * 8192), 16, 0, 0); } while (0)
#define PG8_LDA(dst, b, h) do { _Pragma("unroll") for (int m = 0; m < 4; ++m) _Pragma("unroll") for (int k = 0; k < 2; ++k) dst[m][k] = *(const PG8_LAS bf16x8*)(lds + PG8_SA(b, h) + aoff + m * 2048 + k * 1024); } while (0)
#define PG8_LDB(dst, b, h) do { _Pragma("unroll") for (int n = 0; n < 2; ++n) _Pragma("unroll") for (int k = 0; k < 2; ++k) dst[n][k] = *(const PG8_LAS bf16x8*)(lds + PG8_SB(b, h) + boff + n * 2048 + k * 1024); } while (0)
#define PG8_MMA(ai, bj, At, Bt) do { __builtin_amdgcn_s_setprio(1); _Pragma("unroll") for (int m = 0; m < 4; ++m) _Pragma("unroll") for (int n = 0; n < 2; ++n) _Pragma("unroll") for (int k = 0; k < 2; ++k) \
        acc[ai][bj][m][n] = __builtin_amdgcn_mfma_f32_16x16x32_bf16(Bt[n][k], At[m][k], acc[ai][bj][m][n], 0, 0, 0); __builtin_amdgcn_s_setprio(0); } while (0)
#define PG8_WAIT_V(n) asm volatile("s_waitcnt vmcnt(" #n ")" ::: "memory")
#define PG8_WAIT_L(n) asm volatile("s_waitcnt lgkmcnt(" #n ")" ::: "memory")
#define PG8_BAR __builtin_amdgcn_s_barrier()
#define PG8_SCHED __builtin_amdgcn_sched_barrier(0)
    Unit cur, nxt; int ui = 0;
    if (!S.next(0, cur)) return;
    f32x4 acc[2][2][4][2];
#pragma unroll
    for (int a = 0; a < 2; ++a)
#pragma unroll
        for (int b = 0; b < 2; ++b)
#pragma unroll
            for (int m = 0; m < 4; ++m)
#pragma unroll
                for (int n = 0; n < 2; ++n) acc[a][b][m][n] = (f32x4){0.f, 0.f, 0.f, 0.f};
    bf16x8 At[4][2], B0[2][2], B1[2][2];
    const char* cA = (const char*)g.A + (size_t)cur.pm * tstepA + (size_t)(cur.pn >> g.a_pn_shift) * g.a_pn_bytes; const char* cB = (const char*)g.Bt + (size_t)cur.pn * tstepB;
    S.a_ready(cur);
    if constexpr (SP2) {
        PG8_STAGE(PG8_SB(0, 0), cB, voffB); PG8_STAGE(PG8_SB(0, 1), cB + hstepB, voffB); PG8_STAGE(PG8_SA(0, 0), cA, voffA); PG8_STAGE(PG8_SA(0, 1), cA + hstepA, voffA);
        if (wr == 1) PG8_BAR;
        PG8_WAIT_V(2); PG8_BAR;
        PG8_STAGE(PG8_SB(1, 0), cB + kstep, voffB); PG8_STAGE(PG8_SA(1, 0), cA + kstep, voffA); PG8_STAGE(PG8_SB(1, 1), cB + hstepB + kstep, voffB);
        PG8_WAIT_V(6); PG8_BAR;
    } else {
        PG8_STAGE(PG8_SB(0, 0), cB, voffB); PG8_STAGE(PG8_SA(0, 0), cA, voffA); PG8_STAGE(PG8_SB(0, 1), cB + hstepB, voffB); PG8_STAGE(PG8_SA(0, 1), cA + hstepA, voffA);
        if (wr == 1) PG8_BAR;
        PG8_WAIT_V(4); PG8_BAR;
        PG8_STAGE(PG8_SB(1, 0), cB + kstep, voffB); PG8_STAGE(PG8_SA(1, 0), cA + kstep, voffA); PG8_STAGE(PG8_SB(1, 1), cB + hstepB + kstep, voffB);
        PG8_WAIT_V(6); PG8_BAR;
    }
    for (;;) {
        const bool has_next = S.next(ui + 1, nxt);
        const char* nA = has_next ? (const char*)g.A + (size_t)nxt.pm * tstepA + (size_t)(nxt.pn >> g.a_pn_shift) * g.a_pn_bytes : cA; const char* nB = has_next ? (const char*)g.Bt + (size_t)nxt.pn * tstepB : cB;
        for (int t = 0; t < nt; t += 2) {
            const bool last = (t == nt - 2);
            const char* a1 = cA + (size_t)(t + 1) * kstep;
            const char* a2 = last ? nA : cA + (size_t)(t + 2) * kstep; const char* b2 = last ? nB : cB + (size_t)(t + 2) * kstep;
            const char* a3 = a2 + kstep; const char* b3 = b2 + kstep;
            if (last && has_next) S.a_ready(nxt);
            if constexpr (SP2) {
            PG8_LDB(B0, 0, 0); PG8_LDB(B1, 0, 1); PG8_SCHED; PG8_LDA(At, 0, 0); PG8_STAGE(PG8_SA(1, 1), a1 + hstepA, voffA);
            PG8_WAIT_V(8); PG8_WAIT_L(0); PG8_BAR; PG8_MMA(0, 0, At, B0); PG8_MMA(0, 1, At, B1); PG8_BAR; PG8_SCHED;
            PG8_LDA(At, 0, 1); PG8_STAGE(PG8_SB(0, 0), b2, voffB); PG8_STAGE(PG8_SB(0, 1), b2 + hstepB, voffB); PG8_STAGE(PG8_SA(0, 0), a2, voffA);
            PG8_WAIT_V(8); PG8_WAIT_L(0); PG8_BAR; PG8_MMA(1, 0, At, B0); PG8_MMA(1, 1, At, B1); PG8_BAR; PG8_SCHED;
            PG8_LDB(B0, 1, 0); PG8_LDB(B1, 1, 1); PG8_SCHED; PG8_LDA(At, 1, 0); PG8_STAGE(PG8_SA(0, 1), a2 + hstepA, voffA);
            PG8_WAIT_V(8); PG8_WAIT_L(0); PG8_BAR; PG8_MMA(0, 0, At, B0); PG8_MMA(0, 1, At, B1); PG8_BAR; PG8_SCHED;
            PG8_LDA(At, 1, 1); PG8_STAGE(PG8_SB(1, 0), b3, voffB); PG8_STAGE(PG8_SB(1, 1), b3 + hstepB, voffB); PG8_STAGE(PG8_SA(1, 0), a3, voffA);
            PG8_WAIT_V(8); PG8_WAIT_L(0); PG8_BAR; PG8_MMA(1, 0, At, B0); PG8_MMA(1, 1, At, B1); PG8_BAR; PG8_SCHED;
            } else {
            PG8_LDB(B0, 0, 0); PG8_SCHED; PG8_LDA(At, 0, 0); PG8_STAGE(PG8_SA(1, 1), a1 + hstepA, voffA);
            PG8_WAIT_L(8); PG8_BAR; PG8_WAIT_L(0); PG8_MMA(0, 0, At, B0); PG8_BAR; PG8_SCHED;
            PG8_LDB(B1, 0, 1); PG8_STAGE(PG8_SB(0, 0), b2, voffB);
            PG8_BAR; PG8_WAIT_L(0); PG8_MMA(0, 1, At, B1); PG8_BAR;
            PG8_LDA(At, 0, 1); PG8_STAGE(PG8_SA(0, 0), a2, voffA);
            PG8_BAR; PG8_WAIT_L(0); PG8_MMA(1, 0, At, B0); PG8_BAR; PG8_SCHED;
            PG8_STAGE(PG8_SB(0, 1), b2 + hstepB, voffB);
            PG8_WAIT_V(6); PG8_BAR; PG8_MMA(1, 1, At, B1); PG8_BAR;
            PG8_LDB(B0, 1, 0); PG8_SCHED; PG8_LDA(At, 1, 0); PG8_STAGE(PG8_SA(0, 1), a2 + hstepA, voffA);
            PG8_WAIT_L(8); PG8_BAR; PG8_WAIT_L(0); PG8_MMA(0, 0, At, B0); PG8_BAR; PG8_SCHED;
            PG8_LDB(B1, 1, 1); PG8_STAGE(PG8_SB(1, 0), b3, voffB);
            PG8_BAR; PG8_WAIT_L(0); PG8_MMA(0, 1, At, B1); PG8_BAR;
            PG8_LDA(At, 1, 1); PG8_STAGE(PG8_SA(1, 0), a3, voffA);
            PG8_BAR; PG8_WAIT_L(0); PG8_MMA(1, 0, At, B0); PG8_BAR; PG8_SCHED;
            PG8_STAGE(PG8_SB(1, 1), b3 + hstepB, voffB);
            PG8_WAIT_V(6); PG8_BAR; PG8_MMA(1, 1, At, B1); PG8_BAR;
            }
        }
        if constexpr (ALIGN_EPI) { if (wr == 0) PG8_BAR; }
        if constexpr (!Epi::AFTER_DRAIN) { E(acc, cur, wr, wc, fr, fq); S.done(cur); }
        if (!has_next) break;
#pragma unroll
        for (int a = 0; a < 2; ++a)
#pragma unroll
            for (int b = 0; b < 2; ++b)
#pragma unroll
                for (int m = 0; m < 4; ++m)
#pragma unroll
                    for (int n = 0; n < 2; ++n) acc[a][b][m][n] = (f32x4){0.f, 0.f, 0.f, 0.f};
        cur = nxt; cA = nA; cB = nB; ++ui;
        if constexpr (ALIGN_EPI) { if (wr == 1) PG8_BAR; }
    }
    PG8_WAIT_V(0);
    if constexpr (!ALIGN_EPI) { if (wr == 0) PG8_BAR; }
    PG8_BAR;
    if constexpr (Epi::AFTER_DRAIN) { E.fused(acc, cur, wr, wc, fr, fq, lds, wid, lane); S.done(cur); }
#undef PG8_SA
#undef PG8_SB
#undef PG8_STAGE
#undef PG8_LDA
#undef PG8_LDB
#undef PG8_MMA
#undef PG8_WAIT_V
#undef PG8_WAIT_L
#undef PG8_BAR
#undef PG8_SCHED
}
}
namespace att {
typedef unsigned short bf16_t;
typedef short bf16x8 __attribute__((ext_vector_type(8)));
typedef short s16x4 __attribute__((ext_vector_type(4)));
typedef float f32x16 __attribute__((ext_vector_type(16)));
typedef float f32x4 __attribute__((ext_vector_type(4)));
typedef unsigned u32x4 __attribute__((ext_vector_type(4)));
constexpr int NW = 8, QBLK = 32, KVBLK = 64, QB = NW * QBLK;
constexpr int DK = 192, DV = 128;
constexpr int QS = 1536, KVS = 2048, KRS = 64, OS = 1024;
constexpr int SHM_V = KVBLK * DV * 2, SHM_K = KVBLK * DK * 2;
constexpr int LDS_QR = 2 * SHM_V + 2 * SHM_K + NW * 64 * 4;
constexpr int LDS_BYTES = LDS_QR + NW * 8192;
constexpr float SCALE = 0.07216878364870322f;
constexpr float THR = 8.f;
#define KSWZ(row, colB) ((row) * 384 + ((colB) ^ (((row) & 7) << 4)))
#define SBAR() __builtin_amdgcn_sched_barrier(0)
__device__ __forceinline__ int v_st(int k, int c) { const int kk = (k & ~0xC) | ((k & 4) << 1) | ((k & 8) >> 1); return ((kk >> 3) * 4 + (c >> 5)) * 512 + ((kk & 7) * 32 + (c & 31)) * 2; }
__device__ __forceinline__ int v_rd_base(int lane) { return ((lane & 3) << 3) | (((lane >> 2) & 3) << 6) | (((lane >> 4) & 1) << 5) | (((lane >> 5) & 1) << 8); }
constexpr int v_rd_off(int d0, int ks, int half) { return d0 * 512 + ks * 4096 + half * 2048; }
__device__ __forceinline__ int crow(int r, int hi) { return (r & 3) + 8 * (r >> 2) + 4 * hi; }
__device__ __forceinline__ unsigned cvtpk(float lo, float hi) { unsigned r; asm volatile("v_cvt_pk_bf16_f32 %0, %1, %2" : "=v"(r) : "v"(lo), "v"(hi)); return r; }
__device__ __forceinline__ bf16x8 load8(const bf16_t* p) { return *reinterpret_cast<const bf16x8*>(p); }
__device__ __forceinline__ void mask_tile(f32x16& p0, f32x16& p1, int dq) {
    const float NEG = -__builtin_inff();
#pragma unroll
    for (int r = 0; r < 16; ++r) {
        const int c = (r & 3) + 8 * (r >> 2);
        if (dq - c < 0) p0[r] = NEG;
        if (dq - c - 32 < 0) p1[r] = NEG;
    }
}
__device__ __forceinline__ void partialSM(f32x16& p0, f32x16& p1, float& m_reg, float& mn, float& alpha) {
    float pmax = p0[0]; for (int r = 1; r < 16; ++r) pmax = fmaxf(pmax, p0[r]); for (int r = 0; r < 16; ++r) pmax = fmaxf(pmax, p1[r]);
    { auto rr = __builtin_amdgcn_permlane32_swap(__float_as_uint(pmax), __float_as_uint(pmax), false, false);
      pmax = fmaxf(__uint_as_float(rr[0]), __uint_as_float(rr[1])); }
    constexpr float C2 = 1.4426950408889634f * SCALE;
    if (__builtin_expect(__all((pmax - m_reg) * SCALE <= THR), 1)) { mn = m_reg; alpha = 1.f; }
    else { mn = fmaxf(m_reg, pmax); alpha = __builtin_amdgcn_exp2f((m_reg - mn) * C2); m_reg = mn; }
    const float mnL = -mn * C2;
    for (int r = 0; r < 16; ++r) p0[r] = fmaf(p0[r], C2, mnL); for (int r = 0; r < 16; ++r) p1[r] = fmaf(p1[r], C2, mnL);
    for (int r = 0; r < 16; ++r) p0[r] = __builtin_amdgcn_exp2f(p0[r]);
}
__device__ __forceinline__ void finishSM(f32x16& p0, f32x16& p1, float alpha, float& l_reg, bf16x8& pa0, bf16x8& pa1, bf16x8& pa2, bf16x8& pa3) {
    for (int r = 0; r < 16; ++r) p1[r] = __builtin_amdgcn_exp2f(p1[r]);
    float ps = 0; for (int r = 0; r < 16; ++r) ps += p0[r]; for (int r = 0; r < 16; ++r) ps += p1[r];
    { auto rr = __builtin_amdgcn_permlane32_swap(__float_as_uint(ps), __float_as_uint(ps), false, false);
      ps = __uint_as_float(rr[0]) + __uint_as_float(rr[1]); }
    l_reg = l_reg * alpha + ps;
#define PK4(P, B_, OUT) do { unsigned a0 = cvtpk(P[B_+0], P[B_+1]), a1 = cvtpk(P[B_+2], P[B_+3]);                          \
        unsigned b0 = cvtpk(P[B_+4], P[B_+5]), b1 = cvtpk(P[B_+6], P[B_+7]);                                             \
        auto r0 = __builtin_amdgcn_permlane32_swap(a0, b0, false, false); auto r1 = __builtin_amdgcn_permlane32_swap(a1, b1, false, false); \
        u32x4 w = {r0[0], r1[0], r0[1], r1[1]}; OUT = *reinterpret_cast<bf16x8*>(&w); } while (0)
    PK4(p0, 0, pa0); PK4(p0, 8, pa1); PK4(p1, 0, pa2); PK4(p1, 8, pa3);
#undef PK4
}
template <int KB>
__device__ __forceinline__ void qkt(f32x16& p0, f32x16& p1, const char* K_lds, int r32, int hi, const bf16x8* qr, const char* qrl) {
    p0 = f32x16{}; p1 = f32x16{};
    const char* kb[4];
#pragma unroll
    for (int dd = 0; dd < 4; ++dd) kb[dd] = K_lds + KB * SHM_K + KSWZ(r32, (dd * 16 + hi * 8) * 2);
#pragma unroll
    for (int d0 = 0; d0 < 12; ++d0) { const char* a = kb[d0 & 3] + (d0 >> 2) * 128;
        bf16x8 b0 = *reinterpret_cast<const bf16x8*>(a);
        bf16x8 b1 = *reinterpret_cast<const bf16x8*>(a + 32 * 384);
        const bf16x8 qf = d0 < 4 ? qr[d0 & 3] : *reinterpret_cast<const bf16x8*>(qrl + (d0 - 4) * 1024);
        p0 = __builtin_amdgcn_mfma_f32_32x32x16_bf16(b0, qf, p0, 0, 0, 0);
        p1 = __builtin_amdgcn_mfma_f32_32x32x16_bf16(b1, qf, p1, 0, 0, 0); }
}
template <int VB>
__device__ __forceinline__ void pv_tile(f32x16* o, int vb0, bf16x8 pa0, bf16x8 pa1, bf16x8 pa2, bf16x8 pa3) {
#define TRRD(dst, off) asm volatile("ds_read_b64_tr_b16 %0, %1 offset:%2" : "=&v"(dst) : "v"(vb0), "i"(off) : "memory")
#define PV_D0(d0) do { s16x4 l0, l1, l2, l3, h0, h1, h2, h3; constexpr int b_ = VB * SHM_V + v_rd_off(d0, 0, 0);   \
        TRRD(l0, b_); TRRD(h0, b_ + 2048); TRRD(l1, b_ + 4096); TRRD(h1, b_ + 6144); TRRD(l2, b_ + 8192); TRRD(h2, b_ + 10240); TRRD(l3, b_ + 12288); TRRD(h3, b_ + 14336); \
        asm volatile("s_waitcnt lgkmcnt(0)" ::: "memory"); SBAR();   \
        o[d0] = __builtin_amdgcn_mfma_f32_32x32x16_bf16(pa0, (bf16x8){l0[0], l0[1], l0[2], l0[3], h0[0], h0[1], h0[2], h0[3]}, o[d0], 0, 0, 0);   \
        o[d0] = __builtin_amdgcn_mfma_f32_32x32x16_bf16(pa1, (bf16x8){l1[0], l1[1], l1[2], l1[3], h1[0], h1[1], h1[2], h1[3]}, o[d0], 0, 0, 0);   \
        o[d0] = __builtin_amdgcn_mfma_f32_32x32x16_bf16(pa2, (bf16x8){l2[0], l2[1], l2[2], l2[3], h2[0], h2[1], h2[2], h2[3]}, o[d0], 0, 0, 0);   \
        o[d0] = __builtin_amdgcn_mfma_f32_32x32x16_bf16(pa3, (bf16x8){l3[0], l3[1], l3[2], l3[3], h3[0], h3[1], h3[2], h3[3]}, o[d0], 0, 0, 0); } while (0)
    PV_D0(0); PV_D0(1); PV_D0(2); PV_D0(3);
#undef PV_D0
#undef TRRD
}
struct BlockRef { const bf16_t* Qn; const bf16_t* Qr; const bf16_t* Kn; const bf16_t* Kr; const bf16_t* V; bf16_t* O; int P0; };
struct Seam { bf16x8 qr[4]; bf16x8 st_v0, st_v1, st_k0, st_k1, st_k2; };
#define VMW() asm volatile("s_waitcnt vmcnt(0)" ::: "memory")
#define VMWN(n) asm volatile("s_waitcnt vmcnt(%0)" :: "i"(n) : "memory")
#define SLOAD_H(R_, k0) do { const char* vb_ = (const char*)((R_).V + (size_t)(k0) * KVS); const char* kb_ = (const char*)((R_).Kn + (size_t)(k0) * KVS); const char* rb_ = (const char*)((R_).Kr + (size_t)(k0) * KRS); \
                         S.st_v0 = *(const bf16x8*)(vb_ + voff); S.st_v1 = *(const bf16x8*)(vb_ + 32 * KVS * 2 + voff);      \
                         S.st_k0 = *(const bf16x8*)(kb_ + voff); S.st_k1 = *(const bf16x8*)(kb_ + 32 * KVS * 2 + voff);      \
                         S.st_k2 = *(const bf16x8*)(rb_ + roff); } while (0)
#define SLOAD_V(R_, k0) do { const char* vb_ = (const char*)((R_).V + (size_t)(k0) * KVS); S.st_v0 = *(const bf16x8*)(vb_ + voff); S.st_v1 = *(const bf16x8*)(vb_ + 32 * KVS * 2 + voff); } while (0)
#define SLOAD_K(R_, k0) do { const char* kb_ = (const char*)((R_).Kn + (size_t)(k0) * KVS); const char* rb_ = (const char*)((R_).Kr + (size_t)(k0) * KRS); \
                         S.st_k0 = *(const bf16x8*)(kb_ + voff); S.st_k1 = *(const bf16x8*)(kb_ + 32 * KVS * 2 + voff); S.st_k2 = *(const bf16x8*)(rb_ + roff); } while (0)
#define SWRITE_HK(bf) do { *(bf16x8*)(K_lds + (bf) * SHM_K + kws) = S.st_k0; *(bf16x8*)(K_lds + (bf) * SHM_K + kws + 32 * 384) = S.st_k1; *(bf16x8*)(K_lds + (bf) * SHM_K + kws2) = S.st_k2; } while (0)
#define SWRITE_HV(bf) do { *(bf16x8*)(V_lds + (bf) * SHM_V + vst0) = S.st_v0; *(bf16x8*)(V_lds + (bf) * SHM_V + vst1) = S.st_v1; } while (0)
#define SWRITE_H(bf) do { SWRITE_HV(bf); SWRITE_HK(bf); } while (0)
#define QLOAD(R_) do { const char* qn_ = (const char*)((R_).Qn + (size_t)(wid * QBLK) * QS); const char* qr_ = (const char*)((R_).Qr + (size_t)(wid * QBLK) * QS); \
                       _Pragma("unroll") for (int d0 = 0; d0 < 4; ++d0) S.qr[d0] = *(const bf16x8*)(qn_ + qoff + d0 * 32);          \
                       _Pragma("unroll") for (int d0 = 4; d0 < 8; ++d0) *(bf16x8*)(qrl + (d0 - 4) * 1024) = *(const bf16x8*)(qn_ + qoff + d0 * 32);          \
                       _Pragma("unroll") for (int d0 = 0; d0 < 4; ++d0) *(bf16x8*)(qrl + (d0 + 4) * 1024) = *(const bf16x8*)(qr_ + qoff + d0 * 32); } while (0)
__device__ __forceinline__ void attn_prime(const BlockRef& cur, char* lds, Seam& S, const int tid0) {
    const int tid = tid0, wid = __builtin_amdgcn_readfirstlane(tid >> 6), lane = tid & 63, r32 = lane & 31, hi = lane >> 5;
    const int sr = tid >> 4, sc = (tid & 15) * 8, kws = KSWZ(sr, sc * 2), rr = tid >> 3, rc = (tid & 7) * 8, kws2 = KSWZ(rr, (128 + rc) * 2); char* K_lds = lds + 2 * SHM_V;
    char* qrl = lds + LDS_QR + wid * 8192 + lane * 16;
    const unsigned voff = (unsigned)((sr * KVS + sc) * 2), roff = (unsigned)((rr * KRS + rc) * 2), qoff = (unsigned)((r32 * QS + hi * 8) * 2);
    QLOAD(cur);
    SLOAD_H(cur, 0); VMW(); SWRITE_HK(0);
    __syncthreads();
}
__device__ __forceinline__ void attn_block(const BlockRef& cur, const BlockRef& nxt, char* lds, Seam& S, const int tid0) {
    const int tid = tid0, wid = __builtin_amdgcn_readfirstlane(tid >> 6), lane = tid & 63, r32 = lane & 31, hi = lane >> 5;
    const int NT = cur.P0 / KVBLK + 4;
    const int qlo = cur.P0 + wid * QBLK, qm = qlo + r32 - 4 * hi;
    char* V_lds = lds; char* K_lds = lds + 2 * SHM_V;
    float* ws = (float*)(lds + 2 * SHM_V + 2 * SHM_K) + wid * 64; float* li_l = ws, * al_l = ws + 32;
    float m_reg = -1e30f, l_reg = 0; f32x16 o[4] = {};
    const int sr = tid >> 4, sc = (tid & 15) * 8, vst0 = v_st(sr, sc), vst1 = v_st(32 + sr, sc), kws = KSWZ(sr, sc * 2);
    const int rr = tid >> 3, rc = (tid & 7) * 8, kws2 = KSWZ(rr, (128 + rc) * 2);
    const int vb0 = (int)(uintptr_t)V_lds + v_rd_base(lane);
    char* qrl = lds + LDS_QR + wid * 8192 + lane * 16;
    const unsigned voff = (unsigned)((sr * KVS + sc) * 2), roff = (unsigned)((rr * KRS + rc) * 2), qoff = (unsigned)((r32 * QS + hi * 8) * 2);
#define RESC(a) do { if (__any((a) < 1.f)) { if (hi == 0) al_l[r32] = (a); asm volatile("s_waitcnt lgkmcnt(0)" ::: "memory");              \
                     for (int d_ = 0; d_ < 4; ++d_) for (int r = 0; r < 16; ++r) o[d_][r] *= al_l[crow(r, hi)]; } } while (0)
#define MASKT(P0_, P1_, t) do { const int kb_ = (t) * KVBLK; if (kb_ + KVBLK - 1 > qlo) mask_tile(P0_, P1_, qm - kb_); } while (0)
    f32x16 pA0, pA1, pB0, pB1; float mnA, mnB, alA, alB; bf16x8 pa0, pa1, pa2, pa3;
    SWRITE_HV(0); SBAR();
    if (NT > 1) SLOAD_H(cur, KVBLK);
    SBAR(); qkt<0>(pA0, pA1, K_lds, r32, hi, S.qr, qrl);
    MASKT(pA0, pA1, 0); partialSM(pA0, pA1, m_reg, mnA, alA);
    if (NT > 1) { VMW(); SWRITE_HK(1); }
    __syncthreads();
#define HALF_STEP(PX0, PX1, mnX, alX, PY0, PY1, alY, t, KB, VB, SB) do {                                                      \
        SWRITE_HV(KB);                                                             \
        if ((t) + 1 < NT) { SLOAD_V(cur, ((t) + 1) * KVBLK); SLOAD_K(cur, ((t) + 1) * KVBLK); }         \
        SBAR(); qkt<KB>(PX0, PX1, K_lds, r32, hi, S.qr, qrl);                                                                       \
        finishSM(PY0, PY1, alY, l_reg, pa0, pa1, pa2, pa3); SBAR();                                                           \
        pv_tile<VB>(o, vb0, pa0, pa1, pa2, pa3); MASKT(PX0, PX1, (t)); partialSM(PX0, PX1, m_reg, mnX, alX);                  \
        if ((t) + 1 < NT) { VMW(); SWRITE_HK(SB); }                                                                           \
        RESC(alX); __syncthreads(); } while (0)
    for (int t = 1; t + 1 < NT; t += 2) {
        HALF_STEP(pB0, pB1, mnB, alB, pA0, pA1, alA, t, 1, 0, 0);
        HALF_STEP(pA0, pA1, mnA, alA, pB0, pB1, alB, t + 1, 0, 1, 1);
    }
    const bool even = (NT & 1) == 0;
    if (even) { SWRITE_HV(1); SBAR(); qkt<1>(pB0, pB1, K_lds, r32, hi, S.qr, qrl); SBAR(); }
    SLOAD_H(nxt, 0); SBAR();
    QLOAD(nxt);
    SBAR();
    finishSM(pA0, pA1, alA, l_reg, pa0, pa1, pa2, pa3); SBAR();
    pv_tile<0>(o, vb0, pa0, pa1, pa2, pa3);
    if (even) { MASKT(pB0, pB1, NT - 1); partialSM(pB0, pB1, m_reg, mnB, alB); __syncthreads(); RESC(alB);
        finishSM(pB0, pB1, alB, l_reg, pa0, pa1, pa2, pa3); SBAR(); pv_tile<1>(o, vb0, pa0, pa1, pa2, pa3); }
    SBAR(); VMWN(4); SWRITE_HK(0); SBAR();
    if (hi == 0) li_l[r32] = l_reg; asm volatile("s_waitcnt lgkmcnt(0)" ::: "memory");
    float rli[16];
#pragma unroll
    for (int r = 0; r < 16; ++r) rli[r] = __builtin_amdgcn_rcpf(li_l[crow(r, hi)]);
    char* Ow = (char*)(cur.O + (size_t)(wid * QBLK) * OS);
    const unsigned loff = (unsigned)((4 * hi * OS + r32) * 2);
#pragma unroll
    for (int r = 0; r < 16; ++r) { const int cro = ((r & 3) + 8 * (r >> 2)) * OS;
#pragma unroll
        for (int d0 = 0; d0 < 4; ++d0) { const float v = o[d0][r] * rli[r];
            const float vn = __shfl_xor(v, 1);
            if ((r32 & 1) == 0) *(unsigned*)(Ow + (size_t)(cro + d0 * 32) * 2 + loff) = cvtpk(v, vn); } }
    __syncthreads();
#undef RESC
#undef MASKT
#undef HALF_STEP
}
#undef VMW
#undef VMWN
#undef SLOAD_H
#undef SLOAD_V
#undef SLOAD_K
#undef SWRITE_HK
#undef SWRITE_HV
#undef SWRITE_H
#undef QLOAD
#undef SBAR
#undef KSWZ
}
typedef unsigned short bf16_t;
typedef float f32x4 __attribute__((ext_vector_type(4)));
typedef unsigned u32x4 __attribute__((ext_vector_type(4)));
typedef unsigned u32x2 __attribute__((ext_vector_type(2)));
typedef _Float16 h16x4 __attribute__((ext_vector_type(4)));
#define LAS __attribute__((address_space(3)))
#ifndef N_LAUNCHES
#define N_LAUNCHES 1
#endif
constexpr int NPHASE = 10;
constexpr int T = 32768, SEQ = 8192, DM = 1024;
constexpr size_t MiB = 1u << 20;
constexpr size_t WS_RSTDX = 0, WS_RSTDQ = 128 * 1024, WS_RSTDKV = 256 * 1024, WS_CSP = 384 * 1024;
constexpr size_t WS_SS1 = 1 * MiB, WS_SS2 = 3 * MiB;
constexpr size_t WS_CS = 5 * MiB;
constexpr size_t WS_W1 = 7 * MiB;
constexpr size_t WS_WUP = 17 * MiB;
constexpr size_t WS_WDN = 25 * MiB;
constexpr size_t WS_WOUT = 33 * MiB;
constexpr size_t WS_WUQ = 35 * MiB;
constexpr size_t WS_WUKV = 36 * MiB;
constexpr size_t WS_WLRU = 37 * MiB;
constexpr size_t WS_KR = 38 * MiB;
constexpr size_t WS_G1 = 42 * MiB, WS_G2 = 106 * MiB;
constexpr size_t WS_ZC = 170 * MiB;
constexpr size_t WS_SUM = WS_ZC, WS_SUB = WS_ZC + 2 * MiB;
constexpr size_t WS_KV = 218 * MiB;
constexpr size_t WS_R1 = 346 * MiB;
constexpr size_t WS_XB = WS_R1;
constexpr size_t WS_XA = WS_R1;
constexpr size_t WS_YB = WS_R1;
constexpr size_t WS_ZX = WS_R1 + 64 * MiB;
constexpr size_t WS_Q = WS_R1 + 64 * MiB;
constexpr size_t WS_MG = WS_KV;
constexpr size_t WS_H1B = WS_R1 + 64 * MiB;
constexpr size_t WS_U = 42 * MiB;
constexpr size_t WS_H2B = 298 * MiB;
constexpr size_t WS_END = 512 * MiB;
static_assert(WS_Q + (size_t)T * 1536 * 2 <= WS_END && WS_U + (size_t)T * 4096 * 2 <= WS_H1B && WS_W1 + 4864 * 1024 * 2 <= WS_WUP, "d_ws map");

struct Args { const float* in[19]; float* out; unsigned char* ws; int ph_lo, ph_hi; };
static_assert(sizeof(Args) == 19 * 8 + 8 + 8 + 8, "Args has no padding");

__device__ __forceinline__ float wave_sum(float v) {
#pragma unroll
    for (int o = 1; o < 64; o <<= 1) v += __shfl_xor(v, o);
    return v;
}
__device__ __forceinline__ unsigned pkbf(float lo, float hi) { return pg8::cvt_pk_bf16(lo, hi); }
__device__ __forceinline__ float bflo(unsigned w) { return __uint_as_float(w << 16); }
__device__ __forceinline__ float bfhi(unsigned w) { return __uint_as_float(w & 0xffff0000u); }

__device__ __forceinline__ int srccol(int which, int p) {
    if (which == 0) {
        const int t = p >> 8, w = p & 255;
        if (t < 4) return p;
        if (t < 12) return w < 128 ? 1024 + 128 * (t - 4) + w : 2624 + 128 * (t - 4) + (w - 128);
        if (t < 16) return 3648 + (p - 3072);
        if (t == 16) return 2048 + w;
        if (t == 17) return 2304 + w;
        return w < 64 ? 2560 + 4 * (w >> 3) + (w & 3) + 32 * ((w >> 2) & 1) : -1;
    }
    if (which == 1) {
        if (p < 1024) return (p >> 7) * 192 + (p & 127);
        const int q = p - 1024, h = q >> 6, u = q & 63;
        return h * 192 + 128 + 4 * (u >> 3) + (u & 3) + 32 * ((u >> 2) & 1);
    }
    return p;
}
__device__ __forceinline__ void tr_item(const float* W, int ldw, int K, int Nphys, const float* gain, bf16_t* WT, int which, LAS float* scr, int item, int lane, int ksrc0 = 0, int Ksrc = 1 << 30) {
    const int nblk = Nphys / 32, kb = item / nblk, nb = item % nblk, k0 = 64 * kb, n0 = 32 * nb;
    const int src = srccol(which, n0 + (lane & 31));
#pragma unroll 16
    for (int i = 0; i < 32; ++i) { const int kk = 2 * i + (lane >> 5); float v = 0.f;
        const int ks = k0 + kk - ksrc0;
        if (src >= 0 && ks >= 0 && ks < Ksrc) { v = __builtin_nontemporal_load(W + (size_t)ks * ldw + src); if (gain) v *= gain[k0 + kk]; }
        scr[kk * 33 + (lane & 31)] = v; }
    asm volatile("s_waitcnt lgkmcnt(0)" ::: "memory");
    const int c = lane & 7;
#pragma unroll
    for (int j = 0; j < 4; ++j) { const int n = (lane >> 3) + 8 * j; const LAS float* s = scr + (8 * c) * 33 + n;
        u32x4 o; o.x = pkbf(s[0 * 33], s[1 * 33]); o.y = pkbf(s[2 * 33], s[3 * 33]); o.z = pkbf(s[4 * 33], s[5 * 33]); o.w = pkbf(s[6 * 33], s[7 * 33]);
        *(u32x4*)(WT + (size_t)(n0 + n) * K + k0 + 8 * c) = o; }
    asm volatile("s_waitcnt lgkmcnt(0)" ::: "memory");
}
__device__ __forceinline__ void tr_item64(const float* W, int ldw, int K, int Nphys, const float* gain, bf16_t* WT, int which, int item, int lane, int ksrc0 = 0, int Ksrc = 1 << 30) {
    const int nblk = Nphys / 64, kb = item / nblk, nb = item % nblk, k0 = 64 * kb, n0 = 64 * nb;
    const int src = srccol(which, n0 + lane); const bool kin = (k0 - ksrc0 >= 0) && (k0 - ksrc0 < Ksrc);
    float v[64];
#pragma unroll
    for (int kk = 0; kk < 64; ++kk) v[kk] = (src >= 0 && kin) ? __builtin_nontemporal_load(W + (size_t)(k0 + kk - ksrc0) * ldw + src) : 0.f;
    if (gain) {
#pragma unroll
        for (int kk = 0; kk < 64; ++kk) v[kk] *= gain[k0 + kk];
    }
    bf16_t* o = WT + (size_t)(n0 + lane) * K + k0;
#pragma unroll
    for (int j = 0; j < 8; ++j) { u32x4 w; w.x = pkbf(v[8 * j], v[8 * j + 1]); w.y = pkbf(v[8 * j + 2], v[8 * j + 3]); w.z = pkbf(v[8 * j + 4], v[8 * j + 5]); w.w = pkbf(v[8 * j + 6], v[8 * j + 7]); *(u32x4*)(o + 8 * j) = w; }
}
__device__ __forceinline__ void sincos_d(double a, float& s, float& c) {
    const double n = rint(a * 0.63661977236758134308);
    const double r = (a - n * 1.57079632679489655800) - n * 6.123233995736766036e-17, r2 = r * r;
    double sp = -7.6471637318198164759e-13; sp = sp * r2 + 1.6059043836821614599e-10; sp = sp * r2 - 2.5052108385441718775e-08; sp = sp * r2 + 2.7557319223985890653e-06;
    sp = sp * r2 - 1.9841269841269841270e-04; sp = sp * r2 + 8.3333333333333333333e-03; sp = sp * r2 - 1.6666666666666666667e-01; sp = r + r * r2 * sp;
    double cp = 4.7794773323873852974e-14; cp = cp * r2 - 1.1470745597729724714e-11; cp = cp * r2 + 2.0876756987868098979e-09; cp = cp * r2 - 2.7557319223985890653e-07;
    cp = cp * r2 + 2.4801587301587301587e-05; cp = cp * r2 - 1.3888888888888888889e-03; cp = cp * r2 + 4.1666666666666666667e-02; cp = cp * r2 - 0.5; cp = 1.0 + r2 * cp;
    const int q = (int)((long long)n & 3);
    const double ss = (q & 1) ? cp : sp, cc = (q & 1) ? sp : cp;
    s = (float)((q & 2) ? -ss : ss); c = (float)(((q + 1) & 2) ? -cc : cc);
}

#ifdef DIAG
#define DCHK(code, got, want, rtol, atol) do { const float g_ = (got), w_ = (want); if (!(fabsf(g_ - w_) <= (rtol) * fabsf(w_) + (atol))) { atomicMin(DG, (unsigned)(code)); atomicOr(DG + 1, (code) < 50 ? 0u : (code) < 54 ? 1u : (code) < 60 ? 2u : (code) < 70 ? 4u : (code) < 80 ? 8u : 16u); } } while (0)
__device__ __forceinline__ unsigned dhash(unsigned x) { x ^= x >> 16; x *= 0x7feb352du; x ^= x >> 15; x *= 0x846ca68bu; x ^= x >> 16; return x; }
__device__ __forceinline__ float dbf(const bf16_t* p, size_t i) { return __uint_as_float((unsigned)p[i] << 16); }
__device__ __forceinline__ float dsig(float v) { return 1.0f / (1.0f + expf(-v)); }
__device__ __forceinline__ float ddot(const bf16_t* a, const bf16_t* b, int K) { float s = 0.f; for (int k = 0; k < K; ++k) s += dbf(a, k) * dbf(b, k); return s; }
#endif
#define XB_TMO      128
#define XB_XCNT(j)  (256  + 64 * (j))
#define XB_XSUB(j)  (1280 + 64 * (j))
#define XB_XGEN(j)  (2304 + 64 * (j))
#define XB_TOP      3328
#define XB_TOPGEN   3392
#define XCD_BAR_WORDS 3456
#define XB_SPIN_CAP (1u << 18)

__device__ __forceinline__ unsigned xb_ld(unsigned* p)              { return __hip_atomic_load(p, __ATOMIC_RELAXED, __HIP_MEMORY_SCOPE_AGENT); }
__device__ __forceinline__ unsigned xb_add(unsigned* p, unsigned v) { return __hip_atomic_fetch_add(p, v, __ATOMIC_RELAXED, __HIP_MEMORY_SCOPE_AGENT); }
__device__ __forceinline__ unsigned xb_xcc_id() { return (unsigned)__builtin_amdgcn_s_getreg((3 << 11) | 20) & 0xFu; }
#define XB_SPIN(cond, bar) do { unsigned _sp = 0; while (cond) { __builtin_amdgcn_s_sleep(1); \
    if ((++_sp & 255u) == 0u) { if (xb_ld(&(bar)[XB_TMO])) break; if (_sp > XB_SPIN_CAP) { atomicAdd(&(bar)[XB_TMO], 1u); break; } } } } while (0)

struct XcdBarrier {
    unsigned* bar; unsigned x;
    volatile LAS unsigned* st;
};

__device__ __forceinline__ XcdBarrier xcd_barrier_post(unsigned* bar, volatile LAS unsigned* st, const bool leader) {
    XcdBarrier b; b.bar = bar; b.x = xb_xcc_id(); b.st = st;
    if (leader) (void)xb_add(&bar[XB_XCNT(b.x)], 1u);
    return b;
}
__device__ __forceinline__ void xcd_barrier_complete(unsigned* bar, unsigned x, unsigned& nloc, unsigned& nx) {
    const unsigned G = gridDim.x * gridDim.y * gridDim.z;
    unsigned sum, cnt, mine, sp = 0u;
    for (;;) {
        sum = 0u; cnt = 0u; mine = 0u;
#pragma unroll
        for (unsigned j = 0; j < 16; ++j) { const unsigned c = xb_ld(&bar[XB_XCNT(j)]); sum += c; cnt += (c > 0u) ? 1u : 0u; mine = (j == x) ? c : mine; }
        if (sum == G) break;
        __builtin_amdgcn_s_sleep(1);
        if ((++sp & 255u) == 0u) { if (xb_ld(&bar[XB_TMO])) break; if (sp > XB_SPIN_CAP) { atomicAdd(&bar[XB_TMO], 1u); break; } }
    }
    nloc = mine > 0u ? mine : 1u; nx = cnt > 0u ? cnt : 1u;
}

__device__ __forceinline__ void xcd_barrier(const XcdBarrier& b, const bool leader) {
    asm volatile("s_waitcnt vmcnt(0)" ::: "memory");
    __syncthreads();
    if (leader) {
        unsigned* bar = b.bar;
        __builtin_amdgcn_s_waitcnt(0);
        unsigned nloc = b.st[0], nx = b.st[1];
        if (nloc == 0u) { xcd_barrier_complete(bar, b.x, nloc, nx); b.st[0] = nloc; b.st[1] = nx; }
        const unsigned old = xb_add(&bar[XB_XSUB(b.x)], 1u);
        const unsigned gen = old / nloc;
        if (old + 1u == (gen + 1u) * nloc) {
            __builtin_amdgcn_fence(__ATOMIC_RELEASE, "agent");
            asm volatile("s_waitcnt vmcnt(0)" ::: "memory");
            const unsigned og = xb_add(&bar[XB_TOP], 1u);
            const unsigned tg = og / nx;
            if (og + 1u == (tg + 1u) * nx) xb_add(&bar[XB_TOPGEN], 1u);
            else XB_SPIN(xb_ld(&bar[XB_TOPGEN]) == tg, bar);
            __builtin_amdgcn_fence(__ATOMIC_ACQUIRE, "agent");
            xb_add(&bar[XB_XGEN(b.x)], 1u);
            asm volatile("s_waitcnt vmcnt(0)" ::: "memory");
        } else {
            XB_SPIN(xb_ld(&bar[XB_XGEN(b.x)]) == gen, bar);
            __builtin_amdgcn_fence(__ATOMIC_ACQUIRE, "agent");
            asm volatile("s_waitcnt vmcnt(0)" ::: "memory");
        }
    }
    __syncthreads();
}

constexpr size_t WS_BAR = WS_CSP + 65536;
constexpr int LDS_BARW = 153600 - 64;
__global__ void __launch_bounds__(512, 2) fwd_kernel(Args args) {
    extern __shared__ __attribute__((aligned(16))) unsigned char lds[];
    cg::grid_group grid = cg::this_grid();
    const int wave_top = __builtin_amdgcn_readfirstlane((int)threadIdx.x >> 6);
    const int tid = threadIdx.x, lane = tid & 63, wave = wave_top;
    const int G = gridDim.x, gw = blockIdx.x * 8 + wave, NGW = G * 8; (void)tid; (void)lane; (void)gw;
    unsigned char* ws = args.ws;
    const int lo = args.ph_lo, hi = args.ph_hi;
#ifndef PHMASK
#define PHMASK 0x3ff
#endif
#define IN(k) (((PHMASK >> (k)) & 1) && lo <= (k) && (k) < hi)
#ifndef REPMASK
#define REPMASK 0
#endif
#define FRESH_IDS int lane_o_ = __builtin_amdgcn_mbcnt_hi(~0u, __builtin_amdgcn_mbcnt_lo(~0u, 0u)); asm volatile("" : "+v"(lane_o_)); const int lane = lane_o_, wave = wave_top, tid = wave * 64 + lane, gw = blockIdx.x * 8 + wave; (void)tid; (void)gw;
#define PLAIN_IDS int tid_o_ = threadIdx.x; asm volatile("" : "+v"(tid_o_)); const int tid = tid_o_, lane = tid & 63, wave = wave_top, gw = blockIdx.x * 8 + wave; (void)lane; (void)gw;
#define REP(k) for (int rep_ = 0; rep_ <= ((REPMASK >> (k)) & 1); ++rep_)
#ifdef TSTAMP
    unsigned long long* TS = (unsigned long long*)(ws + WS_CSP + 32768);
#define SEAM(k) do { if (IN(k) && IN((k) + 1)) grid.sync(); if (blockIdx.x == 0 && tid == 0) TS[(k) + 1] = __builtin_amdgcn_s_memrealtime(); } while (0)
    if (blockIdx.x == 0 && tid == 0) TS[0] = __builtin_amdgcn_s_memrealtime();
#else
#define SEAM(k) do { if (IN(k) && IN((k) + 1)) { if (lo < 0) grid.sync();   xcd_barrier(xbar, wave_top == 0 && __builtin_amdgcn_mbcnt_hi(~0u, __builtin_amdgcn_mbcnt_lo(~0u, 0u)) == 0u); } } while (0)
#endif
    const float* x = args.in[0];
    float* rstdx = (float*)(ws + WS_RSTDX); float* rstdq = (float*)(ws + WS_RSTDQ); float* rstdkv = (float*)(ws + WS_RSTDKV); float* csp = (float*)(ws + WS_CSP);
    float* SS1 = (float*)(ws + WS_SS1); float* SS2 = (float*)(ws + WS_SS2); float* CS = (float*)(ws + WS_CS);
    bf16_t* W1 = (bf16_t*)(ws + WS_W1); bf16_t* WUP = (bf16_t*)(ws + WS_WUP); bf16_t* WDN = (bf16_t*)(ws + WS_WDN); bf16_t* WOUT = (bf16_t*)(ws + WS_WOUT);
    bf16_t* WUQ = (bf16_t*)(ws + WS_WUQ); bf16_t* WUKV = (bf16_t*)(ws + WS_WUKV); bf16_t* WLRU = (bf16_t*)(ws + WS_WLRU);
    bf16_t* KR = (bf16_t*)(ws + WS_KR); bf16_t* G1 = (bf16_t*)(ws + WS_G1); bf16_t* G2 = (bf16_t*)(ws + WS_G2); bf16_t* ZC = (bf16_t*)(ws + WS_ZC);
    bf16_t* KV = (bf16_t*)(ws + WS_KV); bf16_t* XB = (bf16_t*)(ws + WS_XB); bf16_t* XA = (bf16_t*)(ws + WS_XA); bf16_t* YB = (bf16_t*)(ws + WS_YB);
    bf16_t* ZX = (bf16_t*)(ws + WS_ZX); bf16_t* Q = (bf16_t*)(ws + WS_Q); bf16_t* MG = (bf16_t*)(ws + WS_MG); bf16_t* H1B = (bf16_t*)(ws + WS_H1B); bf16_t* U = (bf16_t*)(ws + WS_U);
    float* SSQ = (float*)(ws + WS_SS2); float* SSKV = (float*)(ws + WS_SS2 + 512 * 1024);
    bf16_t* H2B = (bf16_t*)(ws + WS_H2B); float* SUM = (float*)(ws + WS_SUM); float* SUB = (float*)(ws + WS_SUB);
    unsigned* AB = (unsigned*)args.out; float* OUT = args.out;
    LAS unsigned char* ldsg = (LAS unsigned char*)lds;

    if (threadIdx.x < 2) ((volatile LAS unsigned*)(ldsg + LDS_BARW))[threadIdx.x] = 0u;
    __syncthreads();
    XcdBarrier xbar; xbar.bar = (unsigned*)(ws + WS_BAR); xbar.x = 0; xbar.st = nullptr;
    if (hi - lo > 1) xbar = xcd_barrier_post((unsigned*)(ws + WS_BAR), (volatile LAS unsigned*)(ldsg + LDS_BARW), threadIdx.x == 0);
#ifdef DIAG
    unsigned* DG = (unsigned*)(ws + WS_CSP + 8192); unsigned* SAVE = (unsigned*)(ws + WS_CSP + 16384);
    if (lo >= 100) {
        const int dk = lo - 100; const unsigned gid = blockIdx.x * 512 + tid, NT_ = G * 512;
        if (dk == 0) {
            for (unsigned s = gid; s < 65536; s += NT_) { const unsigned h = dhash(s * 7 + 1);
                { const int p = h % 4864, k = (h >> 13) % 1024, src = srccol(0, p); const float want = src < 0 ? 0.f : args.in[2][(size_t)k * 4672 + src] * args.in[1][k]; DCHK(1, dbf(W1, (size_t)p * 1024 + k), want, 0.01f, 1e-6f); }
                { const int p = h % 1536, k = (h >> 13) % 256; DCHK(2, dbf(WUQ, (size_t)p * 256 + k), args.in[11][(size_t)k * 1536 + srccol(1, p)] * args.in[10][k], 0.01f, 1e-6f); }
                { const int p = h % 2048, k = (h >> 13) % 256; DCHK(3, dbf(WUKV, (size_t)p * 256 + k), args.in[13][(size_t)k * 2048 + p] * args.in[12][k], 0.01f, 1e-6f); }
                { const int p = h % 2048, k = (h >> 13) % 256, nb = p >> 8, isx = (p >> 7) & 1, d = p & 127, kk = k - 128 * (nb & 1);
                  const float want = (kk >= 0 && kk < 128) ? (isx ? args.in[7] : args.in[5])[(size_t)nb * 16384 + kk * 128 + d] : 0.f; DCHK(4, dbf(WLRU, (size_t)p * 256 + k), want, 0.01f, 1e-6f); }
                { const int p = h % 1024, k = (h >> 13) % 1024; DCHK(5, dbf(WOUT, (size_t)p * 1024 + k), args.in[14][(size_t)k * 1024 + p], 0.01f, 1e-6f); }
                { const int p = h % 4096, k = (h >> 13) % 1024; DCHK(6, dbf(WUP, (size_t)p * 1024 + k), args.in[16][(size_t)k * 4096 + p] * args.in[15][k], 0.01f, 1e-6f); }
                { const int p = h % 1024, k = (h >> 13) % 4096; DCHK(7, dbf(WDN, (size_t)p * 4096 + k), args.in[17][(size_t)k * 1024 + p], 0.01f, 1e-6f); }
                { const int r = h % T, c = (h >> 15) % 1024; DCHK(8, dbf(XB, (size_t)r * 1024 + c), x[(size_t)r * 1024 + c], 0.01f, 1e-6f); }
                { const int pos = h % 8191, i = (h >> 13) & 31; const float c0 = CS[(pos * 32 + i) * 2], s0 = CS[(pos * 32 + i) * 2 + 1], c1 = CS[((pos + 1) * 32 + i) * 2], s1 = CS[((pos + 1) * 32 + i) * 2 + 1], cd = CS[(32 + i) * 2], sd = CS[(32 + i) * 2 + 1];
                  DCHK(9, c1, c0 * cd - s0 * sd, 0.f, 1e-5f); DCHK(9, s1, s0 * cd + c0 * sd, 0.f, 1e-5f); DCHK(9, cd, __cosf(powf(10000.f, -(float)i / 32.f)), 0.f, 1e-4f); DCHK(9, CS[i * 2], 1.0f, 0.f, 1e-6f); }
            }
            for (unsigned s = gid; s < 4096; s += NT_) { const int r = dhash(s) % T; float q = 0.f; for (int c = 0; c < 1024; ++c) q += x[(size_t)r * 1024 + c] * x[(size_t)r * 1024 + c]; DCHK(8, rstdx[r], 1.0f / sqrtf(q / 1024.f + 1e-6f), 1e-3f, 0.f); }
        }
        if (dk == 1) for (unsigned s = gid; s < 32768; s += NT_) { const unsigned h = dhash(s * 3 + 11); const int r = h % T, p = (h >> 15) % 4864, t = p >> 8, w = p & 255;
            const float z = ddot(XB + (size_t)r * 1024, W1 + (size_t)p * 1024, 1024) * rstdx[r];
            if (t < 4) DCHK(11, dbf(ZX, (size_t)r * 1024 + p), z, 0.02f, 0.02f);
            else if (t < 12) { if (w < 128) { const float z2 = ddot(XB + (size_t)r * 1024, W1 + (size_t)(p + 128) * 1024, 1024) * rstdx[r];
                const float ge = 0.5f * z * (1.f + tanhf(0.7978845608f * (z + 0.044715f * z * z * z))); DCHK(12, dbf(G1, (size_t)r * 1024 + (t - 4) * 128 + w), ge * dsig(z2), 0.03f, 0.02f); } }
            else if (t < 16) DCHK(13, dbf(G2, (size_t)r * 1024 + p - 3072), dsig(z), 0.02f, 0.01f);
            else DCHK(14, dbf(ZC, (size_t)r * 768 + p - 4096), z, 0.02f, 0.02f); }
        if (dk == 2) for (unsigned s = gid; s < 65536; s += NT_) { const unsigned h = dhash(s * 5 + 3); const int r = (s & 1) ? (h % T) : ((h % 4) * 8192 + (h >> 8) % 6), c = (h >> 15) % 1024, pos = r & 8191;
            float v = args.in[4][c]; for (int j = 0; j < 4; ++j) if (pos - 3 + j >= 0) v += args.in[3][j * 1024 + c] * dbf(ZX, (size_t)(r - 3 + j) * 1024 + c);
            DCHK(21, dbf(XA, (size_t)r * 1024 + c), v, 0.02f, 0.02f);
            if (c < 64) { const int u = c, i = 4 * (u >> 3) + (u & 3), hf = (u >> 2) & 1; const float kl = dbf(ZC, (size_t)r * 768 + 512 + i), kh = dbf(ZC, (size_t)r * 768 + 512 + i + 32), cc = CS[(pos * 32 + i) * 2], ss = CS[(pos * 32 + i) * 2 + 1];
                DCHK(23, dbf(KR, (size_t)r * 64 + u), hf ? kh * cc + kl * ss : kl * cc - kh * ss, 0.02f, 0.02f); }
            if (c == 100) { float q = 0.f, k2 = 0.f; for (int j = 0; j < 256; ++j) { const float a = dbf(ZC, (size_t)r * 768 + j), b = dbf(ZC, (size_t)r * 768 + 256 + j); q += a * a; k2 += b * b; }
                DCHK(22, rstdq[r], 1.0f / sqrtf(q / 256.f + 1e-6f), 1e-3f, 0.f); DCHK(22, rstdkv[r], 1.0f / sqrtf(k2 / 256.f + 1e-6f), 1e-3f, 0.f); } }
        if (dk == 3) for (unsigned s = gid; s < 65536; s += NT_) { const unsigned h = dhash(s * 9 + 5); const int r = h % T, pos = r & 8191;
            { const int c = (h >> 15) % 1024, nb = c >> 7, d = c & 127; float dr = args.in[6][c], di = args.in[8][c];
              for (int k = 0; k < 128; ++k) { const float xv = dbf(XA, (size_t)r * 1024 + nb * 128 + k); dr += xv * args.in[5][(size_t)nb * 16384 + k * 128 + d]; di += xv * args.in[7][(size_t)nb * 16384 + k * 128 + d]; }
              const float rr_ = dsig(dr), ii = dsig(di), la = -8.0f * rr_ * log1pf(expf(-args.in[9][c])), bb = sqrtf(-expm1f(2.f * la)) * ii * dbf(XA, (size_t)r * 1024 + c);
              const pg8::h16x2 pv_ = __builtin_bit_cast(pg8::h16x2, AB[(size_t)r * 1024 + c]);
              DCHK(31, (float)pv_.x, la * 1.4426950408889634f, 0.03f, 1e-5f); DCHK(32, (float)pv_.y, bb, 0.03f, 0.01f); }
            { const int p = (h >> 13) % 1536; const float z = ddot(ZC + (size_t)r * 768, WUQ + (size_t)p * 256, 256) * rstdq[r];
              if (p < 1024) DCHK(33, dbf(Q, (size_t)r * 1536 + p), z, 0.02f, 0.02f);
              else { const int u = (p - 1024) & 63, i = 4 * (u >> 3) + (u & 3), islo = (u & 4) == 0; const float z2 = ddot(ZC + (size_t)r * 768, WUQ + (size_t)(p ^ 4) * 256, 256) * rstdq[r];
                  const float cc = CS[(pos * 32 + i) * 2], ss = CS[(pos * 32 + i) * 2 + 1]; DCHK(34, dbf(Q, (size_t)r * 1536 + p), islo ? z * cc - z2 * ss : z * cc + z2 * ss, 0.02f, 0.03f); } }
            { const int p = (h >> 11) % 2048; DCHK(35, dbf(KV, (size_t)r * 2048 + p), ddot(ZC + (size_t)r * 768 + 256, WUKV + (size_t)p * 256, 256) * rstdkv[r], 0.02f, 0.02f); } }
        if (dk == 3) for (unsigned s = gid; s < 4096; s += NT_) SAVE[s] = AB[dhash(s * 41 + 3) % (unsigned)(T * 1024)];
        if (dk == 4) {
            float* SC = (float*)(ws + WS_ZC + 9 * MiB);
            for (int s = gw; s < 1024; s += NGW) { const unsigned h = dhash(s * 13 + 7); const int b = h & 3, hd = (h >> 2) & 7, pos = (s & 3) == 0 ? (int)((h >> 5) % 300) : (int)((h >> 5) % 8192); const size_t r = (size_t)b * 8192 + pos;
                float* sc = SC + (size_t)s * 8192; float mx = -1e30f;
                for (int j = lane; j <= pos; j += 64) { const size_t kr = (size_t)b * 8192 + j; float d = 0.f;
                    for (int e = 0; e < 128; ++e) d += dbf(Q, r * 1536 + hd * 128 + e) * dbf(KV, kr * 2048 + hd * 256 + e);
                    for (int e = 0; e < 64; ++e) d += dbf(Q, r * 1536 + 1024 + hd * 64 + e) * dbf(KR, kr * 64 + e);
                    d *= 0.07216878364870322f; sc[j] = d; mx = fmaxf(mx, d); }
                for (int o = 1; o < 64; o <<= 1) mx = fmaxf(mx, __shfl_xor(mx, o));
                __builtin_amdgcn_fence(__ATOMIC_RELEASE, "workgroup"); __builtin_amdgcn_s_waitcnt(0);
                float l = 0.f, o0 = 0.f, o1 = 0.f;
                for (int j = 0; j <= pos; ++j) { const float p = expf(__builtin_nontemporal_load(sc + j) - mx); const size_t kr = (size_t)b * 8192 + j; l += p; o0 += p * dbf(KV, kr * 2048 + hd * 256 + 128 + lane); o1 += p * dbf(KV, kr * 2048 + hd * 256 + 192 + lane); }
                DCHK(41, dbf(YB, r * 1024 + hd * 128 + lane), o0 / l, 0.03f, 0.01f); DCHK(41, dbf(YB, r * 1024 + hd * 128 + 64 + lane), o1 / l, 0.03f, 0.01f); } }
        if (dk == 5) for (unsigned s = gid; s < 4096; s += NT_) if (SAVE[s] != AB[dhash(s * 41 + 3) % (unsigned)(T * 1024)]) atomicMin(DG, 48u);
        if (dk == 5) for (unsigned s = gid; s < 8192; s += NT_) { const unsigned h = dhash(s * 17 + 9); const int b = h & 3, c = (h >> 2) % 1024, pos = (s & 3) == 0 ? (int)((h >> 12) % 32) : (s & 3) == 1 ? (int)((h >> 12) % 256) : (int)((h >> 12) % 8192); float hh = 0.f, LL = 0.f;
            for (int j = 0; j <= pos; ++j) { const pg8::h16x2 pv_ = __builtin_bit_cast(pg8::h16x2, AB[((size_t)b * 8192 + j) * 1024 + c]); hh = exp2f((float)pv_.x) * hh + (float)pv_.y; LL += (float)pv_.x;
                if ((j & 31) == 31 && (j >> 5) == (pos >> 5) - 0 && false) {} }
            const size_t o = ((size_t)b * 8192 + pos) * 1024 + c; const int code = pos < 32 ? 51 : pos < 256 ? 52 : 53;
            DCHK(code, dbf(MG, o), dbf(G1, o) * hh + dbf(G2, o) * dbf(YB, o), 0.03f, 0.01f);
            { const int sc_ = (h >> 12) % 256; float h2 = 0.f, L2 = 0.f; for (int j = sc_ * 32; j < sc_ * 32 + 32; ++j) { const pg8::h16x2 pv_ = __builtin_bit_cast(pg8::h16x2, AB[((size_t)b * 8192 + j) * 1024 + c]); h2 = exp2f((float)pv_.x) * h2 + (float)pv_.y; L2 += (float)pv_.x; }
              DCHK(54, SUB[(((size_t)b * 256 + sc_) * 1024 + c) * 2], L2, 1e-3f, 1e-5f); DCHK(55, SUB[(((size_t)b * 256 + sc_) * 1024 + c) * 2 + 1], h2, 1e-3f, 1e-4f); }
            { const int kc = (h >> 12) % 32; float h2 = 0.f, L2 = 0.f; for (int j = kc * 256; j < kc * 256 + 256; ++j) { const pg8::h16x2 pv_ = __builtin_bit_cast(pg8::h16x2, AB[((size_t)b * 8192 + j) * 1024 + c]); h2 = exp2f((float)pv_.x) * h2 + (float)pv_.y; L2 += (float)pv_.x; }
              DCHK(56, SUM[(((size_t)b * 32 + kc) * 1024 + c) * 2], L2, 1e-3f, 1e-5f); DCHK(57, SUM[(((size_t)b * 32 + kc) * 1024 + c) * 2 + 1], h2, 1e-3f, 1e-4f); } }
        if (dk == 6) for (unsigned s = gid; s < 32768; s += NT_) { const unsigned h = dhash(s * 19 + 1); const int r = h % T, c = (h >> 15) % 1024;
            const float v = x[(size_t)r * 1024 + c] + ddot(MG + (size_t)r * 1024, WOUT + (size_t)c * 1024, 1024); DCHK(61, OUT[(size_t)r * 1024 + c], v, 0.02f, 0.02f); DCHK(62, dbf(H1B, (size_t)r * 1024 + c), v, 0.02f, 0.02f);
            if (c == 7) { float q = 0.f, q2 = 0.f; for (int j = 0; j < 1024; ++j) q += OUT[(size_t)r * 1024 + j] * OUT[(size_t)r * 1024 + j]; for (int j = 0; j < 16; ++j) q2 += SS1[(size_t)r * 16 + j]; DCHK(63, q2, q, 1e-3f, 0.f); } }
        if (dk == 7) for (unsigned s = gid; s < 32768; s += NT_) { const unsigned h = dhash(s * 23 + 1); const int r = h % T, c = (h >> 15) % 4096; float q2 = 0.f; for (int j = 0; j < 16; ++j) q2 += SS1[(size_t)r * 16 + j];
            const float u_ = ddot(H1B + (size_t)r * 1024, WUP + (size_t)c * 1024, 1024) / sqrtf(q2 / 1024.f + 1e-6f), rl = fmaxf(u_, 0.f); DCHK(71, dbf(U, (size_t)r * 4096 + c), rl * rl, 0.03f, 0.02f); }
        if (dk == 8) for (unsigned s = gid; s < 16384; s += NT_) { const unsigned h = dhash(s * 29 + 1); const int r = h % T, c = (h >> 15) % 1024;
            const float v = dbf(H1B, (size_t)r * 1024 + c) + ddot(U + (size_t)r * 4096, WDN + (size_t)c * 4096, 4096); DCHK(81, OUT[(size_t)r * 1024 + c], v, 0.02f, 0.04f);
            if (c == 7) { float q = 0.f, q2 = 0.f; for (int j = 0; j < 1024; ++j) q += OUT[(size_t)r * 1024 + j] * OUT[(size_t)r * 1024 + j]; for (int j = 0; j < 16; ++j) q2 += SS2[(size_t)r * 16 + j]; DCHK(82, q2, q, 1e-3f, 0.f); } }
        if (dk == 9) { for (unsigned s = gid; s < 4096; s += NT_) { const int r = dhash(s * 31) % T; float q = 0.f; for (int j = 0; j < 1024; ++j) { const float v = OUT[(size_t)r * 1024 + j] / args.in[18][j]; q += v * v; } DCHK(91, q / 1024.f, 1.0f, 0.01f, 0.f); } }
        if (dk == 10) { if (gid == 0) { const unsigned code = *DG; if (code < 1000u) OUT[0] = 100.0f + 10.0f * (float)code; OUT[1] = 10000.0f * (1.0f + (float)DG[1]); } }
        return;
    }
#endif
    if (IN(0)) REP(0) { PLAIN_IDS
        LAS float* scr = (LAS float*)(ldsg + wave * 16384);
        constexpr int I_W1 = 16 * (4864 / 64), I_UP = 16 * (4096 / 64), I_DN = 64 * (1024 / 64), I_OUT = 16 * 16, I_UQ = 4 * (1536 / 64), I_UKV = 4 * (2048 / 64), I_LRU = 16 * 8;
        constexpr int NITEMS = I_W1 + I_UP + I_DN + I_OUT + I_UQ + I_UKV + I_LRU;
        const int gw4 = gw, NGW4 = NGW;
        {
        for (int m0 = gw4 * 4; m0 < T; m0 += NGW4 * 4) {
            f32x4 v[4][4];
#pragma unroll
            for (int r = 0; r < 4; ++r) { const f32x4* xr = (const f32x4*)(x + (size_t)(m0 + r) * DM) + lane;
#pragma unroll
                for (int j = 0; j < 4; ++j) v[r][j] = __builtin_nontemporal_load(xr + 64 * j); }
#pragma unroll
            for (int r = 0; r < 4; ++r) { float s = 0.f;
#pragma unroll
                for (int j = 0; j < 4; ++j) s += (v[r][j][0] * v[r][j][0] + v[r][j][1] * v[r][j][1]) + (v[r][j][2] * v[r][j][2] + v[r][j][3] * v[r][j][3]);
                s = wave_sum(s);
                if (lane == 0) rstdx[m0 + r] = rsqrtf(s * (1.0f / 1024.0f) + 1e-6f);
                u32x2* o = (u32x2*)(XB + (size_t)(m0 + r) * DM) + lane;
#pragma unroll
                for (int j = 0; j < 4; ++j) { u32x2 w; w.x = pkbf(v[r][j][0], v[r][j][1]); w.y = pkbf(v[r][j][2], v[r][j][3]); o[64 * j] = w; } }
        }
        }
        {
        for (int it = gw4; it < NITEMS; it += NGW4) {
            int r = it;
            if (r < I_W1) { tr_item64(args.in[2], 4672, 1024, 4864, args.in[1], W1, 0, r, lane); continue; } r -= I_W1;
            if (r < I_UP) { tr_item64(args.in[16], 4096, 1024, 4096, args.in[15], WUP, 2, r, lane); continue; } r -= I_UP;
            if (r < I_DN) { tr_item64(args.in[17], 1024, 4096, 1024, nullptr, WDN, 2, r, lane); continue; } r -= I_DN;
            if (r < I_OUT) { tr_item64(args.in[14], 1024, 1024, 1024, nullptr, WOUT, 2, r, lane); continue; } r -= I_OUT;
            if (r < I_UQ) { tr_item64(args.in[11], 1536, 256, 1536, args.in[10], WUQ, 1, r, lane); continue; } r -= I_UQ;
            if (r < I_UKV) { tr_item64(args.in[13], 2048, 256, 2048, args.in[12], WUKV, 2, r, lane); continue; } r -= I_UKV;
            { const int blk = r >> 3, sub = r & 7, nb = blk >> 1, isx = blk & 1;
              tr_item64((isx ? args.in[7] : args.in[5]) + (size_t)nb * 16384, 128, 256, 128, nullptr, WLRU + (size_t)(256 * nb + 128 * isx) * 256, 2, sub, lane, 128 * (nb & 1), 128); }
        }
        for (int i = blockIdx.x * 512 + tid; i < SEQ * 32; i += G * 512) {
            const int pos = i >> 5, k = i & 31; double inv = 1.0; for (int q = 0; q < k; ++q) inv *= 0.74989420933245582730;
            float s, c; sincos_d((double)pos * inv, s, c); CS[2 * i] = c; CS[2 * i + 1] = s;
        }
        for (int i = blockIdx.x * 512 + tid; i < 1024; i += G * 512) csp[i] = 8.0f * 1.4426950408889634f * log1pf(__expf(-args.in[9][i]));
            }
    }
    SEAM(0);

    if (IN(1)) REP(1) { PLAIN_IDS
        pg8::Gemm g{XB, W1, T, 4864, 1024, 1024, 1024, 0, 0}; pg8::StaticOrder S; S.init(T, 4864, G, (int)blockIdx.x);
        pg8::EpiIn E{ZX, G1, G2, ZC, rstdx, SSQ, SSKV, KR, CS};
        pg8::gemm_phase<pg8::EpiIn, pg8::StaticOrder, true, true>(ldsg, g, S, E, tid);
    }
    SEAM(1);

    if (IN(2)) REP(2) { PLAIN_IDS
        const float* cw = args.in[3]; const float* cb = args.in[4];
        for (int it = gw; it < (T / 16) * 2; it += NGW) {
            const int t0 = (it >> 1) * 16, c0 = (it & 1) * 512 + lane * 8;
            float w[4][8], bias[8], h0[8], h1[8], h2[8];
#pragma unroll
            for (int j = 0; j < 4; ++j) { const f32x4 a = *(const f32x4*)(cw + j * 1024 + c0), b = *(const f32x4*)(cw + j * 1024 + c0 + 4);
#pragma unroll
                for (int e = 0; e < 4; ++e) { w[j][e] = a[e]; w[j][4 + e] = b[e]; } }
            { const f32x4 a = *(const f32x4*)(cb + c0), b = *(const f32x4*)(cb + c0 + 4);
#pragma unroll
              for (int e = 0; e < 4; ++e) { bias[e] = a[e]; bias[4 + e] = b[e]; } }
            const bool first = (t0 & (SEQ - 1)) == 0;
            { u32x4 r0 = {0u, 0u, 0u, 0u}, r1 = r0, r2 = r0;
              if (!first) { r0 = *(const u32x4*)(ZX + (size_t)(t0 - 3) * DM + c0); r1 = *(const u32x4*)(ZX + (size_t)(t0 - 2) * DM + c0); r2 = *(const u32x4*)(ZX + (size_t)(t0 - 1) * DM + c0); }
#pragma unroll
              for (int e = 0; e < 4; ++e) { h0[2 * e] = bflo(r0[e]); h0[2 * e + 1] = bfhi(r0[e]); h1[2 * e] = bflo(r1[e]); h1[2 * e + 1] = bfhi(r1[e]); h2[2 * e] = bflo(r2[e]); h2[2 * e + 1] = bfhi(r2[e]); } }
            u32x4 rows[16];
#pragma unroll
            for (int i = 0; i < 16; ++i) rows[i] = __builtin_nontemporal_load((const u32x4*)(ZX + (size_t)(t0 + i) * DM + c0));
#pragma unroll
            for (int i = 0; i < 16; ++i) { const u32x4 r = rows[i]; float cur[8], o[8];
#pragma unroll
                for (int e = 0; e < 4; ++e) { cur[2 * e] = bflo(r[e]); cur[2 * e + 1] = bfhi(r[e]); }
#pragma unroll
                for (int e = 0; e < 8; ++e) { o[e] = bias[e] + w[0][e] * h0[e] + w[1][e] * h1[e] + w[2][e] * h2[e] + w[3][e] * cur[e]; h0[e] = h1[e]; h1[e] = h2[e]; h2[e] = cur[e]; }
                u32x4 ow; ow.x = pkbf(o[0], o[1]); ow.y = pkbf(o[2], o[3]); ow.z = pkbf(o[4], o[5]); ow.w = pkbf(o[6], o[7]);
                *(u32x4*)(XA + (size_t)(t0 + i) * DM + c0) = ow; }
        }
    }
    SEAM(2);

    if (IN(3)) REP(3) { PLAIN_IDS
#ifndef P3SEL
#define P3SEL 7
#endif
        if (P3SEL & 1) { pg8::Gemm g{XA, WLRU, T, 2048, 256, 1024, 256, 512, 1}; pg8::StaticOrder S; S.init(T, 2048, G, (int)blockIdx.x);
#ifdef TESTLRU
          pg8::EpiRowScale E{KV, 2048, SSKV};
          pg8::gemm_phase<pg8::EpiRowScale, pg8::StaticOrder, true, true>(ldsg, g, S, E, tid); }
#else
          pg8::EpiLru E{XA, args.in[6], args.in[8], csp, AB};
          pg8::gemm_phase<pg8::EpiLru, pg8::StaticOrder, true, true>(ldsg, g, S, E, tid); }
#endif
        if (P3SEL & 2) { pg8::Gemm g{ZC, WUQ, T, 1536, 256, 768, 256, 0, 0}; pg8::StaticOrder S; S.init(T, 1536, G, (int)blockIdx.x);
          pg8::EpiQ E{Q, SSQ, CS};
          pg8::gemm_phase<pg8::EpiQ, pg8::StaticOrder, true, true>(ldsg, g, S, E, tid); }
        if (P3SEL & 4) { pg8::Gemm g{ZC + 256, WUKV, T, 2048, 256, 768, 256, 0, 0}; pg8::StaticOrder S; S.init(T, 2048, G, (int)blockIdx.x);
          pg8::EpiRowScale E{KV, 2048, SSKV};
          pg8::gemm_phase<pg8::EpiRowScale, pg8::StaticOrder, true, true>(ldsg, g, S, E, tid); }
    }
    SEAM(3);

    if (IN(4)) REP(4) { FRESH_IDS
        for (int un = blockIdx.x; un < 256; un += G) {
            const int b = un >> 6, ch = un & 63, c = wave * 128 + lane * 2;
            const unsigned* ap = AB + ((size_t)b * SEQ + ch * 128) * DM + c;
            float h0 = 0.f, h1 = 0.f, L0 = 0.f, L1 = 0.f;
            for (int i0 = 0; i0 < 128; i0 += 16) { h16x4 w[16];
#pragma unroll
                for (int i = 0; i < 16; ++i) w[i] = __builtin_nontemporal_load((const h16x4*)(ap + (size_t)(i0 + i) * DM));
#pragma unroll
                for (int i = 0; i < 16; ++i) { const float l0 = (float)w[i][0], l1 = (float)w[i][2];
                    h0 = __builtin_amdgcn_exp2f(l0) * h0 + (float)w[i][1]; h1 = __builtin_amdgcn_exp2f(l1) * h1 + (float)w[i][3]; L0 += l0; L1 += l1; } }
            *(f32x4*)(SUM + (((size_t)b * 64 + ch) * 1024 + c) * 2) = (f32x4){L0, h0, L1, h1};
        }
        {
            constexpr int NITEM = 32 * 16;
#define ITEM_BH(LL) (G == 256 ? (((LL) & 7) + 8 * (2 * ((LL) >> 8) + (((LL) >> 7) & 1))) : ((LL) >> 4))
#define ITEM_X(LL)  (G == 256 ? (((LL) >> 3) & 15) : ((LL) & 15))
            int L = blockIdx.x;
            if (L < NITEM) {
                att::Seam S; int pass = 0;
#define MKREF(r, LL, ps) do { const int bh_ = ITEM_BH(LL), xx_ = ITEM_X(LL), qb_ = (ps) ? 31 - xx_ : xx_, b_ = bh_ >> 3, h_ = bh_ & 7; \
                    const size_t row0_ = (size_t)b_ * SEQ + qb_ * 256, key0_ = (size_t)b_ * SEQ; \
                    r.Qn = Q + row0_ * 1536 + h_ * 128; r.Qr = Q + row0_ * 1536 + 1024 + h_ * 64; r.Kn = KV + key0_ * 2048 + h_ * 256; r.V = r.Kn + 128; r.Kr = KR + key0_ * 64; \
                    r.O = YB + row0_ * 1024 + h_ * 128; r.P0 = qb_ * 256; } while (0)
                att::BlockRef cur, nxt; MKREF(cur, L, 0);
                att::attn_prime(cur, (char*)lds, S, tid);
                for (;;) {
                    const bool more_pass = pass == 0, more_item = L + G < NITEM, last = !more_pass && !more_item;
                    int passn = pass + 1, Ln = L;
                    if (!more_pass) { passn = 0; Ln = more_item ? L + G : L; }
                    MKREF(nxt, Ln, passn);
                    att::attn_block(cur, nxt, (char*)lds, S, tid);
                    if (last) break;
                    cur = nxt; pass = passn; L = Ln;
                }
            }
#undef MKREF
#undef ITEM_BH
#undef ITEM_X
        }
    }
    SEAM(4);

    if (IN(5)) REP(5) { FRESH_IDS
        for (int gi = blockIdx.x; gi < 256; gi += G) {
            const int b = gi >> 6, ch = gi & 63, c = wave * 128 + lane * 2;
            float h0 = 0.f, h1 = 0.f;
            for (int k0 = 0; k0 < ch; k0 += 8) { f32x4 sv[8];
#pragma unroll
                for (int j = 0; j < 8; ++j) { const int kk = (k0 + j < 63) ? k0 + j : 63; sv[j] = *(const f32x4*)(SUM + (((size_t)b * 64 + kk) * 1024 + c) * 2); }
#pragma unroll
                for (int j = 0; j < 8; ++j) if (k0 + j < ch) { h0 = __builtin_amdgcn_exp2f(sv[j][0]) * h0 + sv[j][1]; h1 = __builtin_amdgcn_exp2f(sv[j][2]) * h1 + sv[j][3]; } }
            const size_t row0 = (size_t)b * SEQ + ch * 128;
            for (int i0 = 0; i0 < 128; i0 += 32) { h16x4 w[32]; unsigned g1[32], g2[32], yb[32];
#pragma unroll
                for (int i = 0; i < 32; ++i) { const size_t off = (row0 + i0 + i) * DM + c;
                    w[i] = __builtin_nontemporal_load((const h16x4*)(AB + off)); g1[i] = __builtin_nontemporal_load((const unsigned*)(G1 + off)); g2[i] = __builtin_nontemporal_load((const unsigned*)(G2 + off)); yb[i] = __builtin_nontemporal_load((const unsigned*)(YB + off)); }
#pragma unroll
                for (int i = 0; i < 32; ++i) { const size_t off = (row0 + i0 + i) * DM + c;
                    h0 = __builtin_amdgcn_exp2f((float)w[i][0]) * h0 + (float)w[i][1]; h1 = __builtin_amdgcn_exp2f((float)w[i][2]) * h1 + (float)w[i][3];
                    *(unsigned*)(MG + off) = pkbf(bflo(g1[i]) * h0 + bflo(g2[i]) * bflo(yb[i]), bfhi(g1[i]) * h1 + bfhi(g2[i]) * bfhi(yb[i])); } }
        }
    }
    SEAM(5);

    if (IN(6)) REP(6) { FRESH_IDS
        pg8::Gemm g{MG, WOUT, T, 1024, 1024, 1024, 1024, 0, 0}; pg8::StaticOrder S; S.init(T, 1024, G, (int)blockIdx.x);
        pg8::EpiRes<true> E{x, nullptr, H1B, SS1};
        pg8::gemm_phase<pg8::EpiRes<true>, pg8::StaticOrder, true, true>(ldsg, g, S, E, tid);
    }
    SEAM(6);

    if (IN(7)) REP(7) { FRESH_IDS
        pg8::Gemm g{H1B, WUP, T, 4096, 1024, 1024, 1024, 0, 0}; pg8::StaticOrder S; S.init(T, 4096, G, (int)blockIdx.x);
        pg8::EpiUp E{U, SS1};
        pg8::gemm_phase<pg8::EpiUp, pg8::StaticOrder, true, true>(ldsg, g, S, E, tid);
    }
    SEAM(7);

    if (IN(8)) REP(8) { FRESH_IDS
        pg8::Gemm g{U, WDN, T, 1024, 4096, 4096, 4096, 0, 0}; pg8::StaticOrder S; S.init(T, 1024, G, (int)blockIdx.x);
        pg8::EpiRes<false> E{nullptr, H1B, H2B, SS2};
        pg8::gemm_phase<pg8::EpiRes<false>, pg8::StaticOrder, true, true>(ldsg, g, S, E, tid);
    }
    SEAM(8);

    if (IN(9)) REP(9) { FRESH_IDS
        const float* gf = args.in[18];
        f32x4 gv[4];
#pragma unroll
        for (int j = 0; j < 4; ++j) gv[j] = ((const f32x4*)gf)[lane + 64 * j];
        for (int m0 = gw * 4; m0 < T; m0 += NGW * 4) {
            f32x4 v[4][4]; float rs[4];
#pragma unroll
            for (int r = 0; r < 4; ++r) { const u32x2* o = (const u32x2*)(H2B + (size_t)(m0 + r) * DM) + lane;
#pragma unroll
                for (int j = 0; j < 4; ++j) { const u32x2 bw = __builtin_nontemporal_load(o + 64 * j); v[r][j] = (f32x4){bflo(bw.x), bfhi(bw.x), bflo(bw.y), bfhi(bw.y)}; }
                const f32x4* sp = (const f32x4*)(SS2 + (size_t)(m0 + r) * 16); const f32x4 s = (sp[0] + sp[1]) + (sp[2] + sp[3]);
                rs[r] = rsqrtf(((s[0] + s[1]) + (s[2] + s[3])) * (1.0f / 1024.0f) + 1e-6f); }
#pragma unroll
            for (int r = 0; r < 4; ++r) { f32x4* o = (f32x4*)(OUT + (size_t)(m0 + r) * DM) + lane;
#pragma unroll
                for (int j = 0; j < 4; ++j) __builtin_nontemporal_store(v[r][j] * rs[r] * gv[j], o + 64 * j); }
        }
    }
#ifdef TSTAMP
    grid.sync();
    if (blockIdx.x == 0 && tid == 0) TS[10] = __builtin_amdgcn_s_memrealtime();
    __threadfence(); grid.sync();
    { const float da = (float)(TS[TSTAMP_A + 1] - TS[TSTAMP_A]) * 0.01f, db = (float)(TS[TSTAMP_B + 1] - TS[TSTAMP_B]) * 0.01f;
      for (size_t i = (size_t)blockIdx.x * 512 + tid; i < ((size_t)1 << 22); i += (size_t)G * 512) OUT[i] = (i == 0) ? 10.0f * da : db; }
#endif
#undef IN
#undef SEAM
}

constexpr int LDS_TOTAL = 153600;
static_assert(att::LDS_BYTES <= LDS_TOTAL && pg8::STAGE_BYTES <= LDS_TOTAL, "LDS");
extern "C" void kernel_launch(void* const* d_in, const int* in_sizes, int n_in, void* d_out, int out_size, void* d_ws, size_t ws_size, hipStream_t stream) {
    static int grid = 0;
    if (grid == 0) {
        if (n_in != 19 || out_size != T * DM || ws_size < WS_END) { fprintf(stderr, "kernel_launch: unexpected shapes (n_in %d, out %d, ws %zu)\n", n_in, out_size, ws_size); grid = -1; return; }
        int dev = 0, cus = 0, per_cu = 0;
        (void)hipGetDevice(&dev); (void)hipDeviceGetAttribute(&cus, hipDeviceAttributeMultiprocessorCount, dev);
        if (hipFuncSetAttribute((const void*)fwd_kernel, hipFuncAttributeMaxDynamicSharedMemorySize, LDS_TOTAL) != hipSuccess) { fprintf(stderr, "kernel_launch: hipFuncSetAttribute failed\n"); grid = -1; return; }
        if (hipOccupancyMaxActiveBlocksPerMultiprocessor(&per_cu, (const void*)fwd_kernel, 512, LDS_TOTAL) != hipSuccess || per_cu < 1) { fprintf(stderr, "kernel_launch: occupancy query says %d\n", per_cu); per_cu = 1; }
        (void)hipGetLastError();
        grid = cus * 1;
        if (grid <= 0) grid = 256;
    }
    if (grid < 0) return;
    Args a{};
    for (int i = 0; i < 19; ++i) a.in[i] = (const float*)d_in[i];
    a.out = (float*)d_out; a.ws = (unsigned char*)d_ws;
#if N_LAUNCHES == 1
    a.ph_lo = 0; a.ph_hi = NPHASE;
    (void)hipMemsetAsync((unsigned char*)d_ws + WS_BAR, 0, 16384, stream);
    void* kargs[] = {&a};
    hipError_t e = hipLaunchCooperativeKernel((const void*)fwd_kernel, dim3(grid), dim3(512), kargs, LDS_TOTAL, stream);
    if (e != hipSuccess) fprintf(stderr, "kernel_launch: cooperative launch failed: %s (grid %d)\n", hipGetErrorString(e), grid);
#else
#ifdef DIAG
    (void)hipMemsetAsync((unsigned char*)d_ws + WS_CSP + 8192, 0x7f, 4, stream); (void)hipMemsetAsync((unsigned char*)d_ws + WS_CSP + 8196, 0, 4, stream);
#endif
#ifndef PROBE_LIST
#define PROBE_LIST 0,1,2,3,4,5,6,7,8,9
#endif
    static const int plist[] = {PROBE_LIST};
    for (int pi = 0; pi < (int)(sizeof(plist) / sizeof(int)); ++pi) { const int p = plist[pi]; a.ph_lo = p; a.ph_hi = p + 1;
        hipLaunchKernelGGL(fwd_kernel, dim3(grid), dim3(512), LDS_TOTAL, stream, a);
#ifdef DIAG
        a.ph_lo = 100 + p; a.ph_hi = 101 + p; hipLaunchKernelGGL(fwd_kernel, dim3(grid), dim3(512), LDS_TOTAL, stream, a);
        if (p == NPHASE - 1) { a.ph_lo = 110; a.ph_hi = 111; hipLaunchKernelGGL(fwd_kernel, dim3(grid), dim3(512), LDS_TOTAL, stream, a); }
#endif
        if (hipPeekAtLastError() != hipSuccess) { fprintf(stderr, "kernel_launch: launch %d failed\n", p); break; } }
#endif
}
```

```cpp
#define N_LAUNCHES 1
#include <hip/hip_runtime.h>
#include <hip/hip_cooperative_groups.h>
#include <cstdio>
#include <cstdint>
namespace cg = cooperative_groups;
namespace pg8 {
#define PG8_LAS __attribute__((address_space(3)))
typedef unsigned short bf16_t;
typedef short bf16x8 __attribute__((ext_vector_type(8)));
typedef float f32x4 __attribute__((ext_vector_type(4)));
typedef unsigned u32x4 __attribute__((ext_vector_type(4)));
constexpr int BM = 256, BK = 64, HALF = 128, HTB = HALF * BK * 2  , STAGE_BYTES = 8 * HTB, NXCD = 8, WGM = 8;

__host__ __device__ __forceinline__ int lds_byte(int r, int c) { const int st = (r >> 4) * 2 + (c >> 5), rr = r & 15, cc = c & 31, ob = rr * 64 + cc * 2; return st * 1024 + (ob ^ (((ob >> 9) & 1) << 5)); }
__host__ __device__ __forceinline__ void stage_rc(int b, int& R, int& C) { const int st = b / 1024, sb = b % 1024, swz = sb ^ (((sb >> 9) & 1) << 5); R = (st >> 1) * 16 + swz / 64; C = (st & 1) * 32 + (swz % 64) / 2; }
__host__ __device__ __forceinline__ int perm32(int rho) { const int n = rho >> 4, i = rho & 15; return 8 * (i >> 2) + 4 * n + (i & 3); }

struct Unit { int pm, pn; };
struct Gemm { const bf16_t* A; const bf16_t* Bt; int M, N, K, lda, ldb; long a_pn_bytes; int a_pn_shift; };

struct StaticOrder {
    int nM, nN, nwg, G, c;
    __host__ __device__ void init(int M, int N, int G_, int c_) { nM = M / BM; nN = N / BM; nwg = nM * nN; G = G_; c = c_; }
    __host__ __device__ bool next(int i, Unit& u) const {
        const long L = (long)i * G + c; if (L >= nwg) return false;
        int wgid = (int)L; { const int q = nwg / NXCD, r = nwg % NXCD, xcd = wgid % NXCD, off = wgid / NXCD; wgid = (xcd < r ? xcd * (q + 1) : r * (q + 1) + (xcd - r) * q) + off; }
        const int nig = WGM * nN, gid = wgid / nig, fm = gid * WGM, gsz = (nM - fm) < WGM ? (nM - fm) : WGM;
        u.pm = fm + ((wgid % nig) % gsz); u.pn = (wgid % nig) / gsz; return true;
    }
    __device__ __forceinline__ void a_ready(const Unit&) const {}
    __device__ __forceinline__ void done(const Unit&) const {}
};

__device__ __forceinline__ unsigned cvt_pk_bf16(float lo, float hi) { unsigned r; asm volatile("v_cvt_pk_bf16_f32 %0, %1, %2" : "=v"(r) : "v"(lo), "v"(hi)); return r; }
typedef float f32x2 __attribute__((ext_vector_type(2)));
typedef unsigned u32x2 __attribute__((ext_vector_type(2)));
typedef _Float16 h16x2 __attribute__((ext_vector_type(2)));
__device__ __forceinline__ float fsigmoid(float v) { return __builtin_amdgcn_rcpf(1.0f + __expf(-v)); }
__device__ __forceinline__ float gelu_tanh(float v) { const float y = 1.5957691216057308f * (v + 0.044715f * v * v * v); return v * fsigmoid(y); }
__device__ __forceinline__ u32x4 pack8f(const f32x4 a, const f32x4 b) { u32x4 w; w.x = cvt_pk_bf16(a[0], a[1]); w.y = cvt_pk_bf16(a[2], a[3]); w.z = cvt_pk_bf16(b[0], b[1]); w.w = cvt_pk_bf16(b[2], b[3]); return w; }
__device__ __forceinline__ float bf2f(unsigned short b) { return __uint_as_float((unsigned)b << 16); }

struct EpiIn {
    static constexpr bool PERM = true, AFTER_DRAIN = false;
    bf16_t *ZX, *G1, *G2, *ZC; const float* rstd; float *SSQ, *SSKV; bf16_t* KR; const float* CS;
    __device__ __forceinline__ void operator()(const f32x4 (&acc)[2][2][4][2], const Unit& u, int wr, int wc, int fr, int fq) const {
        const int row0 = u.pm * BM + wr * 64 + fr, cl = wc * 32 + 8 * fq, pn = u.pn;
        float rsv[2][4];
#pragma unroll
        for (int ai = 0; ai < 2; ++ai)
#pragma unroll
            for (int m = 0; m < 4; ++m) rsv[ai][m] = rstd[row0 + ai * HALF + m * 16];
#pragma unroll
        for (int ai = 0; ai < 2; ++ai)
#pragma unroll
            for (int m = 0; m < 4; ++m) { const int row = row0 + ai * HALF + m * 16; const float rs = rsv[ai][m];
                if (pn >= 4 && pn < 12) {
                    f32x4 o[2];
#pragma unroll
                    for (int n = 0; n < 2; ++n)
#pragma unroll
                        for (int e = 0; e < 4; ++e) o[n][e] = gelu_tanh(acc[ai][0][m][n][e] * rs) * fsigmoid(acc[ai][1][m][n][e] * rs);
                    __builtin_nontemporal_store(pack8f(o[0], o[1]), (u32x4*)(G1 + (size_t)row * 1024 + (pn - 4) * 128 + cl));
                } else {
#pragma unroll
                    for (int bj = 0; bj < 2; ++bj) { f32x4 v0 = acc[ai][bj][m][0] * rs, v1 = acc[ai][bj][m][1] * rs;
                        if (pn < 4) *(u32x4*)(ZX + (size_t)row * 1024 + pn * 256 + bj * HALF + cl) = pack8f(v0, v1);
                        else if (pn < 16) {
#pragma unroll
                            for (int e = 0; e < 4; ++e) { v0[e] = fsigmoid(v0[e]); v1[e] = fsigmoid(v1[e]); }
                            __builtin_nontemporal_store(pack8f(v0, v1), (u32x4*)(G2 + (size_t)row * 1024 + (pn - 12) * 256 + bj * HALF + cl));
                        } else if (pn < 18) *(u32x4*)(ZC + (size_t)row * 768 + (pn - 16) * 256 + bj * HALF + cl) = pack8f(v0, v1);
                        else if (bj == 0 && wc < 2) {
                            const float* cs = CS + ((size_t)(row & 8191) * 32 + 16 * wc + 4 * fq) * 2;
                            const f32x4 c01 = *(const f32x4*)cs, c23 = *(const f32x4*)(cs + 4);
                            const float co[4] = {c01[0], c01[2], c23[0], c23[2]}, si[4] = {c01[1], c01[3], c23[1], c23[3]}; f32x4 olo, ohi;
#pragma unroll
                            for (int e2 = 0; e2 < 4; ++e2) { olo[e2] = v0[e2] * co[e2] - v1[e2] * si[e2]; ohi[e2] = v1[e2] * co[e2] + v0[e2] * si[e2]; }
                            *(u32x4*)(KR + (size_t)row * 64 + cl) = pack8f(olo, ohi); }
                    }
                    if (pn == 16 || pn == 17) {
                        float ss = 0.f;
#pragma unroll
                        for (int bj = 0; bj < 2; ++bj)
#pragma unroll
                            for (int n = 0; n < 2; ++n) { const f32x4 z = acc[ai][bj][m][n] * rs; ss += (z[0] * z[0] + z[1] * z[1]) + (z[2] * z[2] + z[3] * z[3]); }
                        ss += __shfl_xor(ss, 16); ss += __shfl_xor(ss, 32);
                        if (fq == 0) (pn == 16 ? SSQ : SSKV)[(size_t)row * 4 + wc] = ss; }
                }
            }
    }
};
__device__ __forceinline__ float one_minus_exp(float x) {
    const float p = -x * (1.0f + x * (0.5f + x * (0.16666667f + x * (0.041666668f + x * 0.0083333338f))));
    const float q = 1.0f - __builtin_amdgcn_exp2f(x * 1.4426950408889634f);
    return x > -0.2f ? p : q;
}
struct EpiLru {
    static constexpr bool PERM = true, AFTER_DRAIN = false;
    const bf16_t* XA; const float *ba, *bx, *csp; unsigned* AB;
    __device__ __forceinline__ void operator()(const f32x4 (&acc)[2][2][4][2], const Unit& u, int wr, int wc, int fr, int fq) const {
        const int c0 = u.pn * 128 + wc * 32 + 8 * fq;
        const unsigned lo = (unsigned)((wr * 64 + fr) * 1024 + c0);
        const char* xau = (const char*)(XA + (size_t)u.pm * BM * 1024); char* abu = (char*)(AB + (size_t)u.pm * BM * 1024);
        u32x4 xw[2][4];
#pragma unroll
        for (int ai = 0; ai < 2; ++ai)
#pragma unroll
            for (int m = 0; m < 4; ++m) xw[ai][m] = *(const u32x4*)(xau + (size_t)((ai * HALF + m * 16) * 1024) * 2 + lo * 2u);
        f32x4 vba[2], vbx[2], vcs[2];
#pragma unroll
        for (int n = 0; n < 2; ++n) { vba[n] = *(const f32x4*)(ba + c0 + 4 * n); vbx[n] = *(const f32x4*)(bx + c0 + 4 * n); vcs[n] = *(const f32x4*)(csp + c0 + 4 * n); }
#pragma unroll
        for (int ai = 0; ai < 2; ++ai)
#pragma unroll
            for (int m = 0; m < 4; ++m)
#pragma unroll
                for (int n = 0; n < 2; ++n) { u32x4 ow;
#pragma unroll
                    for (int e = 0; e < 4; ++e) { const unsigned w = xw[ai][m][2 * n + (e >> 1)]; const float xa = __uint_as_float((e & 1) ? (w & 0xffff0000u) : (w << 16));
                        const float r = fsigmoid(acc[ai][0][m][n][e] + vba[n][e]), ig = fsigmoid(acc[ai][1][m][n][e] + vbx[n][e]);
                        const float la2 = -vcs[n][e] * r; const float b = __builtin_amdgcn_sqrtf(fmaxf(1.0f - __builtin_amdgcn_exp2f(2.0f * la2), 0.f)) * (ig * xa);
                        h16x2 hv; hv.x = (_Float16)la2; hv.y = (_Float16)b; ow[e] = __builtin_bit_cast(unsigned, hv); }
                    *(u32x4*)(abu + (size_t)((ai * HALF + m * 16) * 1024 + 4 * n) * 4 + lo * 4u) = ow; }
    }
};
struct EpiQ {
    static constexpr bool PERM = true, AFTER_DRAIN = false;
    bf16_t* Q; const float* SSp; const float* CS;
    __device__ __forceinline__ void operator()(const f32x4 (&acc)[2][2][4][2], const Unit& u, int wr, int wc, int fr, int fq) const {
        const int row0 = u.pm * BM + wr * 64 + fr, cl = wc * 32 + 8 * fq, pn = u.pn;
        f32x4 spv[2][4];
#pragma unroll
        for (int ai = 0; ai < 2; ++ai)
#pragma unroll
            for (int m = 0; m < 4; ++m) spv[ai][m] = *(const f32x4*)(SSp + (size_t)(row0 + ai * HALF + m * 16) * 4);
#pragma unroll
        for (int ai = 0; ai < 2; ++ai)
#pragma unroll
            for (int m = 0; m < 4; ++m) { const int row = row0 + ai * HALF + m * 16; const f32x4 sp = spv[ai][m]; const float rs = rsqrtf(((sp[0] + sp[1]) + (sp[2] + sp[3])) * (1.0f / 256.0f) + 1e-6f);
                bf16_t* op = Q + (size_t)row * 1536 + pn * 256 + cl;
                if (pn < 4) {
#pragma unroll
                    for (int bj = 0; bj < 2; ++bj) *(u32x4*)(op + bj * HALF) = pack8f(acc[ai][bj][m][0] * rs, acc[ai][bj][m][1] * rs);
                } else {
                    const float* cs = CS + ((size_t)(row & 8191) * 32 + 16 * (wc & 1) + 4 * fq) * 2;
                    const f32x4 c01 = *(const f32x4*)cs, c23 = *(const f32x4*)(cs + 4);
                    const float co[4] = {c01[0], c01[2], c23[0], c23[2]}, si[4] = {c01[1], c01[3], c23[1], c23[3]};
#pragma unroll
                    for (int bj = 0; bj < 2; ++bj) { const f32x4 lo = acc[ai][bj][m][0] * rs, hi = acc[ai][bj][m][1] * rs; f32x4 olo, ohi;
#pragma unroll
                        for (int e = 0; e < 4; ++e) { olo[e] = lo[e] * co[e] - hi[e] * si[e]; ohi[e] = hi[e] * co[e] + lo[e] * si[e]; }
                        *(u32x4*)(op + bj * HALF) = pack8f(olo, ohi); }
                }
            }
    }
};
struct EpiRowScale {
    static constexpr bool PERM = true, AFTER_DRAIN = false;
    bf16_t* O; int ldc; const float* SSp;
    __device__ __forceinline__ void operator()(const f32x4 (&acc)[2][2][4][2], const Unit& u, int wr, int wc, int fr, int fq) const {
        const int row0 = u.pm * BM + wr * 64 + fr, cl = u.pn * 256 + wc * 32 + 8 * fq;
        f32x4 spv[2][4];
#pragma unroll
        for (int ai = 0; ai < 2; ++ai)
#pragma unroll
            for (int m = 0; m < 4; ++m) spv[ai][m] = *(const f32x4*)(SSp + (size_t)(row0 + ai * HALF + m * 16) * 4);
#pragma unroll
        for (int ai = 0; ai < 2; ++ai)
#pragma unroll
            for (int m = 0; m < 4; ++m) { const int row = row0 + ai * HALF + m * 16; const f32x4 sp = spv[ai][m]; const float rs = rsqrtf(((sp[0] + sp[1]) + (sp[2] + sp[3])) * (1.0f / 256.0f) + 1e-6f);
#pragma unroll
                for (int bj = 0; bj < 2; ++bj) *(u32x4*)(O + (size_t)row * ldc + cl + bj * HALF) = pack8f(acc[ai][bj][m][0] * rs, acc[ai][bj][m][1] * rs);
            }
    }
};
template <bool BASE_F32> struct EpiRes {
    static constexpr bool PERM = false, AFTER_DRAIN = false;
    const float* basef; const bf16_t* baseb; bf16_t* outb; float* SS;
    __device__ __forceinline__ void operator()(const f32x4 (&acc)[2][2][4][2], const Unit& u, int wr, int wc, int fr, int fq) const {
        const int row0 = u.pm * BM + wr * 64 + fr, col0 = u.pn * 256 + wc * 32 + 4 * fq;
        constexpr int R = BASE_F32 ? 2 : 4;
#pragma unroll
        for (int ai = 0; ai < 2; ++ai)
#pragma unroll
            for (int m0 = 0; m0 < 4; m0 += R) {
                f32x4 bv[R][2][2];
#pragma unroll
                for (int mm = 0; mm < R; ++mm) { const size_t off = (size_t)(row0 + ai * HALF + (m0 + mm) * 16) * 1024 + col0;
#pragma unroll
                    for (int bj = 0; bj < 2; ++bj)
#pragma unroll
                        for (int n = 0; n < 2; ++n) { const size_t o2 = off + bj * HALF + n * 16;
                            if (BASE_F32) bv[mm][bj][n] = __builtin_nontemporal_load((const f32x4*)(basef + o2));
                            else { const u32x2 bw = *(const u32x2*)(baseb + o2); bv[mm][bj][n] = (f32x4){__uint_as_float(bw.x << 16), __uint_as_float(bw.x & 0xffff0000u), __uint_as_float(bw.y << 16), __uint_as_float(bw.y & 0xffff0000u)}; } } }
#pragma unroll
                for (int mm = 0; mm < R; ++mm) { const int m = m0 + mm, row = row0 + ai * HALF + m * 16; const size_t off = (size_t)row * 1024 + col0; float ss = 0.f;
#pragma unroll
                    for (int bj = 0; bj < 2; ++bj)
#pragma unroll
                        for (int n = 0; n < 2; ++n) { const size_t o2 = off + bj * HALF + n * 16; const f32x4 h = bv[mm][bj][n] + acc[ai][bj][m][n];
                            ss += (h[0] * h[0] + h[1] * h[1]) + (h[2] * h[2] + h[3] * h[3]);
                            u32x2 w; w.x = cvt_pk_bf16(h[0], h[1]); w.y = cvt_pk_bf16(h[2], h[3]); *(u32x2*)(outb + o2) = w; }
                    ss += __shfl_xor(ss, 16); ss += __shfl_xor(ss, 32);
                    if (fq == 0) SS[(size_t)row * 16 + u.pn * 4 + wc] = ss; }
            }
    }
};
struct EpiUp {
    static constexpr bool PERM = true, AFTER_DRAIN = false;
    bf16_t* U; const float* SS;
    __device__ __forceinline__ void operator()(const f32x4 (&acc)[2][2][4][2], const Unit& u, int wr, int wc, int fr, int fq) const {
        const int row0 = u.pm * BM + wr * 64 + fr, cl = u.pn * 256 + wc * 32 + 8 * fq;
        float rsv[2][4];
        { f32x4 t[2][4];
#pragma unroll
          for (int ai = 0; ai < 2; ++ai)
#pragma unroll
            for (int m = 0; m < 4; ++m) t[ai][m] = *(const f32x4*)(SS + (size_t)(row0 + ai * HALF + m * 16) * 16 + 4 * fq);
#pragma unroll
          for (int ai = 0; ai < 2; ++ai)
#pragma unroll
            for (int m = 0; m < 4; ++m) { float s = (t[ai][m][0] + t[ai][m][1]) + (t[ai][m][2] + t[ai][m][3]); s += __shfl_xor(s, 16); s += __shfl_xor(s, 32); rsv[ai][m] = rsqrtf(s * (1.0f / 1024.0f) + 1e-6f); } }
#pragma unroll
        for (int ai = 0; ai < 2; ++ai)
#pragma unroll
            for (int m = 0; m < 4; ++m) { const int row = row0 + ai * HALF + m * 16;
                const float rs = rsv[ai][m];
#pragma unroll
                for (int bj = 0; bj < 2; ++bj) { f32x4 v0 = acc[ai][bj][m][0] * rs, v1 = acc[ai][bj][m][1] * rs;
#pragma unroll
                    for (int e = 0; e < 4; ++e) { const float a = fmaxf(v0[e], 0.f), b = fmaxf(v1[e], 0.f); v0[e] = a * a; v1[e] = b * b; }
                    *(u32x4*)(U + (size_t)row * 4096 + cl + bj * HALF) = pack8f(v0, v1); }
            }
    }
};
template <class Epi, class Sched, bool ALIGN_EPI = false, bool SP2 = false>
__device__ __forceinline__ void gemm_phase(PG8_LAS unsigned char* lds, const Gemm g, const Sched& S, const Epi& E, const int tid0) {
    int tid_ = tid0; asm volatile("" : "+v"(tid_));
    const int tid = tid_, wid = __builtin_amdgcn_readfirstlane(tid >> 6), lane = tid & 63, wr = wid >> 2, wc = wid & 3, fr = lane & 15, fq = lane >> 4;
    int K_ = g.K; asm volatile("" : "+s"(K_));
    const int K = K_, nt = K / BK;
    unsigned voffA[2], voffB[2];
#pragma unroll
    for (int i = 0; i < 2; ++i) { int R, C; stage_rc(tid * 16 + i * 8192, R, C); const int Rb = Epi::PERM ? ((R & ~31) + perm32(R & 31)) : R;
        voffA[i] = (unsigned)(R * g.lda + C) * 2u; voffB[i] = (unsigned)(Rb * g.ldb + C) * 2u; }
    const size_t kstep = (size_t)(BK * 2);
    const size_t hstepA = (size_t)HALF * g.lda * 2, hstepB = (size_t)HALF * g.ldb * 2;
    const size_t tstepA = 2 * hstepA, tstepB = 2 * hstepB;
    const unsigned ldsw = (unsigned)wid * 1024u;
    const int aoff = lds_byte(wr * 64 + fr, fq * 8), boff = lds_byte(wc * 32 + fr, fq * 8);
#define PG8_SA(b, h) (((b) * 2 + (h)) * HTB)
#define PG8_SB(b, h) ((4 + (b) * 2 + (h)) * HTB)
#define PG8_STAGE(bufoff, gbase, voff) do { _Pragma("unroll") for (int _i = 0; _i < 2; ++_i) \
        __builtin_amdgcn_global_load_lds((const unsigned*)((const char*)(gbase) + (voff)[_i]), (PG8_LAS unsigned*)(lds + (bufoff) + ldsw + _i * 8192), 16, 0, 0); } while (0)
#define PG8_LDA(dst, b, h) do { _Pragma("unroll") for (int m = 0; m < 4; ++m) _Pragma("unroll") for (int k = 0; k < 2; ++k) dst[m][k] = *(const PG8_LAS bf16x8*)(lds + PG8_SA(b, h) + aoff + m * 2048 + k * 1024); } while (0)
#define PG8_LDB(dst, b, h) do { _Pragma("unroll") for (int n = 0; n < 2; ++n) _Pragma("unroll") for (int k = 0; k < 2; ++k) dst[n][k] = *(const PG8_LAS bf16x8*)(lds + PG8_SB(b, h) + boff + n * 2048 + k * 1024); } while (0)
#define PG8_MMA(ai, bj, At, Bt) do { __builtin_amdgcn_s_setprio(1); _Pragma("unroll") for (int m = 0; m < 4; ++m) _Pragma("unroll") for (int n = 0; n < 2; ++n) _Pragma("unroll") for (int k = 0; k < 2; ++k) \
        acc[ai][bj][m][n] = __builtin_amdgcn_mfma_f32_16x16x32_bf16(Bt[n][k], At[m][k], acc[ai][bj][m][n], 0, 0, 0); __builtin_amdgcn_s_setprio(0); } while (0)
#define PG8_WAIT_V(n) asm volatile("s_waitcnt vmcnt(" #n ")" ::: "memory")
#define PG8_WAIT_L(n) asm volatile("s_waitcnt lgkmcnt(" #n ")" ::: "memory")
#define PG8_BAR __builtin_amdgcn_s_barrier()
#define PG8_SCHED __builtin_amdgcn_sched_barrier(0)
    Unit cur, nxt; int ui = 0;
    if (!S.next(0, cur)) return;
    f32x4 acc[2][2][4][2];
#pragma unroll
    for (int a = 0; a < 2; ++a)
#pragma unroll
        for (int b = 0; b < 2; ++b)
#pragma unroll
            for (int m = 0; m < 4; ++m)
#pragma unroll
                for (int n = 0; n < 2; ++n) acc[a][b][m][n] = (f32x4){0.f, 0.f, 0.f, 0.f};
    bf16x8 At[4][2], B0[2][2], B1[2][2];
    const char* cA = (const char*)g.A + (size_t)cur.pm * tstepA + (size_t)(cur.pn >> g.a_pn_shift) * g.a_pn_bytes; const char* cB = (const char*)g.Bt + (size_t)cur.pn * tstepB;
    S.a_ready(cur);
    if constexpr (SP2) {
        PG8_STAGE(PG8_SB(0, 0), cB, voffB); PG8_STAGE(PG8_SB(0, 1), cB + hstepB, voffB); PG8_STAGE(PG8_SA(0, 0), cA, voffA); PG8_STAGE(PG8_SA(0, 1), cA + hstepA, voffA);
        if (wr == 1) PG8_BAR;
        PG8_WAIT_V(2); PG8_BAR;
        PG8_STAGE(PG8_SB(1, 0), cB + kstep, voffB); PG8_STAGE(PG8_SA(1, 0), cA + kstep, voffA); PG8_STAGE(PG8_SB(1, 1), cB + hstepB + kstep, voffB);
        PG8_WAIT_V(6); PG8_BAR;
    } else {
        PG8_STAGE(PG8_SB(0, 0), cB, voffB); PG8_STAGE(PG8_SA(0, 0), cA, voffA); PG8_STAGE(PG8_SB(0, 1), cB + hstepB, voffB); PG8_STAGE(PG8_SA(0, 1), cA + hstepA, voffA);
        if (wr == 1) PG8_BAR;
        PG8_WAIT_V(4); PG8_BAR;
        PG8_STAGE(PG8_SB(1, 0), cB + kstep, voffB); PG8_STAGE(PG8_SA(1, 0), cA + kstep, voffA); PG8_STAGE(PG8_SB(1, 1), cB + hstepB + kstep, voffB);
        PG8_WAIT_V(6); PG8_BAR;
    }
    for (;;) {
        const bool has_next = S.next(ui + 1, nxt);
        const char* nA = has_next ? (const char*)g.A + (size_t)nxt.pm * tstepA + (size_t)(nxt.pn >> g.a_pn_shift) * g.a_pn_bytes : cA; const char* nB = has_next ? (const char*)g.Bt + (size_t)nxt.pn * tstepB : cB;
        for (int t = 0; t < nt; t += 2) {
            const bool last = (t == nt - 2);
            const char* a1 = cA + (size_t)(t + 1) * kstep;
            const char* a2 = last ? nA : cA + (size_t)(t + 2) * kstep; const char* b2 = last ? nB : cB + (size_t)(t + 2) * kstep;
            const char* a3 = a2 + kstep; const char* b3 = b2 + kstep;
            if (last && has_next) S.a_ready(nxt);
            if constexpr (SP2) {
            PG8_LDB(B0, 0, 0); PG8_LDB(B1, 0, 1); PG8_SCHED; PG8_LDA(At, 0, 0); PG8_STAGE(PG8_SA(1, 1), a1 + hstepA, voffA);
            PG8_WAIT_V(8); PG8_WAIT_L(0); PG8_BAR; PG8_MMA(0, 0, At, B0); PG8_MMA(0, 1, At, B1); PG8_BAR; PG8_SCHED;
            PG8_LDA(At, 0, 1); PG8_STAGE(PG8_SB(0, 0), b2, voffB); PG8_STAGE(PG8_SB(0, 1), b2 + hstepB, voffB); PG8_STAGE(PG8_SA(0, 0), a2, voffA);
            PG8_WAIT_V(8); PG8_WAIT_L(0); PG8_BAR; PG8_MMA(1, 0, At, B0); PG8_MMA(1, 1, At, B1); PG8_BAR; PG8_SCHED;
            PG8_LDB(B0, 1, 0); PG8_LDB(B1, 1, 1); PG8_SCHED; PG8_LDA(At, 1, 0); PG8_STAGE(PG8_SA(0, 1), a2 + hstepA, voffA);
            PG8_WAIT_V(8); PG8_WAIT_L(0); PG8_BAR; PG8_MMA(0, 0, At, B0); PG8_MMA(0, 1, At, B1); PG8_BAR; PG8_SCHED;
            PG8_LDA(At, 1, 1); PG8_STAGE(PG8_SB(1, 0), b3, voffB); PG8_STAGE(PG8_SB(1, 1), b3 + hstepB, voffB); PG8_STAGE(PG8_SA(1, 0), a3, voffA);
            PG8_WAIT_V(8); PG8_WAIT_L(0); PG8_BAR; PG8_MMA(1, 0, At, B0); PG8_MMA(1, 1, At, B1); PG8_BAR; PG8_SCHED;
            } else {
            PG8_LDB(B0, 0, 0); PG8_SCHED; PG8_LDA(At, 0, 0); PG8_STAGE(PG8_SA(1, 1), a1 + hstepA, voffA);
            PG8_WAIT_L(8); PG8_BAR; PG8_WAIT_L(0); PG8_MMA(0, 0, At, B0); PG8_BAR; PG8_SCHED;
            PG8_LDB(B1, 0, 1); PG8_STAGE(PG8_SB(0, 0), b2, voffB);
            PG8_BAR; PG8_WAIT_L(0); PG8_MMA(0, 1, At, B1); PG8_BAR;
            PG8_LDA(At, 0, 1); PG8_STAGE(PG8_SA(0, 0), a2, voffA);
            PG8_BAR; PG8_WAIT_L(0); PG8_MMA(1, 0, At, B0); PG8_BAR; PG8_SCHED;
            PG8_STAGE(PG8_SB(0, 1), b2 + hstepB, voffB);
            PG8_WAIT_V(6); PG8_BAR; PG8_MMA(1, 1, At, B1); PG8_BAR;
            PG8_LDB(B0, 1, 0); PG8_SCHED; PG8_LDA(At, 1, 0); PG8_STAGE(PG8_SA(0, 1), a2 + hstepA, voffA);
            PG8_WAIT_L(8); PG8_BAR; PG8_WAIT_L(0); PG8_MMA(0, 0, At, B0); PG8_BAR; PG8_SCHED;
            PG8_LDB(B1, 1, 1); PG8_STAGE(PG8_SB(1, 0), b3, voffB);
            PG8_BAR; PG8_WAIT_L(0); PG8_MMA(0, 1, At, B1); PG8_BAR;
            PG8_LDA(At, 1, 1); PG8_STAGE(PG8_SA(1, 0), a3, voffA);
            PG8_BAR; PG8_WAIT_L(0); PG8_MMA(1, 0, At, B0); PG8_BAR; PG8_SCHED;
            PG8_STAGE(PG8_SB(1, 1), b3 + hstepB, voffB);
            PG8_WAIT_V(6); PG8_BAR; PG8_MMA(1, 1, At, B1); PG8_BAR;
            }
        }
        if constexpr (ALIGN_EPI) { if (wr == 0) PG8_BAR; }
        if constexpr (!Epi::AFTER_DRAIN) { E(acc, cur, wr, wc, fr, fq); S.done(cur); }
        if (!has_next) break;
#pragma unroll
        for (int a = 0; a < 2; ++a)
#pragma unroll
            for (int b = 0; b < 2; ++b)
#pragma unroll
                for (int m = 0; m < 4; ++m)
#pragma unroll
                    for (int n = 0; n < 2; ++n) acc[a][b][m][n] = (f32x4){0.f, 0.f, 0.f, 0.f};
        cur = nxt; cA = nA; cB = nB; ++ui;
        if constexpr (ALIGN_EPI) { if (wr == 1) PG8_BAR; }
    }
    PG8_WAIT_V(0);
    if constexpr (!ALIGN_EPI) { if (wr == 0) PG8_BAR; }
    PG8_BAR;
    if constexpr (Epi::AFTER_DRAIN) { E.fused(acc, cur, wr, wc, fr, fq, lds, wid, lane); S.done(cur); }
#undef PG8_SA
#undef PG8_SB
#undef PG8_STAGE
#undef PG8_LDA
#undef PG8_LDB
#undef PG8_MMA
#undef PG8_WAIT_V
#undef PG8_WAIT_L
#undef PG8_BAR
#undef PG8_SCHED
}
}
namespace att {
typedef unsigned short bf16_t;
typedef short bf16x8 __attribute__((ext_vector_type(8)));
typedef short s16x4 __attribute__((ext_vector_type(4)));
typedef float f32x16 __attribute__((ext_vector_type(16)));
typedef float f32x4 __attribute__((ext_vector_type(4)));
typedef unsigned u32x4 __attribute__((ext_vector_type(4)));
constexpr int NW = 8, QBLK = 32, KVBLK = 64, QB = NW * QBLK;
constexpr int DK = 192, DV = 128;
constexpr int QS = 1536, KVS = 2048, KRS = 64, OS = 1024;
constexpr int SHM_V = KVBLK * DV * 2, SHM_K = KVBLK * DK * 2;
constexpr int LDS_QR = 2 * SHM_V + 2 * SHM_K + NW * 64 * 4;
constexpr int LDS_BYTES = LDS_QR + NW * 8192;
constexpr float SCALE = 0.07216878364870322f;
constexpr float THR = 8.f;
#define KSWZ(row, colB) ((row) * 384 + ((colB) ^ (((row) & 7) << 4)))
#define SBAR() __builtin_amdgcn_sched_barrier(0)
__device__ __forceinline__ int v_st(int k, int c) { const int kk = (k & ~0xC) | ((k & 4) << 1) | ((k & 8) >> 1); return ((kk >> 3) * 4 + (c >> 5)) * 512 + ((kk & 7) * 32 + (c & 31)) * 2; }
__device__ __forceinline__ int v_rd_base(int lane) { return ((lane & 3) << 3) | (((lane >> 2) & 3) << 6) | (((lane >> 4) & 1) << 5) | (((lane >> 5) & 1) << 8); }
constexpr int v_rd_off(int d0, int ks, int half) { return d0 * 512 + ks * 4096 + half * 2048; }
__device__ __forceinline__ int crow(int r, int hi) { return (r & 3) + 8 * (r >> 2) + 4 * hi; }
__device__ __forceinline__ unsigned cvtpk(float lo, float hi) { unsigned r; asm volatile("v_cvt_pk_bf16_f32 %0, %1, %2" : "=v"(r) : "v"(lo), "v"(hi)); return r; }
__device__ __forceinline__ bf16x8 load8(const bf16_t* p) { return *reinterpret_cast<const bf16x8*>(p); }
__device__ __forceinline__ void mask_tile(f32x16& p0, f32x16& p1, int dq) {
    const float NEG = -__builtin_inff();
#pragma unroll
    for (int r = 0; r < 16; ++r) {
        const int c = (r & 3) + 8 * (r >> 2);
        if (dq - c < 0) p0[r] = NEG;
        if (dq - c - 32 < 0) p1[r] = NEG;
    }
}
__device__ __forceinline__ void partialSM(f32x16& p0, f32x16& p1, float& m_reg, float& mn, float& alpha) {
    float pmax = p0[0]; for (int r = 1; r < 16; ++r) pmax = fmaxf(pmax, p0[r]); for (int r = 0; r < 16; ++r) pmax = fmaxf(pmax, p1[r]);
    { auto rr = __builtin_amdgcn_permlane32_swap(__float_as_uint(pmax), __float_as_uint(pmax), false, false);
      pmax = fmaxf(__uint_as_float(rr[0]), __uint_as_float(rr[1])); }
    constexpr float C2 = 1.4426950408889634f * SCALE;
    if (__builtin_expect(__all((pmax - m_reg) * SCALE <= THR), 1)) { mn = m_reg; alpha = 1.f; }
    else { mn = fmaxf(m_reg, pmax); alpha = __builtin_amdgcn_exp2f((m_reg - mn) * C2); m_reg = mn; }
    const float mnL = -mn * C2;
    for (int r = 0; r < 16; ++r) p0[r] = fmaf(p0[r], C2, mnL); for (int r = 0; r < 16; ++r) p1[r] = fmaf(p1[r], C2, mnL);
    for (int r = 0; r < 16; ++r) p0[r] = __builtin_amdgcn_exp2f(p0[r]);
}
__device__ __forceinline__ void finishSM(f32x16& p0, f32x16& p1, float alpha, float& l_reg, bf16x8& pa0, bf16x8& pa1, bf16x8& pa2, bf16x8& pa3) {
    for (int r = 0; r < 16; ++r) p1[r] = __builtin_amdgcn_exp2f(p1[r]);
    float ps = 0; for (int r = 0; r < 16; ++r) ps += p0[r]; for (int r = 0; r < 16; ++r) ps += p1[r];
    { auto rr = __builtin_amdgcn_permlane32_swap(__float_as_uint(ps), __float_as_uint(ps), false, false);
      ps = __uint_as_float(rr[0]) + __uint_as_float(rr[1]); }
    l_reg = l_reg * alpha + ps;
#define PK4(P, B_, OUT) do { unsigned a0 = cvtpk(P[B_+0], P[B_+1]), a1 = cvtpk(P[B_+2], P[B_+3]);                          \
        unsigned b0 = cvtpk(P[B_+4], P[B_+5]), b1 = cvtpk(P[B_+6], P[B_+7]);                                             \
        auto r0 = __builtin_amdgcn_permlane32_swap(a0, b0, false, false); auto r1 = __builtin_amdgcn_permlane32_swap(a1, b1, false, false); \
        u32x4 w = {r0[0], r1[0], r0[1], r1[1]}; OUT = *reinterpret_cast<bf16x8*>(&w); } while (0)
    PK4(p0, 0, pa0); PK4(p0, 8, pa1); PK4(p1, 0, pa2); PK4(p1, 8, pa3);
#undef PK4
}
template <int KB>
__device__ __forceinline__ void qkt(f32x16& p0, f32x16& p1, const char* K_lds, int r32, int hi, const bf16x8* qr, const char* qrl) {
    p0 = f32x16{}; p1 = f32x16{};
    const char* kb[4];
#pragma unroll
    for (int dd = 0; dd < 4; ++dd) kb[dd] = K_lds + KB * SHM_K + KSWZ(r32, (dd * 16 + hi * 8) * 2);
#pragma unroll
    for (int d0 = 0; d0 < 12; ++d0) { const char* a = kb[d0 & 3] + (d0 >> 2) * 128;
        bf16x8 b0 = *reinterpret_cast<const bf16x8*>(a);
        bf16x8 b1 = *reinterpret_cast<const bf16x8*>(a + 32 * 384);
        const bf16x8 qf = d0 < 4 ? qr[d0 & 3] : *reinterpret_cast<const bf16x8*>(qrl + (d0 - 4) * 1024);
        p0 = __builtin_amdgcn_mfma_f32_32x32x16_bf16(b0, qf, p0, 0, 0, 0);
        p1 = __builtin_amdgcn_mfma_f32_32x32x16_bf16(b1, qf, p1, 0, 0, 0); }
}
template <int VB>
__device__ __forceinline__ void pv_tile(f32x16* o, int vb0, bf16x8 pa0, bf16x8 pa1, bf16x8 pa2, bf16x8 pa3) {
#define TRRD(dst, off) asm volatile("ds_read_b64_tr_b16 %0, %1 offset:%2" : "=&v"(dst) : "v"(vb0), "i"(off) : "memory")
#define PV_D0(d0) do { s16x4 l0, l1, l2, l3, h0, h1, h2, h3; constexpr int b_ = VB * SHM_V + v_rd_off(d0, 0, 0);   \
        TRRD(l0, b_); TRRD(h0, b_ + 2048); TRRD(l1, b_ + 4096); TRRD(h1, b_ + 6144); TRRD(l2, b_ + 8192); TRRD(h2, b_ + 10240); TRRD(l3, b_ + 12288); TRRD(h3, b_ + 14336); \
        asm volatile("s_waitcnt lgkmcnt(0)" ::: "memory"); SBAR();   \
        o[d0] = __builtin_amdgcn_mfma_f32_32x32x16_bf16(pa0, (bf16x8){l0[0], l0[1], l0[2], l0[3], h0[0], h0[1], h0[2], h0[3]}, o[d0], 0, 0, 0);   \
        o[d0] = __builtin_amdgcn_mfma_f32_32x32x16_bf16(pa1, (bf16x8){l1[0], l1[1], l1[2], l1[3], h1[0], h1[1], h1[2], h1[3]}, o[d0], 0, 0, 0);   \
        o[d0] = __builtin_amdgcn_mfma_f32_32x32x16_bf16(pa2, (bf16x8){l2[0], l2[1], l2[2], l2[3], h2[0], h2[1], h2[2], h2[3]}, o[d0], 0, 0, 0);   \
        o[d0] = __builtin_amdgcn_mfma_f32_32x32x16_bf16(pa3, (bf16x8){l3[0], l3[1], l3[2], l3[3], h3[0], h3[1], h3[2], h3[3]}, o[d0], 0, 0, 0); } while (0)
    PV_D0(0); PV_D0(1); PV_D0(2); PV_D0(3);
#undef PV_D0
#undef TRRD
}
struct BlockRef { const bf16_t* Qn; const bf16_t* Qr; const bf16_t* Kn; const bf16_t* Kr; const bf16_t* V; bf16_t* O; int P0; };
struct Seam { bf16x8 qr[4]; bf16x8 st_v0, st_v1, st_k0, st_k1, st_k2; };
#define VMW() asm volatile("s_waitcnt vmcnt(0)" ::: "memory")
#define VMWN(n) asm volatile("s_waitcnt vmcnt(%0)" :: "i"(n) : "memory")
#define SLOAD_H(R_, k0) do { const char* vb_ = (const char*)((R_).V + (size_t)(k0) * KVS); const char* kb_ = (const char*)((R_).Kn + (size_t)(k0) * KVS); const char* rb_ = (const char*)((R_).Kr + (size_t)(k0) * KRS); \
                         S.st_v0 = *(const bf16x8*)(vb_ + voff); S.st_v1 = *(const bf16x8*)(vb_ + 32 * KVS * 2 + voff);      \
                         S.st_k0 = *(const bf16x8*)(kb_ + voff); S.st_k1 = *(const bf16x8*)(kb_ + 32 * KVS * 2 + voff);      \
                         S.st_k2 = *(const bf16x8*)(rb_ + roff); } while (0)
#define SLOAD_V(R_, k0) do { const char* vb_ = (const char*)((R_).V + (size_t)(k0) * KVS); S.st_v0 = *(const bf16x8*)(vb_ + voff); S.st_v1 = *(const bf16x8*)(vb_ + 32 * KVS * 2 + voff); } while (0)
#define SLOAD_K(R_, k0) do { const char* kb_ = (const char*)((R_).Kn + (size_t)(k0) * KVS); const char* rb_ = (const char*)((R_).Kr + (size_t)(k0) * KRS); \
                         S.st_k0 = *(const bf16x8*)(kb_ + voff); S.st_k1 = *(const bf16x8*)(kb_ + 32 * KVS * 2 + voff); S.st_k2 = *(const bf16x8*)(rb_ + roff); } while (0)
#define SWRITE_HK(bf) do { *(bf16x8*)(K_lds + (bf) * SHM_K + kws) = S.st_k0; *(bf16x8*)(K_lds + (bf) * SHM_K + kws + 32 * 384) = S.st_k1; *(bf16x8*)(K_lds + (bf) * SHM_K + kws2) = S.st_k2; } while (0)
#define SWRITE_HV(bf) do { *(bf16x8*)(V_lds + (bf) * SHM_V + vst0) = S.st_v0; *(bf16x8*)(V_lds + (bf) * SHM_V + vst1) = S.st_v1; } while (0)
#define SWRITE_H(bf) do { SWRITE_HV(bf); SWRITE_HK(bf); } while (0)
#define QLOAD(R_) do { const char* qn_ = (const char*)((R_).Qn + (size_t)(wid * QBLK) * QS); const char* qr_ = (const char*)((R_).Qr + (size_t)(wid * QBLK) * QS); \
                       _Pragma("unroll") for (int d0 = 0; d0 < 4; ++d0) S.qr[d0] = *(const bf16x8*)(qn_ + qoff + d0 * 32);          \
                       _Pragma("unroll") for (int d0 = 4; d0 < 8; ++d0) *(bf16x8*)(qrl + (d0 - 4) * 1024) = *(const bf16x8*)(qn_ + qoff + d0 * 32);          \
                       _Pragma("unroll") for (int d0 = 0; d0 < 4; ++d0) *(bf16x8*)(qrl + (d0 + 4) * 1024) = *(const bf16x8*)(qr_ + qoff + d0 * 32); } while (0)
__device__ __forceinline__ void attn_prime(const BlockRef& cur, char* lds, Seam& S, const int tid0) {
    const int tid = tid0, wid = __builtin_amdgcn_readfirstlane(tid >> 6), lane = tid & 63, r32 = lane & 31, hi = lane >> 5;
    const int sr = tid >> 4, sc = (tid & 15) * 8, kws = KSWZ(sr, sc * 2), rr = tid >> 3, rc = (tid & 7) * 8, kws2 = KSWZ(rr, (128 + rc) * 2); char* K_lds = lds + 2 * SHM_V;
    char* qrl = lds + LDS_QR + wid * 8192 + lane * 16;
    const unsigned voff = (unsigned)((sr * KVS + sc) * 2), roff = (unsigned)((rr * KRS + rc) * 2), qoff = (unsigned)((r32 * QS + hi * 8) * 2);
    QLOAD(cur);
    SLOAD_H(cur, 0); VMW(); SWRITE_HK(0);
    __syncthreads();
}
__device__ __forceinline__ void attn_block(const BlockRef& cur, const BlockRef& nxt, char* lds, Seam& S, const int tid0) {
    const int tid = tid0, wid = __builtin_amdgcn_readfirstlane(tid >> 6), lane = tid & 63, r32 = lane & 31, hi = lane >> 5;
    const int NT = cur.P0 / KVBLK + 4;
    const int qlo = cur.P0 + wid * QBLK, qm = qlo + r32 - 4 * hi;
    char* V_lds = lds; char* K_lds = lds + 2 * SHM_V;
    float* ws = (float*)(lds + 2 * SHM_V + 2 * SHM_K) + wid * 64; float* li_l = ws, * al_l = ws + 32;
    float m_reg = -1e30f, l_reg = 0; f32x16 o[4] = {};
    const int sr = tid >> 4, sc = (tid & 15) * 8, vst0 = v_st(sr, sc), vst1 = v_st(32 + sr, sc), kws = KSWZ(sr, sc * 2);
    const int rr = tid >> 3, rc = (tid & 7) * 8, kws2 = KSWZ(rr, (128 + rc) * 2);
    const int vb0 = (int)(uintptr_t)V_lds + v_rd_base(lane);
    char* qrl = lds + LDS_QR + wid * 8192 + lane * 16;
    const unsigned voff = (unsigned)((sr * KVS + sc) * 2), roff = (unsigned)((rr * KRS + rc) * 2), qoff = (unsigned)((r32 * QS + hi * 8) * 2);
#define RESC(a) do { if (__any((a) < 1.f)) { if (hi == 0) al_l[r32] = (a); asm volatile("s_waitcnt lgkmcnt(0)" ::: "memory");              \
                     for (int d_ = 0; d_ < 4; ++d_) for (int r = 0; r < 16; ++r) o[d_][r] *= al_l[crow(r, hi)]; } } while (0)
#define MASKT(P0_, P1_, t) do { const int kb_ = (t) * KVBLK; if (kb_ + KVBLK - 1 > qlo) mask_tile(P0_, P1_, qm - kb_); } while (0)
    f32x16 pA0, pA1, pB0, pB1; float mnA, mnB, alA, alB; bf16x8 pa0, pa1, pa2, pa3;
    SWRITE_HV(0); SBAR();
    if (NT > 1) SLOAD_H(cur, KVBLK);
    SBAR(); qkt<0>(pA0, pA1, K_lds, r32, hi, S.qr, qrl);
    MASKT(pA0, pA1, 0); partialSM(pA0, pA1, m_reg, mnA, alA);
    if (NT > 1) { VMW(); SWRITE_HK(1); }
    __syncthreads();
#define HALF_STEP(PX0, PX1, mnX, alX, PY0, PY1, alY, t, KB, VB, SB) do {                                                      \
        SWRITE_HV(KB);                                                             \
        if ((t) + 1 < NT) { SLOAD_V(cur, ((t) + 1) * KVBLK); SLOAD_K(cur, ((t) + 1) * KVBLK); }         \
        SBAR(); qkt<KB>(PX0, PX1, K_lds, r32, hi, S.qr, qrl);                                                                       \
        finishSM(PY0, PY1, alY, l_reg, pa0, pa1, pa2, pa3); SBAR();                                                           \
        pv_tile<VB>(o, vb0, pa0, pa1, pa2, pa3); MASKT(PX0, PX1, (t)); partialSM(PX0, PX1, m_reg, mnX, alX);                  \
        if ((t) + 1 < NT) { VMW(); SWRITE_HK(SB); }                                                                           \
        RESC(alX); __syncthreads(); } while (0)
    for (int t = 1; t + 1 < NT; t += 2) {
        HALF_STEP(pB0, pB1, mnB, alB, pA0, pA1, alA, t, 1, 0, 0);
        HALF_STEP(pA0, pA1, mnA, alA, pB0, pB1, alB, t + 1, 0, 1, 1);
    }
    const bool even = (NT & 1) == 0;
    if (even) { SWRITE_HV(1); SBAR(); qkt<1>(pB0, pB1, K_lds, r32, hi, S.qr, qrl); SBAR(); }
    SLOAD_H(nxt, 0); SBAR();
    QLOAD(nxt);
    SBAR();
    finishSM(pA0, pA1, alA, l_reg, pa0, pa1, pa2, pa3); SBAR();
    pv_tile<0>(o, vb0, pa0, pa1, pa2, pa3);
    if (even) { MASKT(pB0, pB1, NT - 1); partialSM(pB0, pB1, m_reg, mnB, alB); __syncthreads(); RESC(alB);
        finishSM(pB0, pB1, alB, l_reg, pa0, pa1, pa2, pa3); SBAR(); pv_tile<1>(o, vb0, pa0, pa1, pa2, pa3); }
    SBAR(); VMWN(4); SWRITE_HK(0); SBAR();
    if (hi == 0) li_l[r32] = l_reg; asm volatile("s_waitcnt lgkmcnt(0)" ::: "memory");
    float rli[16];
#pragma unroll
    for (int r = 0; r < 16; ++r) rli[r] = __builtin_amdgcn_rcpf(li_l[crow(r, hi)]);
    char* Ow = (char*)(cur.O + (size_t)(wid * QBLK) * OS);
    const unsigned loff = (unsigned)((4 * hi * OS + r32) * 2);
#pragma unroll
    for (int r = 0; r < 16; ++r) { const int cro = ((r & 3) + 8 * (r >> 2)) * OS;
#pragma unroll
        for (int d0 = 0; d0 < 4; ++d0) { const float v = o[d0][r] * rli[r];
            const float vn = __shfl_xor(v, 1);
            if ((r32 & 1) == 0) *(unsigned*)(Ow + (size_t)(cro + d0 * 32) * 2 + loff) = cvtpk(v, vn); } }
    __syncthreads();
#undef RESC
#undef MASKT
#undef HALF_STEP
}
#undef VMW
#undef VMWN
#undef SLOAD_H
#undef SLOAD_V
#undef SLOAD_K
#undef SWRITE_HK
#undef SWRITE_HV
#undef SWRITE_H
#undef QLOAD
#undef SBAR
#undef KSWZ
}
typedef unsigned short bf16_t;
typedef float f32x4 __attribute__((ext_vector_type(4)));
typedef unsigned u32x4 __attribute__((ext_vector_type(4)));
typedef unsigned u32x2 __attribute__((ext_vector_type(2)));
typedef _Float16 h16x4 __attribute__((ext_vector_type(4)));
#define LAS __attribute__((address_space(3)))
#ifndef N_LAUNCHES
#define N_LAUNCHES 1
#endif
constexpr int NPHASE = 10;
constexpr int T = 32768, SEQ = 8192, DM = 1024;
constexpr size_t MiB = 1u << 20;
constexpr size_t WS_RSTDX = 0, WS_RSTDQ = 128 * 1024, WS_RSTDKV = 256 * 1024, WS_CSP = 384 * 1024;
constexpr size_t WS_SS1 = 1 * MiB, WS_SS2 = 3 * MiB;
constexpr size_t WS_CS = 5 * MiB;
constexpr size_t WS_W1 = 7 * MiB;
constexpr size_t WS_WUP = 17 * MiB;
constexpr size_t WS_WDN = 25 * MiB;
constexpr size_t WS_WOUT = 33 * MiB;
constexpr size_t WS_WUQ = 35 * MiB;
constexpr size_t WS_WUKV = 36 * MiB;
constexpr size_t WS_WLRU = 37 * MiB;
constexpr size_t WS_KR = 38 * MiB;
constexpr size_t WS_G1 = 42 * MiB, WS_G2 = 106 * MiB;
constexpr size_t WS_ZC = 170 * MiB;
constexpr size_t WS_SUM = WS_ZC, WS_SUB = WS_ZC + 2 * MiB;
constexpr size_t WS_KV = 218 * MiB;
constexpr size_t WS_R1 = 346 * MiB;
constexpr size_t WS_XB = WS_R1;
constexpr size_t WS_XA = WS_R1;
constexpr size_t WS_YB = WS_R1;
constexpr size_t WS_ZX = WS_R1 + 64 * MiB;
constexpr size_t WS_Q = WS_R1 + 64 * MiB;
constexpr size_t WS_MG = WS_KV;
constexpr size_t WS_H1B = WS_R1 + 64 * MiB;
constexpr size_t WS_U = 42 * MiB;
constexpr size_t WS_H2B = 298 * MiB;
constexpr size_t WS_END = 512 * MiB;
static_assert(WS_Q + (size_t)T * 1536 * 2 <= WS_END && WS_U + (size_t)T * 4096 * 2 <= WS_H1B && WS_W1 + 4864 * 1024 * 2 <= WS_WUP, "d_ws map");

struct Args { const float* in[19]; float* out; unsigned char* ws; int ph_lo, ph_hi; };
static_assert(sizeof(Args) == 19 * 8 + 8 + 8 + 8, "Args has no padding");

__device__ __forceinline__ float wave_sum(float v) {
#pragma unroll
    for (int o = 1; o < 64; o <<= 1) v += __shfl_xor(v, o);
    return v;
}
__device__ __forceinline__ unsigned pkbf(float lo, float hi) { return pg8::cvt_pk_bf16(lo, hi); }
__device__ __forceinline__ float bflo(unsigned w) { return __uint_as_float(w << 16); }
__device__ __forceinline__ float bfhi(unsigned w) { return __uint_as_float(w & 0xffff0000u); }

__device__ __forceinline__ int srccol(int which, int p) {
    if (which == 0) {
        const int t = p >> 8, w = p & 255;
        if (t < 4) return p;
        if (t < 12) return w < 128 ? 1024 + 128 * (t - 4) + w : 2624 + 128 * (t - 4) + (w - 128);
        if (t < 16) return 3648 + (p - 3072);
        if (t == 16) return 2048 + w;
        if (t == 17) return 2304 + w;
        return w < 64 ? 2560 + 4 * (w >> 3) + (w & 3) + 32 * ((w >> 2) & 1) : -1;
    }
    if (which == 1) {
        if (p < 1024) return (p >> 7) * 192 + (p & 127);
        const int q = p - 1024, h = q >> 6, u = q & 63;
        return h * 192 + 128 + 4 * (u >> 3) + (u & 3) + 32 * ((u >> 2) & 1);
    }
    return p;
}
__device__ __forceinline__ void tr_item(const float* W, int ldw, int K, int Nphys, const float* gain, bf16_t* WT, int which, LAS float* scr, int item, int lane, int ksrc0 = 0, int Ksrc = 1 << 30) {
    const int nblk = Nphys / 32, kb = item / nblk, nb = item % nblk, k0 = 64 * kb, n0 = 32 * nb;
    const int src = srccol(which, n0 + (lane & 31));
#pragma unroll 16
    for (int i = 0; i < 32; ++i) { const int kk = 2 * i + (lane >> 5); float v = 0.f;
        const int ks = k0 + kk - ksrc0;
        if (src >= 0 && ks >= 0 && ks < Ksrc) { v = __builtin_nontemporal_load(W + (size_t)ks * ldw + src); if (gain) v *= gain[k0 + kk]; }
        scr[kk * 33 + (lane & 31)] = v; }
    asm volatile("s_waitcnt lgkmcnt(0)" ::: "memory");
    const int c = lane & 7;
#pragma unroll
    for (int j = 0; j < 4; ++j) { const int n = (lane >> 3) + 8 * j; const LAS float* s = scr + (8 * c) * 33 + n;
        u32x4 o; o.x = pkbf(s[0 * 33], s[1 * 33]); o.y = pkbf(s[2 * 33], s[3 * 33]); o.z = pkbf(s[4 * 33], s[5 * 33]); o.w = pkbf(s[6 * 33], s[7 * 33]);
        *(u32x4*)(WT + (size_t)(n0 + n) * K + k0 + 8 * c) = o; }
    asm volatile("s_waitcnt lgkmcnt(0)" ::: "memory");
}
__device__ __forceinline__ void tr_item64(const float* W, int ldw, int K, int Nphys, const float* gain, bf16_t* WT, int which, int item, int lane, int ksrc0 = 0, int Ksrc = 1 << 30) {
    const int nblk = Nphys / 64, kb = item / nblk, nb = item % nblk, k0 = 64 * kb, n0 = 64 * nb;
    const int src = srccol(which, n0 + lane); const bool kin = (k0 - ksrc0 >= 0) && (k0 - ksrc0 < Ksrc);
    float v[64];
#pragma unroll
    for (int kk = 0; kk < 64; ++kk) v[kk] = (src >= 0 && kin) ? __builtin_nontemporal_load(W + (size_t)(k0 + kk - ksrc0) * ldw + src) : 0.f;
    if (gain) {
#pragma unroll
        for (int kk = 0; kk < 64; ++kk) v[kk] *= gain[k0 + kk];
    }
    bf16_t* o = WT + (size_t)(n0 + lane) * K + k0;
#pragma unroll
    for (int j = 0; j < 8; ++j) { u32x4 w; w.x = pkbf(v[8 * j], v[8 * j + 1]); w.y = pkbf(v[8 * j + 2], v[8 * j + 3]); w.z = pkbf(v[8 * j + 4], v[8 * j + 5]); w.w = pkbf(v[8 * j + 6], v[8 * j + 7]); *(u32x4*)(o + 8 * j) = w; }
}
__device__ __forceinline__ void sincos_d(double a, float& s, float& c) {
    const double n = rint(a * 0.63661977236758134308);
    const double r = (a - n * 1.57079632679489655800) - n * 6.123233995736766036e-17, r2 = r * r;
    double sp = -7.6471637318198164759e-13; sp = sp * r2 + 1.6059043836821614599e-10; sp = sp * r2 - 2.5052108385441718775e-08; sp = sp * r2 + 2.7557319223985890653e-06;
    sp = sp * r2 - 1.9841269841269841270e-04; sp = sp * r2 + 8.3333333333333333333e-03; sp = sp * r2 - 1.6666666666666666667e-01; sp = r + r * r2 * sp;
    double cp = 4.7794773323873852974e-14; cp = cp * r2 - 1.1470745597729724714e-11; cp = cp * r2 + 2.0876756987868098979e-09; cp = cp * r2 - 2.7557319223985890653e-07;
    cp = cp * r2 + 2.4801587301587301587e-05; cp = cp * r2 - 1.3888888888888888889e-03; cp = cp * r2 + 4.1666666666666666667e-02; cp = cp * r2 - 0.5; cp = 1.0 + r2 * cp;
    const int q = (int)((long long)n & 3);
    const double ss = (q & 1) ? cp : sp, cc = (q & 1) ? sp : cp;
    s = (float)((q & 2) ? -ss : ss); c = (float)(((q + 1) & 2) ? -cc : cc);
}

#ifdef DIAG
#define DCHK(code, got, want, rtol, atol) do { const float g_ = (got), w_ = (want); if (!(fabsf(g_ - w_) <= (rtol) * fabsf(w_) + (atol))) { atomicMin(DG, (unsigned)(code)); atomicOr(DG + 1, (code) < 50 ? 0u : (code) < 54 ? 1u : (code) < 60 ? 2u : (code) < 70 ? 4u : (code) < 80 ? 8u : 16u); } } while (0)
__device__ __forceinline__ unsigned dhash(unsigned x) { x ^= x >> 16; x *= 0x7feb352du; x ^= x >> 15; x *= 0x846ca68bu; x ^= x >> 16; return x; }
__device__ __forceinline__ float dbf(const bf16_t* p, size_t i) { return __uint_as_float((unsigned)p[i] << 16); }
__device__ __forceinline__ float dsig(float v) { return 1.0f / (1.0f + expf(-v)); }
__device__ __forceinline__ float ddot(const bf16_t* a, const bf16_t* b, int K) { float s = 0.f; for (int k = 0; k < K; ++k) s += dbf(a, k) * dbf(b, k); return s; }
#endif
#define XB_TMO      128
#define XB_XCNT(j)  (256  + 64 * (j))
#define XB_XSUB(j)  (1280 + 64 * (j))
#define XB_XGEN(j)  (2304 + 64 * (j))
#define XB_TOP      3328
#define XB_TOPGEN   3392
#define XCD_BAR_WORDS 3456
#define XB_SPIN_CAP (1u << 18)

__device__ __forceinline__ unsigned xb_ld(unsigned* p)              { return __hip_atomic_load(p, __ATOMIC_RELAXED, __HIP_MEMORY_SCOPE_AGENT); }
__device__ __forceinline__ unsigned xb_add(unsigned* p, unsigned v) { return __hip_atomic_fetch_add(p, v, __ATOMIC_RELAXED, __HIP_MEMORY_SCOPE_AGENT); }
__device__ __forceinline__ unsigned xb_xcc_id() { return (unsigned)__builtin_amdgcn_s_getreg((3 << 11) | 20) & 0xFu; }
#define XB_SPIN(cond, bar) do { unsigned _sp = 0; while (cond) { __builtin_amdgcn_s_sleep(1); \
    if ((++_sp & 255u) == 0u) { if (xb_ld(&(bar)[XB_TMO])) break; if (_sp > XB_SPIN_CAP) { atomicAdd(&(bar)[XB_TMO], 1u); break; } } } } while (0)

struct XcdBarrier {
    unsigned* bar; unsigned x;
    volatile LAS unsigned* st;
};

__device__ __forceinline__ XcdBarrier xcd_barrier_post(unsigned* bar, volatile LAS unsigned* st, const bool leader) {
    XcdBarrier b; b.bar = bar; b.x = xb_xcc_id(); b.st = st;
    if (leader) (void)xb_add(&bar[XB_XCNT(b.x)], 1u);
    return b;
}
__device__ __forceinline__ void xcd_barrier_complete(unsigned* bar, unsigned x, unsigned& nloc, unsigned& nx) {
    const unsigned G = gridDim.x * gridDim.y * gridDim.z;
    unsigned sum, cnt, mine, sp = 0u;
    for (;;) {
        sum = 0u; cnt = 0u; mine = 0u;
#pragma unroll
        for (unsigned j = 0; j < 16; ++j) { const unsigned c = xb_ld(&bar[XB_XCNT(j)]); sum += c; cnt += (c > 0u) ? 1u : 0u; mine = (j == x) ? c : mine; }
        if (sum == G) break;
        __builtin_amdgcn_s_sleep(1);
        if ((++sp & 255u) == 0u) { if (xb_ld(&bar[XB_TMO])) break; if (sp > XB_SPIN_CAP) { atomicAdd(&bar[XB_TMO], 1u); break; } }
    }
    nloc = mine > 0u ? mine : 1u; nx = cnt > 0u ? cnt : 1u;
}

__device__ __forceinline__ void xcd_barrier(const XcdBarrier& b, const bool leader) {
    asm volatile("s_waitcnt vmcnt(0)" ::: "memory");
    __syncthreads();
    if (leader) {
        unsigned* bar = b.bar;
        __builtin_amdgcn_s_waitcnt(0);
        unsigned nloc = b.st[0], nx = b.st[1];
        if (nloc == 0u) { xcd_barrier_complete(bar, b.x, nloc, nx); b.st[0] = nloc; b.st[1] = nx; }
        const unsigned old = xb_add(&bar[XB_XSUB(b.x)], 1u);
        const unsigned gen = old / nloc;
        if (old + 1u == (gen + 1u) * nloc) {
            __builtin_amdgcn_fence(__ATOMIC_RELEASE, "agent");
            asm volatile("s_waitcnt vmcnt(0)" ::: "memory");
            const unsigned og = xb_add(&bar[XB_TOP], 1u);
            const unsigned tg = og / nx;
            if (og + 1u == (tg + 1u) * nx) xb_add(&bar[XB_TOPGEN], 1u);
            else XB_SPIN(xb_ld(&bar[XB_TOPGEN]) == tg, bar);
            __builtin_amdgcn_fence(__ATOMIC_ACQUIRE, "agent");
            xb_add(&bar[XB_XGEN(b.x)], 1u);
            asm volatile("s_waitcnt vmcnt(0)" ::: "memory");
        } else {
            XB_SPIN(xb_ld(&bar[XB_XGEN(b.x)]) == gen, bar);
            __builtin_amdgcn_fence(__ATOMIC_ACQUIRE, "agent");
            asm volatile("s_waitcnt vmcnt(0)" ::: "memory");
        }
    }
    __syncthreads();
}

constexpr size_t WS_BAR = WS_CSP + 65536;
constexpr int LDS_BARW = 153600 - 64;
__global__ void __launch_bounds__(512, 2) fwd_kernel(Args args) {
    extern __shared__ __attribute__((aligned(16))) unsigned char lds[];
    cg::grid_group grid = cg::this_grid();
    const int wave_top = __builtin_amdgcn_readfirstlane((int)threadIdx.x >> 6);
    const int tid = threadIdx.x, lane = tid & 63, wave = wave_top;
    const int G = gridDim.x, gw = blockIdx.x * 8 + wave, NGW = G * 8; (void)tid; (void)lane; (void)gw;
    unsigned char* ws = args.ws;
    const int lo = args.ph_lo, hi = args.ph_hi;
#ifndef PHMASK
#define PHMASK 0x3ff
#endif
#define IN(k) (((PHMASK >> (k)) & 1) && lo <= (k) && (k) < hi)
#ifndef REPMASK
#define REPMASK 0
#endif
#define FRESH_IDS int lane_o_ = __builtin_amdgcn_mbcnt_hi(~0u, __builtin_amdgcn_mbcnt_lo(~0u, 0u)); asm volatile("" : "+v"(lane_o_)); const int lane = lane_o_, wave = wave_top, tid = wave * 64 + lane, gw = blockIdx.x * 8 + wave; (void)tid; (void)gw;
#define PLAIN_IDS int tid_o_ = threadIdx.x; asm volatile("" : "+v"(tid_o_)); const int tid = tid_o_, lane = tid & 63, wave = wave_top, gw = blockIdx.x * 8 + wave; (void)lane; (void)gw;
#define REP(k) for (int rep_ = 0; rep_ <= ((REPMASK >> (k)) & 1); ++rep_)
#ifdef TSTAMP
    unsigned long long* TS = (unsigned long long*)(ws + WS_CSP + 32768);
#define SEAM(k) do { if (IN(k) && IN((k) + 1)) grid.sync(); if (blockIdx.x == 0 && tid == 0) TS[(k) + 1] = __builtin_amdgcn_s_memrealtime(); } while (0)
    if (blockIdx.x == 0 && tid == 0) TS[0] = __builtin_amdgcn_s_memrealtime();
#else
#define SEAM(k) do { if (IN(k) && IN((k) + 1)) { if (lo < 0) grid.sync();   xcd_barrier(xbar, wave_top == 0 && __builtin_amdgcn_mbcnt_hi(~0u, __builtin_amdgcn_mbcnt_lo(~0u, 0u)) == 0u); } } while (0)
#endif
    const float* x = args.in[0];
    float* rstdx = (float*)(ws + WS_RSTDX); float* rstdq = (float*)(ws + WS_RSTDQ); float* rstdkv = (float*)(ws + WS_RSTDKV); float* csp = (float*)(ws + WS_CSP);
    float* SS1 = (float*)(ws + WS_SS1); float* SS2 = (float*)(ws + WS_SS2); float* CS = (float*)(ws + WS_CS);
    bf16_t* W1 = (bf16_t*)(ws + WS_W1); bf16_t* WUP = (bf16_t*)(ws + WS_WUP); bf16_t* WDN = (bf16_t*)(ws + WS_WDN); bf16_t* WOUT = (bf16_t*)(ws + WS_WOUT);
    bf16_t* WUQ = (bf16_t*)(ws + WS_WUQ); bf16_t* WUKV = (bf16_t*)(ws + WS_WUKV); bf16_t* WLRU = (bf16_t*)(ws + WS_WLRU);
    bf16_t* KR = (bf16_t*)(ws + WS_KR); bf16_t* G1 = (bf16_t*)(ws + WS_G1); bf16_t* G2 = (bf16_t*)(ws + WS_G2); bf16_t* ZC = (bf16_t*)(ws + WS_ZC);
    bf16_t* KV = (bf16_t*)(ws + WS_KV); bf16_t* XB = (bf16_t*)(ws + WS_XB); bf16_t* XA = (bf16_t*)(ws + WS_XA); bf16_t* YB = (bf16_t*)(ws + WS_YB);
    bf16_t* ZX = (bf16_t*)(ws + WS_ZX); bf16_t* Q = (bf16_t*)(ws + WS_Q); bf16_t* MG = (bf16_t*)(ws + WS_MG); bf16_t* H1B = (bf16_t*)(ws + WS_H1B); bf16_t* U = (bf16_t*)(ws + WS_U);
    float* SSQ = (float*)(ws + WS_SS2); float* SSKV = (float*)(ws + WS_SS2 + 512 * 1024);
    bf16_t* H2B = (bf16_t*)(ws + WS_H2B); float* SUM = (float*)(ws + WS_SUM); float* SUB = (float*)(ws + WS_SUB);
    unsigned* AB = (unsigned*)args.out; float* OUT = args.out;
    LAS unsigned char* ldsg = (LAS unsigned char*)lds;

    if (threadIdx.x < 2) ((volatile LAS unsigned*)(ldsg + LDS_BARW))[threadIdx.x] = 0u;
    __syncthreads();
    XcdBarrier xbar; xbar.bar = (unsigned*)(ws + WS_BAR); xbar.x = 0; xbar.st = nullptr;
    if (hi - lo > 1) xbar = xcd_barrier_post((unsigned*)(ws + WS_BAR), (volatile LAS unsigned*)(ldsg + LDS_BARW), threadIdx.x == 0);
#ifdef DIAG
    unsigned* DG = (unsigned*)(ws + WS_CSP + 8192); unsigned* SAVE = (unsigned*)(ws + WS_CSP + 16384);
    if (lo >= 100) {
        const int dk = lo - 100; const unsigned gid = blockIdx.x * 512 + tid, NT_ = G * 512;
        if (dk == 0) {
            for (unsigned s = gid; s < 65536; s += NT_) { const unsigned h = dhash(s * 7 + 1);
                { const int p = h % 4864, k = (h >> 13) % 1024, src = srccol(0, p); const float want = src < 0 ? 0.f : args.in[2][(size_t)k * 4672 + src] * args.in[1][k]; DCHK(1, dbf(W1, (size_t)p * 1024 + k), want, 0.01f, 1e-6f); }
                { const int p = h % 1536, k = (h >> 13) % 256; DCHK(2, dbf(WUQ, (size_t)p * 256 + k), args.in[11][(size_t)k * 1536 + srccol(1, p)] * args.in[10][k], 0.01f, 1e-6f); }
                { const int p = h % 2048, k = (h >> 13) % 256; DCHK(3, dbf(WUKV, (size_t)p * 256 + k), args.in[13][(size_t)k * 2048 + p] * args.in[12][k], 0.01f, 1e-6f); }
                { const int p = h % 2048, k = (h >> 13) % 256, nb = p >> 8, isx = (p >> 7) & 1, d = p & 127, kk = k - 128 * (nb & 1);
                  const float want = (kk >= 0 && kk < 128) ? (isx ? args.in[7] : args.in[5])[(size_t)nb * 16384 + kk * 128 + d] : 0.f; DCHK(4, dbf(WLRU, (size_t)p * 256 + k), want, 0.01f, 1e-6f); }
                { const int p = h % 1024, k = (h >> 13) % 1024; DCHK(5, dbf(WOUT, (size_t)p * 1024 + k), args.in[14][(size_t)k * 1024 + p], 0.01f, 1e-6f); }
                { const int p = h % 4096, k = (h >> 13) % 1024; DCHK(6, dbf(WUP, (size_t)p * 1024 + k), args.in[16][(size_t)k * 4096 + p] * args.in[15][k], 0.01f, 1e-6f); }
                { const int p = h % 1024, k = (h >> 13) % 4096; DCHK(7, dbf(WDN, (size_t)p * 4096 + k), args.in[17][(size_t)k * 1024 + p], 0.01f, 1e-6f); }
                { const int r = h % T, c = (h >> 15) % 1024; DCHK(8, dbf(XB, (size_t)r * 1024 + c), x[(size_t)r * 1024 + c], 0.01f, 1e-6f); }
                { const int pos = h % 8191, i = (h >> 13) & 31; const float c0 = CS[(pos * 32 + i) * 2], s0 = CS[(pos * 32 + i) * 2 + 1], c1 = CS[((pos + 1) * 32 + i) * 2], s1 = CS[((pos + 1) * 32 + i) * 2 + 1], cd = CS[(32 + i) * 2], sd = CS[(32 + i) * 2 + 1];
                  DCHK(9, c1, c0 * cd - s0 * sd, 0.f, 1e-5f); DCHK(9, s1, s0 * cd + c0 * sd, 0.f, 1e-5f); DCHK(9, cd, __cosf(powf(10000.f, -(float)i / 32.f)), 0.f, 1e-4f); DCHK(9, CS[i * 2], 1.0f, 0.f, 1e-6f); }
            }
            for (unsigned s = gid; s < 4096; s += NT_) { const int r = dhash(s) % T; float q = 0.f; for (int c = 0; c < 1024; ++c) q += x[(size_t)r * 1024 + c] * x[(size_t)r * 1024 + c]; DCHK(8, rstdx[r], 1.0f / sqrtf(q / 1024.f + 1e-6f), 1e-3f, 0.f); }
        }
        if (dk == 1) for (unsigned s = gid; s < 32768; s += NT_) { const unsigned h = dhash(s * 3 + 11); const int r = h % T, p = (h >> 15) % 4864, t = p >> 8, w = p & 255;
            const float z = ddot(XB + (size_t)r * 1024, W1 + (size_t)p * 1024, 1024) * rstdx[r];
            if (t < 4) DCHK(11, dbf(ZX, (size_t)r * 1024 + p), z, 0.02f, 0.02f);
            else if (t < 12) { if (w < 128) { const float z2 = ddot(XB + (size_t)r * 1024, W1 + (size_t)(p + 128) * 1024, 1024) * rstdx[r];
                const float ge = 0.5f * z * (1.f + tanhf(0.7978845608f * (z + 0.044715f * z * z * z))); DCHK(12, dbf(G1, (size_t)r * 1024 + (t - 4) * 128 + w), ge * dsig(z2), 0.03f, 0.02f); } }
            else if (t < 16) DCHK(13, dbf(G2, (size_t)r * 1024 + p - 3072), dsig(z), 0.02f, 0.01f);
            else DCHK(14, dbf(ZC, (size_t)r * 768 + p - 4096), z, 0.02f, 0.02f); }
        if (dk == 2) for (unsigned s = gid; s < 65536; s += NT_) { const unsigned h = dhash(s * 5 + 3); const int r = (s & 1) ? (h % T) : ((h % 4) * 8192 + (h >> 8) % 6), c = (h >> 15) % 1024, pos = r & 8191;
            float v = args.in[4][c]; for (int j = 0; j < 4; ++j) if (pos - 3 + j >= 0) v += args.in[3][j * 1024 + c] * dbf(ZX, (size_t)(r - 3 + j) * 1024 + c);
            DCHK(21, dbf(XA, (size_t)r * 1024 + c), v, 0.02f, 0.02f);
            if (c < 64) { const int u = c, i = 4 * (u >> 3) + (u & 3), hf = (u >> 2) & 1; const float kl = dbf(ZC, (size_t)r * 768 + 512 + i), kh = dbf(ZC, (size_t)r * 768 + 512 + i + 32), cc = CS[(pos * 32 + i) * 2], ss = CS[(pos * 32 + i) * 2 + 1];
                DCHK(23, dbf(KR, (size_t)r * 64 + u), hf ? kh * cc + kl * ss : kl * cc - kh * ss, 0.02f, 0.02f); }
            if (c == 100) { float q = 0.f, k2 = 0.f; for (int j = 0; j < 256; ++j) { const float a = dbf(ZC, (size_t)r * 768 + j), b = dbf(ZC, (size_t)r * 768 + 256 + j); q += a * a; k2 += b * b; }
                DCHK(22, rstdq[r], 1.0f / sqrtf(q / 256.f + 1e-6f), 1e-3f, 0.f); DCHK(22, rstdkv[r], 1.0f / sqrtf(k2 / 256.f + 1e-6f), 1e-3f, 0.f); } }
        if (dk == 3) for (unsigned s = gid; s < 65536; s += NT_) { const unsigned h = dhash(s * 9 + 5); const int r = h % T, pos = r & 8191;
            { const int c = (h >> 15) % 1024, nb = c >> 7, d = c & 127; float dr = args.in[6][c], di = args.in[8][c];
              for (int k = 0; k < 128; ++k) { const float xv = dbf(XA, (size_t)r * 1024 + nb * 128 + k); dr += xv * args.in[5][(size_t)nb * 16384 + k * 128 + d]; di += xv * args.in[7][(size_t)nb * 16384 + k * 128 + d]; }
              const float rr_ = dsig(dr), ii = dsig(di), la = -8.0f * rr_ * log1pf(expf(-args.in[9][c])), bb = sqrtf(-expm1f(2.f * la)) * ii * dbf(XA, (size_t)r * 1024 + c);
              const pg8::h16x2 pv_ = __builtin_bit_cast(pg8::h16x2, AB[(size_t)r * 1024 + c]);
              DCHK(31, (float)pv_.x, la * 1.4426950408889634f, 0.03f, 1e-5f); DCHK(32, (float)pv_.y, bb, 0.03f, 0.01f); }
            { const int p = (h >> 13) % 1536; const float z = ddot(ZC + (size_t)r * 768, WUQ + (size_t)p * 256, 256) * rstdq[r];
              if (p < 1024) DCHK(33, dbf(Q, (size_t)r * 1536 + p), z, 0.02f, 0.02f);
              else { const int u = (p - 1024) & 63, i = 4 * (u >> 3) + (u & 3), islo = (u & 4) == 0; const float z2 = ddot(ZC + (size_t)r * 768, WUQ + (size_t)(p ^ 4) * 256, 256) * rstdq[r];
                  const float cc = CS[(pos * 32 + i) * 2], ss = CS[(pos * 32 + i) * 2 + 1]; DCHK(34, dbf(Q, (size_t)r * 1536 + p), islo ? z * cc - z2 * ss : z * cc + z2 * ss, 0.02f, 0.03f); } }
            { const int p = (h >> 11) % 2048; DCHK(35, dbf(KV, (size_t)r * 2048 + p), ddot(ZC + (size_t)r * 768 + 256, WUKV + (size_t)p * 256, 256) * rstdkv[r], 0.02f, 0.02f); } }
        if (dk == 3) for (unsigned s = gid; s < 4096; s += NT_) SAVE[s] = AB[dhash(s * 41 + 3) % (unsigned)(T * 1024)];
        if (dk == 4) {
            float* SC = (float*)(ws + WS_ZC + 9 * MiB);
            for (int s = gw; s < 1024; s += NGW) { const unsigned h = dhash(s * 13 + 7); const int b = h & 3, hd = (h >> 2) & 7, pos = (s & 3) == 0 ? (int)((h >> 5) % 300) : (int)((h >> 5) % 8192); const size_t r = (size_t)b * 8192 + pos;
                float* sc = SC + (size_t)s * 8192; float mx = -1e30f;
                for (int j = lane; j <= pos; j += 64) { const size_t kr = (size_t)b * 8192 + j; float d = 0.f;
                    for (int e = 0; e < 128; ++e) d += dbf(Q, r * 1536 + hd * 128 + e) * dbf(KV, kr * 2048 + hd * 256 + e);
                    for (int e = 0; e < 64; ++e) d += dbf(Q, r * 1536 + 1024 + hd * 64 + e) * dbf(KR, kr * 64 + e);
                    d *= 0.07216878364870322f; sc[j] = d; mx = fmaxf(mx, d); }
                for (int o = 1; o < 64; o <<= 1) mx = fmaxf(mx, __shfl_xor(mx, o));
                __builtin_amdgcn_fence(__ATOMIC_RELEASE, "workgroup"); __builtin_amdgcn_s_waitcnt(0);
                float l = 0.f, o0 = 0.f, o1 = 0.f;
                for (int j = 0; j <= pos; ++j) { const float p = expf(__builtin_nontemporal_load(sc + j) - mx); const size_t kr = (size_t)b * 8192 + j; l += p; o0 += p * dbf(KV, kr * 2048 + hd * 256 + 128 + lane); o1 += p * dbf(KV, kr * 2048 + hd * 256 + 192 + lane); }
                DCHK(41, dbf(YB, r * 1024 + hd * 128 + lane), o0 / l, 0.03f, 0.01f); DCHK(41, dbf(YB, r * 1024 + hd * 128 + 64 + lane), o1 / l, 0.03f, 0.01f); } }
        if (dk == 5) for (unsigned s = gid; s < 4096; s += NT_) if (SAVE[s] != AB[dhash(s * 41 + 3) % (unsigned)(T * 1024)]) atomicMin(DG, 48u);
        if (dk == 5) for (unsigned s = gid; s < 8192; s += NT_) { const unsigned h = dhash(s * 17 + 9); const int b = h & 3, c = (h >> 2) % 1024, pos = (s & 3) == 0 ? (int)((h >> 12) % 32) : (s & 3) == 1 ? (int)((h >> 12) % 256) : (int)((h >> 12) % 8192); float hh = 0.f, LL = 0.f;
            for (int j = 0; j <= pos; ++j) { const pg8::h16x2 pv_ = __builtin_bit_cast(pg8::h16x2, AB[((size_t)b * 8192 + j) * 1024 + c]); hh = exp2f((float)pv_.x) * hh + (float)pv_.y; LL += (float)pv_.x;
                if ((j & 31) == 31 && (j >> 5) == (pos >> 5) - 0 && false) {} }
            const size_t o = ((size_t)b * 8192 + pos) * 1024 + c; const int code = pos < 32 ? 51 : pos < 256 ? 52 : 53;
            DCHK(code, dbf(MG, o), dbf(G1, o) * hh + dbf(G2, o) * dbf(YB, o), 0.03f, 0.01f);
            { const int sc_ = (h >> 12) % 256; float h2 = 0.f, L2 = 0.f; for (int j = sc_ * 32; j < sc_ * 32 + 32; ++j) { const pg8::h16x2 pv_ = __builtin_bit_cast(pg8::h16x2, AB[((size_t)b * 8192 + j) * 1024 + c]); h2 = exp2f((float)pv_.x) * h2 + (float)pv_.y; L2 += (float)pv_.x; }
              DCHK(54, SUB[(((size_t)b * 256 + sc_) * 1024 + c) * 2], L2, 1e-3f, 1e-5f); DCHK(55, SUB[(((size_t)b * 256 + sc_) * 1024 + c) * 2 + 1], h2, 1e-3f, 1e-4f); }
            { const int kc = (h >> 12) % 32; float h2 = 0.f, L2 = 0.f; for (int j = kc * 256; j < kc * 256 + 256; ++j) { const pg8::h16x2 pv_ = __builtin_bit_cast(pg8::h16x2, AB[((size_t)b * 8192 + j) * 1024 + c]); h2 = exp2f((float)pv_.x) * h2 + (float)pv_.y; L2 += (float)pv_.x; }
              DCHK(56, SUM[(((size_t)b * 32 + kc) * 1024 + c) * 2], L2, 1e-3f, 1e-5f); DCHK(57, SUM[(((size_t)b * 32 + kc) * 1024 + c) * 2 + 1], h2, 1e-3f, 1e-4f); } }
        if (dk == 6) for (unsigned s = gid; s < 32768; s += NT_) { const unsigned h = dhash(s * 19 + 1); const int r = h % T, c = (h >> 15) % 1024;
            const float v = x[(size_t)r * 1024 + c] + ddot(MG + (size_t)r * 1024, WOUT + (size_t)c * 1024, 1024); DCHK(61, OUT[(size_t)r * 1024 + c], v, 0.02f, 0.02f); DCHK(62, dbf(H1B, (size_t)r * 1024 + c), v, 0.02f, 0.02f);
            if (c == 7) { float q = 0.f, q2 = 0.f; for (int j = 0; j < 1024; ++j) q += OUT[(size_t)r * 1024 + j] * OUT[(size_t)r * 1024 + j]; for (int j = 0; j < 16; ++j) q2 += SS1[(size_t)r * 16 + j]; DCHK(63, q2, q, 1e-3f, 0.f); } }
        if (dk == 7) for (unsigned s = gid; s < 32768; s += NT_) { const unsigned h = dhash(s * 23 + 1); const int r = h % T, c = (h >> 15) % 4096; float q2 = 0.f; for (int j = 0; j < 16; ++j) q2 += SS1[(size_t)r * 16 + j];
            const float u_ = ddot(H1B + (size_t)r * 1024, WUP + (size_t)c * 1024, 1024) / sqrtf(q2 / 1024.f + 1e-6f), rl = fmaxf(u_, 0.f); DCHK(71, dbf(U, (size_t)r * 4096 + c), rl * rl, 0.03f, 0.02f); }
        if (dk == 8) for (unsigned s = gid; s < 16384; s += NT_) { const unsigned h = dhash(s * 29 + 1); const int r = h % T, c = (h >> 15) % 1024;
            const float v = dbf(H1B, (size_t)r * 1024 + c) + ddot(U + (size_t)r * 4096, WDN + (size_t)c * 4096, 4096); DCHK(81, OUT[(size_t)r * 1024 + c], v, 0.02f, 0.04f);
            if (c == 7) { float q = 0.f, q2 = 0.f; for (int j = 0; j < 1024; ++j) q += OUT[(size_t)r * 1024 + j] * OUT[(size_t)r * 1024 + j]; for (int j = 0; j < 16; ++j) q2 += SS2[(size_t)r * 16 + j]; DCHK(82, q2, q, 1e-3f, 0.f); } }
        if (dk == 9) { for (unsigned s = gid; s < 4096; s += NT_) { const int r = dhash(s * 31) % T; float q = 0.f; for (int j = 0; j < 1024; ++j) { const float v = OUT[(size_t)r * 1024 + j] / args.in[18][j]; q += v * v; } DCHK(91, q / 1024.f, 1.0f, 0.01f, 0.f); } }
        if (dk == 10) { if (gid == 0) { const unsigned code = *DG; if (code < 1000u) OUT[0] = 100.0f + 10.0f * (float)code; OUT[1] = 10000.0f * (1.0f + (float)DG[1]); } }
        return;
    }
#endif
    if (IN(0)) REP(0) { PLAIN_IDS
        LAS float* scr = (LAS float*)(ldsg + wave * 16384);
        constexpr int I_W1 = 16 * (4864 / 64), I_UP = 16 * (4096 / 64), I_DN = 64 * (1024 / 64), I_OUT = 16 * 16, I_UQ = 4 * (1536 / 64), I_UKV = 4 * (2048 / 64), I_LRU = 16 * 8;
        constexpr int NITEMS = I_W1 + I_UP + I_DN + I_OUT + I_UQ + I_UKV + I_LRU;
        const int gw4 = gw, NGW4 = NGW;
        {
        for (int m0 = gw4 * 4; m0 < T; m0 += NGW4 * 4) {
            f32x4 v[4][4];
#pragma unroll
            for (int r = 0; r < 4; ++r) { const f32x4* xr = (const f32x4*)(x + (size_t)(m0 + r) * DM) + lane;
#pragma unroll
                for (int j = 0; j < 4; ++j) v[r][j] = __builtin_nontemporal_load(xr + 64 * j); }
#pragma unroll
            for (int r = 0; r < 4; ++r) { float s = 0.f;
#pragma unroll
                for (int j = 0; j < 4; ++j) s += (v[r][j][0] * v[r][j][0] + v[r][j][1] * v[r][j][1]) + (v[r][j][2] * v[r][j][2] + v[r][j][3] * v[r][j][3]);
                s = wave_sum(s);
                if (lane == 0) rstdx[m0 + r] = rsqrtf(s * (1.0f / 1024.0f) + 1e-6f);
                u32x2* o = (u32x2*)(XB + (size_t)(m0 + r) * DM) + lane;
#pragma unroll
                for (int j = 0; j < 4; ++j) { u32x2 w; w.x = pkbf(v[r][j][0], v[r][j][1]); w.y = pkbf(v[r][j][2], v[r][j][3]); o[64 * j] = w; } }
        }
        }
        {
        for (int it = gw4; it < NITEMS; it += NGW4) {
            int r = it;
            if (r < I_W1) { tr_item64(args.in[2], 4672, 1024, 4864, args.in[1], W1, 0, r, lane); continue; } r -= I_W1;
            if (r < I_UP) { tr_item64(args.in[16], 4096, 1024, 4096, args.in[15], WUP, 2, r, lane); continue; } r -= I_UP;
            if (r < I_DN) { tr_item64(args.in[17], 1024, 4096, 1024, nullptr, WDN, 2, r, lane); continue; } r -= I_DN;
            if (r < I_OUT) { tr_item64(args.in[14], 1024, 1024, 1024, nullptr, WOUT, 2, r, lane); continue; } r -= I_OUT;
            if (r < I_UQ) { tr_item64(args.in[11], 1536, 256, 1536, args.in[10], WUQ, 1, r, lane); continue; } r -= I_UQ;
            if (r < I_UKV) { tr_item64(args.in[13], 2048, 256, 2048, args.in[12], WUKV, 2, r, lane); continue; } r -= I_UKV;
            { const int blk = r >> 3, sub = r & 7, nb = blk >> 1, isx = blk & 1;
              tr_item64((isx ? args.in[7] : args.in[5]) + (size_t)nb * 16384, 128, 256, 128, nullptr, WLRU + (size_t)(256 * nb + 128 * isx) * 256, 2, sub, lane, 128 * (nb & 1), 128); }
        }
        for (int i = blockIdx.x * 512 + tid; i < SEQ * 32; i += G * 512) {
            const int pos = i >> 5, k = i & 31; double inv = 1.0; for (int q = 0; q < k; ++q) inv *= 0.74989420933245582730;
            float s, c; sincos_d((double)pos * inv, s, c); CS[2 * i] = c; CS[2 * i + 1] = s;
        }
        for (int i = blockIdx.x * 512 + tid; i < 1024; i += G * 512) csp[i] = 8.0f * 1.4426950408889634f * log1pf(__expf(-args.in[9][i]));
            }
    }
    SEAM(0);

    if (IN(1)) REP(1) { PLAIN_IDS
        pg8::Gemm g{XB, W1, T, 4864, 1024, 1024, 1024, 0, 0}; pg8::StaticOrder S; S.init(T, 4864, G, (int)blockIdx.x);
        pg8::EpiIn E{ZX, G1, G2, ZC, rstdx, SSQ, SSKV, KR, CS};
        pg8::gemm_phase<pg8::EpiIn, pg8::StaticOrder, true, true>(ldsg, g, S, E, tid);
    }
    SEAM(1);

    if (IN(2)) REP(2) { PLAIN_IDS
        const float* cw = args.in[3]; const float* cb = args.in[4];
        for (int it = gw; it < (T / 16) * 2; it += NGW) {
            const int t0 = (it >> 1) * 16, c0 = (it & 1) * 512 + lane * 8;
            float w[4][8], bias[8], h0[8], h1[8], h2[8];
#pragma unroll
            for (int j = 0; j < 4; ++j) { const f32x4 a = *(const f32x4*)(cw + j * 1024 + c0), b = *(const f32x4*)(cw + j * 1024 + c0 + 4);
#pragma unroll
                for (int e = 0; e < 4; ++e) { w[j][e] = a[e]; w[j][4 + e] = b[e]; } }
            { const f32x4 a = *(const f32x4*)(cb + c0), b = *(const f32x4*)(cb + c0 + 4);
#pragma unroll
              for (int e = 0; e < 4; ++e) { bias[e] = a[e]; bias[4 + e] = b[e]; } }
            const bool first = (t0 & (SEQ - 1)) == 0;
            { u32x4 r0 = {0u, 0u, 0u, 0u}, r1 = r0, r2 = r0;
              if (!first) { r0 = *(const u32x4*)(ZX + (size_t)(t0 - 3) * DM + c0); r1 = *(const u32x4*)(ZX + (size_t)(t0 - 2) * DM + c0); r2 = *(const u32x4*)(ZX + (size_t)(t0 - 1) * DM + c0); }
#pragma unroll
              for (int e = 0; e < 4; ++e) { h0[2 * e] = bflo(r0[e]); h0[2 * e + 1] = bfhi(r0[e]); h1[2 * e] = bflo(r1[e]); h1[2 * e + 1] = bfhi(r1[e]); h2[2 * e] = bflo(r2[e]); h2[2 * e + 1] = bfhi(r2[e]); } }
            u32x4 rows[16];
#pragma unroll
            for (int i = 0; i < 16; ++i) rows[i] = __builtin_nontemporal_load((const u32x4*)(ZX + (size_t)(t0 + i) * DM + c0));
#pragma unroll
            for (int i = 0; i < 16; ++i) { const u32x4 r = rows[i]; float cur[8], o[8];
#pragma unroll
                for (int e = 0; e < 4; ++e) { cur[2 * e] = bflo(r[e]); cur[2 * e + 1] = bfhi(r[e]); }
#pragma unroll
                for (int e = 0; e < 8; ++e) { o[e] = bias[e] + w[0][e] * h0[e] + w[1][e] * h1[e] + w[2][e] * h2[e] + w[3][e] * cur[e]; h0[e] = h1[e]; h1[e] = h2[e]; h2[e] = cur[e]; }
                u32x4 ow; ow.x = pkbf(o[0], o[1]); ow.y = pkbf(o[2], o[3]); ow.z = pkbf(o[4], o[5]); ow.w = pkbf(o[6], o[7]);
                *(u32x4*)(XA + (size_t)(t0 + i) * DM + c0) = ow; }
        }
    }
    SEAM(2);

    if (IN(3)) REP(3) { PLAIN_IDS
#ifndef P3SEL
#define P3SEL 7
#endif
        if (P3SEL & 1) { pg8::Gemm g{XA, WLRU, T, 2048, 256, 1024, 256, 512, 1}; pg8::StaticOrder S; S.init(T, 2048, G, (int)blockIdx.x);
#ifdef TESTLRU
          pg8::EpiRowScale E{KV, 2048, SSKV};
          pg8::gemm_phase<pg8::EpiRowScale, pg8::StaticOrder, true, true>(ldsg, g, S, E, tid); }
#else
          pg8::EpiLru E{XA, args.in[6], args.in[8], csp, AB};
          pg8::gemm_phase<pg8::EpiLru, pg8::StaticOrder, true, true>(ldsg, g, S, E, tid); }
#endif
        if (P3SEL & 2) { pg8::Gemm g{ZC, WUQ, T, 1536, 256, 768, 256, 0, 0}; pg8::StaticOrder S; S.init(T, 1536, G, (int)blockIdx.x);
          pg8::EpiQ E{Q, SSQ, CS};
          pg8::gemm_phase<pg8::EpiQ, pg8::StaticOrder, true, true>(ldsg, g, S, E, tid); }
        if (P3SEL & 4) { pg8::Gemm g{ZC + 256, WUKV, T, 2048, 256, 768, 256, 0, 0}; pg8::StaticOrder S; S.init(T, 2048, G, (int)blockIdx.x);
          pg8::EpiRowScale E{KV, 2048, SSKV};
          pg8::gemm_phase<pg8::EpiRowScale, pg8::StaticOrder, true, true>(ldsg, g, S, E, tid); }
    }
    SEAM(3);

    if (IN(4)) REP(4) { FRESH_IDS
        for (int un = blockIdx.x; un < 256; un += G) {
            const int b = un >> 6, ch = un & 63, c = wave * 128 + lane * 2;
            const unsigned* ap = AB + ((size_t)b * SEQ + ch * 128) * DM + c;
            float h0 = 0.f, h1 = 0.f, L0 = 0.f, L1 = 0.f;
            for (int i0 = 0; i0 < 128; i0 += 16) { h16x4 w[16];
#pragma unroll
                for (int i = 0; i < 16; ++i) w[i] = __builtin_nontemporal_load((const h16x4*)(ap + (size_t)(i0 + i) * DM));
#pragma unroll
                for (int i = 0; i < 16; ++i) { const float l0 = (float)w[i][0], l1 = (float)w[i][2];
                    h0 = __builtin_amdgcn_exp2f(l0) * h0 + (float)w[i][1]; h1 = __builtin_amdgcn_exp2f(l1) * h1 + (float)w[i][3]; L0 += l0; L1 += l1; } }
            *(f32x4*)(SUM + (((size_t)b * 64 + ch) * 1024 + c) * 2) = (f32x4){L0, h0, L1, h1};
        }
        {
            constexpr int NITEM = 32 * 16;
#define ITEM_BH(LL) (G == 256 ? (((LL) & 7) + 8 * (2 * ((LL) >> 8) + (((LL) >> 7) & 1))) : ((LL) >> 4))
#define ITEM_X(LL)  (G == 256 ? (((LL) >> 3) & 15) : ((LL) & 15))
            int L = blockIdx.x;
            if (L < NITEM) {
                att::Seam S; int pass = 0;
#define MKREF(r, LL, ps) do { const int bh_ = ITEM_BH(LL), xx_ = ITEM_X(LL), qb_ = (ps) ? 31 - xx_ : xx_, b_ = bh_ >> 3, h_ = bh_ & 7; \
                    const size_t row0_ = (size_t)b_ * SEQ + qb_ * 256, key0_ = (size_t)b_ * SEQ; \
                    r.Qn = Q + row0_ * 1536 + h_ * 128; r.Qr = Q + row0_ * 1536 + 1024 + h_ * 64; r.Kn = KV + key0_ * 2048 + h_ * 256; r.V = r.Kn + 128; r.Kr = KR + key0_ * 64; \
                    r.O = YB + row0_ * 1024 + h_ * 128; r.P0 = qb_ * 256; } while (0)
                att::BlockRef cur, nxt; MKREF(cur, L, 0);
                att::attn_prime(cur, (char*)lds, S, tid);
                for (;;) {
                    const bool more_pass = pass == 0, more_item = L + G < NITEM, last = !more_pass && !more_item;
                    int passn = pass + 1, Ln = L;
                    if (!more_pass) { passn = 0; Ln = more_item ? L + G : L; }
                    MKREF(nxt, Ln, passn);
                    att::attn_block(cur, nxt, (char*)lds, S, tid);
                    if (last) break;
                    cur = nxt; pass = passn; L = Ln;
                }
            }
#undef MKREF
#undef ITEM_BH
#undef ITEM_X
        }
    }
    SEAM(4);

    if (IN(5)) REP(5) { FRESH_IDS
        for (int gi = blockIdx.x; gi < 256; gi += G) {
            const int b = gi >> 6, ch = gi & 63, c = wave * 128 + lane * 2;
            float h0 = 0.f, h1 = 0.f;
            for (int k0 = 0; k0 < ch; k0 += 8) { f32x4 sv[8];
#pragma unroll
                for (int j = 0; j < 8; ++j) { const int kk = (k0 + j < 63) ? k0 + j : 63; sv[j] = *(const f32x4*)(SUM + (((size_t)b * 64 + kk) * 1024 + c) * 2); }
#pragma unroll
                for (int j = 0; j < 8; ++j) if (k0 + j < ch) { h0 = __builtin_amdgcn_exp2f(sv[j][0]) * h0 + sv[j][1]; h1 = __builtin_amdgcn_exp2f(sv[j][2]) * h1 + sv[j][3]; } }
            const size_t row0 = (size_t)b * SEQ + ch * 128;
            for (int i0 = 0; i0 < 128; i0 += 32) { h16x4 w[32]; unsigned g1[32], g2[32], yb[32];
#pragma unroll
                for (int i = 0; i < 32; ++i) { const size_t off = (row0 + i0 + i) * DM + c;
                    w[i] = __builtin_nontemporal_load((const h16x4*)(AB + off)); g1[i] = __builtin_nontemporal_load((const unsigned*)(G1 + off)); g2[i] = __builtin_nontemporal_load((const unsigned*)(G2 + off)); yb[i] = __builtin_nontemporal_load((const unsigned*)(YB + off)); }
#pragma unroll
                for (int i = 0; i < 32; ++i) { const size_t off = (row0 + i0 + i) * DM + c;
                    h0 = __builtin_amdgcn_exp2f((float)w[i][0]) * h0 + (float)w[i][1]; h1 = __builtin_amdgcn_exp2f((float)w[i][2]) * h1 + (float)w[i][3];
                    *(unsigned*)(MG + off) = pkbf(bflo(g1[i]) * h0 + bflo(g2[i]) * bflo(yb[i]), bfhi(g1[i]) * h1 + bfhi(g2[i]) * bfhi(yb[i])); } }
        }
    }
    SEAM(5);

    if (IN(6)) REP(6) { FRESH_IDS
        pg8::Gemm g{MG, WOUT, T, 1024, 1024, 1024, 1024, 0, 0}; pg8::StaticOrder S; S.init(T, 1024, G, (int)blockIdx.x);
        pg8::EpiRes<true> E{x, nullptr, H1B, SS1};
        pg8::gemm_phase<pg8::EpiRes<true>, pg8::StaticOrder, true, true>(ldsg, g, S, E, tid);
    }
    SEAM(6);

    if (IN(7)) REP(7) { FRESH_IDS
        pg8::Gemm g{H1B, WUP, T, 4096, 1024, 1024, 1024, 0, 0}; pg8::StaticOrder S; S.init(T, 4096, G, (int)blockIdx.x);
        pg8::EpiUp E{U, SS1};
        pg8::gemm_phase<pg8::EpiUp, pg8::StaticOrder, true, true>(ldsg, g, S, E, tid);
    }
    SEAM(7);

    if (IN(8)) REP(8) { FRESH_IDS
        pg8::Gemm g{U, WDN, T, 1024, 4096, 4096, 4096, 0, 0}; pg8::StaticOrder S; S.init(T, 1024, G, (int)blockIdx.x);
        pg8::EpiRes<false> E{nullptr, H1B, H2B, SS2};
        pg8::gemm_phase<pg8::EpiRes<false>, pg8::StaticOrder, true, true>(ldsg, g, S, E, tid);
    }
    SEAM(8);

    if (IN(9)) REP(9) { FRESH_IDS
        const float* gf = args.in[18];
        f32x4 gv[4];
#pragma unroll
        for (int j = 0; j < 4; ++j) gv[j] = ((const f32x4*)gf)[lane + 64 * j];
        for (int m0 = gw * 4; m0 < T; m0 += NGW * 4) {
            f32x4 v[4][4]; float rs[4];
#pragma unroll
            for (int r = 0; r < 4; ++r) { const u32x2* o = (const u32x2*)(H2B + (size_t)(m0 + r) * DM) + lane;
#pragma unroll
                for (int j = 0; j < 4; ++j) { const u32x2 bw = __builtin_nontemporal_load(o + 64 * j); v[r][j] = (f32x4){bflo(bw.x), bfhi(bw.x), bflo(bw.y), bfhi(bw.y)}; }
                const f32x4* sp = (const f32x4*)(SS2 + (size_t)(m0 + r) * 16); const f32x4 s = (sp[0] + sp[1]) + (sp[2] + sp[3]);
                rs[r] = rsqrtf(((s[0] + s[1]) + (s[2] + s[3])) * (1.0f / 1024.0f) + 1e-6f); }
#pragma unroll
            for (int r = 0; r < 4; ++r) { f32x4* o = (f32x4*)(OUT + (size_t)(m0 + r) * DM) + lane;
#pragma unroll
                for (int j = 0; j < 4; ++j) __builtin_nontemporal_store(v[r][j] * rs[r] * gv[j], o + 64 * j); }
        }
    }
#ifdef TSTAMP
    grid.sync();
    if (blockIdx.x == 0 && tid == 0) TS[10] = __builtin_amdgcn_s_memrealtime();
    __threadfence(); grid.sync();
    { const float da = (float)(TS[TSTAMP_A + 1] - TS[TSTAMP_A]) * 0.01f, db = (float)(TS[TSTAMP_B + 1] - TS[TSTAMP_B]) * 0.01f;
      for (size_t i = (size_t)blockIdx.x * 512 + tid; i < ((size_t)1 << 22); i += (size_t)G * 512) OUT[i] = (i == 0) ? 10.0f * da : db; }
#endif
#undef IN
#undef SEAM
}

constexpr int LDS_TOTAL = 153600;
static_assert(att::LDS_BYTES <= LDS_TOTAL && pg8::STAGE_BYTES <= LDS_TOTAL, "LDS");
extern "C" void kernel_launch(void* const* d_in, const int* in_sizes, int n_in, void* d_out, int out_size, void* d_ws, size_t ws_size, hipStream_t stream) {
    static int grid = 0;
    if (grid == 0) {
        if (n_in != 19 || out_size != T * DM || ws_size < WS_END) { fprintf(stderr, "kernel_launch: unexpected shapes (n_in %d, out %d, ws %zu)\n", n_in, out_size, ws_size); grid = -1; return; }
        int dev = 0, cus = 0, per_cu = 0;
        (void)hipGetDevice(&dev); (void)hipDeviceGetAttribute(&cus, hipDeviceAttributeMultiprocessorCount, dev);
        if (hipFuncSetAttribute((const void*)fwd_kernel, hipFuncAttributeMaxDynamicSharedMemorySize, LDS_TOTAL) != hipSuccess) { fprintf(stderr, "kernel_launch: hipFuncSetAttribute failed\n"); grid = -1; return; }
        if (hipOccupancyMaxActiveBlocksPerMultiprocessor(&per_cu, (const void*)fwd_kernel, 512, LDS_TOTAL) != hipSuccess || per_cu < 1) { fprintf(stderr, "kernel_launch: occupancy query says %d\n", per_cu); per_cu = 1; }
        (void)hipGetLastError();
        grid = cus * 1;
        if (grid <= 0) grid = 256;
    }
    if (grid < 0) return;
    Args a{};
    for (int i = 0; i < 19; ++i) a.in[i] = (const float*)d_in[i];
    a.out = (float*)d_out; a.ws = (unsigned char*)d_ws;
#if N_LAUNCHES == 1
    a.ph_lo = 0; a.ph_hi = NPHASE;
    (void)hipMemsetAsync((unsigned char*)d_ws + WS_BAR, 0, 16384, stream);
    void* kargs[] = {&a};
    hipError_t e = hipLaunchCooperativeKernel((const void*)fwd_kernel, dim3(grid), dim3(512), kargs, LDS_TOTAL, stream);
    if (e != hipSuccess) fprintf(stderr, "kernel_launch: cooperative launch failed: %s (grid %d)\n", hipGetErrorString(e), grid);
#else
#ifdef DIAG
    (void)hipMemsetAsync((unsigned char*)d_ws + WS_CSP + 8192, 0x7f, 4, stream); (void)hipMemsetAsync((unsigned char*)d_ws + WS_CSP + 8196, 0, 4, stream);
#endif
#ifndef PROBE_LIST
#define PROBE_LIST 0,1,2,3,4,5,6,7,8,9
#endif
    static const int plist[] = {PROBE_LIST};
    for (int pi = 0; pi < (int)(sizeof(plist) / sizeof(int)); ++pi) { const int p = plist[pi]; a.ph_lo = p; a.ph_hi = p + 1;
        hipLaunchKernelGGL(fwd_kernel, dim3(grid), dim3(512), LDS_TOTAL, stream, a);
#ifdef DIAG
        a.ph_lo = 100 + p; a.ph_hi = 101 + p; hipLaunchKernelGGL(fwd_kernel, dim3(grid), dim3(512), LDS_TOTAL, stream, a);
        if (p == NPHASE - 1) { a.ph_lo = 110; a.ph_hi = 111; hipLaunchKernelGGL(fwd_kernel, dim3(grid), dim3(512), LDS_TOTAL, stream, a); }
#endif
        if (hipPeekAtLastError() != hipSuccess) { fprintf(stderr, "kernel_launch: launch %d failed\n", p); break; } }
#endif
}
```

```cpp
#define N_LAUNCHES 1
#include <hip/hip_runtime.h>
#include <hip/hip_cooperative_groups.h>
#include <cstdio>
#include <cstdint>
namespace cg = cooperative_groups;
namespace pg8 {
#define PG8_LAS __attribute__((address_space(3)))
typedef unsigned short bf16_t;
typedef short bf16x8 __attribute__((ext_vector_type(8)));
typedef float f32x4 __attribute__((ext_vector_type(4)));
typedef unsigned u32x4 __attribute__((ext_vector_type(4)));
constexpr int BM = 256, BK = 64, HALF = 128, HTB = HALF * BK * 2  , STAGE_BYTES = 8 * HTB, NXCD = 8, WGM = 8;

__host__ __device__ __forceinline__ int lds_byte(int r, int c) { const int st = (r >> 4) * 2 + (c >> 5), rr = r & 15, cc = c & 31, ob = rr * 64 + cc * 2; return st * 1024 + (ob ^ (((ob >> 9) & 1) << 5)); }
__host__ __device__ __forceinline__ void stage_rc(int b, int& R, int& C) { const int st = b / 1024, sb = b % 1024, swz = sb ^ (((sb >> 9) & 1) << 5); R = (st >> 1) * 16 + swz / 64; C = (st & 1) * 32 + (swz % 64) / 2; }
__host__ __device__ __forceinline__ int perm32(int rho) { const int n = rho >> 4, i = rho & 15; return 8 * (i >> 2) + 4 * n + (i & 3); }

struct Unit { int pm, pn; };
struct Gemm { const bf16_t* A; const bf16_t* Bt; int M, N, K, lda, ldb; long a_pn_bytes; int a_pn_shift; };

struct StaticOrder {
    int nM, nN, nwg, G, c;
    __host__ __device__ void init(int M, int N, int G_, int c_) { nM = M / BM; nN = N / BM; nwg = nM * nN; G = G_; c = c_; }
    __host__ __device__ bool next(int i, Unit& u) const {
        const long L = (long)i * G + c; if (L >= nwg) return false;
        int wgid = (int)L; { const int q = nwg / NXCD, r = nwg % NXCD, xcd = wgid % NXCD, off = wgid / NXCD; wgid = (xcd < r ? xcd * (q + 1) : r * (q + 1) + (xcd - r) * q) + off; }
        const int nig = WGM * nN, gid = wgid / nig, fm = gid * WGM, gsz = (nM - fm) < WGM ? (nM - fm) : WGM;
        u.pm = fm + ((wgid % nig) % gsz); u.pn = (wgid % nig) / gsz; return true;
    }
    __device__ __forceinline__ void a_ready(const Unit&) const {}
    __device__ __forceinline__ void done(const Unit&) const {}
};

__device__ __forceinline__ unsigned cvt_pk_bf16(float lo, float hi) { unsigned r; asm volatile("v_cvt_pk_bf16_f32 %0, %1, %2" : "=v"(r) : "v"(lo), "v"(hi)); return r; }
typedef float f32x2 __attribute__((ext_vector_type(2)));
typedef unsigned u32x2 __attribute__((ext_vector_type(2)));
typedef _Float16 h16x2 __attribute__((ext_vector_type(2)));
__device__ __forceinline__ float fsigmoid(float v) { return __builtin_amdgcn_rcpf(1.0f + __expf(-v)); }
__device__ __forceinline__ float gelu_tanh(float v) { const float y = 1.5957691216057308f * (v + 0.044715f * v * v * v); return v * fsigmoid(y); }
__device__ __forceinline__ u32x4 pack8f(const f32x4 a, const f32x4 b) { u32x4 w; w.x = cvt_pk_bf16(a[0], a[1]); w.y = cvt_pk_bf16(a[2], a[3]); w.z = cvt_pk_bf16(b[0], b[1]); w.w = cvt_pk_bf16(b[2], b[3]); return w; }
__device__ __forceinline__ float bf2f(unsigned short b) { return __uint_as_float((unsigned)b << 16); }

struct EpiIn {
    static constexpr bool PERM = true, AFTER_DRAIN = false;
    bf16_t *ZX, *G1, *G2, *ZC; const float* rstd; float *SSQ, *SSKV; bf16_t* KR; const float* CS;
    __device__ __forceinline__ void operator()(const f32x4 (&acc)[2][2][4][2], const Unit& u, int wr, int wc, int fr, int fq) const {
        const int row0 = u.pm * BM + wr * 64 + fr, cl = wc * 32 + 8 * fq, pn = u.pn;
        float rsv[2][4];
#pragma unroll
        for (int ai = 0; ai < 2; ++ai)
#pragma unroll
            for (int m = 0; m < 4; ++m) rsv[ai][m] = rstd[row0 + ai * HALF + m * 16];
#pragma unroll
        for (int ai = 0; ai < 2; ++ai)
#pragma unroll
            for (int m = 0; m < 4; ++m) { const int row = row0 + ai * HALF + m * 16; const float rs = rsv[ai][m];
                if (pn >= 4 && pn < 12) {
                    f32x4 o[2];
#pragma unroll
                    for (int n = 0; n < 2; ++n)
#pragma unroll
                        for (int e = 0; e < 4; ++e) o[n][e] = gelu_tanh(acc[ai][0][m][n][e] * rs) * fsigmoid(acc[ai][1][m][n][e] * rs);
                    __builtin_nontemporal_store(pack8f(o[0], o[1]), (u32x4*)(G1 + (size_t)row * 1024 + (pn - 4) * 128 + cl));
                } else {
#pragma unroll
                    for (int bj = 0; bj < 2; ++bj) { f32x4 v0 = acc[ai][bj][m][0] * rs, v1 = acc[ai][bj][m][1] * rs;
                        if (pn < 4) *(u32x4*)(ZX + (size_t)row * 1024 + pn * 256 + bj * HALF + cl) = pack8f(v0, v1);
                        else if (pn < 16) {
#pragma unroll
                            for (int e = 0; e < 4; ++e) { v0[e] = fsigmoid(v0[e]); v1[e] = fsigmoid(v1[e]); }
                            __builtin_nontemporal_store(pack8f(v0, v1), (u32x4*)(G2 + (size_t)row * 1024 + (pn - 12) * 256 + bj * HALF + cl));
                        } else if (pn < 18) *(u32x4*)(ZC + (size_t)row * 768 + (pn - 16) * 256 + bj * HALF + cl) = pack8f(v0, v1);
                        else if (bj == 0 && wc < 2) {
                            const float* cs = CS + ((size_t)(row & 8191) * 32 + 16 * wc + 4 * fq) * 2;
                            const f32x4 c01 = *(const f32x4*)cs, c23 = *(const f32x4*)(cs + 4);
                            const float co[4] = {c01[0], c01[2], c23[0], c23[2]}, si[4] = {c01[1], c01[3], c23[1], c23[3]}; f32x4 olo, ohi;
#pragma unroll
                            for (int e2 = 0; e2 < 4; ++e2) { olo[e2] = v0[e2] * co[e2] - v1[e2] * si[e2]; ohi[e2] = v1[e2] * co[e2] + v0[e2] * si[e2]; }
                            *(u32x4*)(KR + (size_t)row * 64 + cl) = pack8f(olo, ohi); }
                    }
                    if (pn == 16 || pn == 17) {
                        float ss = 0.f;
#pragma unroll
                        for (int bj = 0; bj < 2; ++bj)
#pragma unroll
                            for (int n = 0; n < 2; ++n) { const f32x4 z = acc[ai][bj][m][n] * rs; ss += (z[0] * z[0] + z[1] * z[1]) + (z[2] * z[2] + z[3] * z[3]); }
                        ss += __shfl_xor(ss, 16); ss += __shfl_xor(ss, 32);
                        if (fq == 0) (pn == 16 ? SSQ : SSKV)[(size_t)row * 4 + wc] = ss; }
                }
            }
    }
};
__device__ __forceinline__ float one_minus_exp(float x) {
    const float p = -x * (1.0f + x * (0.5f + x * (0.16666667f + x * (0.041666668f + x * 0.0083333338f))));
    const float q = 1.0f - __builtin_amdgcn_exp2f(x * 1.4426950408889634f);
    return x > -0.2f ? p : q;
}
struct EpiLru {
    static constexpr bool PERM = true, AFTER_DRAIN = false;
    const bf16_t* XA; const float *ba, *bx, *csp; unsigned* AB;
    __device__ __forceinline__ void operator()(const f32x4 (&acc)[2][2][4][2], const Unit& u, int wr, int wc, int fr, int fq) const {
        const int c0 = u.pn * 128 + wc * 32 + 8 * fq;
        const unsigned lo = (unsigned)((wr * 64 + fr) * 1024 + c0);
        const char* xau = (const char*)(XA + (size_t)u.pm * BM * 1024); char* abu = (char*)(AB + (size_t)u.pm * BM * 1024);
        u32x4 xw[2][4];
#pragma unroll
        for (int ai = 0; ai < 2; ++ai)
#pragma unroll
            for (int m = 0; m < 4; ++m) xw[ai][m] = *(const u32x4*)(xau + (size_t)((ai * HALF + m * 16) * 1024) * 2 + lo * 2u);
        f32x4 vba[2], vbx[2], vcs[2];
#pragma unroll
        for (int n = 0; n < 2; ++n) { vba[n] = *(const f32x4*)(ba + c0 + 4 * n); vbx[n] = *(const f32x4*)(bx + c0 + 4 * n); vcs[n] = *(const f32x4*)(csp + c0 + 4 * n); }
#pragma unroll
        for (int ai = 0; ai < 2; ++ai)
#pragma unroll
            for (int m = 0; m < 4; ++m)
#pragma unroll
                for (int n = 0; n < 2; ++n) { u32x4 ow;
#pragma unroll
                    for (int e = 0; e < 4; ++e) { const unsigned w = xw[ai][m][2 * n + (e >> 1)]; const float xa = __uint_as_float((e & 1) ? (w & 0xffff0000u) : (w << 16));
                        const float r = fsigmoid(acc[ai][0][m][n][e] + vba[n][e]), ig = fsigmoid(acc[ai][1][m][n][e] + vbx[n][e]);
                        const float la2 = -vcs[n][e] * r; const float b = __builtin_amdgcn_sqrtf(fmaxf(1.0f - __builtin_amdgcn_exp2f(2.0f * la2), 0.f)) * (ig * xa);
                        h16x2 hv; hv.x = (_Float16)la2; hv.y = (_Float16)b; ow[e] = __builtin_bit_cast(unsigned, hv); }
                    *(u32x4*)(abu + (size_t)((ai * HALF + m * 16) * 1024 + 4 * n) * 4 + lo * 4u) = ow; }
    }
};
struct EpiQ {
    static constexpr bool PERM = true, AFTER_DRAIN = false;
    bf16_t* Q; const float* SSp; const float* CS;
    __device__ __forceinline__ void operator()(const f32x4 (&acc)[2][2][4][2], const Unit& u, int wr, int wc, int fr, int fq) const {
        const int row0 = u.pm * BM + wr * 64 + fr, cl = wc * 32 + 8 * fq, pn = u.pn;
        f32x4 spv[2][4];
#pragma unroll
        for (int ai = 0; ai < 2; ++ai)
#pragma unroll
            for (int m = 0; m < 4; ++m) spv[ai][m] = *(const f32x4*)(SSp + (size_t)(row0 + ai * HALF + m * 16) * 4);
#pragma unroll
        for (int ai = 0; ai < 2; ++ai) {
            f32x4 c01[4], c23[4];
            if (pn >= 4) {
#pragma unroll
                for (int m = 0; m < 4; ++m) { const float* cs = CS + ((size_t)((row0 + ai * HALF + m * 16) & 8191) * 32 + 16 * (wc & 1) + 4 * fq) * 2; c01[m] = *(const f32x4*)cs; c23[m] = *(const f32x4*)(cs + 4); } }
#pragma unroll
            for (int m = 0; m < 4; ++m) { const int row = row0 + ai * HALF + m * 16; const f32x4 sp = spv[ai][m]; const float rs = rsqrtf(((sp[0] + sp[1]) + (sp[2] + sp[3])) * (1.0f / 256.0f) + 1e-6f);
                bf16_t* op = Q + (size_t)row * 1536 + pn * 256 + cl;
                if (pn < 4) {
#pragma unroll
                    for (int bj = 0; bj < 2; ++bj) *(u32x4*)(op + bj * HALF) = pack8f(acc[ai][bj][m][0] * rs, acc[ai][bj][m][1] * rs);
                } else {
                    const float co[4] = {c01[m][0], c01[m][2], c23[m][0], c23[m][2]}, si[4] = {c01[m][1], c01[m][3], c23[m][1], c23[m][3]};
#pragma unroll
                    for (int bj = 0; bj < 2; ++bj) { const f32x4 lo = acc[ai][bj][m][0] * rs, hi = acc[ai][bj][m][1] * rs; f32x4 olo, ohi;
#pragma unroll
                        for (int e = 0; e < 4; ++e) { olo[e] = lo[e] * co[e] - hi[e] * si[e]; ohi[e] = hi[e] * co[e] + lo[e] * si[e]; }
                        *(u32x4*)(op + bj * HALF) = pack8f(olo, ohi); }
                }
            }
        }
    }
};
struct EpiRowScale {
    static constexpr bool PERM = true, AFTER_DRAIN = false;
    bf16_t* O; int ldc; const float* SSp;
    __device__ __forceinline__ void operator()(const f32x4 (&acc)[2][2][4][2], const Unit& u, int wr, int wc, int fr, int fq) const {
        const int row0 = u.pm * BM + wr * 64 + fr, cl = u.pn * 256 + wc * 32 + 8 * fq;
        f32x4 spv[2][4];
#pragma unroll
        for (int ai = 0; ai < 2; ++ai)
#pragma unroll
            for (int m = 0; m < 4; ++m) spv[ai][m] = *(const f32x4*)(SSp + (size_t)(row0 + ai * HALF + m * 16) * 4);
#pragma unroll
        for (int ai = 0; ai < 2; ++ai)
#pragma unroll
            for (int m = 0; m < 4; ++m) { const int row = row0 + ai * HALF + m * 16; const f32x4 sp = spv[ai][m]; const float rs = rsqrtf(((sp[0] + sp[1]) + (sp[2] + sp[3])) * (1.0f / 256.0f) + 1e-6f);
#pragma unroll
                for (int bj = 0; bj < 2; ++bj) *(u32x4*)(O + (size_t)row * ldc + cl + bj * HALF) = pack8f(acc[ai][bj][m][0] * rs, acc[ai][bj][m][1] * rs);
            }
    }
};
template <bool BASE_F32> struct EpiRes {
    static constexpr bool PERM = false, AFTER_DRAIN = false;
    const float* basef; const bf16_t* baseb; bf16_t* outb; float* SS;
    __device__ __forceinline__ void operator()(const f32x4 (&acc)[2][2][4][2], const Unit& u, int wr, int wc, int fr, int fq) const {
        const int row0 = u.pm * BM + wr * 64 + fr, col0 = u.pn * 256 + wc * 32 + 4 * fq;
        constexpr int R = BASE_F32 ? 2 : 4;
#pragma unroll
        for (int ai = 0; ai < 2; ++ai)
#pragma unroll
            for (int m0 = 0; m0 < 4; m0 += R) {
                f32x4 bv[R][2][2];
#pragma unroll
                for (int mm = 0; mm < R; ++mm) { const size_t off = (size_t)(row0 + ai * HALF + (m0 + mm) * 16) * 1024 + col0;
#pragma unroll
                    for (int bj = 0; bj < 2; ++bj)
#pragma unroll
                        for (int n = 0; n < 2; ++n) { const size_t o2 = off + bj * HALF + n * 16;
                            if (BASE_F32) bv[mm][bj][n] = __builtin_nontemporal_load((const f32x4*)(basef + o2));
                            else { const u32x2 bw = *(const u32x2*)(baseb + o2); bv[mm][bj][n] = (f32x4){__uint_as_float(bw.x << 16), __uint_as_float(bw.x & 0xffff0000u), __uint_as_float(bw.y << 16), __uint_as_float(bw.y & 0xffff0000u)}; } } }
#pragma unroll
                for (int mm = 0; mm < R; ++mm) { const int m = m0 + mm, row = row0 + ai * HALF + m * 16; const size_t off = (size_t)row * 1024 + col0; float ss = 0.f;
#pragma unroll
                    for (int bj = 0; bj < 2; ++bj)
#pragma unroll
                        for (int n = 0; n < 2; ++n) { const size_t o2 = off + bj * HALF + n * 16; const f32x4 h = bv[mm][bj][n] + acc[ai][bj][m][n];
                            ss += (h[0] * h[0] + h[1] * h[1]) + (h[2] * h[2] + h[3] * h[3]);
                            u32x2 w; w.x = cvt_pk_bf16(h[0], h[1]); w.y = cvt_pk_bf16(h[2], h[3]); *(u32x2*)(outb + o2) = w; }
                    ss += __shfl_xor(ss, 16); ss += __shfl_xor(ss, 32);
                    if (fq == 0) SS[(size_t)row * 16 + u.pn * 4 + wc] = ss; }
            }
    }
};
struct EpiUp {
    static constexpr bool PERM = true, AFTER_DRAIN = false;
    bf16_t* U; const float* SS;
    __device__ __forceinline__ void operator()(const f32x4 (&acc)[2][2][4][2], const Unit& u, int wr, int wc, int fr, int fq) const {
        const int row0 = u.pm * BM + wr * 64 + fr, cl = u.pn * 256 + wc * 32 + 8 * fq;
        float rsv[2][4];
        { f32x4 t[2][4];
#pragma unroll
          for (int ai = 0; ai < 2; ++ai)
#pragma unroll
            for (int m = 0; m < 4; ++m) t[ai][m] = *(const f32x4*)(SS + (size_t)(row0 + ai * HALF + m * 16) * 16 + 4 * fq);
#pragma unroll
          for (int ai = 0; ai < 2; ++ai)
#pragma unroll
            for (int m = 0; m < 4; ++m) { float s = (t[ai][m][0] + t[ai][m][1]) + (t[ai][m][2] + t[ai][m][3]); s += __shfl_xor(s, 16); s += __shfl_xor(s, 32); rsv[ai][m] = rsqrtf(s * (1.0f / 1024.0f) + 1e-6f); } }
#pragma unroll
        for (int ai = 0; ai < 2; ++ai)
#pragma unroll
            for (int m = 0; m < 4; ++m) { const int row = row0 + ai * HALF + m * 16;
                const float rs = rsv[ai][m];
#pragma unroll
                for (int bj = 0; bj < 2; ++bj) { f32x4 v0 = acc[ai][bj][m][0] * rs, v1 = acc[ai][bj][m][1] * rs;
#pragma unroll
                    for (int e = 0; e < 4; ++e) { const float a = fmaxf(v0[e], 0.f), b = fmaxf(v1[e], 0.f); v0[e] = a * a; v1[e] = b * b; }
                    *(u32x4*)(U + (size_t)row * 4096 + cl + bj * HALF) = pack8f(v0, v1); }
            }
    }
};
template <class Epi, class Sched, bool ALIGN_EPI = false, bool SP2 = false>
__device__ __forceinline__ void gemm_phase(PG8_LAS unsigned char* lds, const Gemm g, const Sched& S, const Epi& E, const int tid0) {
    int tid_ = tid0; asm volatile("" : "+v"(tid_));
    const int tid = tid_, wid = __builtin_amdgcn_readfirstlane(tid >> 6), lane = tid & 63, wr = wid >> 2, wc = wid & 3, fr = lane & 15, fq = lane >> 4;
    int K_ = g.K; asm volatile("" : "+s"(K_));
    const int K = K_, nt = K / BK;
    unsigned voffA[2], voffB[2];
#pragma unroll
    for (int i = 0; i < 2; ++i) { int R, C; stage_rc(tid * 16 + i * 8192, R, C); const int Rb = Epi::PERM ? ((R & ~31) + perm32(R & 31)) : R;
        voffA[i] = (unsigned)(R * g.lda + C) * 2u; voffB[i] = (unsigned)(Rb * g.ldb + C) * 2u; }
    const size_t kstep = (size_t)(BK * 2);
    const size_t hstepA = (size_t)HALF * g.lda * 2, hstepB = (size_t)HALF * g.ldb * 2;
    const size_t tstepA = 2 * hstepA, tstepB = 2 * hstepB;
    const unsigned ldsw = (unsigned)wid * 1024u;
    const int aoff = lds_byte(wr * 64 + fr, fq * 8), boff = lds_byte(wc * 32 + fr, fq * 8);
#define PG8_SA(b, h) (((b) * 2 + (h)) * HTB)
#define PG8_SB(b, h) ((4 + (b) * 2 + (h)) * HTB)
#define PG8_STAGE(bufoff, gbase, voff) do { _Pragma("unroll") for (int _i = 0; _i < 2; ++_i) \
        __builtin_amdgcn_global_load_lds((const unsigned*)((const char*)(gbase) + (voff)[_i]), (PG8_LAS unsigned*)(lds + (bufoff) + ldsw + _i * 8192), 16, 0, 0); } while (0)
#define PG8_LDA(dst, b, h) do { _Pragma("unroll") for (int m = 0; m < 4; ++m) _Pragma("unroll") for (int k = 0; k < 2; ++k) dst[m][k] = *(const PG8_LAS bf16x8*)(lds + PG8_SA(b, h) + aoff + m * 2048 + k * 1024); } while (0)
#define PG8_LDB(dst, b, h) do { _Pragma("unroll") for (int n = 0; n < 2; ++n) _Pragma("unroll") for (int k = 0; k < 2; ++k) dst[n][k] = *(const PG8_LAS bf16x8*)(lds + PG8_SB(b, h) + boff + n * 2048 + k * 1024); } while (0)
#define PG8_MMA(ai, bj, At, Bt) do { __builtin_amdgcn_s_setprio(1); _Pragma("unroll") for (int m = 0; m < 4; ++m) _Pragma("unroll") for (int n = 0; n < 2; ++n) _Pragma("unroll") for (int k = 0; k < 2; ++k) \
        acc[ai][bj][m][n] = __builtin_amdgcn_mfma_f32_16x16x32_bf16(Bt[n][k], At[m][k], acc[ai][bj][m][n], 0, 0, 0); __builtin_amdgcn_s_setprio(0); } while (0)
#define PG8_WAIT_V(n) asm volatile("s_waitcnt vmcnt(" #n ")" ::: "memory")
#define PG8_WAIT_L(n) asm volatile("s_waitcnt lgkmcnt(" #n ")" ::: "memory")
#define PG8_BAR __builtin_amdgcn_s_barrier()
#define PG8_SCHED __builtin_amdgcn_sched_barrier(0)
    Unit cur, nxt; int ui = 0;
    if (!S.next(0, cur)) return;
    f32x4 acc[2][2][4][2];
#pragma unroll
    for (int a = 0; a < 2; ++a)
#pragma unroll
        for (int b = 0; b < 2; ++b)
#pragma unroll
            for (int m = 0; m < 4; ++m)
#pragma unroll
                for (int n = 0; n < 2; ++n) acc[a][b][m][n] = (f32x4){0.f, 0.f, 0.f, 0.f};
    bf16x8 At[4][2], B0[2][2], B1[2][2];
    const char* cA = (const char*)g.A + (size_t)cur.pm * tstepA + (size_t)(cur.pn >> g.a_pn_shift) * g.a_pn_bytes; const char* cB = (const char*)g.Bt + (size_t)cur.pn * tstepB;
    S.a_ready(cur);
    if constexpr (SP2) {
        PG8_STAGE(PG8_SB(0, 0), cB, voffB); PG8_STAGE(PG8_SB(0, 1), cB + hstepB, voffB); PG8_STAGE(PG8_SA(0, 0), cA, voffA); PG8_STAGE(PG8_SA(0, 1), cA + hstepA, voffA);
        if (wr == 1) PG8_BAR;
        PG8_WAIT_V(2); PG8_BAR;
        PG8_STAGE(PG8_SB(1, 0), cB + kstep, voffB); PG8_STAGE(PG8_SA(1, 0), cA + kstep, voffA); PG8_STAGE(PG8_SB(1, 1), cB + hstepB + kstep, voffB);
        PG8_WAIT_V(6); PG8_BAR;
    } else {
        PG8_STAGE(PG8_SB(0, 0), cB, voffB); PG8_STAGE(PG8_SA(0, 0), cA, voffA); PG8_STAGE(PG8_SB(0, 1), cB + hstepB, voffB); PG8_STAGE(PG8_SA(0, 1), cA + hstepA, voffA);
        if (wr == 1) PG8_BAR;
        PG8_WAIT_V(4); PG8_BAR;
        PG8_STAGE(PG8_SB(1, 0), cB + kstep, voffB); PG8_STAGE(PG8_SA(1, 0), cA + kstep, voffA); PG8_STAGE(PG8_SB(1, 1), cB + hstepB + kstep, voffB);
        PG8_WAIT_V(6); PG8_BAR;
    }
    for (;;) {
        const bool has_next = S.next(ui + 1, nxt);
        const char* nA = has_next ? (const char*)g.A + (size_t)nxt.pm * tstepA + (size_t)(nxt.pn >> g.a_pn_shift) * g.a_pn_bytes : cA; const char* nB = has_next ? (const char*)g.Bt + (size_t)nxt.pn * tstepB : cB;
        for (int t = 0; t < nt; t += 2) {
            const bool last = (t == nt - 2);
            const char* a1 = cA + (size_t)(t + 1) * kstep;
            const char* a2 = last ? nA : cA + (size_t)(t + 2) * kstep; const char* b2 = last ? nB : cB + (size_t)(t + 2) * kstep;
            const char* a3 = a2 + kstep; const char* b3 = b2 + kstep;
            if (last && has_next) S.a_ready(nxt);
            if constexpr (SP2) {
            PG8_LDB(B0, 0, 0); PG8_LDB(B1, 0, 1); PG8_SCHED; PG8_LDA(At, 0, 0); PG8_STAGE(PG8_SA(1, 1), a1 + hstepA, voffA);
            PG8_WAIT_V(8); PG8_WAIT_L(0); PG8_BAR; PG8_MMA(0, 0, At, B0); PG8_MMA(0, 1, At, B1); PG8_BAR; PG8_SCHED;
            PG8_LDA(At, 0, 1); PG8_STAGE(PG8_SB(0, 0), b2, voffB); PG8_STAGE(PG8_SB(0, 1), b2 + hstepB, voffB); PG8_STAGE(PG8_SA(0, 0), a2, voffA);
            PG8_WAIT_V(8); PG8_WAIT_L(0); PG8_BAR; PG8_MMA(1, 0, At, B0); PG8_MMA(1, 1, At, B1); PG8_BAR; PG8_SCHED;
            PG8_LDB(B0, 1, 0); PG8_LDB(B1, 1, 1); PG8_SCHED; PG8_LDA(At, 1, 0); PG8_STAGE(PG8_SA(0, 1), a2 + hstepA, voffA);
            PG8_WAIT_V(8); PG8_WAIT_L(0); PG8_BAR; PG8_MMA(0, 0, At, B0); PG8_MMA(0, 1, At, B1); PG8_BAR; PG8_SCHED;
            PG8_LDA(At, 1, 1); PG8_STAGE(PG8_SB(1, 0), b3, voffB); PG8_STAGE(PG8_SB(1, 1), b3 + hstepB, voffB); PG8_STAGE(PG8_SA(1, 0), a3, voffA);
            PG8_WAIT_V(8); PG8_WAIT_L(0); PG8_BAR; PG8_MMA(1, 0, At, B0); PG8_MMA(1, 1, At, B1); PG8_BAR; PG8_SCHED;
            } else {
            PG8_LDB(B0, 0, 0); PG8_SCHED; PG8_LDA(At, 0, 0); PG8_STAGE(PG8_SA(1, 1), a1 + hstepA, voffA);
            PG8_WAIT_L(8); PG8_BAR; PG8_WAIT_L(0); PG8_MMA(0, 0, At, B0); PG8_BAR; PG8_SCHED;
            PG8_LDB(B1, 0, 1); PG8_STAGE(PG8_SB(0, 0), b2, voffB);
            PG8_BAR; PG8_WAIT_L(0); PG8_MMA(0, 1, At, B1); PG8_BAR;
            PG8_LDA(At, 0, 1); PG8_STAGE(PG8_SA(0, 0), a2, voffA);
            PG8_BAR; PG8_WAIT_L(0); PG8_MMA(1, 0, At, B0); PG8_BAR; PG8_SCHED;
            PG8_STAGE(PG8_SB(0, 1), b2 + hstepB, voffB);
            PG8_WAIT_V(6); PG8_BAR; PG8_MMA(1, 1, At, B1); PG8_BAR;
            PG8_LDB(B0, 1, 0); PG8_SCHED; PG8_LDA(At, 1, 0); PG8_STAGE(PG8_SA(0, 1), a2 + hstepA, voffA);
            PG8_WAIT_L(8); PG8_BAR; PG8_WAIT_L(0); PG8_MMA(0, 0, At, B0); PG8_BAR; PG8_SCHED;
            PG8_LDB(B1, 1, 1); PG8_STAGE(PG8_SB(1, 0), b3, voffB);
            PG8_BAR; PG8_WAIT_L(0); PG8_MMA(0, 1, At, B1); PG8_BAR;
            PG8_LDA(At, 1, 1); PG8_STAGE(PG8_SA(1, 0), a3, voffA);
            PG8_BAR; PG8_WAIT_L(0); PG8_MMA(1, 0, At, B0); PG8_BAR; PG8_SCHED;
            PG8_STAGE(PG8_SB(1, 1), b3 + hstepB, voffB);
            PG8_WAIT_V(6); PG8_BAR; PG8_MMA(1, 1, At, B1); PG8_BAR;
            }
        }
        if constexpr (ALIGN_EPI) { if (wr == 0) PG8_BAR; }
        if constexpr (!Epi::AFTER_DRAIN) { E(acc, cur, wr, wc, fr, fq); S.done(cur); }
        if (!has_next) break;
#pragma unroll
        for (int a = 0; a < 2; ++a)
#pragma unroll
            for (int b = 0; b < 2; ++b)
#pragma unroll
                for (int m = 0; m < 4; ++m)
#pragma unroll
                    for (int n = 0; n < 2; ++n) acc[a][b][m][n] = (f32x4){0.f, 0.f, 0.f, 0.f};
        cur = nxt; cA = nA; cB = nB; ++ui;
        if constexpr (ALIGN_EPI) { if (wr == 1) PG8_BAR; }
    }
    PG8_WAIT_V(0);
    if constexpr (!ALIGN_EPI) { if (wr == 0) PG8_BAR; }
    PG8_BAR;
    if constexpr (Epi::AFTER_DRAIN) { E.fused(acc, cur, wr, wc, fr, fq, lds, wid, lane); S.done(cur); }
#undef PG8_SA
#undef PG8_SB
#undef PG8_STAGE
#undef PG8_LDA
#undef PG8_LDB
#undef PG8_MMA
#undef PG8_WAIT_V
#undef PG8_WAIT_L
#undef PG8_BAR
#undef PG8_SCHED
}
}
namespace att {
typedef unsigned short bf16_t;
typedef short bf16x8 __attribute__((ext_vector_type(8)));
typedef short s16x4 __attribute__((ext_vector_type(4)));
typedef float f32x16 __attribute__((ext_vector_type(16)));
typedef float f32x4 __attribute__((ext_vector_type(4)));
typedef unsigned u32x4 __attribute__((ext_vector_type(4)));
constexpr int NW = 8, QBLK = 32, KVBLK = 64, QB = NW * QBLK;
constexpr int DK = 192, DV = 128;
constexpr int QS = 1536, KVS = 2048, KRS = 64, OS = 1024;
constexpr int SHM_V = KVBLK * DV * 2, SHM_K = KVBLK * DK * 2;
constexpr int LDS_QR = 2 * SHM_V + 2 * SHM_K + NW * 64 * 4;
constexpr int LDS_BYTES = LDS_QR + NW * 8192;
constexpr float SCALE = 0.07216878364870322f;
constexpr float THR = 8.f;
#define KSWZ(row, colB) ((row) * 384 + ((colB) ^ (((row) & 7) << 4)))
#define SBAR() __builtin_amdgcn_sched_barrier(0)
__device__ __forceinline__ int v_st(int k, int c) { const int kk = (k & ~0xC) | ((k & 4) << 1) | ((k & 8) >> 1); return ((kk >> 3) * 4 + (c >> 5)) * 512 + ((kk & 7) * 32 + (c & 31)) * 2; }
__device__ __forceinline__ int v_rd_base(int lane) { return ((lane & 3) << 3) | (((lane >> 2) & 3) << 6) | (((lane >> 4) & 1) << 5) | (((lane >> 5) & 1) << 8); }
constexpr int v_rd_off(int d0, int ks, int half) { return d0 * 512 + ks * 4096 + half * 2048; }
__device__ __forceinline__ int crow(int r, int hi) { return (r & 3) + 8 * (r >> 2) + 4 * hi; }
__device__ __forceinline__ unsigned cvtpk(float lo, float hi) { unsigned r; asm volatile("v_cvt_pk_bf16_f32 %0, %1, %2" : "=v"(r) : "v"(lo), "v"(hi)); return r; }
__device__ __forceinline__ bf16x8 load8(const bf16_t* p) { return *reinterpret_cast<const bf16x8*>(p); }
__device__ __forceinline__ void mask_tile(f32x16& p0, f32x16& p1, int dq) {
    const float NEG = -__builtin_inff();
#pragma unroll
    for (int r = 0; r < 16; ++r) {
        const int c = (r & 3) + 8 * (r >> 2);
        if (dq - c < 0) p0[r] = NEG;
        if (dq - c - 32 < 0) p1[r] = NEG;
    }
}
__device__ __forceinline__ void partialSM(f32x16& p0, f32x16& p1, float& m_reg, float& mn, float& alpha) {
    float pmax = p0[0]; for (int r = 1; r < 16; ++r) pmax = fmaxf(pmax, p0[r]); for (int r = 0; r < 16; ++r) pmax = fmaxf(pmax, p1[r]);
    { auto rr = __builtin_amdgcn_permlane32_swap(__float_as_uint(pmax), __float_as_uint(pmax), false, false);
      pmax = fmaxf(__uint_as_float(rr[0]), __uint_as_float(rr[1])); }
    constexpr float C2 = 1.4426950408889634f * SCALE;
    if (__builtin_expect(__all((pmax - m_reg) * SCALE <= THR), 1)) { mn = m_reg; alpha = 1.f; }
    else { mn = fmaxf(m_reg, pmax); alpha = __builtin_amdgcn_exp2f((m_reg - mn) * C2); m_reg = mn; }
    const float mnL = -mn * C2;
    for (int r = 0; r < 16; ++r) p0[r] = fmaf(p0[r], C2, mnL); for (int r = 0; r < 16; ++r) p1[r] = fmaf(p1[r], C2, mnL);
    for (int r = 0; r < 16; ++r) p0[r] = __builtin_amdgcn_exp2f(p0[r]);
}
__device__ __forceinline__ void finishSM(f32x16& p0, f32x16& p1, float alpha, float& l_reg, bf16x8& pa0, bf16x8& pa1, bf16x8& pa2, bf16x8& pa3) {
    for (int r = 0; r < 16; ++r) p1[r] = __builtin_amdgcn_exp2f(p1[r]);
    float ps = 0; for (int r = 0; r < 16; ++r) ps += p0[r]; for (int r = 0; r < 16; ++r) ps += p1[r];
    { auto rr = __builtin_amdgcn_permlane32_swap(__float_as_uint(ps), __float_as_uint(ps), false, false);
      ps = __uint_as_float(rr[0]) + __uint_as_float(rr[1]); }
    l_reg = l_reg * alpha + ps;
#define PK4(P, B_, OUT) do { unsigned a0 = cvtpk(P[B_+0], P[B_+1]), a1 = cvtpk(P[B_+2], P[B_+3]);                          \
        unsigned b0 = cvtpk(P[B_+4], P[B_+5]), b1 = cvtpk(P[B_+6], P[B_+7]);                                             \
        auto r0 = __builtin_amdgcn_permlane32_swap(a0, b0, false, false); auto r1 = __builtin_amdgcn_permlane32_swap(a1, b1, false, false); \
        u32x4 w = {r0[0], r1[0], r0[1], r1[1]}; OUT = *reinterpret_cast<bf16x8*>(&w); } while (0)
    PK4(p0, 0, pa0); PK4(p0, 8, pa1); PK4(p1, 0, pa2); PK4(p1, 8, pa3);
#undef PK4
}
template <int KB>
__device__ __forceinline__ void qkt(f32x16& p0, f32x16& p1, const char* K_lds, int r32, int hi, const bf16x8* qr, const char* qrl) {
    p0 = f32x16{}; p1 = f32x16{};
    const char* kb[4];
#pragma unroll
    for (int dd = 0; dd < 4; ++dd) kb[dd] = K_lds + KB * SHM_K + KSWZ(r32, (dd * 16 + hi * 8) * 2);
#pragma unroll
    for (int d0 = 0; d0 < 12; ++d0) { const char* a = kb[d0 & 3] + (d0 >> 2) * 128;
        bf16x8 b0 = *reinterpret_cast<const bf16x8*>(a);
        bf16x8 b1 = *reinterpret_cast<const bf16x8*>(a + 32 * 384);
        const bf16x8 qf = d0 < 4 ? qr[d0 & 3] : *reinterpret_cast<const bf16x8*>(qrl + (d0 - 4) * 1024);
        p0 = __builtin_amdgcn_mfma_f32_32x32x16_bf16(b0, qf, p0, 0, 0, 0);
        p1 = __builtin_amdgcn_mfma_f32_32x32x16_bf16(b1, qf, p1, 0, 0, 0); }
}
template <int VB>
__device__ __forceinline__ void pv_tile(f32x16* o, int vb0, bf16x8 pa0, bf16x8 pa1, bf16x8 pa2, bf16x8 pa3) {
#define TRRD(dst, off) asm volatile("ds_read_b64_tr_b16 %0, %1 offset:%2" : "=&v"(dst) : "v"(vb0), "i"(off) : "memory")
#define PV_D0(d0) do { s16x4 l0, l1, l2, l3, h0, h1, h2, h3; constexpr int b_ = VB * SHM_V + v_rd_off(d0, 0, 0);   \
        TRRD(l0, b_); TRRD(h0, b_ + 2048); TRRD(l1, b_ + 4096); TRRD(h1, b_ + 6144); TRRD(l2, b_ + 8192); TRRD(h2, b_ + 10240); TRRD(l3, b_ + 12288); TRRD(h3, b_ + 14336); \
        asm volatile("s_waitcnt lgkmcnt(0)" ::: "memory"); SBAR();   \
        o[d0] = __builtin_amdgcn_mfma_f32_32x32x16_bf16(pa0, (bf16x8){l0[0], l0[1], l0[2], l0[3], h0[0], h0[1], h0[2], h0[3]}, o[d0], 0, 0, 0);   \
        o[d0] = __builtin_amdgcn_mfma_f32_32x32x16_bf16(pa1, (bf16x8){l1[0], l1[1], l1[2], l1[3], h1[0], h1[1], h1[2], h1[3]}, o[d0], 0, 0, 0);   \
        o[d0] = __builtin_amdgcn_mfma_f32_32x32x16_bf16(pa2, (bf16x8){l2[0], l2[1], l2[2], l2[3], h2[0], h2[1], h2[2], h2[3]}, o[d0], 0, 0, 0);   \
        o[d0] = __builtin_amdgcn_mfma_f32_32x32x16_bf16(pa3, (bf16x8){l3[0], l3[1], l3[2], l3[3], h3[0], h3[1], h3[2], h3[3]}, o[d0], 0, 0, 0); } while (0)
    PV_D0(0); PV_D0(1); PV_D0(2); PV_D0(3);
#undef PV_D0
#undef TRRD
}
struct BlockRef { const bf16_t* Qn; const bf16_t* Qr; const bf16_t* Kn; const bf16_t* Kr; const bf16_t* V; bf16_t* O; int P0; };
struct Seam { bf16x8 qr[4]; bf16x8 st_v0, st_v1, st_k0, st_k1, st_k2; };
#define VMW() asm volatile("s_waitcnt vmcnt(0)" ::: "memory")
#define VMWN(n) asm volatile("s_waitcnt vmcnt(%0)" :: "i"(n) : "memory")
#define SLOAD_H(R_, k0) do { const char* vb_ = (const char*)((R_).V + (size_t)(k0) * KVS); const char* kb_ = (const char*)((R_).Kn + (size_t)(k0) * KVS); const char* rb_ = (const char*)((R_).Kr + (size_t)(k0) * KRS); \
                         S.st_v0 = *(const bf16x8*)(vb_ + voff); S.st_v1 = *(const bf16x8*)(vb_ + 32 * KVS * 2 + voff);      \
                         S.st_k0 = *(const bf16x8*)(kb_ + voff); S.st_k1 = *(const bf16x8*)(kb_ + 32 * KVS * 2 + voff);      \
                         S.st_k2 = *(const bf16x8*)(rb_ + roff); } while (0)
#define SLOAD_V(R_, k0) do { const char* vb_ = (const char*)((R_).V + (size_t)(k0) * KVS); S.st_v0 = *(const bf16x8*)(vb_ + voff); S.st_v1 = *(const bf16x8*)(vb_ + 32 * KVS * 2 + voff); } while (0)
#define SLOAD_K(R_, k0) do { const char* kb_ = (const char*)((R_).Kn + (size_t)(k0) * KVS); const char* rb_ = (const char*)((R_).Kr + (size_t)(k0) * KRS); \
                         S.st_k0 = *(const bf16x8*)(kb_ + voff); S.st_k1 = *(const bf16x8*)(kb_ + 32 * KVS * 2 + voff); S.st_k2 = *(const bf16x8*)(rb_ + roff); } while (0)
#define SWRITE_HK(bf) do { *(bf16x8*)(K_lds + (bf) * SHM_K + kws) = S.st_k0; *(bf16x8*)(K_lds + (bf) * SHM_K + kws + 32 * 384) = S.st_k1; *(bf16x8*)(K_lds + (bf) * SHM_K + kws2) = S.st_k2; } while (0)
#define SWRITE_HV(bf) do { *(bf16x8*)(V_lds + (bf) * SHM_V + vst0) = S.st_v0; *(bf16x8*)(V_lds + (bf) * SHM_V + vst1) = S.st_v1; } while (0)
#define SWRITE_H(bf) do { SWRITE_HV(bf); SWRITE_HK(bf); } while (0)
#define QLOAD(R_) do { const char* qn_ = (const char*)((R_).Qn + (size_t)(wid * QBLK) * QS); const char* qr_ = (const char*)((R_).Qr + (size_t)(wid * QBLK) * QS); \
                       _Pragma("unroll") for (int d0 = 0; d0 < 4; ++d0) S.qr[d0] = *(const bf16x8*)(qn_ + qoff + d0 * 32);          \
                       _Pragma("unroll") for (int d0 = 4; d0 < 8; ++d0) *(bf16x8*)(qrl + (d0 - 4) * 1024) = *(const bf16x8*)(qn_ + qoff + d0 * 32);          \
                       _Pragma("unroll") for (int d0 = 0; d0 < 4; ++d0) *(bf16x8*)(qrl + (d0 + 4) * 1024) = *(const bf16x8*)(qr_ + qoff + d0 * 32); } while (0)
__device__ __forceinline__ void attn_prime(const BlockRef& cur, char* lds, Seam& S, const int tid0) {
    const int tid = tid0, wid = __builtin_amdgcn_readfirstlane(tid >> 6), lane = tid & 63, r32 = lane & 31, hi = lane >> 5;
    const int sr = tid >> 4, sc = (tid & 15) * 8, kws = KSWZ(sr, sc * 2), rr = tid >> 3, rc = (tid & 7) * 8, kws2 = KSWZ(rr, (128 + rc) * 2); char* K_lds = lds + 2 * SHM_V;
    char* qrl = lds + LDS_QR + wid * 8192 + lane * 16;
    const unsigned voff = (unsigned)((sr * KVS + sc) * 2), roff = (unsigned)((rr * KRS + rc) * 2), qoff = (unsigned)((r32 * QS + hi * 8) * 2);
    QLOAD(cur);
    SLOAD_H(cur, 0); VMW(); SWRITE_HK(0);
    __syncthreads();
}
__device__ __forceinline__ void attn_block(const BlockRef& cur, const BlockRef& nxt, char* lds, Seam& S, const int tid0) {
    const int tid = tid0, wid = __builtin_amdgcn_readfirstlane(tid >> 6), lane = tid & 63, r32 = lane & 31, hi = lane >> 5;
    const int NT = cur.P0 / KVBLK + 4;
    const int qlo = cur.P0 + wid * QBLK, qm = qlo + r32 - 4 * hi;
    char* V_lds = lds; char* K_lds = lds + 2 * SHM_V;
    float* ws = (float*)(lds + 2 * SHM_V + 2 * SHM_K) + wid * 64; float* li_l = ws, * al_l = ws + 32;
    float m_reg = -1e30f, l_reg = 0; f32x16 o[4] = {};
    const int sr = tid >> 4, sc = (tid & 15) * 8, vst0 = v_st(sr, sc), vst1 = v_st(32 + sr, sc), kws = KSWZ(sr, sc * 2);
    const int rr = tid >> 3, rc = (tid & 7) * 8, kws2 = KSWZ(rr, (128 + rc) * 2);
    const int vb0 = (int)(uintptr_t)V_lds + v_rd_base(lane);
    char* qrl = lds + LDS_QR + wid * 8192 + lane * 16;
    const unsigned voff = (unsigned)((sr * KVS + sc) * 2), roff = (unsigned)((rr * KRS + rc) * 2), qoff = (unsigned)((r32 * QS + hi * 8) * 2);
#define RESC(a) do { if (__any((a) < 1.f)) { if (hi == 0) al_l[r32] = (a); asm volatile("s_waitcnt lgkmcnt(0)" ::: "memory");              \
                     for (int d_ = 0; d_ < 4; ++d_) for (int r = 0; r < 16; ++r) o[d_][r] *= al_l[crow(r, hi)]; } } while (0)
#define MASKT(P0_, P1_, t) do { const int kb_ = (t) * KVBLK; if (kb_ + KVBLK - 1 > qlo) mask_tile(P0_, P1_, qm - kb_); } while (0)
    f32x16 pA0, pA1, pB0, pB1; float mnA, mnB, alA, alB; bf16x8 pa0, pa1, pa2, pa3;
    SWRITE_HV(0); SBAR();
    if (NT > 1) SLOAD_H(cur, KVBLK);
    SBAR(); qkt<0>(pA0, pA1, K_lds, r32, hi, S.qr, qrl);
    MASKT(pA0, pA1, 0); partialSM(pA0, pA1, m_reg, mnA, alA);
    if (NT > 1) { VMW(); SWRITE_HK(1); }
    __syncthreads();
#define HALF_STEP(PX0, PX1, mnX, alX, PY0, PY1, alY, t, KB, VB, SB) do {                                                      \
        SWRITE_HV(KB);                                                             \
        if ((t) + 1 < NT) { SLOAD_V(cur, ((t) + 1) * KVBLK); SLOAD_K(cur, ((t) + 1) * KVBLK); }         \
        SBAR(); qkt<KB>(PX0, PX1, K_lds, r32, hi, S.qr, qrl);                                                                       \
        finishSM(PY0, PY1, alY, l_reg, pa0, pa1, pa2, pa3); SBAR();                                                           \
        pv_tile<VB>(o, vb0, pa0, pa1, pa2, pa3); MASKT(PX0, PX1, (t)); partialSM(PX0, PX1, m_reg, mnX, alX);                  \
        if ((t) + 1 < NT) { VMW(); SWRITE_HK(SB); }                                                                           \
        RESC(alX); __syncthreads(); } while (0)
    for (int t = 1; t + 1 < NT; t += 2) {
        HALF_STEP(pB0, pB1, mnB, alB, pA0, pA1, alA, t, 1, 0, 0);
        HALF_STEP(pA0, pA1, mnA, alA, pB0, pB1, alB, t + 1, 0, 1, 1);
    }
    const bool even = (NT & 1) == 0;
    if (even) { SWRITE_HV(1); SBAR(); qkt<1>(pB0, pB1, K_lds, r32, hi, S.qr, qrl); SBAR(); }
    SLOAD_H(nxt, 0); SBAR();
    QLOAD(nxt);
    SBAR();
    finishSM(pA0, pA1, alA, l_reg, pa0, pa1, pa2, pa3); SBAR();
    pv_tile<0>(o, vb0, pa0, pa1, pa2, pa3);
    if (even) { MASKT(pB0, pB1, NT - 1); partialSM(pB0, pB1, m_reg, mnB, alB); __syncthreads(); RESC(alB);
        finishSM(pB0, pB1, alB, l_reg, pa0, pa1, pa2, pa3); SBAR(); pv_tile<1>(o, vb0, pa0, pa1, pa2, pa3); }
    SBAR(); VMWN(4); SWRITE_HK(0); SBAR();
    if (hi == 0) li_l[r32] = l_reg; asm volatile("s_waitcnt lgkmcnt(0)" ::: "memory");
    float rli[16];
#pragma unroll
    for (int r = 0; r < 16; ++r) rli[r] = __builtin_amdgcn_rcpf(li_l[crow(r, hi)]);
    char* Ow = (char*)(cur.O + (size_t)(wid * QBLK) * OS);
    const unsigned loff = (unsigned)((4 * hi * OS + r32) * 2);
#pragma unroll
    for (int r = 0; r < 16; ++r) { const int cro = ((r & 3) + 8 * (r >> 2)) * OS;
#pragma unroll
        for (int d0 = 0; d0 < 4; ++d0) { const float v = o[d0][r] * rli[r];
            const float vn = __shfl_xor(v, 1);
            if ((r32 & 1) == 0) *(unsigned*)(Ow + (size_t)(cro + d0 * 32) * 2 + loff) = cvtpk(v, vn); } }
    __syncthreads();
#undef RESC
#undef MASKT
#undef HALF_STEP
}
#undef VMW
#undef VMWN
#undef SLOAD_H
#undef SLOAD_V
#undef SLOAD_K
#undef SWRITE_HK
#undef SWRITE_HV
#undef SWRITE_H
#undef QLOAD
#undef SBAR
#undef KSWZ
}
typedef unsigned short bf16_t;
typedef float f32x4 __attribute__((ext_vector_type(4)));
typedef unsigned u32x4 __attribute__((ext_vector_type(4)));
typedef unsigned u32x2 __attribute__((ext_vector_type(2)));
typedef _Float16 h16x4 __attribute__((ext_vector_type(4)));
#define LAS __attribute__((address_space(3)))
#ifndef N_LAUNCHES
#define N_LAUNCHES 1
#endif
constexpr int NPHASE = 10;
constexpr int T = 32768, SEQ = 8192, DM = 1024;
constexpr size_t MiB = 1u << 20;
constexpr size_t WS_RSTDX = 0, WS_RSTDQ = 128 * 1024, WS_RSTDKV = 256 * 1024, WS_CSP = 384 * 1024;
constexpr size_t WS_SS1 = 1 * MiB, WS_SS2 = 3 * MiB;
constexpr size_t WS_CS = 5 * MiB;
constexpr size_t WS_W1 = 7 * MiB;
constexpr size_t WS_WUP = 17 * MiB;
constexpr size_t WS_WDN = 25 * MiB;
constexpr size_t WS_WOUT = 33 * MiB;
constexpr size_t WS_WUQ = 35 * MiB;
constexpr size_t WS_WUKV = 36 * MiB;
constexpr size_t WS_WLRU = 37 * MiB;
constexpr size_t WS_KR = 38 * MiB;
constexpr size_t WS_G1 = 42 * MiB, WS_G2 = 106 * MiB;
constexpr size_t WS_ZC = 170 * MiB;
constexpr size_t WS_SUM = WS_ZC, WS_SUB = WS_ZC + 2 * MiB;
constexpr size_t WS_KV = 218 * MiB;
constexpr size_t WS_R1 = 346 * MiB;
constexpr size_t WS_XB = WS_R1;
constexpr size_t WS_XA = WS_R1;
constexpr size_t WS_YB = WS_R1;
constexpr size_t WS_ZX = WS_R1 + 64 * MiB;
constexpr size_t WS_Q = WS_R1 + 64 * MiB;
constexpr size_t WS_MG = WS_KV;
constexpr size_t WS_H1B = WS_R1 + 64 * MiB;
constexpr size_t WS_U = 42 * MiB;
constexpr size_t WS_H2B = 298 * MiB;
constexpr size_t WS_END = 512 * MiB;
static_assert(WS_Q + (size_t)T * 1536 * 2 <= WS_END && WS_U + (size_t)T * 4096 * 2 <= WS_H1B && WS_W1 + 4864 * 1024 * 2 <= WS_WUP, "d_ws map");

struct Args { const float* in[19]; float* out; unsigned char* ws; int ph_lo, ph_hi; };
static_assert(sizeof(Args) == 19 * 8 + 8 + 8 + 8, "Args has no padding");

__device__ __forceinline__ float wave_sum(float v) {
#pragma unroll
    for (int o = 1; o < 64; o <<= 1) v += __shfl_xor(v, o);
    return v;
}
__device__ __forceinline__ unsigned pkbf(float lo, float hi) { return pg8::cvt_pk_bf16(lo, hi); }
__device__ __forceinline__ float bflo(unsigned w) { return __uint_as_float(w << 16); }
__device__ __forceinline__ float bfhi(unsigned w) { return __uint_as_float(w & 0xffff0000u); }

__device__ __forceinline__ int srccol(int which, int p) {
    if (which == 0) {
        const int t = p >> 8, w = p & 255;
        if (t < 4) return p;
        if (t < 12) return w < 128 ? 1024 + 128 * (t - 4) + w : 2624 + 128 * (t - 4) + (w - 128);
        if (t < 16) return 3648 + (p - 3072);
        if (t == 16) return 2048 + w;
        if (t == 17) return 2304 + w;
        return w < 64 ? 2560 + 4 * (w >> 3) + (w & 3) + 32 * ((w >> 2) & 1) : -1;
    }
    if (which == 1) {
        if (p < 1024) return (p >> 7) * 192 + (p & 127);
        const int q = p - 1024, h = q >> 6, u = q & 63;
        return h * 192 + 128 + 4 * (u >> 3) + (u & 3) + 32 * ((u >> 2) & 1);
    }
    return p;
}
__device__ __forceinline__ void tr_item(const float* W, int ldw, int K, int Nphys, const float* gain, bf16_t* WT, int which, LAS float* scr, int item, int lane, int ksrc0 = 0, int Ksrc = 1 << 30) {
    const int nblk = Nphys / 32, kb = item / nblk, nb = item % nblk, k0 = 64 * kb, n0 = 32 * nb;
    const int src = srccol(which, n0 + (lane & 31));
#pragma unroll 16
    for (int i = 0; i < 32; ++i) { const int kk = 2 * i + (lane >> 5); float v = 0.f;
        const int ks = k0 + kk - ksrc0;
        if (src >= 0 && ks >= 0 && ks < Ksrc) { v = __builtin_nontemporal_load(W + (size_t)ks * ldw + src); if (gain) v *= gain[k0 + kk]; }
        scr[kk * 33 + (lane & 31)] = v; }
    asm volatile("s_waitcnt lgkmcnt(0)" ::: "memory");
    const int c = lane & 7;
#pragma unroll
    for (int j = 0; j < 4; ++j) { const int n = (lane >> 3) + 8 * j; const LAS float* s = scr + (8 * c) * 33 + n;
        u32x4 o; o.x = pkbf(s[0 * 33], s[1 * 33]); o.y = pkbf(s[2 * 33], s[3 * 33]); o.z = pkbf(s[4 * 33], s[5 * 33]); o.w = pkbf(s[6 * 33], s[7 * 33]);
        *(u32x4*)(WT + (size_t)(n0 + n) * K + k0 + 8 * c) = o; }
    asm volatile("s_waitcnt lgkmcnt(0)" ::: "memory");
}
__device__ __forceinline__ void tr_item64(const float* W, int ldw, int K, int Nphys, const float* gain, bf16_t* WT, int which, int item, int lane, int ksrc0 = 0, int Ksrc = 1 << 30) {
    const int nblk = Nphys / 64, kb = item / nblk, nb = item % nblk, k0 = 64 * kb, n0 = 64 * nb;
    const int src = srccol(which, n0 + lane); const bool kin = (k0 - ksrc0 >= 0) && (k0 - ksrc0 < Ksrc);
    float v[64];
#pragma unroll
    for (int kk = 0; kk < 64; ++kk) v[kk] = (src >= 0 && kin) ? __builtin_nontemporal_load(W + (size_t)(k0 + kk - ksrc0) * ldw + src) : 0.f;
    if (gain) {
#pragma unroll
        for (int kk = 0; kk < 64; ++kk) v[kk] *= gain[k0 + kk];
    }
    bf16_t* o = WT + (size_t)(n0 + lane) * K + k0;
#pragma unroll
    for (int j = 0; j < 8; ++j) { u32x4 w; w.x = pkbf(v[8 * j], v[8 * j + 1]); w.y = pkbf(v[8 * j + 2], v[8 * j + 3]); w.z = pkbf(v[8 * j + 4], v[8 * j + 5]); w.w = pkbf(v[8 * j + 6], v[8 * j + 7]); *(u32x4*)(o + 8 * j) = w; }
}
__device__ __forceinline__ void sincos_d(double a, float& s, float& c) {
    const double n = rint(a * 0.63661977236758134308);
    const double r = (a - n * 1.57079632679489655800) - n * 6.123233995736766036e-17, r2 = r * r;
    double sp = -7.6471637318198164759e-13; sp = sp * r2 + 1.6059043836821614599e-10; sp = sp * r2 - 2.5052108385441718775e-08; sp = sp * r2 + 2.7557319223985890653e-06;
    sp = sp * r2 - 1.9841269841269841270e-04; sp = sp * r2 + 8.3333333333333333333e-03; sp = sp * r2 - 1.6666666666666666667e-01; sp = r + r * r2 * sp;
    double cp = 4.7794773323873852974e-14; cp = cp * r2 - 1.1470745597729724714e-11; cp = cp * r2 + 2.0876756987868098979e-09; cp = cp * r2 - 2.7557319223985890653e-07;
    cp = cp * r2 + 2.4801587301587301587e-05; cp = cp * r2 - 1.3888888888888888889e-03; cp = cp * r2 + 4.1666666666666666667e-02; cp = cp * r2 - 0.5; cp = 1.0 + r2 * cp;
    const int q = (int)((long long)n & 3);
    const double ss = (q & 1) ? cp : sp, cc = (q & 1) ? sp : cp;
    s = (float)((q & 2) ? -ss : ss); c = (float)(((q + 1) & 2) ? -cc : cc);
}

#ifdef DIAG
#define DCHK(code, got, want, rtol, atol) do { const float g_ = (got), w_ = (want); if (!(fabsf(g_ - w_) <= (rtol) * fabsf(w_) + (atol))) { atomicMin(DG, (unsigned)(code)); atomicOr(DG + 1, (code) < 50 ? 0u : (code) < 54 ? 1u : (code) < 60 ? 2u : (code) < 70 ? 4u : (code) < 80 ? 8u : 16u); } } while (0)
__device__ __forceinline__ unsigned dhash(unsigned x) { x ^= x >> 16; x *= 0x7feb352du; x ^= x >> 15; x *= 0x846ca68bu; x ^= x >> 16; return x; }
__device__ __forceinline__ float dbf(const bf16_t* p, size_t i) { return __uint_as_float((unsigned)p[i] << 16); }
__device__ __forceinline__ float dsig(float v) { return 1.0f / (1.0f + expf(-v)); }
__device__ __forceinline__ float ddot(const bf16_t* a, const bf16_t* b, int K) { float s = 0.f; for (int k = 0; k < K; ++k) s += dbf(a, k) * dbf(b, k); return s; }
#endif
#define XB_TMO      128
#define XB_XCNT(j)  (256  + 64 * (j))
#define XB_XSUB(j)  (1280 + 64 * (j))
#define XB_XGEN(j)  (2304 + 64 * (j))
#define XB_TOP      3328
#define XB_TOPGEN   3392
#define XCD_BAR_WORDS 3456
#define XB_SPIN_CAP (1u << 18)

__device__ __forceinline__ unsigned xb_ld(unsigned* p)              { return __hip_atomic_load(p, __ATOMIC_RELAXED, __HIP_MEMORY_SCOPE_AGENT); }
__device__ __forceinline__ unsigned xb_add(unsigned* p, unsigned v) { return __hip_atomic_fetch_add(p, v, __ATOMIC_RELAXED, __HIP_MEMORY_SCOPE_AGENT); }
__device__ __forceinline__ unsigned xb_xcc_id() { return (unsigned)__builtin_amdgcn_s_getreg((3 << 11) | 20) & 0xFu; }
#define XB_SPIN(cond, bar) do { unsigned _sp = 0; while (cond) { __builtin_amdgcn_s_sleep(1); \
    if ((++_sp & 255u) == 0u) { if (xb_ld(&(bar)[XB_TMO])) break; if (_sp > XB_SPIN_CAP) { atomicAdd(&(bar)[XB_TMO], 1u); break; } } } } while (0)

struct XcdBarrier {
    unsigned* bar; unsigned x;
    volatile LAS unsigned* st;
};

__device__ __forceinline__ XcdBarrier xcd_barrier_post(unsigned* bar, volatile LAS unsigned* st, const bool leader) {
    XcdBarrier b; b.bar = bar; b.x = xb_xcc_id(); b.st = st;
    if (leader) (void)xb_add(&bar[XB_XCNT(b.x)], 1u);
    return b;
}
__device__ __forceinline__ void xcd_barrier_complete(unsigned* bar, unsigned x, unsigned& nloc, unsigned& nx) {
    const unsigned G = gridDim.x * gridDim.y * gridDim.z;
    unsigned sum, cnt, mine, sp = 0u;
    for (;;) {
        sum = 0u; cnt = 0u; mine = 0u;
#pragma unroll
        for (unsigned j = 0; j < 16; ++j) { const unsigned c = xb_ld(&bar[XB_XCNT(j)]); sum += c; cnt += (c > 0u) ? 1u : 0u; mine = (j == x) ? c : mine; }
        if (sum == G) break;
        __builtin_amdgcn_s_sleep(1);
        if ((++sp & 255u) == 0u) { if (xb_ld(&bar[XB_TMO])) break; if (sp > XB_SPIN_CAP) { atomicAdd(&bar[XB_TMO], 1u); break; } }
    }
    nloc = mine > 0u ? mine : 1u; nx = cnt > 0u ? cnt : 1u;
}

__device__ __forceinline__ void xcd_barrier(const XcdBarrier& b, const bool leader) {
    asm volatile("s_waitcnt vmcnt(0)" ::: "memory");
    __syncthreads();
    if (leader) {
        unsigned* bar = b.bar;
        __builtin_amdgcn_s_waitcnt(0);
        unsigned nloc = b.st[0], nx = b.st[1];
        if (nloc == 0u) { xcd_barrier_complete(bar, b.x, nloc, nx); b.st[0] = nloc; b.st[1] = nx; }
        const unsigned old = xb_add(&bar[XB_XSUB(b.x)], 1u);
        const unsigned gen = old / nloc;
        if (old + 1u == (gen + 1u) * nloc) {
            __builtin_amdgcn_fence(__ATOMIC_RELEASE, "agent");
            asm volatile("s_waitcnt vmcnt(0)" ::: "memory");
            const unsigned og = xb_add(&bar[XB_TOP], 1u);
            const unsigned tg = og / nx;
            if (og + 1u == (tg + 1u) * nx) xb_add(&bar[XB_TOPGEN], 1u);
            else XB_SPIN(xb_ld(&bar[XB_TOPGEN]) == tg, bar);
            __builtin_amdgcn_fence(__ATOMIC_ACQUIRE, "agent");
            xb_add(&bar[XB_XGEN(b.x)], 1u);
            asm volatile("s_waitcnt vmcnt(0)" ::: "memory");
        } else {
            XB_SPIN(xb_ld(&bar[XB_XGEN(b.x)]) == gen, bar);
            __builtin_amdgcn_fence(__ATOMIC_ACQUIRE, "agent");
            asm volatile("s_waitcnt vmcnt(0)" ::: "memory");
        }
    }
    __syncthreads();
}

constexpr size_t WS_BAR = WS_CSP + 65536;
constexpr int LDS_BARW = 153600 - 64;
__global__ void __launch_bounds__(512, 2) fwd_kernel(Args args) {
    extern __shared__ __attribute__((aligned(16))) unsigned char lds[];
    cg::grid_group grid = cg::this_grid();
    const int wave_top = __builtin_amdgcn_readfirstlane((int)threadIdx.x >> 6);
    const int tid = threadIdx.x, lane = tid & 63, wave = wave_top;
    const int G = gridDim.x, gw = blockIdx.x * 8 + wave, NGW = G * 8; (void)tid; (void)lane; (void)gw;
    unsigned char* ws = args.ws;
    const int lo = args.ph_lo, hi = args.ph_hi;
#ifndef PHMASK
#define PHMASK 0x3ff
#endif
#define IN(k) (((PHMASK >> (k)) & 1) && lo <= (k) && (k) < hi)
#ifndef REPMASK
#define REPMASK 0
#endif
#define FRESH_IDS int lane_o_ = __builtin_amdgcn_mbcnt_hi(~0u, __builtin_amdgcn_mbcnt_lo(~0u, 0u)); asm volatile("" : "+v"(lane_o_)); const int lane = lane_o_, wave = wave_top, tid = wave * 64 + lane, gw = blockIdx.x * 8 + wave; (void)tid; (void)gw;
#define PLAIN_IDS int tid_o_ = threadIdx.x; asm volatile("" : "+v"(tid_o_)); const int tid = tid_o_, lane = tid & 63, wave = wave_top, gw = blockIdx.x * 8 + wave; (void)lane; (void)gw;
#define REP(k) for (int rep_ = 0; rep_ <= ((REPMASK >> (k)) & 1); ++rep_)
#ifdef TSTAMP
    unsigned long long* TS = (unsigned long long*)(ws + WS_CSP + 32768);
#define SEAM(k) do { if (IN(k) && IN((k) + 1)) grid.sync(); if (blockIdx.x == 0 && tid == 0) TS[(k) + 1] = __builtin_amdgcn_s_memrealtime(); } while (0)
    if (blockIdx.x == 0 && tid == 0) TS[0] = __builtin_amdgcn_s_memrealtime();
#else
#define SEAM(k) do { if (IN(k) && IN((k) + 1)) { if (lo < 0) grid.sync();   xcd_barrier(xbar, wave_top == 0 && __builtin_amdgcn_mbcnt_hi(~0u, __builtin_amdgcn_mbcnt_lo(~0u, 0u)) == 0u); } } while (0)
#endif
    const float* x = args.in[0];
    float* rstdx = (float*)(ws + WS_RSTDX); float* rstdq = (float*)(ws + WS_RSTDQ); float* rstdkv = (float*)(ws + WS_RSTDKV); float* csp = (float*)(ws + WS_CSP);
    float* SS1 = (float*)(ws + WS_SS1); float* SS2 = (float*)(ws + WS_SS2); float* CS = (float*)(ws + WS_CS);
    bf16_t* W1 = (bf16_t*)(ws + WS_W1); bf16_t* WUP = (bf16_t*)(ws + WS_WUP); bf16_t* WDN = (bf16_t*)(ws + WS_WDN); bf16_t* WOUT = (bf16_t*)(ws + WS_WOUT);
    bf16_t* WUQ = (bf16_t*)(ws + WS_WUQ); bf16_t* WUKV = (bf16_t*)(ws + WS_WUKV); bf16_t* WLRU = (bf16_t*)(ws + WS_WLRU);
    bf16_t* KR = (bf16_t*)(ws + WS_KR); bf16_t* G1 = (bf16_t*)(ws + WS_G1); bf16_t* G2 = (bf16_t*)(ws + WS_G2); bf16_t* ZC = (bf16_t*)(ws + WS_ZC);
    bf16_t* KV = (bf16_t*)(ws + WS_KV); bf16_t* XB = (bf16_t*)(ws + WS_XB); bf16_t* XA = (bf16_t*)(ws + WS_XA); bf16_t* YB = (bf16_t*)(ws + WS_YB);
    bf16_t* ZX = (bf16_t*)(ws + WS_ZX); bf16_t* Q = (bf16_t*)(ws + WS_Q); bf16_t* MG = (bf16_t*)(ws + WS_MG); bf16_t* H1B = (bf16_t*)(ws + WS_H1B); bf16_t* U = (bf16_t*)(ws + WS_U);
    float* SSQ = (float*)(ws + WS_SS2); float* SSKV = (float*)(ws + WS_SS2 + 512 * 1024);
    bf16_t* H2B = (bf16_t*)(ws + WS_H2B); float* SUM = (float*)(ws + WS_SUM); float* SUB = (float*)(ws + WS_SUB);
    unsigned* AB = (unsigned*)args.out; float* OUT = args.out;
    LAS unsigned char* ldsg = (LAS unsigned char*)lds;

    if (threadIdx.x < 2) ((volatile LAS unsigned*)(ldsg + LDS_BARW))[threadIdx.x] = 0u;
    __syncthreads();
    XcdBarrier xbar; xbar.bar = (unsigned*)(ws + WS_BAR); xbar.x = 0; xbar.st = nullptr;
    if (hi - lo > 1) xbar = xcd_barrier_post((unsigned*)(ws + WS_BAR), (volatile LAS unsigned*)(ldsg + LDS_BARW), threadIdx.x == 0);
#ifdef DIAG
    unsigned* DG = (unsigned*)(ws + WS_CSP + 8192); unsigned* SAVE = (unsigned*)(ws + WS_CSP + 16384);
    if (lo >= 100) {
        const int dk = lo - 100; const unsigned gid = blockIdx.x * 512 + tid, NT_ = G * 512;
        if (dk == 0) {
            for (unsigned s = gid; s < 65536; s += NT_) { const unsigned h = dhash(s * 7 + 1);
                { const int p = h % 4864, k = (h >> 13) % 1024, src = srccol(0, p); const float want = src < 0 ? 0.f : args.in[2][(size_t)k * 4672 + src] * args.in[1][k]; DCHK(1, dbf(W1, (size_t)p * 1024 + k), want, 0.01f, 1e-6f); }
                { const int p = h % 1536, k = (h >> 13) % 256; DCHK(2, dbf(WUQ, (size_t)p * 256 + k), args.in[11][(size_t)k * 1536 + srccol(1, p)] * args.in[10][k], 0.01f, 1e-6f); }
                { const int p = h % 2048, k = (h >> 13) % 256; DCHK(3, dbf(WUKV, (size_t)p * 256 + k), args.in[13][(size_t)k * 2048 + p] * args.in[12][k], 0.01f, 1e-6f); }
                { const int p = h % 2048, k = (h >> 13) % 256, nb = p >> 8, isx = (p >> 7) & 1, d = p & 127, kk = k - 128 * (nb & 1);
                  const float want = (kk >= 0 && kk < 128) ? (isx ? args.in[7] : args.in[5])[(size_t)nb * 16384 + kk * 128 + d] : 0.f; DCHK(4, dbf(WLRU, (size_t)p * 256 + k), want, 0.01f, 1e-6f); }
                { const int p = h % 1024, k = (h >> 13) % 1024; DCHK(5, dbf(WOUT, (size_t)p * 1024 + k), args.in[14][(size_t)k * 1024 + p], 0.01f, 1e-6f); }
                { const int p = h % 4096, k = (h >> 13) % 1024; DCHK(6, dbf(WUP, (size_t)p * 1024 + k), args.in[16][(size_t)k * 4096 + p] * args.in[15][k], 0.01f, 1e-6f); }
                { const int p = h % 1024, k = (h >> 13) % 4096; DCHK(7, dbf(WDN, (size_t)p * 4096 + k), args.in[17][(size_t)k * 1024 + p], 0.01f, 1e-6f); }
                { const int r = h % T, c = (h >> 15) % 1024; DCHK(8, dbf(XB, (size_t)r * 1024 + c), x[(size_t)r * 1024 + c], 0.01f, 1e-6f); }
                { const int pos = h % 8191, i = (h >> 13) & 31; const float c0 = CS[(pos * 32 + i) * 2], s0 = CS[(pos * 32 + i) * 2 + 1], c1 = CS[((pos + 1) * 32 + i) * 2], s1 = CS[((pos + 1) * 32 + i) * 2 + 1], cd = CS[(32 + i) * 2], sd = CS[(32 + i) * 2 + 1];
                  DCHK(9, c1, c0 * cd - s0 * sd, 0.f, 1e-5f); DCHK(9, s1, s0 * cd + c0 * sd, 0.f, 1e-5f); DCHK(9, cd, __cosf(powf(10000.f, -(float)i / 32.f)), 0.f, 1e-4f); DCHK(9, CS[i * 2], 1.0f, 0.f, 1e-6f); }
            }
            for (unsigned s = gid; s < 4096; s += NT_) { const int r = dhash(s) % T; float q = 0.f; for (int c = 0; c < 1024; ++c) q += x[(size_t)r * 1024 + c] * x[(size_t)r * 1024 + c]; DCHK(8, rstdx[r], 1.0f / sqrtf(q / 1024.f + 1e-6f), 1e-3f, 0.f); }
        }
        if (dk == 1) for (unsigned s = gid; s < 32768; s += NT_) { const unsigned h = dhash(s * 3 + 11); const int r = h % T, p = (h >> 15) % 4864, t = p >> 8, w = p & 255;
            const float z = ddot(XB + (size_t)r * 1024, W1 + (size_t)p * 1024, 1024) * rstdx[r];
            if (t < 4) DCHK(11, dbf(ZX, (size_t)r * 1024 + p), z, 0.02f, 0.02f);
            else if (t < 12) { if (w < 128) { const float z2 = ddot(XB + (size_t)r * 1024, W1 + (size_t)(p + 128) * 1024, 1024) * rstdx[r];
                const float ge = 0.5f * z * (1.f + tanhf(0.7978845608f * (z + 0.044715f * z * z * z))); DCHK(12, dbf(G1, (size_t)r * 1024 + (t - 4) * 128 + w), ge * dsig(z2), 0.03f, 0.02f); } }
            else if (t < 16) DCHK(13, dbf(G2, (size_t)r * 1024 + p - 3072), dsig(z), 0.02f, 0.01f);
            else DCHK(14, dbf(ZC, (size_t)r * 768 + p - 4096), z, 0.02f, 0.02f); }
        if (dk == 2) for (unsigned s = gid; s < 65536; s += NT_) { const unsigned h = dhash(s * 5 + 3); const int r = (s & 1) ? (h % T) : ((h % 4) * 8192 + (h >> 8) % 6), c = (h >> 15) % 1024, pos = r & 8191;
            float v = args.in[4][c]; for (int j = 0; j < 4; ++j) if (pos - 3 + j >= 0) v += args.in[3][j * 1024 + c] * dbf(ZX, (size_t)(r - 3 + j) * 1024 + c);
            DCHK(21, dbf(XA, (size_t)r * 1024 + c), v, 0.02f, 0.02f);
            if (c < 64) { const int u = c, i = 4 * (u >> 3) + (u & 3), hf = (u >> 2) & 1; const float kl = dbf(ZC, (size_t)r * 768 + 512 + i), kh = dbf(ZC, (size_t)r * 768 + 512 + i + 32), cc = CS[(pos * 32 + i) * 2], ss = CS[(pos * 32 + i) * 2 + 1];
                DCHK(23, dbf(KR, (size_t)r * 64 + u), hf ? kh * cc + kl * ss : kl * cc - kh * ss, 0.02f, 0.02f); }
            if (c == 100) { float q = 0.f, k2 = 0.f; for (int j = 0; j < 256; ++j) { const float a = dbf(ZC, (size_t)r * 768 + j), b = dbf(ZC, (size_t)r * 768 + 256 + j); q += a * a; k2 += b * b; }
                DCHK(22, rstdq[r], 1.0f / sqrtf(q / 256.f + 1e-6f), 1e-3f, 0.f); DCHK(22, rstdkv[r], 1.0f / sqrtf(k2 / 256.f + 1e-6f), 1e-3f, 0.f); } }
        if (dk == 3) for (unsigned s = gid; s < 65536; s += NT_) { const unsigned h = dhash(s * 9 + 5); const int r = h % T, pos = r & 8191;
            { const int c = (h >> 15) % 1024, nb = c >> 7, d = c & 127; float dr = args.in[6][c], di = args.in[8][c];
              for (int k = 0; k < 128; ++k) { const float xv = dbf(XA, (size_t)r * 1024 + nb * 128 + k); dr += xv * args.in[5][(size_t)nb * 16384 + k * 128 + d]; di += xv * args.in[7][(size_t)nb * 16384 + k * 128 + d]; }
              const float rr_ = dsig(dr), ii = dsig(di), la = -8.0f * rr_ * log1pf(expf(-args.in[9][c])), bb = sqrtf(-expm1f(2.f * la)) * ii * dbf(XA, (size_t)r * 1024 + c);
              const pg8::h16x2 pv_ = __builtin_bit_cast(pg8::h16x2, AB[(size_t)r * 1024 + c]);
              DCHK(31, (float)pv_.x, la * 1.4426950408889634f, 0.03f, 1e-5f); DCHK(32, (float)pv_.y, bb, 0.03f, 0.01f); }
            { const int p = (h >> 13) % 1536; const float z = ddot(ZC + (size_t)r * 768, WUQ + (size_t)p * 256, 256) * rstdq[r];
              if (p < 1024) DCHK(33, dbf(Q, (size_t)r * 1536 + p), z, 0.02f, 0.02f);
              else { const int u = (p - 1024) & 63, i = 4 * (u >> 3) + (u & 3), islo = (u & 4) == 0; const float z2 = ddot(ZC + (size_t)r * 768, WUQ + (size_t)(p ^ 4) * 256, 256) * rstdq[r];
                  const float cc = CS[(pos * 32 + i) * 2], ss = CS[(pos * 32 + i) * 2 + 1]; DCHK(34, dbf(Q, (size_t)r * 1536 + p), islo ? z * cc - z2 * ss : z * cc + z2 * ss, 0.02f, 0.03f); } }
            { const int p = (h >> 11) % 2048; DCHK(35, dbf(KV, (size_t)r * 2048 + p), ddot(ZC + (size_t)r * 768 + 256, WUKV + (size_t)p * 256, 256) * rstdkv[r], 0.02f, 0.02f); } }
        if (dk == 3) for (unsigned s = gid; s < 4096; s += NT_) SAVE[s] = AB[dhash(s * 41 + 3) % (unsigned)(T * 1024)];
        if (dk == 4) {
            float* SC = (float*)(ws + WS_ZC + 9 * MiB);
            for (int s = gw; s < 1024; s += NGW) { const unsigned h = dhash(s * 13 + 7); const int b = h & 3, hd = (h >> 2) & 7, pos = (s & 3) == 0 ? (int)((h >> 5) % 300) : (int)((h >> 5) % 8192); const size_t r = (size_t)b * 8192 + pos;
                float* sc = SC + (size_t)s * 8192; float mx = -1e30f;
                for (int j = lane; j <= pos; j += 64) { const size_t kr = (size_t)b * 8192 + j; float d = 0.f;
                    for (int e = 0; e < 128; ++e) d += dbf(Q, r * 1536 + hd * 128 + e) * dbf(KV, kr * 2048 + hd * 256 + e);
                    for (int e = 0; e < 64; ++e) d += dbf(Q, r * 1536 + 1024 + hd * 64 + e) * dbf(KR, kr * 64 + e);
                    d *= 0.07216878364870322f; sc[j] = d; mx = fmaxf(mx, d); }
                for (int o = 1; o < 64; o <<= 1) mx = fmaxf(mx, __shfl_xor(mx, o));
                __builtin_amdgcn_fence(__ATOMIC_RELEASE, "workgroup"); __builtin_amdgcn_s_waitcnt(0);
                float l = 0.f, o0 = 0.f, o1 = 0.f;
                for (int j = 0; j <= pos; ++j) { const float p = expf(__builtin_nontemporal_load(sc + j) - mx); const size_t kr = (size_t)b * 8192 + j; l += p; o0 += p * dbf(KV, kr * 2048 + hd * 256 + 128 + lane); o1 += p * dbf(KV, kr * 2048 + hd * 256 + 192 + lane); }
                DCHK(41, dbf(YB, r * 1024 + hd * 128 + lane), o0 / l, 0.03f, 0.01f); DCHK(41, dbf(YB, r * 1024 + hd * 128 + 64 + lane), o1 / l, 0.03f, 0.01f); } }
        if (dk == 5) for (unsigned s = gid; s < 4096; s += NT_) if (SAVE[s] != AB[dhash(s * 41 + 3) % (unsigned)(T * 1024)]) atomicMin(DG, 48u);
        if (dk == 5) for (unsigned s = gid; s < 8192; s += NT_) { const unsigned h = dhash(s * 17 + 9); const int b = h & 3, c = (h >> 2) % 1024, pos = (s & 3) == 0 ? (int)((h >> 12) % 32) : (s & 3) == 1 ? (int)((h >> 12) % 256) : (int)((h >> 12) % 8192); float hh = 0.f, LL = 0.f;
            for (int j = 0; j <= pos; ++j) { const pg8::h16x2 pv_ = __builtin_bit_cast(pg8::h16x2, AB[((size_t)b * 8192 + j) * 1024 + c]); hh = exp2f((float)pv_.x) * hh + (float)pv_.y; LL += (float)pv_.x;
                if ((j & 31) == 31 && (j >> 5) == (pos >> 5) - 0 && false) {} }
            const size_t o = ((size_t)b * 8192 + pos) * 1024 + c; const int code = pos < 32 ? 51 : pos < 256 ? 52 : 53;
            DCHK(code, dbf(MG, o), dbf(G1, o) * hh + dbf(G2, o) * dbf(YB, o), 0.03f, 0.01f);
            { const int sc_ = (h >> 12) % 256; float h2 = 0.f, L2 = 0.f; for (int j = sc_ * 32; j < sc_ * 32 + 32; ++j) { const pg8::h16x2 pv_ = __builtin_bit_cast(pg8::h16x2, AB[((size_t)b * 8192 + j) * 1024 + c]); h2 = exp2f((float)pv_.x) * h2 + (float)pv_.y; L2 += (float)pv_.x; }
              DCHK(54, SUB[(((size_t)b * 256 + sc_) * 1024 + c) * 2], L2, 1e-3f, 1e-5f); DCHK(55, SUB[(((size_t)b * 256 + sc_) * 1024 + c) * 2 + 1], h2, 1e-3f, 1e-4f); }
            { const int kc = (h >> 12) % 32; float h2 = 0.f, L2 = 0.f; for (int j = kc * 256; j < kc * 256 + 256; ++j) { const pg8::h16x2 pv_ = __builtin_bit_cast(pg8::h16x2, AB[((size_t)b * 8192 + j) * 1024 + c]); h2 = exp2f((float)pv_.x) * h2 + (float)pv_.y; L2 += (float)pv_.x; }
              DCHK(56, SUM[(((size_t)b * 32 + kc) * 1024 + c) * 2], L2, 1e-3f, 1e-5f); DCHK(57, SUM[(((size_t)b * 32 + kc) * 1024 + c) * 2 + 1], h2, 1e-3f, 1e-4f); } }
        if (dk == 6) for (unsigned s = gid; s < 32768; s += NT_) { const unsigned h = dhash(s * 19 + 1); const int r = h % T, c = (h >> 15) % 1024;
            const float v = x[(size_t)r * 1024 + c] + ddot(MG + (size_t)r * 1024, WOUT + (size_t)c * 1024, 1024); DCHK(61, OUT[(size_t)r * 1024 + c], v, 0.02f, 0.02f); DCHK(62, dbf(H1B, (size_t)r * 1024 + c), v, 0.02f, 0.02f);
            if (c == 7) { float q = 0.f, q2 = 0.f; for (int j = 0; j < 1024; ++j) q += OUT[(size_t)r * 1024 + j] * OUT[(size_t)r * 1024 + j]; for (int j = 0; j < 16; ++j) q2 += SS1[(size_t)r * 16 + j]; DCHK(63, q2, q, 1e-3f, 0.f); } }
        if (dk == 7) for (unsigned s = gid; s < 32768; s += NT_) { const unsigned h = dhash(s * 23 + 1); const int r = h % T, c = (h >> 15) % 4096; float q2 = 0.f; for (int j = 0; j < 16; ++j) q2 += SS1[(size_t)r * 16 + j];
            const float u_ = ddot(H1B + (size_t)r * 1024, WUP + (size_t)c * 1024, 1024) / sqrtf(q2 / 1024.f + 1e-6f), rl = fmaxf(u_, 0.f); DCHK(71, dbf(U, (size_t)r * 4096 + c), rl * rl, 0.03f, 0.02f); }
        if (dk == 8) for (unsigned s = gid; s < 16384; s += NT_) { const unsigned h = dhash(s * 29 + 1); const int r = h % T, c = (h >> 15) % 1024;
            const float v = dbf(H1B, (size_t)r * 1024 + c) + ddot(U + (size_t)r * 4096, WDN + (size_t)c * 4096, 4096); DCHK(81, OUT[(size_t)r * 1024 + c], v, 0.02f, 0.04f);
            if (c == 7) { float q = 0.f, q2 = 0.f; for (int j = 0; j < 1024; ++j) q += OUT[(size_t)r * 1024 + j] * OUT[(size_t)r * 1024 + j]; for (int j = 0; j < 16; ++j) q2 += SS2[(size_t)r * 16 + j]; DCHK(82, q2, q, 1e-3f, 0.f); } }
        if (dk == 9) { for (unsigned s = gid; s < 4096; s += NT_) { const int r = dhash(s * 31) % T; float q = 0.f; for (int j = 0; j < 1024; ++j) { const float v = OUT[(size_t)r * 1024 + j] / args.in[18][j]; q += v * v; } DCHK(91, q / 1024.f, 1.0f, 0.01f, 0.f); } }
        if (dk == 10) { if (gid == 0) { const unsigned code = *DG; if (code < 1000u) OUT[0] = 100.0f + 10.0f * (float)code; OUT[1] = 10000.0f * (1.0f + (float)DG[1]); } }
        return;
    }
#endif
    if (IN(0)) REP(0) { PLAIN_IDS
        LAS float* scr = (LAS float*)(ldsg + wave * 16384);
        constexpr int I_W1 = 16 * (4864 / 64), I_UP = 16 * (4096 / 64), I_DN = 64 * (1024 / 64), I_OUT = 16 * 16, I_UQ = 4 * (1536 / 64), I_UKV = 4 * (2048 / 64), I_LRU = 16 * 8;
        constexpr int NITEMS = I_W1 + I_UP + I_DN + I_OUT + I_UQ + I_UKV + I_LRU;
        const int gw4 = gw, NGW4 = NGW;
        {
        for (int m0 = gw4 * 4; m0 < T; m0 += NGW4 * 4) {
            f32x4 v[4][4];
#pragma unroll
            for (int r = 0; r < 4; ++r) { const f32x4* xr = (const f32x4*)(x + (size_t)(m0 + r) * DM) + lane;
#pragma unroll
                for (int j = 0; j < 4; ++j) v[r][j] = __builtin_nontemporal_load(xr + 64 * j); }
#pragma unroll
            for (int r = 0; r < 4; ++r) { float s = 0.f;
#pragma unroll
                for (int j = 0; j < 4; ++j) s += (v[r][j][0] * v[r][j][0] + v[r][j][1] * v[r][j][1]) + (v[r][j][2] * v[r][j][2] + v[r][j][3] * v[r][j][3]);
                s = wave_sum(s);
                if (lane == 0) rstdx[m0 + r] = rsqrtf(s * (1.0f / 1024.0f) + 1e-6f);
                u32x2* o = (u32x2*)(XB + (size_t)(m0 + r) * DM) + lane;
#pragma unroll
                for (int j = 0; j < 4; ++j) { u32x2 w; w.x = pkbf(v[r][j][0], v[r][j][1]); w.y = pkbf(v[r][j][2], v[r][j][3]); o[64 * j] = w; } }
        }
        }
        {
        for (int it = gw4; it < NITEMS; it += NGW4) {
            int r = it;
            if (r < I_W1) { tr_item64(args.in[2], 4672, 1024, 4864, args.in[1], W1, 0, r, lane); continue; } r -= I_W1;
            if (r < I_UP) { tr_item64(args.in[16], 4096, 1024, 4096, args.in[15], WUP, 2, r, lane); continue; } r -= I_UP;
            if (r < I_DN) { tr_item64(args.in[17], 1024, 4096, 1024, nullptr, WDN, 2, r, lane); continue; } r -= I_DN;
            if (r < I_OUT) { tr_item64(args.in[14], 1024, 1024, 1024, nullptr, WOUT, 2, r, lane); continue; } r -= I_OUT;
            if (r < I_UQ) { tr_item64(args.in[11], 1536, 256, 1536, args.in[10], WUQ, 1, r, lane); continue; } r -= I_UQ;
            if (r < I_UKV) { tr_item64(args.in[13], 2048, 256, 2048, args.in[12], WUKV, 2, r, lane); continue; } r -= I_UKV;
            { const int blk = r >> 3, sub = r & 7, nb = blk >> 1, isx = blk & 1;
              tr_item64((isx ? args.in[7] : args.in[5]) + (size_t)nb * 16384, 128, 256, 128, nullptr, WLRU + (size_t)(256 * nb + 128 * isx) * 256, 2, sub, lane, 128 * (nb & 1), 128); }
        }
        for (int i = blockIdx.x * 512 + tid; i < SEQ * 32; i += G * 512) {
            const int pos = i >> 5, k = i & 31; double inv = 1.0; for (int q = 0; q < k; ++q) inv *= 0.74989420933245582730;
            float s, c; sincos_d((double)pos * inv, s, c); CS[2 * i] = c; CS[2 * i + 1] = s;
        }
        for (int i = blockIdx.x * 512 + tid; i < 1024; i += G * 512) csp[i] = 8.0f * 1.4426950408889634f * log1pf(__expf(-args.in[9][i]));
            }
    }
    SEAM(0);

    if (IN(1)) REP(1) { PLAIN_IDS
        pg8::Gemm g{XB, W1, T, 4864, 1024, 1024, 1024, 0, 0}; pg8::StaticOrder S; S.init(T, 4864, G, (int)blockIdx.x);
        pg8::EpiIn E{ZX, G1, G2, ZC, rstdx, SSQ, SSKV, KR, CS};
        pg8::gemm_phase<pg8::EpiIn, pg8::StaticOrder, true, true>(ldsg, g, S, E, tid);
    }
    SEAM(1);

    if (IN(2)) REP(2) { PLAIN_IDS
        const float* cw = args.in[3]; const float* cb = args.in[4];
        for (int it = gw; it < (T / 16) * 2; it += NGW) {
            const int t0 = (it >> 1) * 16, c0 = (it & 1) * 512 + lane * 8;
            float w[4][8], bias[8], h0[8], h1[8], h2[8];
#pragma unroll
            for (int j = 0; j < 4; ++j) { const f32x4 a = *(const f32x4*)(cw + j * 1024 + c0), b = *(const f32x4*)(cw + j * 1024 + c0 + 4);
#pragma unroll
                for (int e = 0; e < 4; ++e) { w[j][e] = a[e]; w[j][4 + e] = b[e]; } }
            { const f32x4 a = *(const f32x4*)(cb + c0), b = *(const f32x4*)(cb + c0 + 4);
#pragma unroll
              for (int e = 0; e < 4; ++e) { bias[e] = a[e]; bias[4 + e] = b[e]; } }
            const bool first = (t0 & (SEQ - 1)) == 0;
            { u32x4 r0 = {0u, 0u, 0u, 0u}, r1 = r0, r2 = r0;
              if (!first) { r0 = *(const u32x4*)(ZX + (size_t)(t0 - 3) * DM + c0); r1 = *(const u32x4*)(ZX + (size_t)(t0 - 2) * DM + c0); r2 = *(const u32x4*)(ZX + (size_t)(t0 - 1) * DM + c0); }
#pragma unroll
              for (int e = 0; e < 4; ++e) { h0[2 * e] = bflo(r0[e]); h0[2 * e + 1] = bfhi(r0[e]); h1[2 * e] = bflo(r1[e]); h1[2 * e + 1] = bfhi(r1[e]); h2[2 * e] = bflo(r2[e]); h2[2 * e + 1] = bfhi(r2[e]); } }
            u32x4 rows[16];
#pragma unroll
            for (int i = 0; i < 16; ++i) rows[i] = __builtin_nontemporal_load((const u32x4*)(ZX + (size_t)(t0 + i) * DM + c0));
#pragma unroll
            for (int i = 0; i < 16; ++i) { const u32x4 r = rows[i]; float cur[8], o[8];
#pragma unroll
                for (int e = 0; e < 4; ++e) { cur[2 * e] = bflo(r[e]); cur[2 * e + 1] = bfhi(r[e]); }
#pragma unroll
                for (int e = 0; e < 8; ++e) { o[e] = bias[e] + w[0][e] * h0[e] + w[1][e] * h1[e] + w[2][e] * h2[e] + w[3][e] * cur[e]; h0[e] = h1[e]; h1[e] = h2[e]; h2[e] = cur[e]; }
                u32x4 ow; ow.x = pkbf(o[0], o[1]); ow.y = pkbf(o[2], o[3]); ow.z = pkbf(o[4], o[5]); ow.w = pkbf(o[6], o[7]);
                *(u32x4*)(XA + (size_t)(t0 + i) * DM + c0) = ow; }
        }
    }
    SEAM(2);

    if (IN(3)) REP(3) { PLAIN_IDS
#ifndef P3SEL
#define P3SEL 7
#endif
        if (P3SEL & 1) { pg8::Gemm g{XA, WLRU, T, 2048, 256, 1024, 256, 512, 1}; pg8::StaticOrder S; S.init(T, 2048, G, (int)blockIdx.x);
#ifdef TESTLRU
          pg8::EpiRowScale E{KV, 2048, SSKV};
          pg8::gemm_phase<pg8::EpiRowScale, pg8::StaticOrder, true, true>(ldsg, g, S, E, tid); }
#else
          pg8::EpiLru E{XA, args.in[6], args.in[8], csp, AB};
          pg8::gemm_phase<pg8::EpiLru, pg8::StaticOrder, true, true>(ldsg, g, S, E, tid); }
#endif
        if (P3SEL & 2) { pg8::Gemm g{ZC, WUQ, T, 1536, 256, 768, 256, 0, 0}; pg8::StaticOrder S; S.init(T, 1536, G, (int)blockIdx.x);
          pg8::EpiQ E{Q, SSQ, CS};
          pg8::gemm_phase<pg8::EpiQ, pg8::StaticOrder, true, true>(ldsg, g, S, E, tid); }
        if (P3SEL & 4) { pg8::Gemm g{ZC + 256, WUKV, T, 2048, 256, 768, 256, 0, 0}; pg8::StaticOrder S; S.init(T, 2048, G, (int)blockIdx.x);
          pg8::EpiRowScale E{KV, 2048, SSKV};
          pg8::gemm_phase<pg8::EpiRowScale, pg8::StaticOrder, true, true>(ldsg, g, S, E, tid); }
    }
    SEAM(3);

    if (IN(4)) REP(4) { FRESH_IDS
        for (int un = blockIdx.x; un < 256; un += G) {
            const int b = un >> 6, ch = un & 63, c = wave * 128 + lane * 2;
            const unsigned* ap = AB + ((size_t)b * SEQ + ch * 128) * DM + c;
            float h0 = 0.f, h1 = 0.f, L0 = 0.f, L1 = 0.f;
            for (int i0 = 0; i0 < 128; i0 += 16) { h16x4 w[16];
#pragma unroll
                for (int i = 0; i < 16; ++i) w[i] = __builtin_nontemporal_load((const h16x4*)(ap + (size_t)(i0 + i) * DM));
#pragma unroll
                for (int i = 0; i < 16; ++i) { const float l0 = (float)w[i][0], l1 = (float)w[i][2];
                    h0 = __builtin_amdgcn_exp2f(l0) * h0 + (float)w[i][1]; h1 = __builtin_amdgcn_exp2f(l1) * h1 + (float)w[i][3]; L0 += l0; L1 += l1; } }
            *(f32x4*)(SUM + (((size_t)b * 64 + ch) * 1024 + c) * 2) = (f32x4){L0, h0, L1, h1};
        }
        {
            constexpr int NITEM = 32 * 16;
#define ITEM_BH(LL) (G == 256 ? (((LL) & 7) + 8 * (2 * ((LL) >> 8) + (((LL) >> 7) & 1))) : ((LL) >> 4))
#define ITEM_X(LL)  (G == 256 ? (((LL) >> 3) & 15) : ((LL) & 15))
            int L = blockIdx.x;
            if (L < NITEM) {
                att::Seam S; int pass = 0;
#define MKREF(r, LL, ps) do { const int bh_ = ITEM_BH(LL), xx_ = ITEM_X(LL), qb_ = (ps) ? 31 - xx_ : xx_, b_ = bh_ >> 3, h_ = bh_ & 7; \
                    const size_t row0_ = (size_t)b_ * SEQ + qb_ * 256, key0_ = (size_t)b_ * SEQ; \
                    r.Qn = Q + row0_ * 1536 + h_ * 128; r.Qr = Q + row0_ * 1536 + 1024 + h_ * 64; r.Kn = KV + key0_ * 2048 + h_ * 256; r.V = r.Kn + 128; r.Kr = KR + key0_ * 64; \
                    r.O = YB + row0_ * 1024 + h_ * 128; r.P0 = qb_ * 256; } while (0)
                att::BlockRef cur, nxt; MKREF(cur, L, 0);
                att::attn_prime(cur, (char*)lds, S, tid);
                for (;;) {
                    const bool more_pass = pass == 0, more_item = L + G < NITEM, last = !more_pass && !more_item;
                    int passn = pass + 1, Ln = L;
                    if (!more_pass) { passn = 0; Ln = more_item ? L + G : L; }
                    MKREF(nxt, Ln, passn);
                    att::attn_block(cur, nxt, (char*)lds, S, tid);
                    if (last) break;
                    cur = nxt; pass = passn; L = Ln;
                }
            }
#undef MKREF
#undef ITEM_BH
#undef ITEM_X
        }
    }
    SEAM(4);

    if (IN(5)) REP(5) { FRESH_IDS
        for (int gi = blockIdx.x; gi < 256; gi += G) {
            const int b = gi >> 6, ch = gi & 63, c = wave * 128 + lane * 2;
            float h0 = 0.f, h1 = 0.f;
            for (int k0 = 0; k0 < ch; k0 += 8) { f32x4 sv[8];
#pragma unroll
                for (int j = 0; j < 8; ++j) { const int kk = (k0 + j < 63) ? k0 + j : 63; sv[j] = *(const f32x4*)(SUM + (((size_t)b * 64 + kk) * 1024 + c) * 2); }
#pragma unroll
                for (int j = 0; j < 8; ++j) if (k0 + j < ch) { h0 = __builtin_amdgcn_exp2f(sv[j][0]) * h0 + sv[j][1]; h1 = __builtin_amdgcn_exp2f(sv[j][2]) * h1 + sv[j][3]; } }
            const size_t row0 = (size_t)b * SEQ + ch * 128;
            for (int i0 = 0; i0 < 128; i0 += 32) { h16x4 w[32]; unsigned g1[32], g2[32], yb[32];
#pragma unroll
                for (int i = 0; i < 32; ++i) { const size_t off = (row0 + i0 + i) * DM + c;
                    w[i] = __builtin_nontemporal_load((const h16x4*)(AB + off)); g1[i] = __builtin_nontemporal_load((const unsigned*)(G1 + off)); g2[i] = __builtin_nontemporal_load((const unsigned*)(G2 + off)); yb[i] = __builtin_nontemporal_load((const unsigned*)(YB + off)); }
#pragma unroll
                for (int i = 0; i < 32; ++i) { const size_t off = (row0 + i0 + i) * DM + c;
                    h0 = __builtin_amdgcn_exp2f((float)w[i][0]) * h0 + (float)w[i][1]; h1 = __builtin_amdgcn_exp2f((float)w[i][2]) * h1 + (float)w[i][3];
                    *(unsigned*)(MG + off) = pkbf(bflo(g1[i]) * h0 + bflo(g2[i]) * bflo(yb[i]), bfhi(g1[i]) * h1 + bfhi(g2[i]) * bfhi(yb[i])); } }
        }
    }
    SEAM(5);

    if (IN(6)) REP(6) { FRESH_IDS
        pg8::Gemm g{MG, WOUT, T, 1024, 1024, 1024, 1024, 0, 0}; pg8::StaticOrder S; S.init(T, 1024, G, (int)blockIdx.x);
        pg8::EpiRes<true> E{x, nullptr, H1B, SS1};
        pg8::gemm_phase<pg8::EpiRes<true>, pg8::StaticOrder, true, true>(ldsg, g, S, E, tid);
    }
    SEAM(6);

    if (IN(7)) REP(7) { FRESH_IDS
        pg8::Gemm g{H1B, WUP, T, 4096, 1024, 1024, 1024, 0, 0}; pg8::StaticOrder S; S.init(T, 4096, G, (int)blockIdx.x);
        pg8::EpiUp E{U, SS1};
        pg8::gemm_phase<pg8::EpiUp, pg8::StaticOrder, true, true>(ldsg, g, S, E, tid);
    }
    SEAM(7);

    if (IN(8)) REP(8) { FRESH_IDS
        pg8::Gemm g{U, WDN, T, 1024, 4096, 4096, 4096, 0, 0}; pg8::StaticOrder S; S.init(T, 1024, G, (int)blockIdx.x);
        pg8::EpiRes<false> E{nullptr, H1B, H2B, SS2};
        pg8::gemm_phase<pg8::EpiRes<false>, pg8::StaticOrder, true, true>(ldsg, g, S, E, tid);
    }
    SEAM(8);

    if (IN(9)) REP(9) { FRESH_IDS
        const float* gf = args.in[18];
        f32x4 gv[4];
#pragma unroll
        for (int j = 0; j < 4; ++j) gv[j] = ((const f32x4*)gf)[lane + 64 * j];
        for (int m0 = gw * 4; m0 < T; m0 += NGW * 4) {
            f32x4 v[4][4]; float rs[4];
#pragma unroll
            for (int r = 0; r < 4; ++r) { const u32x2* o = (const u32x2*)(H2B + (size_t)(m0 + r) * DM) + lane;
#pragma unroll
                for (int j = 0; j < 4; ++j) { const u32x2 bw = __builtin_nontemporal_load(o + 64 * j); v[r][j] = (f32x4){bflo(bw.x), bfhi(bw.x), bflo(bw.y), bfhi(bw.y)}; }
                const f32x4* sp = (const f32x4*)(SS2 + (size_t)(m0 + r) * 16); const f32x4 s = (sp[0] + sp[1]) + (sp[2] + sp[3]);
                rs[r] = rsqrtf(((s[0] + s[1]) + (s[2] + s[3])) * (1.0f / 1024.0f) + 1e-6f); }
#pragma unroll
            for (int r = 0; r < 4; ++r) { f32x4* o = (f32x4*)(OUT + (size_t)(m0 + r) * DM) + lane;
#pragma unroll
                for (int j = 0; j < 4; ++j) __builtin_nontemporal_store(v[r][j] * rs[r] * gv[j], o + 64 * j); }
        }
    }
#ifdef TSTAMP
    grid.sync();
    if (blockIdx.x == 0 && tid == 0) TS[10] = __builtin_amdgcn_s_memrealtime();
    __threadfence(); grid.sync();
    { const float da = (float)(TS[TSTAMP_A + 1] - TS[TSTAMP_A]) * 0.01f, db = (float)(TS[TSTAMP_B + 1] - TS[TSTAMP_B]) * 0.01f;
      for (size_t i = (size_t)blockIdx.x * 512 + tid; i < ((size_t)1 << 22); i += (size_t)G * 512) OUT[i] = (i == 0) ? 10.0f * da : db; }
#endif
#undef IN
#undef SEAM
}

constexpr int LDS_TOTAL = 153600;
static_assert(att::LDS_BYTES <= LDS_TOTAL && pg8::STAGE_BYTES <= LDS_TOTAL, "LDS");
extern "C" void kernel_launch(void* const* d_in, const int* in_sizes, int n_in, void* d_out, int out_size, void* d_ws, size_t ws_size, hipStream_t stream) {
    static int grid = 0;
    if (grid == 0) {
        if (n_in != 19 || out_size != T * DM || ws_size < WS_END) { fprintf(stderr, "kernel_launch: unexpected shapes (n_in %d, out %d, ws %zu)\n", n_in, out_size, ws_size); grid = -1; return; }
        int dev = 0, cus = 0, per_cu = 0;
        (void)hipGetDevice(&dev); (void)hipDeviceGetAttribute(&cus, hipDeviceAttributeMultiprocessorCount, dev);
        if (hipFuncSetAttribute((const void*)fwd_kernel, hipFuncAttributeMaxDynamicSharedMemorySize, LDS_TOTAL) != hipSuccess) { fprintf(stderr, "kernel_launch: hipFuncSetAttribute failed\n"); grid = -1; return; }
        if (hipOccupancyMaxActiveBlocksPerMultiprocessor(&per_cu, (const void*)fwd_kernel, 512, LDS_TOTAL) != hipSuccess || per_cu < 1) { fprintf(stderr, "kernel_launch: occupancy query says %d\n", per_cu); per_cu = 1; }
        (void)hipGetLastError();
        grid = cus * 1;
        if (grid <= 0) grid = 256;
    }
    if (grid < 0) return;
    Args a{};
    for (int i = 0; i < 19; ++i) a.in[i] = (const float*)d_in[i];
    a.out = (float*)d_out; a.ws = (unsigned char*)d_ws;
#if N_LAUNCHES == 1
    a.ph_lo = 0; a.ph_hi = NPHASE;
    (void)hipMemsetAsync((unsigned char*)d_ws + WS_BAR, 0, 16384, stream);
    void* kargs[] = {&a};
    hipError_t e = hipLaunchCooperativeKernel((const void*)fwd_kernel, dim3(grid), dim3(512), kargs, LDS_TOTAL, stream);
    if (e != hipSuccess) fprintf(stderr, "kernel_launch: cooperative launch failed: %s (grid %d)\n", hipGetErrorString(e), grid);
#else
#ifdef DIAG
    (void)hipMemsetAsync((unsigned char*)d_ws + WS_CSP + 8192, 0x7f, 4, stream); (void)hipMemsetAsync((unsigned char*)d_ws + WS_CSP + 8196, 0, 4, stream);
#endif
#ifndef PROBE_LIST
#define PROBE_LIST 0,1,2,3,4,5,6,7,8,9
#endif
    static const int plist[] = {PROBE_LIST};
    for (int pi = 0; pi < (int)(sizeof(plist) / sizeof(int)); ++pi) { const int p = plist[pi]; a.ph_lo = p; a.ph_hi = p + 1;
        hipLaunchKernelGGL(fwd_kernel, dim3(grid), dim3(512), LDS_TOTAL, stream, a);
#ifdef DIAG
        a.ph_lo = 100 + p; a.ph_hi = 101 + p; hipLaunchKernelGGL(fwd_kernel, dim3(grid), dim3(512), LDS_TOTAL, stream, a);
        if (p == NPHASE - 1) { a.ph_lo = 110; a.ph_hi = 111; hipLaunchKernelGGL(fwd_kernel, dim3(grid), dim3(512), LDS_TOTAL, stream, a); }
#endif
        if (hipPeekAtLastError() != hipSuccess) { fprintf(stderr, "kernel_launch: launch %d failed\n", p); break; } }
#endif
}
```

```cpp
#define N_LAUNCHES 1
#include <hip/hip_runtime.h>
#include <hip/hip_cooperative_groups.h>
#include <cstdio>
#include <cstdint>
namespace cg = cooperative_groups;
namespace pg8 {
#define PG8_LAS __attribute__((address_space(3)))
typedef unsigned short bf16_t;
typedef short bf16x8 __attribute__((ext_vector_type(8)));
typedef float f32x4 __attribute__((ext_vector_type(4)));
typedef unsigned u32x4 __attribute__((ext_vector_type(4)));
constexpr int BM = 256, BK = 64, HALF = 128, HTB = HALF * BK * 2  , STAGE_BYTES = 8 * HTB, NXCD = 8, WGM = 8;

__host__ __device__ __forceinline__ int lds_byte(int r, int c) { const int st = (r >> 4) * 2 + (c >> 5), rr = r & 15, cc = c & 31, ob = rr * 64 + cc * 2; return st * 1024 + (ob ^ (((ob >> 9) & 1) << 5)); }
__host__ __device__ __forceinline__ void stage_rc(int b, int& R, int& C) { const int st = b / 1024, sb = b % 1024, swz = sb ^ (((sb >> 9) & 1) << 5); R = (st >> 1) * 16 + swz / 64; C = (st & 1) * 32 + (swz % 64) / 2; }
__host__ __device__ __forceinline__ int perm32(int rho) { const int n = rho >> 4, i = rho & 15; return 8 * (i >> 2) + 4 * n + (i & 3); }

struct Unit { int pm, pn; };
struct Gemm { const bf16_t* A; const bf16_t* Bt; int M, N, K, lda, ldb; long a_pn_bytes; int a_pn_shift; };

struct StaticOrder {
    int nM, nN, nwg, G, c;
    __host__ __device__ void init(int M, int N, int G_, int c_) { nM = M / BM; nN = N / BM; nwg = nM * nN; G = G_; c = c_; }
    __host__ __device__ bool next(int i, Unit& u) const {
        const long L = (long)i * G + c; if (L >= nwg) return false;
        int wgid = (int)L; { const int q = nwg / NXCD, r = nwg % NXCD, xcd = wgid % NXCD, off = wgid / NXCD; wgid = (xcd < r ? xcd * (q + 1) : r * (q + 1) + (xcd - r) * q) + off; }
        const int nig = WGM * nN, gid = wgid / nig, fm = gid * WGM, gsz = (nM - fm) < WGM ? (nM - fm) : WGM;
        u.pm = fm + ((wgid % nig) % gsz); u.pn = (wgid % nig) / gsz; return true;
    }
    __device__ __forceinline__ void a_ready(const Unit&) const {}
    __device__ __forceinline__ void done(const Unit&) const {}
};

__device__ __forceinline__ unsigned cvt_pk_bf16(float lo, float hi) { unsigned r; asm volatile("v_cvt_pk_bf16_f32 %0, %1, %2" : "=v"(r) : "v"(lo), "v"(hi)); return r; }
typedef float f32x2 __attribute__((ext_vector_type(2)));
typedef unsigned u32x2 __attribute__((ext_vector_type(2)));
typedef _Float16 h16x2 __attribute__((ext_vector_type(2)));
__device__ __forceinline__ float fsigmoid(float v) { return __builtin_amdgcn_rcpf(1.0f + __expf(-v)); }
__device__ __forceinline__ float gelu_tanh(float v) { const float y = 1.5957691216057308f * (v + 0.044715f * v * v * v); return v * fsigmoid(y); }
__device__ __forceinline__ u32x4 pack8f(const f32x4 a, const f32x4 b) { u32x4 w; w.x = cvt_pk_bf16(a[0], a[1]); w.y = cvt_pk_bf16(a[2], a[3]); w.z = cvt_pk_bf16(b[0], b[1]); w.w = cvt_pk_bf16(b[2], b[3]); return w; }
__device__ __forceinline__ float bf2f(unsigned short b) { return __uint_as_float((unsigned)b << 16); }

struct EpiIn {
    static constexpr bool PERM = true, AFTER_DRAIN = false;
    bf16_t *ZX, *G1, *G2, *ZC; const float* rstd; float *SSQ, *SSKV; bf16_t* KR; const float* CS;
    __device__ __forceinline__ void operator()(const f32x4 (&acc)[2][2][4][2], const Unit& u, int wr, int wc, int fr, int fq) const {
        const int row0 = u.pm * BM + wr * 64 + fr, cl = wc * 32 + 8 * fq, pn = u.pn;
        float rsv[2][4];
#pragma unroll
        for (int ai = 0; ai < 2; ++ai)
#pragma unroll
            for (int m = 0; m < 4; ++m) rsv[ai][m] = rstd[row0 + ai * HALF + m * 16];
#pragma unroll
        for (int ai = 0; ai < 2; ++ai)
#pragma unroll
            for (int m = 0; m < 4; ++m) { const int row = row0 + ai * HALF + m * 16; const float rs = rsv[ai][m];
                if (pn >= 4 && pn < 12) {
                    f32x4 o[2];
#pragma unroll
                    for (int n = 0; n < 2; ++n)
#pragma unroll
                        for (int e = 0; e < 4; ++e) o[n][e] = gelu_tanh(acc[ai][0][m][n][e] * rs) * fsigmoid(acc[ai][1][m][n][e] * rs);
                    __builtin_nontemporal_store(pack8f(o[0], o[1]), (u32x4*)(G1 + (size_t)row * 1024 + (pn - 4) * 128 + cl));
                } else {
#pragma unroll
                    for (int bj = 0; bj < 2; ++bj) { f32x4 v0 = acc[ai][bj][m][0] * rs, v1 = acc[ai][bj][m][1] * rs;
                        if (pn < 4) *(u32x4*)(ZX + (size_t)row * 1024 + pn * 256 + bj * HALF + cl) = pack8f(v0, v1);
                        else if (pn < 16) {
#pragma unroll
                            for (int e = 0; e < 4; ++e) { v0[e] = fsigmoid(v0[e]); v1[e] = fsigmoid(v1[e]); }
                            __builtin_nontemporal_store(pack8f(v0, v1), (u32x4*)(G2 + (size_t)row * 1024 + (pn - 12) * 256 + bj * HALF + cl));
                        } else if (pn < 18) *(u32x4*)(ZC + (size_t)row * 768 + (pn - 16) * 256 + bj * HALF + cl) = pack8f(v0, v1);
                        else if (bj == 0 && wc < 2) {
                            const float* cs = CS + ((size_t)(row & 8191) * 32 + 16 * wc + 4 * fq) * 2;
                            const f32x4 c01 = *(const f32x4*)cs, c23 = *(const f32x4*)(cs + 4);
                            const float co[4] = {c01[0], c01[2], c23[0], c23[2]}, si[4] = {c01[1], c01[3], c23[1], c23[3]}; f32x4 olo, ohi;
#pragma unroll
                            for (int e2 = 0; e2 < 4; ++e2) { olo[e2] = v0[e2] * co[e2] - v1[e2] * si[e2]; ohi[e2] = v1[e2] * co[e2] + v0[e2] * si[e2]; }
                            *(u32x4*)(KR + (size_t)row * 64 + cl) = pack8f(olo, ohi); }
                    }
                    if (pn == 16 || pn == 17) {
                        float ss = 0.f;
#pragma unroll
                        for (int bj = 0; bj < 2; ++bj)
#pragma unroll
                            for (int n = 0; n < 2; ++n) { const f32x4 z = acc[ai][bj][m][n] * rs; ss += (z[0] * z[0] + z[1] * z[1]) + (z[2] * z[2] + z[3] * z[3]); }
                        ss += __shfl_xor(ss, 16); ss += __shfl_xor(ss, 32);
                        if (fq == 0) (pn == 16 ? SSQ : SSKV)[(size_t)row * 4 + wc] = ss; }
                }
            }
    }
};
__device__ __forceinline__ float one_minus_exp(float x) {
    const float p = -x * (1.0f + x * (0.5f + x * (0.16666667f + x * (0.041666668f + x * 0.0083333338f))));
    const float q = 1.0f - __builtin_amdgcn_exp2f(x * 1.4426950408889634f);
    return x > -0.2f ? p : q;
}
struct EpiLru {
    static constexpr bool PERM = true, AFTER_DRAIN = false;
    const bf16_t* XA; const float *ba, *bx, *csp; unsigned* AB;
    __device__ __forceinline__ void operator()(const f32x4 (&acc)[2][2][4][2], const Unit& u, int wr, int wc, int fr, int fq) const {
        const int c0 = u.pn * 128 + wc * 32 + 8 * fq;
        const unsigned lo = (unsigned)((wr * 64 + fr) * 1024 + c0);
        const char* xau = (const char*)(XA + (size_t)u.pm * BM * 1024); char* abu = (char*)(AB + (size_t)u.pm * BM * 1024);
        u32x4 xw[2][4];
#pragma unroll
        for (int ai = 0; ai < 2; ++ai)
#pragma unroll
            for (int m = 0; m < 4; ++m) xw[ai][m] = *(const u32x4*)(xau + (size_t)((ai * HALF + m * 16) * 1024) * 2 + lo * 2u);
        f32x4 vba[2], vbx[2], vcs[2];
#pragma unroll
        for (int n = 0; n < 2; ++n) { vba[n] = *(const f32x4*)(ba + c0 + 4 * n); vbx[n] = *(const f32x4*)(bx + c0 + 4 * n); vcs[n] = *(const f32x4*)(csp + c0 + 4 * n); }
#pragma unroll
        for (int ai = 0; ai < 2; ++ai)
#pragma unroll
            for (int m = 0; m < 4; ++m)
#pragma unroll
                for (int n = 0; n < 2; ++n) { u32x4 ow;
#pragma unroll
                    for (int e = 0; e < 4; ++e) { const unsigned w = xw[ai][m][2 * n + (e >> 1)]; const float xa = __uint_as_float((e & 1) ? (w & 0xffff0000u) : (w << 16));
                        const float r = fsigmoid(acc[ai][0][m][n][e] + vba[n][e]), ig = fsigmoid(acc[ai][1][m][n][e] + vbx[n][e]);
                        const float la2 = -vcs[n][e] * r; const float b = __builtin_amdgcn_sqrtf(fmaxf(1.0f - __builtin_amdgcn_exp2f(2.0f * la2), 0.f)) * (ig * xa);
                        h16x2 hv; hv.x = (_Float16)la2; hv.y = (_Float16)b; ow[e] = __builtin_bit_cast(unsigned, hv); }
                    *(u32x4*)(abu + (size_t)((ai * HALF + m * 16) * 1024 + 4 * n) * 4 + lo * 4u) = ow; }
    }
};
struct EpiQ {
    static constexpr bool PERM = true, AFTER_DRAIN = false;
    bf16_t* Q; const float* SSp; const float* CS;
    __device__ __forceinline__ void operator()(const f32x4 (&acc)[2][2][4][2], const Unit& u, int wr, int wc, int fr, int fq) const {
        const int row0 = u.pm * BM + wr * 64 + fr, cl = wc * 32 + 8 * fq, pn = u.pn;
        f32x4 spv[2][4];
#pragma unroll
        for (int ai = 0; ai < 2; ++ai)
#pragma unroll
            for (int m = 0; m < 4; ++m) spv[ai][m] = *(const f32x4*)(SSp + (size_t)(row0 + ai * HALF + m * 16) * 4);
#pragma unroll
        for (int ai = 0; ai < 2; ++ai) {
            f32x4 c01[4], c23[4];
            if (pn >= 4) {
#pragma unroll
                for (int m = 0; m < 4; ++m) { const float* cs = CS + ((size_t)((row0 + ai * HALF + m * 16) & 8191) * 32 + 16 * (wc & 1) + 4 * fq) * 2; c01[m] = *(const f32x4*)cs; c23[m] = *(const f32x4*)(cs + 4); } }
#pragma unroll
            for (int m = 0; m < 4; ++m) { const int row = row0 + ai * HALF + m * 16; const f32x4 sp = spv[ai][m]; const float rs = rsqrtf(((sp[0] + sp[1]) + (sp[2] + sp[3])) * (1.0f / 256.0f) + 1e-6f);
                bf16_t* op = Q + (size_t)row * 1536 + pn * 256 + cl;
                if (pn < 4) {
#pragma unroll
                    for (int bj = 0; bj < 2; ++bj) *(u32x4*)(op + bj * HALF) = pack8f(acc[ai][bj][m][0] * rs, acc[ai][bj][m][1] * rs);
                } else {
                    const float co[4] = {c01[m][0], c01[m][2], c23[m][0], c23[m][2]}, si[4] = {c01[m][1], c01[m][3], c23[m][1], c23[m][3]};
#pragma unroll
                    for (int bj = 0; bj < 2; ++bj) { const f32x4 lo = acc[ai][bj][m][0] * rs, hi = acc[ai][bj][m][1] * rs; f32x4 olo, ohi;
#pragma unroll
                        for (int e = 0; e < 4; ++e) { olo[e] = lo[e] * co[e] - hi[e] * si[e]; ohi[e] = hi[e] * co[e] + lo[e] * si[e]; }
                        *(u32x4*)(op + bj * HALF) = pack8f(olo, ohi); }
                }
            }
        }
    }
};
struct EpiRowScale {
    static constexpr bool PERM = true, AFTER_DRAIN = false;
    bf16_t* O; int ldc; const float* SSp;
    __device__ __forceinline__ void operator()(const f32x4 (&acc)[2][2][4][2], const Unit& u, int wr, int wc, int fr, int fq) const {
        const int row0 = u.pm * BM + wr * 64 + fr, cl = u.pn * 256 + wc * 32 + 8 * fq;
        f32x4 spv[2][4];
#pragma unroll
        for (int ai = 0; ai < 2; ++ai)
#pragma unroll
            for (int m = 0; m < 4; ++m) spv[ai][m] = *(const f32x4*)(SSp + (size_t)(row0 + ai * HALF + m * 16) * 4);
#pragma unroll
        for (int ai = 0; ai < 2; ++ai)
#pragma unroll
            for (int m = 0; m < 4; ++m) { const int row = row0 + ai * HALF + m * 16; const f32x4 sp = spv[ai][m]; const float rs = rsqrtf(((sp[0] + sp[1]) + (sp[2] + sp[3])) * (1.0f / 256.0f) + 1e-6f);
#pragma unroll
                for (int bj = 0; bj < 2; ++bj) *(u32x4*)(O + (size_t)row * ldc + cl + bj * HALF) = pack8f(acc[ai][bj][m][0] * rs, acc[ai][bj][m][1] * rs);
            }
    }
};
template <bool BASE_F32> struct EpiRes {
    static constexpr bool PERM = false, AFTER_DRAIN = false;
    const float* basef; const bf16_t* baseb; bf16_t* outb; float* SS;
    __device__ __forceinline__ void operator()(const f32x4 (&acc)[2][2][4][2], const Unit& u, int wr, int wc, int fr, int fq) const {
        const int row0 = u.pm * BM + wr * 64 + fr, col0 = u.pn * 256 + wc * 32 + 4 * fq;
        constexpr int R = 4;
#pragma unroll
        for (int ai = 0; ai < 2; ++ai)
#pragma unroll
            for (int m0 = 0; m0 < 4; m0 += R) {
                f32x4 bv[R][2][2];
#pragma unroll
                for (int mm = 0; mm < R; ++mm) { const size_t off = (size_t)(row0 + ai * HALF + (m0 + mm) * 16) * 1024 + col0;
#pragma unroll
                    for (int bj = 0; bj < 2; ++bj)
#pragma unroll
                        for (int n = 0; n < 2; ++n) { const size_t o2 = off + bj * HALF + n * 16;
                            if (BASE_F32) bv[mm][bj][n] = __builtin_nontemporal_load((const f32x4*)(basef + o2));
                            else { const u32x2 bw = *(const u32x2*)(baseb + o2); bv[mm][bj][n] = (f32x4){__uint_as_float(bw.x << 16), __uint_as_float(bw.x & 0xffff0000u), __uint_as_float(bw.y << 16), __uint_as_float(bw.y & 0xffff0000u)}; } } }
#pragma unroll
                for (int mm = 0; mm < R; ++mm) { const int m = m0 + mm, row = row0 + ai * HALF + m * 16; const size_t off = (size_t)row * 1024 + col0; float ss = 0.f;
#pragma unroll
                    for (int bj = 0; bj < 2; ++bj)
#pragma unroll
                        for (int n = 0; n < 2; ++n) { const size_t o2 = off + bj * HALF + n * 16; const f32x4 h = bv[mm][bj][n] + acc[ai][bj][m][n];
                            ss += (h[0] * h[0] + h[1] * h[1]) + (h[2] * h[2] + h[3] * h[3]);
                            u32x2 w; w.x = cvt_pk_bf16(h[0], h[1]); w.y = cvt_pk_bf16(h[2], h[3]); *(u32x2*)(outb + o2) = w; }
                    ss += __shfl_xor(ss, 16); ss += __shfl_xor(ss, 32);
                    if (fq == 0) SS[(size_t)row * 16 + u.pn * 4 + wc] = ss; }
            }
    }
};
struct EpiUp {
    static constexpr bool PERM = true, AFTER_DRAIN = false;
    bf16_t* U; const float* SS;
    __device__ __forceinline__ void operator()(const f32x4 (&acc)[2][2][4][2], const Unit& u, int wr, int wc, int fr, int fq) const {
        const int row0 = u.pm * BM + wr * 64 + fr, cl = u.pn * 256 + wc * 32 + 8 * fq;
        float rsv[2][4];
        { f32x4 t[2][4];
#pragma unroll
          for (int ai = 0; ai < 2; ++ai)
#pragma unroll
            for (int m = 0; m < 4; ++m) t[ai][m] = *(const f32x4*)(SS + (size_t)(row0 + ai * HALF + m * 16) * 16 + 4 * fq);
#pragma unroll
          for (int ai = 0; ai < 2; ++ai)
#pragma unroll
            for (int m = 0; m < 4; ++m) { float s = (t[ai][m][0] + t[ai][m][1]) + (t[ai][m][2] + t[ai][m][3]); s += __shfl_xor(s, 16); s += __shfl_xor(s, 32); rsv[ai][m] = rsqrtf(s * (1.0f / 1024.0f) + 1e-6f); } }
#pragma unroll
        for (int ai = 0; ai < 2; ++ai)
#pragma unroll
            for (int m = 0; m < 4; ++m) { const int row = row0 + ai * HALF + m * 16;
                const float rs = rsv[ai][m];
#pragma unroll
                for (int bj = 0; bj < 2; ++bj) { f32x4 v0 = acc[ai][bj][m][0] * rs, v1 = acc[ai][bj][m][1] * rs;
#pragma unroll
                    for (int e = 0; e < 4; ++e) { const float a = fmaxf(v0[e], 0.f), b = fmaxf(v1[e], 0.f); v0[e] = a * a; v1[e] = b * b; }
                    *(u32x4*)(U + (size_t)row * 4096 + cl + bj * HALF) = pack8f(v0, v1); }
            }
    }
};
template <class Epi, class Sched, bool ALIGN_EPI = false, bool SP2 = false>
__device__ __forceinline__ void gemm_phase(PG8_LAS unsigned char* lds, const Gemm g, const Sched& S, const Epi& E, const int tid0) {
    int tid_ = tid0; asm volatile("" : "+v"(tid_));
    const int tid = tid_, wid = __builtin_amdgcn_readfirstlane(tid >> 6), lane = tid & 63, wr = wid >> 2, wc = wid & 3, fr = lane & 15, fq = lane >> 4;
    int K_ = g.K; asm volatile("" : "+s"(K_));
    const int K = K_, nt = K / BK;
    unsigned voffA[2], voffB[2];
#pragma unroll
    for (int i = 0; i < 2; ++i) { int R, C; stage_rc(tid * 16 + i * 8192, R, C); const int Rb = Epi::PERM ? ((R & ~31) + perm32(R & 31)) : R;
        voffA[i] = (unsigned)(R * g.lda + C) * 2u; voffB[i] = (unsigned)(Rb * g.ldb + C) * 2u; }
    const size_t kstep = (size_t)(BK * 2);
    const size_t hstepA = (size_t)HALF * g.lda * 2, hstepB = (size_t)HALF * g.ldb * 2;
    const size_t tstepA = 2 * hstepA, tstepB = 2 * hstepB;
    const unsigned ldsw = (unsigned)wid * 1024u;
    const int aoff = lds_byte(wr * 64 + fr, fq * 8), boff = lds_byte(wc * 32 + fr, fq * 8);
#define PG8_SA(b, h) (((b) * 2 + (h)) * HTB)
#define PG8_SB(b, h) ((4 + (b) * 2 + (h)) * HTB)
#define PG8_STAGE(bufoff, gbase, voff) do { _Pragma("unroll") for (int _i = 0; _i < 2; ++_i) \
        __builtin_amdgcn_global_load_lds((const unsigned*)((const char*)(gbase) + (voff)[_i]), (PG8_LAS unsigned*)(lds + (bufoff) + ldsw + _i * 8192), 16, 0, 0); } while (0)
#define PG8_LDA(dst, b, h) do { _Pragma("unroll") for (int m = 0; m < 4; ++m) _Pragma("unroll") for (int k = 0; k < 2; ++k) dst[m][k] = *(const PG8_LAS bf16x8*)(lds + PG8_SA(b, h) + aoff + m * 2048 + k * 1024); } while (0)
#define PG8_LDB(dst, b, h) do { _Pragma("unroll") for (int n = 0; n < 2; ++n) _Pragma("unroll") for (int k = 0; k < 2; ++k) dst[n][k] = *(const PG8_LAS bf16x8*)(lds + PG8_SB(b, h) + boff + n * 2048 + k * 1024); } while (0)
#define PG8_MMA(ai, bj, At, Bt) do { __builtin_amdgcn_s_setprio(1); _Pragma("unroll") for (int m = 0; m < 4; ++m) _Pragma("unroll") for (int n = 0; n < 2; ++n) _Pragma("unroll") for (int k = 0; k < 2; ++k) \
        acc[ai][bj][m][n] = __builtin_amdgcn_mfma_f32_16x16x32_bf16(Bt[n][k], At[m][k], acc[ai][bj][m][n], 0, 0, 0); __builtin_amdgcn_s_setprio(0); } while (0)
#define PG8_WAIT_V(n) asm volatile("s_waitcnt vmcnt(" #n ")" ::: "memory")
#define PG8_WAIT_L(n) asm volatile("s_waitcnt lgkmcnt(" #n ")" ::: "memory")
#define PG8_BAR __builtin_amdgcn_s_barrier()
#define PG8_SCHED __builtin_amdgcn_sched_barrier(0)
    Unit cur, nxt; int ui = 0;
    if (!S.next(0, cur)) return;
    f32x4 acc[2][2][4][2];
#pragma unroll
    for (int a = 0; a < 2; ++a)
#pragma unroll
        for (int b = 0; b < 2; ++b)
#pragma unroll
            for (int m = 0; m < 4; ++m)
#pragma unroll
                for (int n = 0; n < 2; ++n) acc[a][b][m][n] = (f32x4){0.f, 0.f, 0.f, 0.f};
    bf16x8 At[4][2], B0[2][2], B1[2][2];
    const char* cA = (const char*)g.A + (size_t)cur.pm * tstepA + (size_t)(cur.pn >> g.a_pn_shift) * g.a_pn_bytes; const char* cB = (const char*)g.Bt + (size_t)cur.pn * tstepB;
    S.a_ready(cur);
    if constexpr (SP2) {
        PG8_STAGE(PG8_SB(0, 0), cB, voffB); PG8_STAGE(PG8_SB(0, 1), cB + hstepB, voffB); PG8_STAGE(PG8_SA(0, 0), cA, voffA); PG8_STAGE(PG8_SA(0, 1), cA + hstepA, voffA);
        if (wr == 1) PG8_BAR;
        PG8_WAIT_V(2); PG8_BAR;
        PG8_STAGE(PG8_SB(1, 0), cB + kstep, voffB); PG8_STAGE(PG8_SA(1, 0), cA + kstep, voffA); PG8_STAGE(PG8_SB(1, 1), cB + hstepB + kstep, voffB);
        PG8_WAIT_V(6); PG8_BAR;
    } else {
        PG8_STAGE(PG8_SB(0, 0), cB, voffB); PG8_STAGE(PG8_SA(0, 0), cA, voffA); PG8_STAGE(PG8_SB(0, 1), cB + hstepB, voffB); PG8_STAGE(PG8_SA(0, 1), cA + hstepA, voffA);
        if (wr == 1) PG8_BAR;
        PG8_WAIT_V(4); PG8_BAR;
        PG8_STAGE(PG8_SB(1, 0), cB + kstep, voffB); PG8_STAGE(PG8_SA(1, 0), cA + kstep, voffA); PG8_STAGE(PG8_SB(1, 1), cB + hstepB + kstep, voffB);
        PG8_WAIT_V(6); PG8_BAR;
    }
    for (;;) {
        const bool has_next = S.next(ui + 1, nxt);
        const char* nA = has_next ? (const char*)g.A + (size_t)nxt.pm * tstepA + (size_t)(nxt.pn >> g.a_pn_shift) * g.a_pn_bytes : cA; const char* nB = has_next ? (const char*)g.Bt + (size_t)nxt.pn * tstepB : cB;
        for (int t = 0; t < nt; t += 2) {
            const bool last = (t == nt - 2);
            const char* a1 = cA + (size_t)(t + 1) * kstep;
            const char* a2 = last ? nA : cA + (size_t)(t + 2) * kstep; const char* b2 = last ? nB : cB + (size_t)(t + 2) * kstep;
            const char* a3 = a2 + kstep; const char* b3 = b2 + kstep;
            if (last && has_next) S.a_ready(nxt);
            if constexpr (SP2) {
            PG8_LDB(B0, 0, 0); PG8_LDB(B1, 0, 1); PG8_SCHED; PG8_LDA(At, 0, 0); PG8_STAGE(PG8_SA(1, 1), a1 + hstepA, voffA);
            PG8_WAIT_V(8); PG8_WAIT_L(0); PG8_BAR; PG8_MMA(0, 0, At, B0); PG8_MMA(0, 1, At, B1); PG8_BAR; PG8_SCHED;
            PG8_LDA(At, 0, 1); PG8_STAGE(PG8_SB(0, 0), b2, voffB); PG8_STAGE(PG8_SB(0, 1), b2 + hstepB, voffB); PG8_STAGE(PG8_SA(0, 0), a2, voffA);
            PG8_WAIT_V(8); PG8_WAIT_L(0); PG8_BAR; PG8_MMA(1, 0, At, B0); PG8_MMA(1, 1, At, B1); PG8_BAR; PG8_SCHED;
            PG8_LDB(B0, 1, 0); PG8_LDB(B1, 1, 1); PG8_SCHED; PG8_LDA(At, 1, 0); PG8_STAGE(PG8_SA(0, 1), a2 + hstepA, voffA);
            PG8_WAIT_V(8); PG8_WAIT_L(0); PG8_BAR; PG8_MMA(0, 0, At, B0); PG8_MMA(0, 1, At, B1); PG8_BAR; PG8_SCHED;
            PG8_LDA(At, 1, 1); PG8_STAGE(PG8_SB(1, 0), b3, voffB); PG8_STAGE(PG8_SB(1, 1), b3 + hstepB, voffB); PG8_STAGE(PG8_SA(1, 0), a3, voffA);
            PG8_WAIT_V(8); PG8_WAIT_L(0); PG8_BAR; PG8_MMA(1, 0, At, B0); PG8_MMA(1, 1, At, B1); PG8_BAR; PG8_SCHED;
            } else {
            PG8_LDB(B0, 0, 0); PG8_SCHED; PG8_LDA(At, 0, 0); PG8_STAGE(PG8_SA(1, 1), a1 + hstepA, voffA);
            PG8_WAIT_L(8); PG8_BAR; PG8_WAIT_L(0); PG8_MMA(0, 0, At, B0); PG8_BAR; PG8_SCHED;
            PG8_LDB(B1, 0, 1); PG8_STAGE(PG8_SB(0, 0), b2, voffB);
            PG8_BAR; PG8_WAIT_L(0); PG8_MMA(0, 1, At, B1); PG8_BAR;
            PG8_LDA(At, 0, 1); PG8_STAGE(PG8_SA(0, 0), a2, voffA);
            PG8_BAR; PG8_WAIT_L(0); PG8_MMA(1, 0, At, B0); PG8_BAR; PG8_SCHED;
            PG8_STAGE(PG8_SB(0, 1), b2 + hstepB, voffB);
            PG8_WAIT_V(6); PG8_BAR; PG8_MMA(1, 1, At, B1); PG8_BAR;
            PG8_LDB(B0, 1, 0); PG8_SCHED; PG8_LDA(At, 1, 0); PG8_STAGE(PG8_SA(0, 1), a2 + hstepA, voffA);
            PG8_WAIT_L(8); PG8_BAR; PG8_WAIT_L(0); PG8_MMA(0, 0, At, B0); PG8_BAR; PG8_SCHED;
            PG8_LDB(B1, 1, 1); PG8_STAGE(PG8_SB(1, 0), b3, voffB);
            PG8_BAR; PG8_WAIT_L(0); PG8_MMA(0, 1, At, B1); PG8_BAR;
            PG8_LDA(At, 1, 1); PG8_STAGE(PG8_SA(1, 0), a3, voffA);
            PG8_BAR; PG8_WAIT_L(0); PG8_MMA(1, 0, At, B0); PG8_BAR; PG8_SCHED;
            PG8_STAGE(PG8_SB(1, 1), b3 + hstepB, voffB);
            PG8_WAIT_V(6); PG8_BAR; PG8_MMA(1, 1, At, B1); PG8_BAR;
            }
        }
        if constexpr (ALIGN_EPI) { if (wr == 0) PG8_BAR; }
        if constexpr (!Epi::AFTER_DRAIN) { E(acc, cur, wr, wc, fr, fq); S.done(cur); }
        if (!has_next) break;
#pragma unroll
        for (int a = 0; a < 2; ++a)
#pragma unroll
            for (int b = 0; b < 2; ++b)
#pragma unroll
                for (int m = 0; m < 4; ++m)
#pragma unroll
                    for (int n = 0; n < 2; ++n) acc[a][b][m][n] = (f32x4){0.f, 0.f, 0.f, 0.f};
        cur = nxt; cA = nA; cB = nB; ++ui;
        if constexpr (ALIGN_EPI) { if (wr == 1) PG8_BAR; }
    }
    PG8_WAIT_V(0);
    if constexpr (!ALIGN_EPI) { if (wr == 0) PG8_BAR; }
    PG8_BAR;
    if constexpr (Epi::AFTER_DRAIN) { E.fused(acc, cur, wr, wc, fr, fq, lds, wid, lane); S.done(cur); }
#undef PG8_SA
#undef PG8_SB
#undef PG8_STAGE
#undef PG8_LDA
#undef PG8_LDB
#undef PG8_MMA
#undef PG8_WAIT_V
#undef PG8_WAIT_L
#undef PG8_BAR
#undef PG8_SCHED
}
}
namespace att {
typedef unsigned short bf16_t;
typedef short bf16x8 __attribute__((ext_vector_type(8)));
typedef short s16x4 __attribute__((ext_vector_type(4)));
typedef float f32x16 __attribute__((ext_vector_type(16)));
typedef float f32x4 __attribute__((ext_vector_type(4)));
typedef unsigned u32x4 __attribute__((ext_vector_type(4)));
constexpr int NW = 8, QBLK = 32, KVBLK = 64, QB = NW * QBLK;
constexpr int DK = 192, DV = 128;
constexpr int QS = 1536, KVS = 2048, KRS = 64, OS = 1024;
constexpr int SHM_V = KVBLK * DV * 2, SHM_K = KVBLK * DK * 2;
constexpr int LDS_QR = 2 * SHM_V + 2 * SHM_K + NW * 64 * 4;
constexpr int LDS_BYTES = LDS_QR + NW * 8192;
constexpr float SCALE = 0.07216878364870322f;
constexpr float THR = 8.f;
#define KSWZ(row, colB) ((row) * 384 + ((colB) ^ (((row) & 7) << 4)))
#define SBAR() __builtin_amdgcn_sched_barrier(0)
__device__ __forceinline__ int v_st(int k, int c) { const int kk = (k & ~0xC) | ((k & 4) << 1) | ((k & 8) >> 1); return ((kk >> 3) * 4 + (c >> 5)) * 512 + ((kk & 7) * 32 + (c & 31)) * 2; }
__device__ __forceinline__ int v_rd_base(int lane) { return ((lane & 3) << 3) | (((lane >> 2) & 3) << 6) | (((lane >> 4) & 1) << 5) | (((lane >> 5) & 1) << 8); }
constexpr int v_rd_off(int d0, int ks, int half) { return d0 * 512 + ks * 4096 + half * 2048; }
__device__ __forceinline__ int crow(int r, int hi) { return (r & 3) + 8 * (r >> 2) + 4 * hi; }
__device__ __forceinline__ unsigned cvtpk(float lo, float hi) { unsigned r; asm volatile("v_cvt_pk_bf16_f32 %0, %1, %2" : "=v"(r) : "v"(lo), "v"(hi)); return r; }
__device__ __forceinline__ bf16x8 load8(const bf16_t* p) { return *reinterpret_cast<const bf16x8*>(p); }
__device__ __forceinline__ void mask_tile(f32x16& p0, f32x16& p1, int dq) {
    const float NEG = -__builtin_inff();
#pragma unroll
    for (int r = 0; r < 16; ++r) {
        const int c = (r & 3) + 8 * (r >> 2);
        if (dq - c < 0) p0[r] = NEG;
        if (dq - c - 32 < 0) p1[r] = NEG;
    }
}
__device__ __forceinline__ void partialSM(f32x16& p0, f32x16& p1, float& m_reg, float& mn, float& alpha) {
    float pmax = p0[0]; for (int r = 1; r < 16; ++r) pmax = fmaxf(pmax, p0[r]); for (int r = 0; r < 16; ++r) pmax = fmaxf(pmax, p1[r]);
    { auto rr = __builtin_amdgcn_permlane32_swap(__float_as_uint(pmax), __float_as_uint(pmax), false, false);
      pmax = fmaxf(__uint_as_float(rr[0]), __uint_as_float(rr[1])); }
    constexpr float C2 = 1.4426950408889634f * SCALE;
    if (__builtin_expect(__all((pmax - m_reg) * SCALE <= THR), 1)) { mn = m_reg; alpha = 1.f; }
    else { mn = fmaxf(m_reg, pmax); alpha = __builtin_amdgcn_exp2f((m_reg - mn) * C2); m_reg = mn; }
    const float mnL = -mn * C2;
    for (int r = 0; r < 16; ++r) p0[r] = fmaf(p0[r], C2, mnL); for (int r = 0; r < 16; ++r) p1[r] = fmaf(p1[r], C2, mnL);
    for (int r = 0; r < 16; ++r) p0[r] = __builtin_amdgcn_exp2f(p0[r]);
}
__device__ __forceinline__ void finishSM(f32x16& p0, f32x16& p1, float alpha, float& l_reg, bf16x8& pa0, bf16x8& pa1, bf16x8& pa2, bf16x8& pa3) {
    for (int r = 0; r < 16; ++r) p1[r] = __builtin_amdgcn_exp2f(p1[r]);
    float ps = 0; for (int r = 0; r < 16; ++r) ps += p0[r]; for (int r = 0; r < 16; ++r) ps += p1[r];
    { auto rr = __builtin_amdgcn_permlane32_swap(__float_as_uint(ps), __float_as_uint(ps), false, false);
      ps = __uint_as_float(rr[0]) + __uint_as_float(rr[1]); }
    l_reg = l_reg * alpha + ps;
#define PK4(P, B_, OUT) do { unsigned a0 = cvtpk(P[B_+0], P[B_+1]), a1 = cvtpk(P[B_+2], P[B_+3]);                          \
        unsigned b0 = cvtpk(P[B_+4], P[B_+5]), b1 = cvtpk(P[B_+6], P[B_+7]);                                             \
        auto r0 = __builtin_amdgcn_permlane32_swap(a0, b0, false, false); auto r1 = __builtin_amdgcn_permlane32_swap(a1, b1, false, false); \
        u32x4 w = {r0[0], r1[0], r0[1], r1[1]}; OUT = *reinterpret_cast<bf16x8*>(&w); } while (0)
    PK4(p0, 0, pa0); PK4(p0, 8, pa1); PK4(p1, 0, pa2); PK4(p1, 8, pa3);
#undef PK4
}
template <int KB>
__device__ __forceinline__ void qkt(f32x16& p0, f32x16& p1, const char* K_lds, int r32, int hi, const bf16x8* qr, const char* qrl) {
    p0 = f32x16{}; p1 = f32x16{};
    const char* kb[4];
#pragma unroll
    for (int dd = 0; dd < 4; ++dd) kb[dd] = K_lds + KB * SHM_K + KSWZ(r32, (dd * 16 + hi * 8) * 2);
#pragma unroll
    for (int d0 = 0; d0 < 12; ++d0) { const char* a = kb[d0 & 3] + (d0 >> 2) * 128;
        bf16x8 b0 = *reinterpret_cast<const bf16x8*>(a);
        bf16x8 b1 = *reinterpret_cast<const bf16x8*>(a + 32 * 384);
        const bf16x8 qf = d0 < 4 ? qr[d0 & 3] : *reinterpret_cast<const bf16x8*>(qrl + (d0 - 4) * 1024);
        p0 = __builtin_amdgcn_mfma_f32_32x32x16_bf16(b0, qf, p0, 0, 0, 0);
        p1 = __builtin_amdgcn_mfma_f32_32x32x16_bf16(b1, qf, p1, 0, 0, 0); }
}
template <int VB>
__device__ __forceinline__ void pv_tile(f32x16* o, int vb0, bf16x8 pa0, bf16x8 pa1, bf16x8 pa2, bf16x8 pa3) {
#define TRRD(dst, off) asm volatile("ds_read_b64_tr_b16 %0, %1 offset:%2" : "=&v"(dst) : "v"(vb0), "i"(off) : "memory")
#define PV_D0(d0) do { s16x4 l0, l1, l2, l3, h0, h1, h2, h3; constexpr int b_ = VB * SHM_V + v_rd_off(d0, 0, 0);   \
        TRRD(l0, b_); TRRD(h0, b_ + 2048); TRRD(l1, b_ + 4096); TRRD(h1, b_ + 6144); TRRD(l2, b_ + 8192); TRRD(h2, b_ + 10240); TRRD(l3, b_ + 12288); TRRD(h3, b_ + 14336); \
        asm volatile("s_waitcnt lgkmcnt(0)" ::: "memory"); SBAR();   \
        o[d0] = __builtin_amdgcn_mfma_f32_32x32x16_bf16(pa0, (bf16x8){l0[0], l0[1], l0[2], l0[3], h0[0], h0[1], h0[2], h0[3]}, o[d0], 0, 0, 0);   \
        o[d0] = __builtin_amdgcn_mfma_f32_32x32x16_bf16(pa1, (bf16x8){l1[0], l1[1], l1[2], l1[3], h1[0], h1[1], h1[2], h1[3]}, o[d0], 0, 0, 0);   \
        o[d0] = __builtin_amdgcn_mfma_f32_32x32x16_bf16(pa2, (bf16x8){l2[0], l2[1], l2[2], l2[3], h2[0], h2[1], h2[2], h2[3]}, o[d0], 0, 0, 0);   \
        o[d0] = __builtin_amdgcn_mfma_f32_32x32x16_bf16(pa3, (bf16x8){l3[0], l3[1], l3[2], l3[3], h3[0], h3[1], h3[2], h3[3]}, o[d0], 0, 0, 0); } while (0)
    PV_D0(0); PV_D0(1); PV_D0(2); PV_D0(3);
#undef PV_D0
#undef TRRD
}
struct BlockRef { const bf16_t* Qn; const bf16_t* Qr; const bf16_t* Kn; const bf16_t* Kr; const bf16_t* V; bf16_t* O; int P0; };
struct Seam { bf16x8 qr[4]; bf16x8 st_v0, st_v1, st_k0, st_k1, st_k2; };
#define VMW() asm volatile("s_waitcnt vmcnt(0)" ::: "memory")
#define VMWN(n) asm volatile("s_waitcnt vmcnt(%0)" :: "i"(n) : "memory")
#define SLOAD_H(R_, k0) do { const char* vb_ = (const char*)((R_).V + (size_t)(k0) * KVS); const char* kb_ = (const char*)((R_).Kn + (size_t)(k0) * KVS); const char* rb_ = (const char*)((R_).Kr + (size_t)(k0) * KRS); \
                         S.st_v0 = *(const bf16x8*)(vb_ + voff); S.st_v1 = *(const bf16x8*)(vb_ + 32 * KVS * 2 + voff);      \
                         S.st_k0 = *(const bf16x8*)(kb_ + voff); S.st_k1 = *(const bf16x8*)(kb_ + 32 * KVS * 2 + voff);      \
                         S.st_k2 = *(const bf16x8*)(rb_ + roff); } while (0)
#define SLOAD_V(R_, k0) do { const char* vb_ = (const char*)((R_).V + (size_t)(k0) * KVS); S.st_v0 = *(const bf16x8*)(vb_ + voff); S.st_v1 = *(const bf16x8*)(vb_ + 32 * KVS * 2 + voff); } while (0)
#define SLOAD_K(R_, k0) do { const char* kb_ = (const char*)((R_).Kn + (size_t)(k0) * KVS); const char* rb_ = (const char*)((R_).Kr + (size_t)(k0) * KRS); \
                         S.st_k0 = *(const bf16x8*)(kb_ + voff); S.st_k1 = *(const bf16x8*)(kb_ + 32 * KVS * 2 + voff); S.st_k2 = *(const bf16x8*)(rb_ + roff); } while (0)
#define SWRITE_HK(bf) do { *(bf16x8*)(K_lds + (bf) * SHM_K + kws) = S.st_k0; *(bf16x8*)(K_lds + (bf) * SHM_K + kws + 32 * 384) = S.st_k1; *(bf16x8*)(K_lds + (bf) * SHM_K + kws2) = S.st_k2; } while (0)
#define SWRITE_HV(bf) do { *(bf16x8*)(V_lds + (bf) * SHM_V + vst0) = S.st_v0; *(bf16x8*)(V_lds + (bf) * SHM_V + vst1) = S.st_v1; } while (0)
#define SWRITE_H(bf) do { SWRITE_HV(bf); SWRITE_HK(bf); } while (0)
#define QLOAD(R_) do { const char* qn_ = (const char*)((R_).Qn + (size_t)(wid * QBLK) * QS); const char* qr_ = (const char*)((R_).Qr + (size_t)(wid * QBLK) * QS); \
                       _Pragma("unroll") for (int d0 = 0; d0 < 4; ++d0) S.qr[d0] = *(const bf16x8*)(qn_ + qoff + d0 * 32);          \
                       _Pragma("unroll") for (int d0 = 4; d0 < 8; ++d0) *(bf16x8*)(qrl + (d0 - 4) * 1024) = *(const bf16x8*)(qn_ + qoff + d0 * 32);          \
                       _Pragma("unroll") for (int d0 = 0; d0 < 4; ++d0) *(bf16x8*)(qrl + (d0 + 4) * 1024) = *(const bf16x8*)(qr_ + qoff + d0 * 32); } while (0)
__device__ __forceinline__ void attn_prime(const BlockRef& cur, char* lds, Seam& S, const int tid0) {
    const int tid = tid0, wid = __builtin_amdgcn_readfirstlane(tid >> 6), lane = tid & 63, r32 = lane & 31, hi = lane >> 5;
    const int sr = tid >> 4, sc = (tid & 15) * 8, kws = KSWZ(sr, sc * 2), rr = tid >> 3, rc = (tid & 7) * 8, kws2 = KSWZ(rr, (128 + rc) * 2); char* K_lds = lds + 2 * SHM_V;
    char* qrl = lds + LDS_QR + wid * 8192 + lane * 16;
    const unsigned voff = (unsigned)((sr * KVS + sc) * 2), roff = (unsigned)((rr * KRS + rc) * 2), qoff = (unsigned)((r32 * QS + hi * 8) * 2);
    QLOAD(cur);
    SLOAD_H(cur, 0); VMW(); SWRITE_HK(0);
    __syncthreads();
}
__device__ __forceinline__ void attn_block(const BlockRef& cur, const BlockRef& nxt, char* lds, Seam& S, const int tid0) {
    const int tid = tid0, wid = __builtin_amdgcn_readfirstlane(tid >> 6), lane = tid & 63, r32 = lane & 31, hi = lane >> 5;
    const int NT = cur.P0 / KVBLK + 4;
    const int qlo = cur.P0 + wid * QBLK, qm = qlo + r32 - 4 * hi;
    char* V_lds = lds; char* K_lds = lds + 2 * SHM_V;
    float* ws = (float*)(lds + 2 * SHM_V + 2 * SHM_K) + wid * 64; float* li_l = ws, * al_l = ws + 32;
    float m_reg = -1e30f, l_reg = 0; f32x16 o[4] = {};
    const int sr = tid >> 4, sc = (tid & 15) * 8, vst0 = v_st(sr, sc), vst1 = v_st(32 + sr, sc), kws = KSWZ(sr, sc * 2);
    const int rr = tid >> 3, rc = (tid & 7) * 8, kws2 = KSWZ(rr, (128 + rc) * 2);
    const int vb0 = (int)(uintptr_t)V_lds + v_rd_base(lane);
    char* qrl = lds + LDS_QR + wid * 8192 + lane * 16;
    const unsigned voff = (unsigned)((sr * KVS + sc) * 2), roff = (unsigned)((rr * KRS + rc) * 2), qoff = (unsigned)((r32 * QS + hi * 8) * 2);
#define RESC(a) do { if (__any((a) < 1.f)) { if (hi == 0) al_l[r32] = (a); asm volatile("s_waitcnt lgkmcnt(0)" ::: "memory");              \
                     for (int d_ = 0; d_ < 4; ++d_) for (int r = 0; r < 16; ++r) o[d_][r] *= al_l[crow(r, hi)]; } } while (0)
#define MASKT(P0_, P1_, t) do { const int kb_ = (t) * KVBLK; if (kb_ + KVBLK - 1 > qlo) mask_tile(P0_, P1_, qm - kb_); } while (0)
    f32x16 pA0, pA1, pB0, pB1; float mnA, mnB, alA, alB; bf16x8 pa0, pa1, pa2, pa3;
    SWRITE_HV(0); SBAR();
    if (NT > 1) SLOAD_H(cur, KVBLK);
    SBAR(); qkt<0>(pA0, pA1, K_lds, r32, hi, S.qr, qrl);
    MASKT(pA0, pA1, 0); partialSM(pA0, pA1, m_reg, mnA, alA);
    if (NT > 1) { VMW(); SWRITE_HK(1); }
    __syncthreads();
#define HALF_STEP(PX0, PX1, mnX, alX, PY0, PY1, alY, t, KB, VB, SB) do {                                                      \
        SWRITE_HV(KB);                                                             \
        if ((t) + 1 < NT) { SLOAD_V(cur, ((t) + 1) * KVBLK); SLOAD_K(cur, ((t) + 1) * KVBLK); }         \
        SBAR(); qkt<KB>(PX0, PX1, K_lds, r32, hi, S.qr, qrl);                                                                       \
        finishSM(PY0, PY1, alY, l_reg, pa0, pa1, pa2, pa3); SBAR();                                                           \
        pv_tile<VB>(o, vb0, pa0, pa1, pa2, pa3); MASKT(PX0, PX1, (t)); partialSM(PX0, PX1, m_reg, mnX, alX);                  \
        if ((t) + 1 < NT) { VMW(); SWRITE_HK(SB); }                                                                           \
        RESC(alX); __syncthreads(); } while (0)
    for (int t = 1; t + 1 < NT; t += 2) {
        HALF_STEP(pB0, pB1, mnB, alB, pA0, pA1, alA, t, 1, 0, 0);
        HALF_STEP(pA0, pA1, mnA, alA, pB0, pB1, alB, t + 1, 0, 1, 1);
    }
    const bool even = (NT & 1) == 0;
    if (even) { SWRITE_HV(1); SBAR(); qkt<1>(pB0, pB1, K_lds, r32, hi, S.qr, qrl); SBAR(); }
    SLOAD_H(nxt, 0); SBAR();
    QLOAD(nxt);
    SBAR();
    finishSM(pA0, pA1, alA, l_reg, pa0, pa1, pa2, pa3); SBAR();
    pv_tile<0>(o, vb0, pa0, pa1, pa2, pa3);
    if (even) { MASKT(pB0, pB1, NT - 1); partialSM(pB0, pB1, m_reg, mnB, alB); __syncthreads(); RESC(alB);
        finishSM(pB0, pB1, alB, l_reg, pa0, pa1, pa2, pa3); SBAR(); pv_tile<1>(o, vb0, pa0, pa1, pa2, pa3); }
    SBAR(); VMWN(4); SWRITE_HK(0); SBAR();
    if (hi == 0) li_l[r32] = l_reg; asm volatile("s_waitcnt lgkmcnt(0)" ::: "memory");
    float rli[16];
#pragma unroll
    for (int r = 0; r < 16; ++r) rli[r] = __builtin_amdgcn_rcpf(li_l[crow(r, hi)]);
    char* Ow = (char*)(cur.O + (size_t)(wid * QBLK) * OS);
    const unsigned loff = (unsigned)((4 * hi * OS + r32) * 2);
#pragma unroll
    for (int r = 0; r < 16; ++r) { const int cro = ((r & 3) + 8 * (r >> 2)) * OS;
#pragma unroll
        for (int d0 = 0; d0 < 4; ++d0) { const float v = o[d0][r] * rli[r];
            const float vn = __shfl_xor(v, 1);
            if ((r32 & 1) == 0) *(unsigned*)(Ow + (size_t)(cro + d0 * 32) * 2 + loff) = cvtpk(v, vn); } }
    __syncthreads();
#undef RESC
#undef MASKT
#undef HALF_STEP
}
#undef VMW
#undef VMWN
#undef SLOAD_H
#undef SLOAD_V
#undef SLOAD_K
#undef SWRITE_HK
#undef SWRITE_HV
#undef SWRITE_H
#undef QLOAD
#undef SBAR
#undef KSWZ
}
typedef unsigned short bf16_t;
typedef float f32x4 __attribute__((ext_vector_type(4)));
typedef unsigned u32x4 __attribute__((ext_vector_type(4)));
typedef unsigned u32x2 __attribute__((ext_vector_type(2)));
typedef _Float16 h16x4 __attribute__((ext_vector_type(4)));
#define LAS __attribute__((address_space(3)))
#ifndef N_LAUNCHES
#define N_LAUNCHES 1
#endif
constexpr int NPHASE = 10;
constexpr int T = 32768, SEQ = 8192, DM = 1024;
constexpr size_t MiB = 1u << 20;
constexpr size_t WS_RSTDX = 0, WS_RSTDQ = 128 * 1024, WS_RSTDKV = 256 * 1024, WS_CSP = 384 * 1024;
constexpr size_t WS_SS1 = 1 * MiB, WS_SS2 = 3 * MiB;
constexpr size_t WS_CS = 5 * MiB;
constexpr size_t WS_W1 = 7 * MiB;
constexpr size_t WS_WUP = 17 * MiB;
constexpr size_t WS_WDN = 25 * MiB;
constexpr size_t WS_WOUT = 33 * MiB;
constexpr size_t WS_WUQ = 35 * MiB;
constexpr size_t WS_WUKV = 36 * MiB;
constexpr size_t WS_WLRU = 37 * MiB;
constexpr size_t WS_KR = 38 * MiB;
constexpr size_t WS_G1 = 42 * MiB, WS_G2 = 106 * MiB;
constexpr size_t WS_ZC = 170 * MiB;
constexpr size_t WS_SUM = WS_ZC, WS_SUB = WS_ZC + 2 * MiB;
constexpr size_t WS_KV = 218 * MiB;
constexpr size_t WS_R1 = 346 * MiB;
constexpr size_t WS_XB = WS_R1;
constexpr size_t WS_XA = WS_R1;
constexpr size_t WS_YB = WS_R1;
constexpr size_t WS_ZX = WS_R1 + 64 * MiB;
constexpr size_t WS_Q = WS_R1 + 64 * MiB;
constexpr size_t WS_MG = WS_KV;
constexpr size_t WS_H1B = WS_R1 + 64 * MiB;
constexpr size_t WS_U = 42 * MiB;
constexpr size_t WS_H2B = 298 * MiB;
constexpr size_t WS_END = 512 * MiB;
static_assert(WS_Q + (size_t)T * 1536 * 2 <= WS_END && WS_U + (size_t)T * 4096 * 2 <= WS_H1B && WS_W1 + 4864 * 1024 * 2 <= WS_WUP, "d_ws map");

struct Args { const float* in[19]; float* out; unsigned char* ws; int ph_lo, ph_hi; };
static_assert(sizeof(Args) == 19 * 8 + 8 + 8 + 8, "Args has no padding");

__device__ __forceinline__ float wave_sum(float v) {
#pragma unroll
    for (int o = 1; o < 64; o <<= 1) v += __shfl_xor(v, o);
    return v;
}
__device__ __forceinline__ unsigned pkbf(float lo, float hi) { return pg8::cvt_pk_bf16(lo, hi); }
__device__ __forceinline__ float bflo(unsigned w) { return __uint_as_float(w << 16); }
__device__ __forceinline__ float bfhi(unsigned w) { return __uint_as_float(w & 0xffff0000u); }

__device__ __forceinline__ int srccol(int which, int p) {
    if (which == 0) {
        const int t = p >> 8, w = p & 255;
        if (t < 4) return p;
        if (t < 12) return w < 128 ? 1024 + 128 * (t - 4) + w : 2624 + 128 * (t - 4) + (w - 128);
        if (t < 16) return 3648 + (p - 3072);
        if (t == 16) return 2048 + w;
        if (t == 17) return 2304 + w;
        return w < 64 ? 2560 + 4 * (w >> 3) + (w & 3) + 32 * ((w >> 2) & 1) : -1;
    }
    if (which == 1) {
        if (p < 1024) return (p >> 7) * 192 + (p & 127);
        const int q = p - 1024, h = q >> 6, u = q & 63;
        return h * 192 + 128 + 4 * (u >> 3) + (u & 3) + 32 * ((u >> 2) & 1);
    }
    return p;
}
__device__ __forceinline__ void tr_item(const float* W, int ldw, int K, int Nphys, const float* gain, bf16_t* WT, int which, LAS float* scr, int item, int lane, int ksrc0 = 0, int Ksrc = 1 << 30) {
    const int nblk = Nphys / 32, kb = item / nblk, nb = item % nblk, k0 = 64 * kb, n0 = 32 * nb;
    const int src = srccol(which, n0 + (lane & 31));
#pragma unroll 16
    for (int i = 0; i < 32; ++i) { const int kk = 2 * i + (lane >> 5); float v = 0.f;
        const int ks = k0 + kk - ksrc0;
        if (src >= 0 && ks >= 0 && ks < Ksrc) { v = __builtin_nontemporal_load(W + (size_t)ks * ldw + src); if (gain) v *= gain[k0 + kk]; }
        scr[kk * 33 + (lane & 31)] = v; }
    asm volatile("s_waitcnt lgkmcnt(0)" ::: "memory");
    const int c = lane & 7;
#pragma unroll
    for (int j = 0; j < 4; ++j) { const int n = (lane >> 3) + 8 * j; const LAS float* s = scr + (8 * c) * 33 + n;
        u32x4 o; o.x = pkbf(s[0 * 33], s[1 * 33]); o.y = pkbf(s[2 * 33], s[3 * 33]); o.z = pkbf(s[4 * 33], s[5 * 33]); o.w = pkbf(s[6 * 33], s[7 * 33]);
        *(u32x4*)(WT + (size_t)(n0 + n) * K + k0 + 8 * c) = o; }
    asm volatile("s_waitcnt lgkmcnt(0)" ::: "memory");
}
__device__ __forceinline__ void tr_item64(const float* W, int ldw, int K, int Nphys, const float* gain, bf16_t* WT, int which, int item, int lane, int ksrc0 = 0, int Ksrc = 1 << 30) {
    const int nblk = Nphys / 64, kb = item / nblk, nb = item % nblk, k0 = 64 * kb, n0 = 64 * nb;
    const int src = srccol(which, n0 + lane); const bool kin = (k0 - ksrc0 >= 0) && (k0 - ksrc0 < Ksrc);
    float v[64];
#pragma unroll
    for (int kk = 0; kk < 64; ++kk) v[kk] = (src >= 0 && kin) ? __builtin_nontemporal_load(W + (size_t)(k0 + kk - ksrc0) * ldw + src) : 0.f;
    if (gain) {
#pragma unroll
        for (int kk = 0; kk < 64; ++kk) v[kk] *= gain[k0 + kk];
    }
    bf16_t* o = WT + (size_t)(n0 + lane) * K + k0;
#pragma unroll
    for (int j = 0; j < 8; ++j) { u32x4 w; w.x = pkbf(v[8 * j], v[8 * j + 1]); w.y = pkbf(v[8 * j + 2], v[8 * j + 3]); w.z = pkbf(v[8 * j + 4], v[8 * j + 5]); w.w = pkbf(v[8 * j + 6], v[8 * j + 7]); *(u32x4*)(o + 8 * j) = w; }
}
__device__ __forceinline__ void sincos_d(double a, float& s, float& c) {
    const double n = rint(a * 0.63661977236758134308);
    const double r = (a - n * 1.57079632679489655800) - n * 6.123233995736766036e-17, r2 = r * r;
    double sp = -7.6471637318198164759e-13; sp = sp * r2 + 1.6059043836821614599e-10; sp = sp * r2 - 2.5052108385441718775e-08; sp = sp * r2 + 2.7557319223985890653e-06;
    sp = sp * r2 - 1.9841269841269841270e-04; sp = sp * r2 + 8.3333333333333333333e-03; sp = sp * r2 - 1.6666666666666666667e-01; sp = r + r * r2 * sp;
    double cp = 4.7794773323873852974e-14; cp = cp * r2 - 1.1470745597729724714e-11; cp = cp * r2 + 2.0876756987868098979e-09; cp = cp * r2 - 2.7557319223985890653e-07;
    cp = cp * r2 + 2.4801587301587301587e-05; cp = cp * r2 - 1.3888888888888888889e-03; cp = cp * r2 + 4.1666666666666666667e-02; cp = cp * r2 - 0.5; cp = 1.0 + r2 * cp;
    const int q = (int)((long long)n & 3);
    const double ss = (q & 1) ? cp : sp, cc = (q & 1) ? sp : cp;
    s = (float)((q & 2) ? -ss : ss); c = (float)(((q + 1) & 2) ? -cc : cc);
}

#ifdef DIAG
#define DCHK(code, got, want, rtol, atol) do { const float g_ = (got), w_ = (want); if (!(fabsf(g_ - w_) <= (rtol) * fabsf(w_) + (atol))) { atomicMin(DG, (unsigned)(code)); atomicOr(DG + 1, (code) < 50 ? 0u : (code) < 54 ? 1u : (code) < 60 ? 2u : (code) < 70 ? 4u : (code) < 80 ? 8u : 16u); } } while (0)
__device__ __forceinline__ unsigned dhash(unsigned x) { x ^= x >> 16; x *= 0x7feb352du; x ^= x >> 15; x *= 0x846ca68bu; x ^= x >> 16; return x; }
__device__ __forceinline__ float dbf(const bf16_t* p, size_t i) { return __uint_as_float((unsigned)p[i] << 16); }
__device__ __forceinline__ float dsig(float v) { return 1.0f / (1.0f + expf(-v)); }
__device__ __forceinline__ float ddot(const bf16_t* a, const bf16_t* b, int K) { float s = 0.f; for (int k = 0; k < K; ++k) s += dbf(a, k) * dbf(b, k); return s; }
#endif
#define XB_TMO      128
#define XB_XCNT(j)  (256  + 64 * (j))
#define XB_XSUB(j)  (1280 + 64 * (j))
#define XB_XGEN(j)  (2304 + 64 * (j))
#define XB_TOP      3328
#define XB_TOPGEN   3392
#define XCD_BAR_WORDS 3456
#define XB_SPIN_CAP (1u << 18)

__device__ __forceinline__ unsigned xb_ld(unsigned* p)              { return __hip_atomic_load(p, __ATOMIC_RELAXED, __HIP_MEMORY_SCOPE_AGENT); }
__device__ __forceinline__ unsigned xb_add(unsigned* p, unsigned v) { return __hip_atomic_fetch_add(p, v, __ATOMIC_RELAXED, __HIP_MEMORY_SCOPE_AGENT); }
__device__ __forceinline__ unsigned xb_xcc_id() { return (unsigned)__builtin_amdgcn_s_getreg((3 << 11) | 20) & 0xFu; }
#define XB_SPIN(cond, bar) do { unsigned _sp = 0; while (cond) { __builtin_amdgcn_s_sleep(1); \
    if ((++_sp & 255u) == 0u) { if (xb_ld(&(bar)[XB_TMO])) break; if (_sp > XB_SPIN_CAP) { atomicAdd(&(bar)[XB_TMO], 1u); break; } } } } while (0)

struct XcdBarrier {
    unsigned* bar; unsigned x;
    volatile LAS unsigned* st;
};

__device__ __forceinline__ XcdBarrier xcd_barrier_post(unsigned* bar, volatile LAS unsigned* st, const bool leader) {
    XcdBarrier b; b.bar = bar; b.x = xb_xcc_id(); b.st = st;
    if (leader) (void)xb_add(&bar[XB_XCNT(b.x)], 1u);
    return b;
}
__device__ __forceinline__ void xcd_barrier_complete(unsigned* bar, unsigned x, unsigned& nloc, unsigned& nx) {
    const unsigned G = gridDim.x * gridDim.y * gridDim.z;
    unsigned sum, cnt, mine, sp = 0u;
    for (;;) {
        sum = 0u; cnt = 0u; mine = 0u;
#pragma unroll
        for (unsigned j = 0; j < 16; ++j) { const unsigned c = xb_ld(&bar[XB_XCNT(j)]); sum += c; cnt += (c > 0u) ? 1u : 0u; mine = (j == x) ? c : mine; }
        if (sum == G) break;
        __builtin_amdgcn_s_sleep(1);
        if ((++sp & 255u) == 0u) { if (xb_ld(&bar[XB_TMO])) break; if (sp > XB_SPIN_CAP) { atomicAdd(&bar[XB_TMO], 1u); break; } }
    }
    nloc = mine > 0u ? mine : 1u; nx = cnt > 0u ? cnt : 1u;
}

__device__ __forceinline__ void xcd_barrier(const XcdBarrier& b, const bool leader) {
    asm volatile("s_waitcnt vmcnt(0)" ::: "memory");
    __syncthreads();
    if (leader) {
        unsigned* bar = b.bar;
        __builtin_amdgcn_s_waitcnt(0);
        unsigned nloc = b.st[0], nx = b.st[1];
        if (nloc == 0u) { xcd_barrier_complete(bar, b.x, nloc, nx); b.st[0] = nloc; b.st[1] = nx; }
        const unsigned old = xb_add(&bar[XB_XSUB(b.x)], 1u);
        const unsigned gen = old / nloc;
        if (old + 1u == (gen + 1u) * nloc) {
            __builtin_amdgcn_fence(__ATOMIC_RELEASE, "agent");
            asm volatile("s_waitcnt vmcnt(0)" ::: "memory");
            const unsigned og = xb_add(&bar[XB_TOP], 1u);
            const unsigned tg = og / nx;
            if (og + 1u == (tg + 1u) * nx) xb_add(&bar[XB_TOPGEN], 1u);
            else XB_SPIN(xb_ld(&bar[XB_TOPGEN]) == tg, bar);
            __builtin_amdgcn_fence(__ATOMIC_ACQUIRE, "agent");
            xb_add(&bar[XB_XGEN(b.x)], 1u);
            asm volatile("s_waitcnt vmcnt(0)" ::: "memory");
        } else {
            XB_SPIN(xb_ld(&bar[XB_XGEN(b.x)]) == gen, bar);
            __builtin_amdgcn_fence(__ATOMIC_ACQUIRE, "agent");
            asm volatile("s_waitcnt vmcnt(0)" ::: "memory");
        }
    }
    __syncthreads();
}

constexpr size_t WS_BAR = WS_CSP + 65536;
constexpr int LDS_BARW = 153600 - 64;
__global__ void __launch_bounds__(512, 2) fwd_kernel(Args args) {
    extern __shared__ __attribute__((aligned(16))) unsigned char lds[];
    cg::grid_group grid = cg::this_grid();
    const int wave_top = __builtin_amdgcn_readfirstlane((int)threadIdx.x >> 6);
    const int tid = threadIdx.x, lane = tid & 63, wave = wave_top;
    const int G = gridDim.x, gw = blockIdx.x * 8 + wave, NGW = G * 8; (void)tid; (void)lane; (void)gw;
    unsigned char* ws = args.ws;
    const int lo = args.ph_lo, hi = args.ph_hi;
#ifndef PHMASK
#define PHMASK 0x3ff
#endif
#define IN(k) (((PHMASK >> (k)) & 1) && lo <= (k) && (k) < hi)
#ifndef REPMASK
#define REPMASK 0
#endif
#define FRESH_IDS int lane_o_ = __builtin_amdgcn_mbcnt_hi(~0u, __builtin_amdgcn_mbcnt_lo(~0u, 0u)); asm volatile("" : "+v"(lane_o_)); const int lane = lane_o_, wave = wave_top, tid = wave * 64 + lane, gw = blockIdx.x * 8 + wave; (void)tid; (void)gw;
#define PLAIN_IDS int tid_o_ = threadIdx.x; asm volatile("" : "+v"(tid_o_)); const int tid = tid_o_, lane = tid & 63, wave = wave_top, gw = blockIdx.x * 8 + wave; (void)lane; (void)gw;
#define REP(k) for (int rep_ = 0; rep_ <= ((REPMASK >> (k)) & 1); ++rep_)
#ifdef TSTAMP
    unsigned long long* TS = (unsigned long long*)(ws + WS_CSP + 32768);
#define SEAM(k) do { if (IN(k) && IN((k) + 1)) grid.sync(); if (blockIdx.x == 0 && tid == 0) TS[(k) + 1] = __builtin_amdgcn_s_memrealtime(); } while (0)
    if (blockIdx.x == 0 && tid == 0) TS[0] = __builtin_amdgcn_s_memrealtime();
#else
#define SEAM(k) do { if (IN(k) && IN((k) + 1)) { if (lo < 0) grid.sync();   xcd_barrier(xbar, wave_top == 0 && __builtin_amdgcn_mbcnt_hi(~0u, __builtin_amdgcn_mbcnt_lo(~0u, 0u)) == 0u); } } while (0)
#endif
    const float* x = args.in[0];
    float* rstdx = (float*)(ws + WS_RSTDX); float* rstdq = (float*)(ws + WS_RSTDQ); float* rstdkv = (float*)(ws + WS_RSTDKV); float* csp = (float*)(ws + WS_CSP);
    float* SS1 = (float*)(ws + WS_SS1); float* SS2 = (float*)(ws + WS_SS2); float* CS = (float*)(ws + WS_CS);
    bf16_t* W1 = (bf16_t*)(ws + WS_W1); bf16_t* WUP = (bf16_t*)(ws + WS_WUP); bf16_t* WDN = (bf16_t*)(ws + WS_WDN); bf16_t* WOUT = (bf16_t*)(ws + WS_WOUT);
    bf16_t* WUQ = (bf16_t*)(ws + WS_WUQ); bf16_t* WUKV = (bf16_t*)(ws + WS_WUKV); bf16_t* WLRU = (bf16_t*)(ws + WS_WLRU);
    bf16_t* KR = (bf16_t*)(ws + WS_KR); bf16_t* G1 = (bf16_t*)(ws + WS_G1); bf16_t* G2 = (bf16_t*)(ws + WS_G2); bf16_t* ZC = (bf16_t*)(ws + WS_ZC);
    bf16_t* KV = (bf16_t*)(ws + WS_KV); bf16_t* XB = (bf16_t*)(ws + WS_XB); bf16_t* XA = (bf16_t*)(ws + WS_XA); bf16_t* YB = (bf16_t*)(ws + WS_YB);
    bf16_t* ZX = (bf16_t*)(ws + WS_ZX); bf16_t* Q = (bf16_t*)(ws + WS_Q); bf16_t* MG = (bf16_t*)(ws + WS_MG); bf16_t* H1B = (bf16_t*)(ws + WS_H1B); bf16_t* U = (bf16_t*)(ws + WS_U);
    float* SSQ = (float*)(ws + WS_SS2); float* SSKV = (float*)(ws + WS_SS2 + 512 * 1024);
    bf16_t* H2B = (bf16_t*)(ws + WS_H2B); float* SUM = (float*)(ws + WS_SUM); float* SUB = (float*)(ws + WS_SUB);
    unsigned* AB = (unsigned*)args.out; float* OUT = args.out;
    LAS unsigned char* ldsg = (LAS unsigned char*)lds;

    if (threadIdx.x < 2) ((volatile LAS unsigned*)(ldsg + LDS_BARW))[threadIdx.x] = 0u;
    __syncthreads();
    XcdBarrier xbar; xbar.bar = (unsigned*)(ws + WS_BAR); xbar.x = 0; xbar.st = nullptr;
    if (hi - lo > 1) xbar = xcd_barrier_post((unsigned*)(ws + WS_BAR), (volatile LAS unsigned*)(ldsg + LDS_BARW), threadIdx.x == 0);
#ifdef DIAG
    unsigned* DG = (unsigned*)(ws + WS_CSP + 8192); unsigned* SAVE = (unsigned*)(ws + WS_CSP + 16384);
    if (lo >= 100) {
        const int dk = lo - 100; const unsigned gid = blockIdx.x * 512 + tid, NT_ = G * 512;
        if (dk == 0) {
            for (unsigned s = gid; s < 65536; s += NT_) { const unsigned h = dhash(s * 7 + 1);
                { const int p = h % 4864, k = (h >> 13) % 1024, src = srccol(0, p); const float want = src < 0 ? 0.f : args.in[2][(size_t)k * 4672 + src] * args.in[1][k]; DCHK(1, dbf(W1, (size_t)p * 1024 + k), want, 0.01f, 1e-6f); }
                { const int p = h % 1536, k = (h >> 13) % 256; DCHK(2, dbf(WUQ, (size_t)p * 256 + k), args.in[11][(size_t)k * 1536 + srccol(1, p)] * args.in[10][k], 0.01f, 1e-6f); }
                { const int p = h % 2048, k = (h >> 13) % 256; DCHK(3, dbf(WUKV, (size_t)p * 256 + k), args.in[13][(size_t)k * 2048 + p] * args.in[12][k], 0.01f, 1e-6f); }
                { const int p = h % 2048, k = (h >> 13) % 256, nb = p >> 8, isx = (p >> 7) & 1, d = p & 127, kk = k - 128 * (nb & 1);
                  const float want = (kk >= 0 && kk < 128) ? (isx ? args.in[7] : args.in[5])[(size_t)nb * 16384 + kk * 128 + d] : 0.f; DCHK(4, dbf(WLRU, (size_t)p * 256 + k), want, 0.01f, 1e-6f); }
                { const int p = h % 1024, k = (h >> 13) % 1024; DCHK(5, dbf(WOUT, (size_t)p * 1024 + k), args.in[14][(size_t)k * 1024 + p], 0.01f, 1e-6f); }
                { const int p = h % 4096, k = (h >> 13) % 1024; DCHK(6, dbf(WUP, (size_t)p * 1024 + k), args.in[16][(size_t)k * 4096 + p] * args.in[15][k], 0.01f, 1e-6f); }
                { const int p = h % 1024, k = (h >> 13) % 4096; DCHK(7, dbf(WDN, (size_t)p * 4096 + k), args.in[17][(size_t)k * 1024 + p], 0.01f, 1e-6f); }
                { const int r = h % T, c = (h >> 15) % 1024; DCHK(8, dbf(XB, (size_t)r * 1024 + c), x[(size_t)r * 1024 + c], 0.01f, 1e-6f); }
                { const int pos = h % 8191, i = (h >> 13) & 31; const float c0 = CS[(pos * 32 + i) * 2], s0 = CS[(pos * 32 + i) * 2 + 1], c1 = CS[((pos + 1) * 32 + i) * 2], s1 = CS[((pos + 1) * 32 + i) * 2 + 1], cd = CS[(32 + i) * 2], sd = CS[(32 + i) * 2 + 1];
                  DCHK(9, c1, c0 * cd - s0 * sd, 0.f, 1e-5f); DCHK(9, s1, s0 * cd + c0 * sd, 0.f, 1e-5f); DCHK(9, cd, __cosf(powf(10000.f, -(float)i / 32.f)), 0.f, 1e-4f); DCHK(9, CS[i * 2], 1.0f, 0.f, 1e-6f); }
            }
            for (unsigned s = gid; s < 4096; s += NT_) { const int r = dhash(s) % T; float q = 0.f; for (int c = 0; c < 1024; ++c) q += x[(size_t)r * 1024 + c] * x[(size_t)r * 1024 + c]; DCHK(8, rstdx[r], 1.0f / sqrtf(q / 1024.f + 1e-6f), 1e-3f, 0.f); }
        }
        if (dk == 1) for (unsigned s = gid; s < 32768; s += NT_) { const unsigned h = dhash(s * 3 + 11); const int r = h % T, p = (h >> 15) % 4864, t = p >> 8, w = p & 255;
            const float z = ddot(XB + (size_t)r * 1024, W1 + (size_t)p * 1024, 1024) * rstdx[r];
            if (t < 4) DCHK(11, dbf(ZX, (size_t)r * 1024 + p), z, 0.02f, 0.02f);
            else if (t < 12) { if (w < 128) { const float z2 = ddot(XB + (size_t)r * 1024, W1 + (size_t)(p + 128) * 1024, 1024) * rstdx[r];
                const float ge = 0.5f * z * (1.f + tanhf(0.7978845608f * (z + 0.044715f * z * z * z))); DCHK(12, dbf(G1, (size_t)r * 1024 + (t - 4) * 128 + w), ge * dsig(z2), 0.03f, 0.02f); } }
            else if (t < 16) DCHK(13, dbf(G2, (size_t)r * 1024 + p - 3072), dsig(z), 0.02f, 0.01f);
            else DCHK(14, dbf(ZC, (size_t)r * 768 + p - 4096), z, 0.02f, 0.02f); }
        if (dk == 2) for (unsigned s = gid; s < 65536; s += NT_) { const unsigned h = dhash(s * 5 + 3); const int r = (s & 1) ? (h % T) : ((h % 4) * 8192 + (h >> 8) % 6), c = (h >> 15) % 1024, pos = r & 8191;
            float v = args.in[4][c]; for (int j = 0; j < 4; ++j) if (pos - 3 + j >= 0) v += args.in[3][j * 1024 + c] * dbf(ZX, (size_t)(r - 3 + j) * 1024 + c);
            DCHK(21, dbf(XA, (size_t)r * 1024 + c), v, 0.02f, 0.02f);
            if (c < 64) { const int u = c, i = 4 * (u >> 3) + (u & 3), hf = (u >> 2) & 1; const float kl = dbf(ZC, (size_t)r * 768 + 512 + i), kh = dbf(ZC, (size_t)r * 768 + 512 + i + 32), cc = CS[(pos * 32 + i) * 2], ss = CS[(pos * 32 + i) * 2 + 1];
                DCHK(23, dbf(KR, (size_t)r * 64 + u), hf ? kh * cc + kl * ss : kl * cc - kh * ss, 0.02f, 0.02f); }
            if (c == 100) { float q = 0.f, k2 = 0.f; for (int j = 0; j < 256; ++j) { const float a = dbf(ZC, (size_t)r * 768 + j), b = dbf(ZC, (size_t)r * 768 + 256 + j); q += a * a; k2 += b * b; }
                DCHK(22, rstdq[r], 1.0f / sqrtf(q / 256.f + 1e-6f), 1e-3f, 0.f); DCHK(22, rstdkv[r], 1.0f / sqrtf(k2 / 256.f + 1e-6f), 1e-3f, 0.f); } }
        if (dk == 3) for (unsigned s = gid; s < 65536; s += NT_) { const unsigned h = dhash(s * 9 + 5); const int r = h % T, pos = r & 8191;
            { const int c = (h >> 15) % 1024, nb = c >> 7, d = c & 127; float dr = args.in[6][c], di = args.in[8][c];
              for (int k = 0; k < 128; ++k) { const float xv = dbf(XA, (size_t)r * 1024 + nb * 128 + k); dr += xv * args.in[5][(size_t)nb * 16384 + k * 128 + d]; di += xv * args.in[7][(size_t)nb * 16384 + k * 128 + d]; }
              const float rr_ = dsig(dr), ii = dsig(di), la = -8.0f * rr_ * log1pf(expf(-args.in[9][c])), bb = sqrtf(-expm1f(2.f * la)) * ii * dbf(XA, (size_t)r * 1024 + c);
              const pg8::h16x2 pv_ = __builtin_bit_cast(pg8::h16x2, AB[(size_t)r * 1024 + c]);
              DCHK(31, (float)pv_.x, la * 1.4426950408889634f, 0.03f, 1e-5f); DCHK(32, (float)pv_.y, bb, 0.03f, 0.01f); }
            { const int p = (h >> 13) % 1536; const float z = ddot(ZC + (size_t)r * 768, WUQ + (size_t)p * 256, 256) * rstdq[r];
              if (p < 1024) DCHK(33, dbf(Q, (size_t)r * 1536 + p), z, 0.02f, 0.02f);
              else { const int u = (p - 1024) & 63, i = 4 * (u >> 3) + (u & 3), islo = (u & 4) == 0; const float z2 = ddot(ZC + (size_t)r * 768, WUQ + (size_t)(p ^ 4) * 256, 256) * rstdq[r];
                  const float cc = CS[(pos * 32 + i) * 2], ss = CS[(pos * 32 + i) * 2 + 1]; DCHK(34, dbf(Q, (size_t)r * 1536 + p), islo ? z * cc - z2 * ss : z * cc + z2 * ss, 0.02f, 0.03f); } }
            { const int p = (h >> 11) % 2048; DCHK(35, dbf(KV, (size_t)r * 2048 + p), ddot(ZC + (size_t)r * 768 + 256, WUKV + (size_t)p * 256, 256) * rstdkv[r], 0.02f, 0.02f); } }
        if (dk == 3) for (unsigned s = gid; s < 4096; s += NT_) SAVE[s] = AB[dhash(s * 41 + 3) % (unsigned)(T * 1024)];
        if (dk == 4) {
            float* SC = (float*)(ws + WS_ZC + 9 * MiB);
            for (int s = gw; s < 1024; s += NGW) { const unsigned h = dhash(s * 13 + 7); const int b = h & 3, hd = (h >> 2) & 7, pos = (s & 3) == 0 ? (int)((h >> 5) % 300) : (int)((h >> 5) % 8192); const size_t r = (size_t)b * 8192 + pos;
                float* sc = SC + (size_t)s * 8192; float mx = -1e30f;
                for (int j = lane; j <= pos; j += 64) { const size_t kr = (size_t)b * 8192 + j; float d = 0.f;
                    for (int e = 0; e < 128; ++e) d += dbf(Q, r * 1536 + hd * 128 + e) * dbf(KV, kr * 2048 + hd * 256 + e);
                    for (int e = 0; e < 64; ++e) d += dbf(Q, r * 1536 + 1024 + hd * 64 + e) * dbf(KR, kr * 64 + e);
                    d *= 0.07216878364870322f; sc[j] = d; mx = fmaxf(mx, d); }
                for (int o = 1; o < 64; o <<= 1) mx = fmaxf(mx, __shfl_xor(mx, o));
                __builtin_amdgcn_fence(__ATOMIC_RELEASE, "workgroup"); __builtin_amdgcn_s_waitcnt(0);
                float l = 0.f, o0 = 0.f, o1 = 0.f;
                for (int j = 0; j <= pos; ++j) { const float p = expf(__builtin_nontemporal_load(sc + j) - mx); const size_t kr = (size_t)b * 8192 + j; l += p; o0 += p * dbf(KV, kr * 2048 + hd * 256 + 128 + lane); o1 += p * dbf(KV, kr * 2048 + hd * 256 + 192 + lane); }
                DCHK(41, dbf(YB, r * 1024 + hd * 128 + lane), o0 / l, 0.03f, 0.01f); DCHK(41, dbf(YB, r * 1024 + hd * 128 + 64 + lane), o1 / l, 0.03f, 0.01f); } }
        if (dk == 5) for (unsigned s = gid; s < 4096; s += NT_) if (SAVE[s] != AB[dhash(s * 41 + 3) % (unsigned)(T * 1024)]) atomicMin(DG, 48u);
        if (dk == 5) for (unsigned s = gid; s < 8192; s += NT_) { const unsigned h = dhash(s * 17 + 9); const int b = h & 3, c = (h >> 2) % 1024, pos = (s & 3) == 0 ? (int)((h >> 12) % 32) : (s & 3) == 1 ? (int)((h >> 12) % 256) : (int)((h >> 12) % 8192); float hh = 0.f, LL = 0.f;
            for (int j = 0; j <= pos; ++j) { const pg8::h16x2 pv_ = __builtin_bit_cast(pg8::h16x2, AB[((size_t)b * 8192 + j) * 1024 + c]); hh = exp2f((float)pv_.x) * hh + (float)pv_.y; LL += (float)pv_.x;
                if ((j & 31) == 31 && (j >> 5) == (pos >> 5) - 0 && false) {} }
            const size_t o = ((size_t)b * 8192 + pos) * 1024 + c; const int code = pos < 32 ? 51 : pos < 256 ? 52 : 53;
            DCHK(code, dbf(MG, o), dbf(G1, o) * hh + dbf(G2, o) * dbf(YB, o), 0.03f, 0.01f);
            { const int sc_ = (h >> 12) % 256; float h2 = 0.f, L2 = 0.f; for (int j = sc_ * 32; j < sc_ * 32 + 32; ++j) { const pg8::h16x2 pv_ = __builtin_bit_cast(pg8::h16x2, AB[((size_t)b * 8192 + j) * 1024 + c]); h2 = exp2f((float)pv_.x) * h2 + (float)pv_.y; L2 += (float)pv_.x; }
              DCHK(54, SUB[(((size_t)b * 256 + sc_) * 1024 + c) * 2], L2, 1e-3f, 1e-5f); DCHK(55, SUB[(((size_t)b * 256 + sc_) * 1024 + c) * 2 + 1], h2, 1e-3f, 1e-4f); }
            { const int kc = (h >> 12) % 32; float h2 = 0.f, L2 = 0.f; for (int j = kc * 256; j < kc * 256 + 256; ++j) { const pg8::h16x2 pv_ = __builtin_bit_cast(pg8::h16x2, AB[((size_t)b * 8192 + j) * 1024 + c]); h2 = exp2f((float)pv_.x) * h2 + (float)pv_.y; L2 += (float)pv_.x; }
              DCHK(56, SUM[(((size_t)b * 32 + kc) * 1024 + c) * 2], L2, 1e-3f, 1e-5f); DCHK(57, SUM[(((size_t)b * 32 + kc) * 1024 + c) * 2 + 1], h2, 1e-3f, 1e-4f); } }
        if (dk == 6) for (unsigned s = gid; s < 32768; s += NT_) { const unsigned h = dhash(s * 19 + 1); const int r = h % T, c = (h >> 15) % 1024;
            const float v = x[(size_t)r * 1024 + c] + ddot(MG + (size_t)r * 1024, WOUT + (size_t)c * 1024, 1024); DCHK(61, OUT[(size_t)r * 1024 + c], v, 0.02f, 0.02f); DCHK(62, dbf(H1B, (size_t)r * 1024 + c), v, 0.02f, 0.02f);
            if (c == 7) { float q = 0.f, q2 = 0.f; for (int j = 0; j < 1024; ++j) q += OUT[(size_t)r * 1024 + j] * OUT[(size_t)r * 1024 + j]; for (int j = 0; j < 16; ++j) q2 += SS1[(size_t)r * 16 + j]; DCHK(63, q2, q, 1e-3f, 0.f); } }
        if (dk == 7) for (unsigned s = gid; s < 32768; s += NT_) { const unsigned h = dhash(s * 23 + 1); const int r = h % T, c = (h >> 15) % 4096; float q2 = 0.f; for (int j = 0; j < 16; ++j) q2 += SS1[(size_t)r * 16 + j];
            const float u_ = ddot(H1B + (size_t)r * 1024, WUP + (size_t)c * 1024, 1024) / sqrtf(q2 / 1024.f + 1e-6f), rl = fmaxf(u_, 0.f); DCHK(71, dbf(U, (size_t)r * 4096 + c), rl * rl, 0.03f, 0.02f); }
        if (dk == 8) for (unsigned s = gid; s < 16384; s += NT_) { const unsigned h = dhash(s * 29 + 1); const int r = h % T, c = (h >> 15) % 1024;
            const float v = dbf(H1B, (size_t)r * 1024 + c) + ddot(U + (size_t)r * 4096, WDN + (size_t)c * 4096, 4096); DCHK(81, OUT[(size_t)r * 1024 + c], v, 0.02f, 0.04f);
            if (c == 7) { float q = 0.f, q2 = 0.f; for (int j = 0; j < 1024; ++j) q += OUT[(size_t)r * 1024 + j] * OUT[(size_t)r * 1024 + j]; for (int j = 0; j < 16; ++j) q2 += SS2[(size_t)r * 16 + j]; DCHK(82, q2, q, 1e-3f, 0.f); } }
        if (dk == 9) { for (unsigned s = gid; s < 4096; s += NT_) { const int r = dhash(s * 31) % T; float q = 0.f; for (int j = 0; j < 1024; ++j) { const float v = OUT[(size_t)r * 1024 + j] / args.in[18][j]; q += v * v; } DCHK(91, q / 1024.f, 1.0f, 0.01f, 0.f); } }
        if (dk == 10) { if (gid == 0) { const unsigned code = *DG; if (code < 1000u) OUT[0] = 100.0f + 10.0f * (float)code; OUT[1] = 10000.0f * (1.0f + (float)DG[1]); } }
        return;
    }
#endif
    if (IN(0)) REP(0) { PLAIN_IDS
        LAS float* scr = (LAS float*)(ldsg + wave * 16384);
        constexpr int I_W1 = 16 * (4864 / 64), I_UP = 16 * (4096 / 64), I_DN = 64 * (1024 / 64), I_OUT = 16 * 16, I_UQ = 4 * (1536 / 64), I_UKV = 4 * (2048 / 64), I_LRU = 16 * 8;
        constexpr int NITEMS = I_W1 + I_UP + I_DN + I_OUT + I_UQ + I_UKV + I_LRU;
        const int gw4 = gw, NGW4 = NGW;
        {
        for (int m0 = gw4 * 4; m0 < T; m0 += NGW4 * 4) {
            f32x4 v[4][4];
#pragma unroll
            for (int r = 0; r < 4; ++r) { const f32x4* xr = (const f32x4*)(x + (size_t)(m0 + r) * DM) + lane;
#pragma unroll
                for (int j = 0; j < 4; ++j) v[r][j] = __builtin_nontemporal_load(xr + 64 * j); }
#pragma unroll
            for (int r = 0; r < 4; ++r) { float s = 0.f;
#pragma unroll
                for (int j = 0; j < 4; ++j) s += (v[r][j][0] * v[r][j][0] + v[r][j][1] * v[r][j][1]) + (v[r][j][2] * v[r][j][2] + v[r][j][3] * v[r][j][3]);
                s = wave_sum(s);
                if (lane == 0) rstdx[m0 + r] = rsqrtf(s * (1.0f / 1024.0f) + 1e-6f);
                u32x2* o = (u32x2*)(XB + (size_t)(m0 + r) * DM) + lane;
#pragma unroll
                for (int j = 0; j < 4; ++j) { u32x2 w; w.x = pkbf(v[r][j][0], v[r][j][1]); w.y = pkbf(v[r][j][2], v[r][j][3]); o[64 * j] = w; } }
        }
        }
        {
        for (int it = gw4; it < NITEMS; it += NGW4) {
            int r = it;
            if (r < I_W1) { tr_item64(args.in[2], 4672, 1024, 4864, args.in[1], W1, 0, r, lane); continue; } r -= I_W1;
            if (r < I_UP) { tr_item64(args.in[16], 4096, 1024, 4096, args.in[15], WUP, 2, r, lane); continue; } r -= I_UP;
            if (r < I_DN) { tr_item64(args.in[17], 1024, 4096, 1024, nullptr, WDN, 2, r, lane); continue; } r -= I_DN;
            if (r < I_OUT) { tr_item64(args.in[14], 1024, 1024, 1024, nullptr, WOUT, 2, r, lane); continue; } r -= I_OUT;
            if (r < I_UQ) { tr_item64(args.in[11], 1536, 256, 1536, args.in[10], WUQ, 1, r, lane); continue; } r -= I_UQ;
            if (r < I_UKV) { tr_item64(args.in[13], 2048, 256, 2048, args.in[12], WUKV, 2, r, lane); continue; } r -= I_UKV;
            { const int blk = r >> 3, sub = r & 7, nb = blk >> 1, isx = blk & 1;
              tr_item64((isx ? args.in[7] : args.in[5]) + (size_t)nb * 16384, 128, 256, 128, nullptr, WLRU + (size_t)(256 * nb + 128 * isx) * 256, 2, sub, lane, 128 * (nb & 1), 128); }
        }
        for (int i = blockIdx.x * 512 + tid; i < SEQ * 32; i += G * 512) {
            const int pos = i >> 5, k = i & 31; double inv = 1.0; for (int q = 0; q < k; ++q) inv *= 0.74989420933245582730;
            float s, c; sincos_d((double)pos * inv, s, c); CS[2 * i] = c; CS[2 * i + 1] = s;
        }
        for (int i = blockIdx.x * 512 + tid; i < 1024; i += G * 512) csp[i] = 8.0f * 1.4426950408889634f * log1pf(__expf(-args.in[9][i]));
            }
    }
    SEAM(0);

    if (IN(1)) REP(1) { PLAIN_IDS
        pg8::Gemm g{XB, W1, T, 4864, 1024, 1024, 1024, 0, 0}; pg8::StaticOrder S; S.init(T, 4864, G, (int)blockIdx.x);
        pg8::EpiIn E{ZX, G1, G2, ZC, rstdx, SSQ, SSKV, KR, CS};
        pg8::gemm_phase<pg8::EpiIn, pg8::StaticOrder, true, true>(ldsg, g, S, E, tid);
    }
    SEAM(1);

    if (IN(2)) REP(2) { PLAIN_IDS
        const float* cw = args.in[3]; const float* cb = args.in[4];
        for (int it = gw; it < (T / 16) * 2; it += NGW) {
            const int t0 = (it >> 1) * 16, c0 = (it & 1) * 512 + lane * 8;
            float w[4][8], bias[8], h0[8], h1[8], h2[8];
#pragma unroll
            for (int j = 0; j < 4; ++j) { const f32x4 a = *(const f32x4*)(cw + j * 1024 + c0), b = *(const f32x4*)(cw + j * 1024 + c0 + 4);
#pragma unroll
                for (int e = 0; e < 4; ++e) { w[j][e] = a[e]; w[j][4 + e] = b[e]; } }
            { const f32x4 a = *(const f32x4*)(cb + c0), b = *(const f32x4*)(cb + c0 + 4);
#pragma unroll
              for (int e = 0; e < 4; ++e) { bias[e] = a[e]; bias[4 + e] = b[e]; } }
            const bool first = (t0 & (SEQ - 1)) == 0;
            { u32x4 r0 = {0u, 0u, 0u, 0u}, r1 = r0, r2 = r0;
              if (!first) { r0 = *(const u32x4*)(ZX + (size_t)(t0 - 3) * DM + c0); r1 = *(const u32x4*)(ZX + (size_t)(t0 - 2) * DM + c0); r2 = *(const u32x4*)(ZX + (size_t)(t0 - 1) * DM + c0); }
#pragma unroll
              for (int e = 0; e < 4; ++e) { h0[2 * e] = bflo(r0[e]); h0[2 * e + 1] = bfhi(r0[e]); h1[2 * e] = bflo(r1[e]); h1[2 * e + 1] = bfhi(r1[e]); h2[2 * e] = bflo(r2[e]); h2[2 * e + 1] = bfhi(r2[e]); } }
            u32x4 rows[16];
#pragma unroll
            for (int i = 0; i < 16; ++i) rows[i] = __builtin_nontemporal_load((const u32x4*)(ZX + (size_t)(t0 + i) * DM + c0));
#pragma unroll
            for (int i = 0; i < 16; ++i) { const u32x4 r = rows[i]; float cur[8], o[8];
#pragma unroll
                for (int e = 0; e < 4; ++e) { cur[2 * e] = bflo(r[e]); cur[2 * e + 1] = bfhi(r[e]); }
#pragma unroll
                for (int e = 0; e < 8; ++e) { o[e] = bias[e] + w[0][e] * h0[e] + w[1][e] * h1[e] + w[2][e] * h2[e] + w[3][e] * cur[e]; h0[e] = h1[e]; h1[e] = h2[e]; h2[e] = cur[e]; }
                u32x4 ow; ow.x = pkbf(o[0], o[1]); ow.y = pkbf(o[2], o[3]); ow.z = pkbf(o[4], o[5]); ow.w = pkbf(o[6], o[7]);
                *(u32x4*)(XA + (size_t)(t0 + i) * DM + c0) = ow; }
        }
    }
    SEAM(2);

    if (IN(3)) REP(3) { PLAIN_IDS
#ifndef P3SEL
#define P3SEL 7
#endif
        if (P3SEL & 1) { pg8::Gemm g{XA, WLRU, T, 2048, 256, 1024, 256, 512, 1}; pg8::StaticOrder S; S.init(T, 2048, G, (int)blockIdx.x);
#ifdef TESTLRU
          pg8::EpiRowScale E{KV, 2048, SSKV};
          pg8::gemm_phase<pg8::EpiRowScale, pg8::StaticOrder, true, true>(ldsg, g, S, E, tid); }
#else
          pg8::EpiLru E{XA, args.in[6], args.in[8], csp, AB};
          pg8::gemm_phase<pg8::EpiLru, pg8::StaticOrder, true, true>(ldsg, g, S, E, tid); }
#endif
        if (P3SEL & 2) { pg8::Gemm g{ZC, WUQ, T, 1536, 256, 768, 256, 0, 0}; pg8::StaticOrder S; S.init(T, 1536, G, (int)blockIdx.x);
          pg8::EpiQ E{Q, SSQ, CS};
          pg8::gemm_phase<pg8::EpiQ, pg8::StaticOrder, true, true>(ldsg, g, S, E, tid); }
        if (P3SEL & 4) { pg8::Gemm g{ZC + 256, WUKV, T, 2048, 256, 768, 256, 0, 0}; pg8::StaticOrder S; S.init(T, 2048, G, (int)blockIdx.x);
          pg8::EpiRowScale E{KV, 2048, SSKV};
          pg8::gemm_phase<pg8::EpiRowScale, pg8::StaticOrder, true, true>(ldsg, g, S, E, tid); }
    }
    SEAM(3);

    if (IN(4)) REP(4) { FRESH_IDS
        for (int un = blockIdx.x; un < 256; un += G) {
            const int b = un >> 6, ch = un & 63, c = wave * 128 + lane * 2;
            const unsigned* ap = AB + ((size_t)b * SEQ + ch * 128) * DM + c;
            float h0 = 0.f, h1 = 0.f, L0 = 0.f, L1 = 0.f;
            for (int i0 = 0; i0 < 128; i0 += 16) { h16x4 w[16];
#pragma unroll
                for (int i = 0; i < 16; ++i) w[i] = __builtin_nontemporal_load((const h16x4*)(ap + (size_t)(i0 + i) * DM));
#pragma unroll
                for (int i = 0; i < 16; ++i) { const float l0 = (float)w[i][0], l1 = (float)w[i][2];
                    h0 = __builtin_amdgcn_exp2f(l0) * h0 + (float)w[i][1]; h1 = __builtin_amdgcn_exp2f(l1) * h1 + (float)w[i][3]; L0 += l0; L1 += l1; } }
            *(f32x4*)(SUM + (((size_t)b * 64 + ch) * 1024 + c) * 2) = (f32x4){L0, h0, L1, h1};
        }
        {
            constexpr int NITEM = 32 * 16;
#define ITEM_BH(LL) (G == 256 ? (((LL) & 7) + 8 * (2 * ((LL) >> 8) + (((LL) >> 7) & 1))) : ((LL) >> 4))
#define ITEM_X(LL)  (G == 256 ? (((LL) >> 3) & 15) : ((LL) & 15))
            int L = blockIdx.x;
            if (L < NITEM) {
                att::Seam S; int pass = 0;
#define MKREF(r, LL, ps) do { const int bh_ = ITEM_BH(LL), xx_ = ITEM_X(LL), qb_ = (ps) ? 31 - xx_ : xx_, b_ = bh_ >> 3, h_ = bh_ & 7; \
                    const size_t row0_ = (size_t)b_ * SEQ + qb_ * 256, key0_ = (size_t)b_ * SEQ; \
                    r.Qn = Q + row0_ * 1536 + h_ * 128; r.Qr = Q + row0_ * 1536 + 1024 + h_ * 64; r.Kn = KV + key0_ * 2048 + h_ * 256; r.V = r.Kn + 128; r.Kr = KR + key0_ * 64; \
                    r.O = YB + row0_ * 1024 + h_ * 128; r.P0 = qb_ * 256; } while (0)
                att::BlockRef cur, nxt; MKREF(cur, L, 0);
                att::attn_prime(cur, (char*)lds, S, tid);
                for (;;) {
                    const bool more_pass = pass == 0, more_item = L + G < NITEM, last = !more_pass && !more_item;
                    int passn = pass + 1, Ln = L;
                    if (!more_pass) { passn = 0; Ln = more_item ? L + G : L; }
                    MKREF(nxt, Ln, passn);
                    att::attn_block(cur, nxt, (char*)lds, S, tid);
                    if (last) break;
                    cur = nxt; pass = passn; L = Ln;
                }
            }
#undef MKREF
#undef ITEM_BH
#undef ITEM_X
        }
    }
    SEAM(4);

    if (IN(5)) REP(5) { FRESH_IDS
        for (int gi = blockIdx.x; gi < 256; gi += G) {
            const int b = gi >> 6, ch = gi & 63, c = wave * 128 + lane * 2;
            float h0 = 0.f, h1 = 0.f;
            for (int k0 = 0; k0 < ch; k0 += 8) { f32x4 sv[8];
#pragma unroll
                for (int j = 0; j < 8; ++j) { const int kk = (k0 + j < 63) ? k0 + j : 63; sv[j] = *(const f32x4*)(SUM + (((size_t)b * 64 + kk) * 1024 + c) * 2); }
#pragma unroll
                for (int j = 0; j < 8; ++j) if (k0 + j < ch) { h0 = __builtin_amdgcn_exp2f(sv[j][0]) * h0 + sv[j][1]; h1 = __builtin_amdgcn_exp2f(sv[j][2]) * h1 + sv[j][3]; } }
            const size_t row0 = (size_t)b * SEQ + ch * 128;
            for (int i0 = 0; i0 < 128; i0 += 32) { h16x4 w[32]; unsigned g1[32], g2[32], yb[32];
#pragma unroll
                for (int i = 0; i < 32; ++i) { const size_t off = (row0 + i0 + i) * DM + c;
                    w[i] = __builtin_nontemporal_load((const h16x4*)(AB + off)); g1[i] = __builtin_nontemporal_load((const unsigned*)(G1 + off)); g2[i] = __builtin_nontemporal_load((const unsigned*)(G2 + off)); yb[i] = __builtin_nontemporal_load((const unsigned*)(YB + off)); }
#pragma unroll
                for (int i = 0; i < 32; ++i) { const size_t off = (row0 + i0 + i) * DM + c;
                    h0 = __builtin_amdgcn_exp2f((float)w[i][0]) * h0 + (float)w[i][1]; h1 = __builtin_amdgcn_exp2f((float)w[i][2]) * h1 + (float)w[i][3];
                    *(unsigned*)(MG + off) = pkbf(bflo(g1[i]) * h0 + bflo(g2[i]) * bflo(yb[i]), bfhi(g1[i]) * h1 + bfhi(g2[i]) * bfhi(yb[i])); } }
        }
    }
    SEAM(5);

    if (IN(6)) REP(6) { FRESH_IDS
        pg8::Gemm g{MG, WOUT, T, 1024, 1024, 1024, 1024, 0, 0}; pg8::StaticOrder S; S.init(T, 1024, G, (int)blockIdx.x);
        pg8::EpiRes<true> E{x, nullptr, H1B, SS1};
        pg8::gemm_phase<pg8::EpiRes<true>, pg8::StaticOrder, true, true>(ldsg, g, S, E, tid);
    }
    SEAM(6);

    if (IN(7)) REP(7) { FRESH_IDS
        pg8::Gemm g{H1B, WUP, T, 4096, 1024, 1024, 1024, 0, 0}; pg8::StaticOrder S; S.init(T, 4096, G, (int)blockIdx.x);
        pg8::EpiUp E{U, SS1};
        pg8::gemm_phase<pg8::EpiUp, pg8::StaticOrder, true, true>(ldsg, g, S, E, tid);
    }
    SEAM(7);

    if (IN(8)) REP(8) { FRESH_IDS
        pg8::Gemm g{U, WDN, T, 1024, 4096, 4096, 4096, 0, 0}; pg8::StaticOrder S; S.init(T, 1024, G, (int)blockIdx.x);
        pg8::EpiRes<false> E{nullptr, H1B, H2B, SS2};
        pg8::gemm_phase<pg8::EpiRes<false>, pg8::StaticOrder, true, true>(ldsg, g, S, E, tid);
    }
    SEAM(8);

    if (IN(9)) REP(9) { FRESH_IDS
        const float* gf = args.in[18];
        f32x4 gv[4];
#pragma unroll
        for (int j = 0; j < 4; ++j) gv[j] = ((const f32x4*)gf)[lane + 64 * j];
        for (int m0 = gw * 4; m0 < T; m0 += NGW * 4) {
            f32x4 v[4][4]; float rs[4];
#pragma unroll
            for (int r = 0; r < 4; ++r) { const u32x2* o = (const u32x2*)(H2B + (size_t)(m0 + r) * DM) + lane;
#pragma unroll
                for (int j = 0; j < 4; ++j) { const u32x2 bw = __builtin_nontemporal_load(o + 64 * j); v[r][j] = (f32x4){bflo(bw.x), bfhi(bw.x), bflo(bw.y), bfhi(bw.y)}; }
                const f32x4* sp = (const f32x4*)(SS2 + (size_t)(m0 + r) * 16); const f32x4 s = (sp[0] + sp[1]) + (sp[2] + sp[3]);
                rs[r] = rsqrtf(((s[0] + s[1]) + (s[2] + s[3])) * (1.0f / 1024.0f) + 1e-6f); }
#pragma unroll
            for (int r = 0; r < 4; ++r) { f32x4* o = (f32x4*)(OUT + (size_t)(m0 + r) * DM) + lane;
#pragma unroll
                for (int j = 0; j < 4; ++j) __builtin_nontemporal_store(v[r][j] * rs[r] * gv[j], o + 64 * j); }
        }
    }
#ifdef TSTAMP
    grid.sync();
    if (blockIdx.x == 0 && tid == 0) TS[10] = __builtin_amdgcn_s_memrealtime();
    __threadfence(); grid.sync();
    { const float da = (float)(TS[TSTAMP_A + 1] - TS[TSTAMP_A]) * 0.01f, db = (float)(TS[TSTAMP_B + 1] - TS[TSTAMP_B]) * 0.01f;
      for (size_t i = (size_t)blockIdx.x * 512 + tid; i < ((size_t)1 << 22); i += (size_t)G * 512) OUT[i] = (i == 0) ? 10.0f * da : db; }
#endif
#undef IN
#undef SEAM
}

constexpr int LDS_TOTAL = 153600;
static_assert(att::LDS_BYTES <= LDS_TOTAL && pg8::STAGE_BYTES <= LDS_TOTAL, "LDS");
extern "C" void kernel_launch(void* const* d_in, const int* in_sizes, int n_in, void* d_out, int out_size, void* d_ws, size_t ws_size, hipStream_t stream) {
    static int grid = 0;
    if (grid == 0) {
        if (n_in != 19 || out_size != T * DM || ws_size < WS_END) { fprintf(stderr, "kernel_launch: unexpected shapes (n_in %d, out %d, ws %zu)\n", n_in, out_size, ws_size); grid = -1; return; }
        int dev = 0, cus = 0, per_cu = 0;
        (void)hipGetDevice(&dev); (void)hipDeviceGetAttribute(&cus, hipDeviceAttributeMultiprocessorCount, dev);
        if (hipFuncSetAttribute((const void*)fwd_kernel, hipFuncAttributeMaxDynamicSharedMemorySize, LDS_TOTAL) != hipSuccess) { fprintf(stderr, "kernel_launch: hipFuncSetAttribute failed\n"); grid = -1; return; }
        if (hipOccupancyMaxActiveBlocksPerMultiprocessor(&per_cu, (const void*)fwd_kernel, 512, LDS_TOTAL) != hipSuccess || per_cu < 1) { fprintf(stderr, "kernel_launch: occupancy query says %d\n", per_cu); per_cu = 1; }
        (void)hipGetLastError();
        grid = cus * 1;
        if (grid <= 0) grid = 256;
    }
    if (grid < 0) return;
    Args a{};
    for (int i = 0; i < 19; ++i) a.in[i] = (const float*)d_in[i];
    a.out = (float*)d_out; a.ws = (unsigned char*)d_ws;
#if N_LAUNCHES == 1
    a.ph_lo = 0; a.ph_hi = NPHASE;
    (void)hipMemsetAsync((unsigned char*)d_ws + WS_BAR, 0, 16384, stream);
    void* kargs[] = {&a};
    hipError_t e = hipLaunchCooperativeKernel((const void*)fwd_kernel, dim3(grid), dim3(512), kargs, LDS_TOTAL, stream);
    if (e != hipSuccess) fprintf(stderr, "kernel_launch: cooperative launch failed: %s (grid %d)\n", hipGetErrorString(e), grid);
#else
#ifdef DIAG
    (void)hipMemsetAsync((unsigned char*)d_ws + WS_CSP + 8192, 0x7f, 4, stream); (void)hipMemsetAsync((unsigned char*)d_ws + WS_CSP + 8196, 0, 4, stream);
#endif
#ifndef PROBE_LIST
#define PROBE_LIST 0,1,2,3,4,5,6,7,8,9
#endif
    static const int plist[] = {PROBE_LIST};
    for (int pi = 0; pi < (int)(sizeof(plist) / sizeof(int)); ++pi) { const int p = plist[pi]; a.ph_lo = p; a.ph_hi = p + 1;
        hipLaunchKernelGGL(fwd_kernel, dim3(grid), dim3(512), LDS_TOTAL, stream, a);
#ifdef DIAG
        a.ph_lo = 100 + p; a.ph_hi = 101 + p; hipLaunchKernelGGL(fwd_kernel, dim3(grid), dim3(512), LDS_TOTAL, stream, a);
        if (p == NPHASE - 1) { a.ph_lo = 110; a.ph_hi = 111; hipLaunchKernelGGL(fwd_kernel, dim3(grid), dim3(512), LDS_TOTAL, stream, a); }
#endif
        if (hipPeekAtLastError() != hipSuccess) { fprintf(stderr, "kernel_launch: launch %d failed\n", p); break; } }
#endif
}
```
